# Optimizing an MI355X kernel written in HIP

```python
import math
import jax
import jax.numpy as jnp
from jax import lax
import numpy as np

D_MODEL = 2048
BATCH = 2
SEQ = 4096
DEPTH = 2

GRID_W = 64
CTX_LEN = 256
HEAD_DIM = 128
ROPE_BASE = 10000.0
BLOCK = 128
WINDOW = 128
A_Q_HEADS = D_MODEL // HEAD_DIM // 2
A_KV_HEADS = A_Q_HEADS // 4
B_Q_HEADS = D_MODEL // HEAD_DIM // 2
B_KV_HEADS = B_Q_HEADS // 4
AB_SIZES = (A_Q_HEADS * HEAD_DIM, A_KV_HEADS * HEAD_DIM, A_KV_HEADS * HEAD_DIM,
            B_Q_HEADS * HEAD_DIM, B_KV_HEADS * HEAD_DIM, B_KV_HEADS * HEAD_DIM)
AB_IN = sum(AB_SIZES)
AB_OUT = (A_Q_HEADS + B_Q_HEADS) * HEAD_DIM
C_HEADS = D_MODEL // (2 * HEAD_DIM)
C_V_DIM = 2 * HEAD_DIM
C_SIZES = (C_HEADS * 2 * HEAD_DIM, C_HEADS * 2 * HEAD_DIM, C_HEADS * C_V_DIM)
C_IN = sum(C_SIZES)
C_OUT = C_HEADS * C_V_DIM
N_EXPERTS = 16
EC_FACTOR = 2
D_EXPERT = D_MODEL
EPS = 1e-6
NEG_INF = -1e30

kernel_name = 'hybrid_diffusion_prefix_block'


def rms_norm(x, g):
    xf = x.astype(jnp.float32)
    xf = xf * lax.rsqrt(jnp.mean(xf * xf, axis=-1, keepdims=True) + EPS)
    return xf.astype(x.dtype) * g


def rope_tables(n_rows, dtype):
    row = jnp.repeat(jnp.arange(n_rows), GRID_W).astype(jnp.float32)
    col = jnp.tile(jnp.arange(GRID_W), n_rows).astype(jnp.float32)
    n_freq = HEAD_DIM // 4
    inv = ROPE_BASE ** (-jnp.arange(n_freq, dtype=jnp.float32) / n_freq)
    ar = row[:, None] * inv
    ac = col[:, None] * inv
    return tuple(t.astype(dtype) for t in (jnp.cos(ar), jnp.sin(ar), jnp.cos(ac), jnp.sin(ac)))


def apply_rope(x, rope):
    cr, sr, cc, sc = (t[:, None, :] for t in rope)
    r1, r2, c1, c2 = jnp.split(x, 4, axis=-1)
    return jnp.concatenate([r1 * cr - r2 * sr, r2 * cr + r1 * sr,
                            c1 * cc - c2 * sc, c2 * cc + c1 * sc], axis=-1)


def _split(p, sizes):
    return jnp.split(p, [int(s) for s in np.cumsum(sizes)[:-1]], axis=-1)


def _to_heads(t):
    return t.reshape(t.shape[:-1] + (t.shape[-1] // HEAD_DIM, HEAD_DIM))


def _blocked(fn, q):
    B, T = q.shape[:2]
    nb = T // BLOCK
    qb = jnp.swapaxes(q.reshape((B, nb, BLOCK) + q.shape[2:]), 0, 1)
    o = lax.map(fn, qb)
    return jnp.swapaxes(o, 0, 1).reshape((B, T) + o.shape[3:])


def dense_gqa(q, k, v, sink=None):
    B, L, Hq, d = q.shape
    Hkv = k.shape[2]
    G = Hq // Hkv
    qg = q.reshape(B, L, Hkv, G, d)
    s = jnp.einsum('bqhgd,bkhd->bhgqk', qg, k).astype(jnp.float32) * (d ** -0.5)
    if sink is not None:
        s_sink = jnp.broadcast_to(sink.astype(jnp.float32).reshape(1, Hkv, G, 1, 1), s.shape[:-1] + (1,))
        p = jax.nn.softmax(jnp.concatenate([s, s_sink], axis=-1), axis=-1)[..., :-1]
    else:
        p = jax.nn.softmax(s, axis=-1)
    o = jnp.einsum('bhgqk,bkhd->bqhgd', p.astype(v.dtype), v)
    return o.reshape(B, L, Hq * d)


def blocked_gqa(q, k, v):
    return _blocked(lambda qb: dense_gqa(qb, k, v), q)


def windowed_gqa_latent(q, k, v, kc, vc, sink):
    B, T, Hq, d = q.shape
    Hkv = k.shape[2]
    G = Hq // Hkv
    nb = T // BLOCK
    L = kc.shape[1]
    qb = q.reshape(B, nb, BLOCK, Hkv, G, d)
    pad = ((0, 0), (BLOCK, BLOCK), (0, 0), (0, 0))
    kp = jnp.pad(k, pad).reshape(B, nb + 2, BLOCK, Hkv, d)
    vp = jnp.pad(v, pad).reshape(B, nb + 2, BLOCK, Hkv, d)
    kband = jnp.concatenate([kp[:, :-2], kp[:, 1:-1], kp[:, 2:]], axis=2)
    vband = jnp.concatenate([vp[:, :-2], vp[:, 1:-1], vp[:, 2:]], axis=2)
    scale = d ** -0.5
    s_band = jnp.einsum('bnqhgd,bnkhd->bnhgqk', qb, kband).astype(jnp.float32) * scale
    s_ctx = jnp.einsum('bnqhgd,bchd->bnhgqc', qb, kc).astype(jnp.float32) * scale
    q_pos = jnp.arange(nb)[:, None, None] * BLOCK + jnp.arange(BLOCK)[None, :, None]
    k_pos = (jnp.arange(nb)[:, None, None] - 1) * BLOCK + jnp.arange(3 * BLOCK)[None, None, :]
    mask = (jnp.abs(q_pos - k_pos) <= WINDOW) & (k_pos >= 0) & (k_pos < T)
    s_band = jnp.where(mask[None, :, None, None], s_band, NEG_INF)
    s_sink = jnp.broadcast_to(sink.astype(jnp.float32).reshape(1, 1, Hkv, G, 1, 1), s_band.shape[:-1] + (1,))
    p = jax.nn.softmax(jnp.concatenate([s_ctx, s_band, s_sink], axis=-1), axis=-1).astype(v.dtype)
    o = (jnp.einsum('bnhgqc,bchd->bnqhgd', p[..., :L], vc)
         + jnp.einsum('bnhgqk,bnkhd->bnqhgd', p[..., L:L + 3 * BLOCK], vband))
    return o.reshape(B, T, Hq * d)


def diff_attn(q, k, v, lam):
    d = q.shape[-1]
    s = jnp.einsum('bqhmd,bkhmd->bmhqk', q, k).astype(jnp.float32) * (d ** -0.5)
    p = jax.nn.softmax(s, axis=-1)
    a = p[:, 0] - lam * p[:, 1]
    return jnp.einsum('bhqk,bkhe->bqhe', a.astype(v.dtype), v)


def mixer_ab(hl, hc, w_in, w_out, sink, q_g, k_g, rope, need_ctx):
    qla, kla, vla, qlb, klb, vlb = [_to_heads(t) for t in _split(hl @ w_in, AB_SIZES)]
    qca, kca, vca, qcb, kcb, vcb = [_to_heads(t) for t in _split(hc @ w_in, AB_SIZES)]
    qlb, klb = rms_norm(qlb, q_g), rms_norm(klb, k_g)
    qcb, kcb = rms_norm(qcb, q_g), rms_norm(kcb, k_g)
    ya = windowed_gqa_latent(apply_rope(qla, rope), apply_rope(kla, rope), vla, kca, vca, sink)
    yb = blocked_gqa(apply_rope(qlb, rope),
                     jnp.concatenate([kcb, apply_rope(klb, rope)], axis=1),
                     jnp.concatenate([vcb, vlb], axis=1))
    yl = jnp.concatenate([ya, yb], axis=-1) @ w_out
    yc = None
    if need_ctx:
        yc = jnp.concatenate([dense_gqa(qca, kca, vca, sink), dense_gqa(qcb, kcb, vcb)], axis=-1) @ w_out
    return yl, yc


def mixer_c(hl, hc, w_in, w_out, lam_p, sub_g, lambda_init, rope, need_ctx):
    def heads(h):
        q, k, v = _split(h @ w_in, C_SIZES)
        lead = h.shape[:-1]
        return (q.reshape(lead + (C_HEADS, 2, HEAD_DIM)), k.reshape(lead + (C_HEADS, 2, HEAD_DIM)),
                v.reshape(lead + (C_HEADS, C_V_DIM)))

    def rot(t):
        B, T = t.shape[:2]
        return apply_rope(t.reshape(B, T, 2 * C_HEADS, HEAD_DIM), rope).reshape(t.shape)

    def finish(o):
        lead = o.shape[:-2]
        return (rms_norm(o, sub_g) * (1.0 - lambda_init)).reshape(lead + (C_OUT,)) @ w_out

    ql, kl, vl = heads(hl)
    qc, kc, vc = heads(hc)
    lp = lam_p.astype(jnp.float32)
    lam = jnp.exp(jnp.sum(lp[0] * lp[1])) - jnp.exp(jnp.sum(lp[2] * lp[3])) + lambda_init
    k_all = jnp.concatenate([kc, rot(kl)], axis=1)
    v_all = jnp.concatenate([vc, vl], axis=1)
    yl = finish(_blocked(lambda qb: diff_attn(qb, k_all, v_all, lam), rot(ql)))
    yc = finish(diff_attn(qc, kc, vc, lam)) if need_ctx else None
    return yl, yc


def ec_moe(h, w_r, w_g, w_u, w_d):
    B, N, D = h.shape
    cap = EC_FACTOR * N // N_EXPERTS
    aff = jax.nn.softmax(jnp.einsum('bnd,de->bne', h, w_r).astype(jnp.float32), axis=-1)
    gate, idx = lax.top_k(jnp.swapaxes(aff, 1, 2), cap)
    xg = jax.vmap(lambda hb, ib: hb[ib])(h, idx)
    a = jnp.einsum('becd,edf->becf', xg, w_g)
    u = jnp.einsum('becd,edf->becf', xg, w_u)
    y = jnp.einsum('becf,efd->becd', jax.nn.silu(a) * u, w_d) * gate[..., None].astype(h.dtype)
    return jax.vmap(lambda yb, ib: jnp.zeros((N, D), yb.dtype).at[ib].add(yb))(y, idx)


def _mods(cv, w, b):
    return jnp.split(jax.nn.silu(cv) @ w + b, 6, axis=-1)


def setup_inputs(seed: int = 0) -> dict:
    key = jax.random.key(seed)
    ks = jax.random.split(key, 20)
    D = D_MODEL
    n_even = (DEPTH + 1) // 2
    n_odd = DEPTH // 2

    def nrm(k, shape, s):
        return jax.random.normal(k, shape, jnp.float32) * s

    return {
        'x': nrm(ks[0], (BATCH, SEQ, D), 1.0),
        'c': nrm(ks[1], (BATCH, D), 1.0),
        'ctx': nrm(ks[2], (BATCH, CTX_LEN, D), 1.0),
        'c_ctx': nrm(ks[3], (D,), 1.0),
        'mod_w': nrm(ks[4], (DEPTH, D, 6 * D), 0.5 * D ** -0.5),
        'mod_b': nrm(ks[5], (DEPTH, 6 * D), 0.01),
        'norm_g': 1.0 + nrm(ks[6], (DEPTH, 4, D), 0.02),
        'ab_w_in': nrm(ks[7], (n_even, D, AB_IN), D ** -0.5),
        'ab_w_out': nrm(ks[8], (n_even, AB_OUT, D), AB_OUT ** -0.5),
        'ab_sink': nrm(ks[9], (n_even, A_Q_HEADS), 1.0),
        'ab_q_norm': 1.0 + nrm(ks[10], (n_even, HEAD_DIM), 0.02),
        'ab_k_norm': 1.0 + nrm(ks[11], (n_even, HEAD_DIM), 0.02),
        'dif_w_in': nrm(ks[12], (n_odd, D, C_IN), D ** -0.5),
        'dif_w_out': nrm(ks[13], (n_odd, C_OUT, D), C_OUT ** -0.5),
        'dif_lambda': nrm(ks[14], (n_odd, 4, HEAD_DIM), 0.1),
        'dif_subln': 1.0 + nrm(ks[15], (n_odd, C_V_DIM), 0.02),
        'router_w': nrm(ks[16], (DEPTH, D, N_EXPERTS), D ** -0.5),
        'exp_w_gate': nrm(ks[17], (DEPTH, N_EXPERTS, D, D_EXPERT), D ** -0.5),
        'exp_w_up': nrm(ks[18], (DEPTH, N_EXPERTS, D, D_EXPERT), D ** -0.5),
        'exp_w_down': nrm(ks[19], (DEPTH, N_EXPERTS, D_EXPERT, D), D_EXPERT ** -0.5),
    }


def reference(x, c, ctx, c_ctx, mod_w, mod_b, norm_g, ab_w_in, ab_w_out, ab_sink, ab_q_norm, ab_k_norm,
              dif_w_in, dif_w_out, dif_lambda, dif_subln, router_w, exp_w_gate, exp_w_up, exp_w_down):
    n_rows = x.shape[1] // GRID_W
    rope = rope_tables(n_rows, x.dtype)
    xl, xc = x, ctx
    for i in range(DEPTH):
        need_ctx = i < DEPTH - 1
        sa_l, ca_l, ga_l, sf_l, cf_l, gf_l = [m[:, None, :] for m in _mods(c, mod_w[i], mod_b[i])]
        sa_c, ca_c, ga_c, sf_c, cf_c, gf_c = _mods(c_ctx, mod_w[i], mod_b[i])
        g_pre_a, g_post_a, g_pre_f, g_post_f = norm_g[i]
        hl = rms_norm(xl, g_pre_a) * (1.0 + ca_l) + sa_l
        hc = rms_norm(xc, g_pre_a) * (1.0 + ca_c) + sa_c
        j = i // 2
        if i % 2 == 0:
            yl, yc = mixer_ab(hl, hc, ab_w_in[j], ab_w_out[j], ab_sink[j], ab_q_norm[j], ab_k_norm[j],
                              rope, need_ctx)
        else:
            lambda_init = 0.8 - 0.6 * math.exp(-0.3 * i)
            yl, yc = mixer_c(hl, hc, dif_w_in[j], dif_w_out[j], dif_lambda[j], dif_subln[j], lambda_init,
                             rope, need_ctx)
        xl = xl + ga_l * rms_norm(yl, g_post_a)
        hl = rms_norm(xl, g_pre_f) * (1.0 + cf_l) + sf_l
        xl = xl + gf_l * rms_norm(ec_moe(hl, router_w[i], exp_w_gate[i], exp_w_up[i], exp_w_down[i]), g_post_f)
        if need_ctx:
            xc = xc + ga_c * rms_norm(yc, g_post_a)
            hc = rms_norm(xc, g_pre_f) * (1.0 + cf_c) + sf_c
            xc = xc + gf_c * rms_norm(ec_moe(hc, router_w[i], exp_w_gate[i], exp_w_up[i], exp_w_down[i]), g_post_f)
    return xl
```

```cpp
#include <hip/hip_runtime.h>
#include <cstdio>
#include <cstdint>

#ifndef MK_ONE_LAUNCH
#define MK_ONE_LAUNCH 1
#endif

namespace pg8 {
#define PG8_LAS __attribute__((address_space(3)))
typedef unsigned short bf16_t;
typedef short bf16x8 __attribute__((ext_vector_type(8)));
typedef float f32x4 __attribute__((ext_vector_type(4)));
typedef unsigned u32x4 __attribute__((ext_vector_type(4)));
constexpr int BM = 256, BK = 64, HALF = 128, HTB = HALF * BK * 2  , STAGE_BYTES = 8 * HTB, NXCD = 8, WGM = 8;

__host__ __device__ __forceinline__ int lds_byte(int r, int c) { const int st = (r >> 4) * 2 + (c >> 5), rr = r & 15, cc = c & 31, ob = rr * 64 + cc * 2; return st * 1024 + (ob ^ (((ob >> 9) & 1) << 5)); }
__host__ __device__ __forceinline__ void stage_rc(int b, int& R, int& C) { const int st = b / 1024, sb = b % 1024, swz = sb ^ (((sb >> 9) & 1) << 5); R = (st >> 1) * 16 + swz / 64; C = (st & 1) * 32 + (swz % 64) / 2; }
__host__ __device__ __forceinline__ int perm32(int rho) { const int n = rho >> 4, i = rho & 15; return 8 * (i >> 2) + 4 * n + (i & 3); }

struct Unit { int pm, pn; };
struct Gemm { const bf16_t* A; const bf16_t* Bt; int M, N, K; };

struct StaticOrder {
    int nM, nN, nwg, G, c;
    __host__ __device__ void init(int M, int N, int G_, int c_) { nM = M / BM; nN = N / BM; nwg = nM * nN; G = G_; c = c_; }
    __host__ __device__ bool next(int i, Unit& u) const {
        const long L = (long)i * G + c; if (L >= nwg) return false;
        int wgid = (int)L; { const int q = nwg / NXCD, r = nwg % NXCD, xcd = wgid % NXCD, off = wgid / NXCD; wgid = (xcd < r ? xcd * (q + 1) : r * (q + 1) + (xcd - r) * q) + off; }
        const int nig = WGM * nN, gid = wgid / nig, fm = gid * WGM, gsz = (nM - fm) < WGM ? (nM - fm) : WGM;
        u.pm = fm + ((wgid % nig) % gsz); u.pn = (wgid % nig) / gsz; return true;
    }
    __device__ __forceinline__ void a_ready(const Unit&) const {}
    __device__ __forceinline__ void done(const Unit&) const {}
};

__device__ __forceinline__ unsigned cvt_pk_bf16(float lo, float hi) { unsigned r; asm volatile("v_cvt_pk_bf16_f32 %0, %1, %2" : "=v"(r) : "v"(lo), "v"(hi)); return r; }
struct DenseOrder {
    StaticOrder so; int kind;
    __device__ void init(int nM, int nN, int G_, int c_, int kind_) { so.init(nM * BM, nN * BM, G_, c_); kind = kind_; }
    __device__ bool next(int i, Unit& u) const {
        if (!so.next(i, u)) return false;
        if (kind == 1) { const int b = u.pm >> 4, j = u.pm & 15; u.pm = 17 * b + 1 + j; }
        return true;
    }
    __device__ __forceinline__ void a_ready(const Unit&) const {}
    __device__ __forceinline__ void done(const Unit&) const {}
};
struct MoeOrder {
    int NP, NJ, nU, G, c;
    __device__ void init(int NP_, int NJ_, int G_, int c_) { NP = NP_; NJ = NJ_; nU = 16 * NP_ * NJ_; G = G_; c = c_; }
    __device__ bool next(int i, Unit& u) const {
        const int L = i * G + c; if (L >= nU) return false;
        const int xcd = L & 7, off = L >> 3, id = xcd * (nU >> 3) + off;
        const int per = NJ * NP, e = id / per, rem = id - e * per, j = rem / NP, p = rem - j * NP;
        u.pm = 5 * e + p; u.pn = NJ * e + j; return true;
    }
    __device__ __forceinline__ void a_ready(const Unit&) const {}
    __device__ __forceinline__ void done(const Unit&) const {}
};

struct EpiStoreBf16 {
    static constexpr bool PERM = true, AFTER_DRAIN = false;
    bf16_t* O; int ldc; int nmod;
    __device__ __forceinline__ void operator()(const f32x4 (&acc)[2][2][4][2], const Unit& u, int wr, int wc, int fr, int fq) const {
        const int row0 = u.pm * BM + wr * 64 + fr, col0 = (u.pn % nmod) * BM + wc * 32 + 8 * fq;
#pragma unroll
        for (int ai = 0; ai < 2; ++ai)
#pragma unroll
            for (int m = 0; m < 4; ++m) { bf16_t* rowp = O + (size_t)(row0 + ai * HALF + m * 16) * ldc + col0;
#pragma unroll
                for (int bj = 0; bj < 2; ++bj) { const f32x4 v0 = acc[ai][bj][m][0], v1 = acc[ai][bj][m][1];
                    u32x4 w; w.x = cvt_pk_bf16(v0[0], v0[1]); w.y = cvt_pk_bf16(v0[2], v0[3]); w.z = cvt_pk_bf16(v1[0], v1[1]); w.w = cvt_pk_bf16(v1[2], v1[3]);
                    *(u32x4*)(rowp + bj * HALF) = w; } }
    }
};
struct EpiStoreF32 {
    static constexpr bool PERM = true, AFTER_DRAIN = false;
    float* O; int ldc;
    __device__ __forceinline__ void operator()(const f32x4 (&acc)[2][2][4][2], const Unit& u, int wr, int wc, int fr, int fq) const {
        const int row0 = u.pm * BM + wr * 64 + fr, col0 = u.pn * BM + wc * 32 + 8 * fq;
#pragma unroll
        for (int ai = 0; ai < 2; ++ai)
#pragma unroll
            for (int m = 0; m < 4; ++m) { float* rowp = O + (size_t)(row0 + ai * HALF + m * 16) * ldc + col0;
#pragma unroll
                for (int bj = 0; bj < 2; ++bj) { *(f32x4*)(rowp + bj * HALF) = acc[ai][bj][m][0]; *(f32x4*)(rowp + bj * HALF + 4) = acc[ai][bj][m][1]; } }
    }
};
__device__ __forceinline__ float silu_f(float g) { return g * __builtin_amdgcn_rcpf(1.0f + __builtin_amdgcn_exp2f(-1.4426950408889634f * g)); }
struct EpiSwiGLU {
    static constexpr bool PERM = true, AFTER_DRAIN = false;
    bf16_t* O; int ldc;
    __device__ __forceinline__ void operator()(const f32x4 (&acc)[2][2][4][2], const Unit& u, int wr, int wc, int fr, int fq) const {
        const int row0 = u.pm * BM + wr * 64 + fr, col0 = (u.pn & 15) * HALF + wc * 32 + 8 * fq;
#pragma unroll
        for (int ai = 0; ai < 2; ++ai)
#pragma unroll
            for (int m = 0; m < 4; ++m) { bf16_t* rowp = O + (size_t)(row0 + ai * HALF + m * 16) * ldc + col0;
                const f32x4 g0 = acc[ai][0][m][0], g1 = acc[ai][0][m][1], u0 = acc[ai][1][m][0], u1 = acc[ai][1][m][1];
                u32x4 w;
                w.x = cvt_pk_bf16(silu_f(g0[0]) * u0[0], silu_f(g0[1]) * u0[1]); w.y = cvt_pk_bf16(silu_f(g0[2]) * u0[2], silu_f(g0[3]) * u0[3]);
                w.z = cvt_pk_bf16(silu_f(g1[0]) * u1[0], silu_f(g1[1]) * u1[1]); w.w = cvt_pk_bf16(silu_f(g1[2]) * u1[2], silu_f(g1[3]) * u1[3]);
                *(u32x4*)rowp = w; }
    }
};

template <class Epi, class Sched, bool ALIGN_EPI = false, bool SP2 = false>
__device__ __forceinline__ void gemm_phase(PG8_LAS unsigned char* lds, const Gemm g, const Sched& S, const Epi& E) {
    const int tid = threadIdx.x, wid = __builtin_amdgcn_readfirstlane(tid >> 6), lane = tid & 63, wr = wid >> 2, wc = wid & 3, fr = lane & 15, fq = lane >> 4;
    const int K = g.K, nt = K / BK;
    unsigned voffA[2], voffB[2];
#pragma unroll
    for (int i = 0; i < 2; ++i) { int R, C; stage_rc(tid * 16 + i * 8192, R, C); const int Rb = Epi::PERM ? ((R & ~31) + perm32(R & 31)) : R;
        voffA[i] = (unsigned)(R * K + C) * 2u; voffB[i] = (unsigned)(Rb * K + C) * 2u; }
    const size_t kstep = (size_t)(BK * 2);
    const size_t hstep = (size_t)HALF * K * 2;
    const size_t tstep = 2 * hstep;
    const unsigned ldsw = (unsigned)wid * 1024u;
    const int aoff = lds_byte(wr * 64 + fr, fq * 8), boff = lds_byte(wc * 32 + fr, fq * 8);
#define PG8_SA(b, h) (((b) * 2 + (h)) * HTB)
#define PG8_SB(b, h) ((4 + (b) * 2 + (h)) * HTB)
#define PG8_STAGE(bufoff, gbase, voff) do { _Pragma("unroll") for (int _i = 0; _i < 2; ++_i) \
        __builtin_amdgcn_global_load_lds((const unsigned*)((const char*)(gbase) + (voff)[_i]), (PG8_LAS unsigned*)(lds + (bufoff) + ldsw + _i * 8192), 16, 0, 0); } while (0)
#define PG8_LDA(dst, b, h) do { _Pragma("unroll") for (int m = 0; m < 4; ++m) _Pragma("unroll") for (int k = 0; k < 2; ++k) dst[m][k] = *(const PG8_LAS bf16x8*)(lds + PG8_SA(b, h) + aoff + m * 2048 + k * 1024); } while (0)
#define PG8_LDB(dst, b, h) do { _Pragma("unroll") for (int n = 0; n < 2; ++n) _Pragma("unroll") for (int k = 0; k < 2; ++k) dst[n][k] = *(const PG8_LAS bf16x8*)(lds + PG8_SB(b, h) + boff + n * 2048 + k * 1024); } while (0)
#define PG8_MMA(ai, bj, At, Bt) do { __builtin_amdgcn_s_setprio(1); _Pragma("unroll") for (int m = 0; m < 4; ++m) _Pragma("unroll") for (int n = 0; n < 2; ++n) _Pragma("unroll") for (int k = 0; k < 2; ++k) \
        acc[ai][bj][m][n] = __builtin_amdgcn_mfma_f32_16x16x32_bf16(Bt[n][k], At[m][k], acc[ai][bj][m][n], 0, 0, 0); __builtin_amdgcn_s_setprio(0); } while (0)
#define PG8_WAIT_V(n) asm volatile("s_waitcnt vmcnt(" #n ")" ::: "memory")
#define PG8_WAIT_L(n) asm volatile("s_waitcnt lgkmcnt(" #n ")" ::: "memory")
#define PG8_BAR __builtin_amdgcn_s_barrier()
#define PG8_SCHED __builtin_amdgcn_sched_barrier(0)
    Unit cur, nxt; int ui = 0;
    if (!S.next(0, cur)) return;
    f32x4 acc[2][2][4][2];
#pragma unroll
    for (int a = 0; a < 2; ++a)
#pragma unroll
        for (int b = 0; b < 2; ++b)
#pragma unroll
            for (int m = 0; m < 4; ++m)
#pragma unroll
                for (int n = 0; n < 2; ++n) acc[a][b][m][n] = (f32x4){0.f, 0.f, 0.f, 0.f};
    bf16x8 At[4][2], B0[2][2], B1[2][2];
    const char* cA = (const char*)g.A + (size_t)cur.pm * tstep; const char* cB = (const char*)g.Bt + (size_t)cur.pn * tstep;
    S.a_ready(cur);
    if constexpr (SP2) {
        PG8_STAGE(PG8_SB(0, 0), cB, voffB); PG8_STAGE(PG8_SB(0, 1), cB + hstep, voffB); PG8_STAGE(PG8_SA(0, 0), cA, voffA); PG8_STAGE(PG8_SA(0, 1), cA + hstep, voffA);
        if (wr == 1) PG8_BAR;
        PG8_WAIT_V(2); PG8_BAR;
        PG8_STAGE(PG8_SB(1, 0), cB + kstep, voffB); PG8_STAGE(PG8_SA(1, 0), cA + kstep, voffA); PG8_STAGE(PG8_SB(1, 1), cB + hstep + kstep, voffB);
        PG8_WAIT_V(6); PG8_BAR;
    } else {
        PG8_STAGE(PG8_SB(0, 0), cB, voffB); PG8_STAGE(PG8_SA(0, 0), cA, voffA); PG8_STAGE(PG8_SB(0, 1), cB + hstep, voffB); PG8_STAGE(PG8_SA(0, 1), cA + hstep, voffA);
        if (wr == 1) PG8_BAR;
        PG8_WAIT_V(4); PG8_BAR;
        PG8_STAGE(PG8_SB(1, 0), cB + kstep, voffB); PG8_STAGE(PG8_SA(1, 0), cA + kstep, voffA); PG8_STAGE(PG8_SB(1, 1), cB + hstep + kstep, voffB);
        PG8_WAIT_V(6); PG8_BAR;
    }
    for (;;) {
        const bool has_next = S.next(ui + 1, nxt);
        const char* nA = has_next ? (const char*)g.A + (size_t)nxt.pm * tstep : cA; const char* nB = has_next ? (const char*)g.Bt + (size_t)nxt.pn * tstep : cB;
        for (int t = 0; t < nt; t += 2) {
            const bool last = (t == nt - 2);
            const char* a1 = cA + (size_t)(t + 1) * kstep;
            const char* a2 = last ? nA : cA + (size_t)(t + 2) * kstep; const char* b2 = last ? nB : cB + (size_t)(t + 2) * kstep;
            const char* a3 = a2 + kstep; const char* b3 = b2 + kstep;
            if (last && has_next) S.a_ready(nxt);
            if constexpr (SP2) {
            PG8_LDB(B0, 0, 0); PG8_LDB(B1, 0, 1); PG8_SCHED; PG8_LDA(At, 0, 0); PG8_STAGE(PG8_SA(1, 1), a1 + hstep, voffA);
            PG8_WAIT_V(8); PG8_WAIT_L(0); PG8_BAR; PG8_MMA(0, 0, At, B0); PG8_MMA(0, 1, At, B1); PG8_BAR; PG8_SCHED;
            PG8_LDA(At, 0, 1); PG8_STAGE(PG8_SB(0, 0), b2, voffB); PG8_STAGE(PG8_SB(0, 1), b2 + hstep, voffB); PG8_STAGE(PG8_SA(0, 0), a2, voffA);
            PG8_WAIT_V(8); PG8_WAIT_L(0); PG8_BAR; PG8_MMA(1, 0, At, B0); PG8_MMA(1, 1, At, B1); PG8_BAR; PG8_SCHED;
            PG8_LDB(B0, 1, 0); PG8_LDB(B1, 1, 1); PG8_SCHED; PG8_LDA(At, 1, 0); PG8_STAGE(PG8_SA(0, 1), a2 + hstep, voffA);
            PG8_WAIT_V(8); PG8_WAIT_L(0); PG8_BAR; PG8_MMA(0, 0, At, B0); PG8_MMA(0, 1, At, B1); PG8_BAR; PG8_SCHED;
            PG8_LDA(At, 1, 1); PG8_STAGE(PG8_SB(1, 0), b3, voffB); PG8_STAGE(PG8_SB(1, 1), b3 + hstep, voffB); PG8_STAGE(PG8_SA(1, 0), a3, voffA);
            PG8_WAIT_V(8); PG8_WAIT_L(0); PG8_BAR; PG8_MMA(1, 0, At, B0); PG8_MMA(1, 1, At, B1); PG8_BAR; PG8_SCHED;
            } else {
            PG8_LDB(B0, 0, 0); PG8_SCHED; PG8_LDA(At, 0, 0); PG8_STAGE(PG8_SA(1, 1), a1 + hstep, voffA);
            PG8_WAIT_L(8); PG8_BAR; PG8_WAIT_L(0); PG8_MMA(0, 0, At, B0); PG8_BAR; PG8_SCHED;
            PG8_LDB(B1, 0, 1); PG8_STAGE(PG8_SB(0, 0), b2, voffB);
            PG8_BAR; PG8_WAIT_L(0); PG8_MMA(0, 1, At, B1); PG8_BAR;
            PG8_LDA(At, 0, 1); PG8_STAGE(PG8_SA(0, 0), a2, voffA);
            PG8_BAR; PG8_WAIT_L(0); PG8_MMA(1, 0, At, B0); PG8_BAR; PG8_SCHED;
            PG8_STAGE(PG8_SB(0, 1), b2 + hstep, voffB);
            PG8_WAIT_V(6); PG8_BAR; PG8_MMA(1, 1, At, B1); PG8_BAR;
            PG8_LDB(B0, 1, 0); PG8_SCHED; PG8_LDA(At, 1, 0); PG8_STAGE(PG8_SA(0, 1), a2 + hstep, voffA);
            PG8_WAIT_L(8); PG8_BAR; PG8_WAIT_L(0); PG8_MMA(0, 0, At, B0); PG8_BAR; PG8_SCHED;
            PG8_LDB(B1, 1, 1); PG8_STAGE(PG8_SB(1, 0), b3, voffB);
            PG8_BAR; PG8_WAIT_L(0); PG8_MMA(0, 1, At, B1); PG8_BAR;
            PG8_LDA(At, 1, 1); PG8_STAGE(PG8_SA(1, 0), a3, voffA);
            PG8_BAR; PG8_WAIT_L(0); PG8_MMA(1, 0, At, B0); PG8_BAR; PG8_SCHED;
            PG8_STAGE(PG8_SB(1, 1), b3 + hstep, voffB);
            PG8_WAIT_V(6); PG8_BAR; PG8_MMA(1, 1, At, B1); PG8_BAR;
            }
        }
        if constexpr (ALIGN_EPI) { if (wr == 0) PG8_BAR; }
        if constexpr (!Epi::AFTER_DRAIN) { E(acc, cur, wr, wc, fr, fq); S.done(cur); }
        if (!has_next) break;
#pragma unroll
        for (int a = 0; a < 2; ++a)
#pragma unroll
            for (int b = 0; b < 2; ++b)
#pragma unroll
                for (int m = 0; m < 4; ++m)
#pragma unroll
                    for (int n = 0; n < 2; ++n) acc[a][b][m][n] = (f32x4){0.f, 0.f, 0.f, 0.f};
        cur = nxt; cA = nA; cB = nB; ++ui;
        if constexpr (ALIGN_EPI) { if (wr == 1) PG8_BAR; }
    }
    PG8_WAIT_V(0);
    if constexpr (!ALIGN_EPI) { if (wr == 0) PG8_BAR; }
    PG8_BAR;
    if constexpr (Epi::AFTER_DRAIN) { E.fused(acc, cur, wr, wc, fr, fq, lds, wid, lane); S.done(cur); }
#undef PG8_SA
#undef PG8_SB
#undef PG8_STAGE
#undef PG8_LDA
#undef PG8_LDB
#undef PG8_MMA
#undef PG8_WAIT_V
#undef PG8_WAIT_L
#undef PG8_BAR
#undef PG8_SCHED
}
}
namespace att {
using bf16x8 = __attribute__((ext_vector_type(8))) short;
using s16x4  = __attribute__((ext_vector_type(4))) short;
using f32x16 = __attribute__((ext_vector_type(16))) float;
using u32x4  = __attribute__((ext_vector_type(4))) unsigned;
typedef unsigned short bf16;
constexpr int D = 128, NW = 8, QBLK = 32, KVBLK = 64;
constexpr float SCALE = 0.088388347648318440f;
constexpr float THR = 8.f;
constexpr int SHM_V = KVBLK * D * 2, SHM_K = KVBLK * D * 2, SHM_ATTN = 2 * SHM_V + 2 * SHM_K + NW * 64 * 4;
#define KSWZ(row, colB) ((row) * 256 + ((colB) ^ (((row) & 7) << 4)))
#define SBAR() __builtin_amdgcn_sched_barrier(0)
__device__ __forceinline__ int crow(int r, int hi) { return (r & 3) + 8 * (r >> 2) + 4 * hi; }
__device__ __forceinline__ unsigned cvtpk(float lo, float hi) { unsigned r; asm volatile("v_cvt_pk_bf16_f32 %0, %1, %2" : "=v"(r) : "v"(lo), "v"(hi)); return r; }

__device__ __forceinline__ void partialSM(f32x16& p0, f32x16& p1, float& m_reg, float& mn, float& alpha, bool domask, int dm, int hi) {
  constexpr float C = SCALE * 1.4426950408889634f;
  if (domask) {
    const int db = dm + 4 * hi + 128;
#pragma unroll
    for (int r = 0; r < 16; ++r) { const int d0 = db + (r & 3) + 8 * (r >> 2);
      if ((unsigned)d0 > 256u) p0[r] = -1e30f; if ((unsigned)(d0 + 32) > 256u) p1[r] = -1e30f; }
  }
  float pmax = p0[0];
#pragma unroll
  for (int r = 1; r < 16; ++r) pmax = fmaxf(pmax, p0[r]);
#pragma unroll
  for (int r = 0; r < 16; ++r) pmax = fmaxf(pmax, p1[r]);
  { auto rr = __builtin_amdgcn_permlane32_swap(__float_as_uint(pmax), __float_as_uint(pmax), false, false);
    pmax = fmaxf(__uint_as_float(rr[0]), __uint_as_float(rr[1])); }
  if (__builtin_expect(__all(pmax - m_reg <= THR / SCALE), 1)) { mn = m_reg; alpha = 1.f; }
  else { mn = fmaxf(m_reg, pmax); alpha = __builtin_amdgcn_exp2f((m_reg - mn) * C); m_reg = mn; }
  float mnC = -mn * C;
#pragma unroll
  for (int r = 0; r < 16; ++r) p0[r] = fmaf(p0[r], C, mnC);
#pragma unroll
  for (int r = 0; r < 16; ++r) p1[r] = fmaf(p1[r], C, mnC);
#pragma unroll
  for (int r = 0; r < 16; ++r) p0[r] = __builtin_amdgcn_exp2f(p0[r]);
}
__device__ __forceinline__ void finishSM(f32x16& p0, f32x16& p1, float alpha, float& l_reg, bf16x8& pa0, bf16x8& pa1, bf16x8& pa2, bf16x8& pa3) {
#pragma unroll
  for (int r = 0; r < 16; ++r) p1[r] = __builtin_amdgcn_exp2f(p1[r]);
  float ps = 0;
#pragma unroll
  for (int r = 0; r < 16; ++r) ps += p0[r];
#pragma unroll
  for (int r = 0; r < 16; ++r) ps += p1[r];
  { auto rr = __builtin_amdgcn_permlane32_swap(__float_as_uint(ps), __float_as_uint(ps), false, false);
    ps = __uint_as_float(rr[0]) + __uint_as_float(rr[1]); }
  l_reg = l_reg * alpha + ps;
#define PK4(P, BASE, OUT) do { unsigned a0 = cvtpk(P[BASE + 0], P[BASE + 1]), a1 = cvtpk(P[BASE + 2], P[BASE + 3]);   \
    unsigned b0 = cvtpk(P[BASE + 4], P[BASE + 5]), b1 = cvtpk(P[BASE + 6], P[BASE + 7]);                              \
    auto r0 = __builtin_amdgcn_permlane32_swap(a0, b0, false, false); auto r1 = __builtin_amdgcn_permlane32_swap(a1, b1, false, false); \
    u32x4 w = {r0[0], r1[0], r0[1], r1[1]}; OUT = *reinterpret_cast<bf16x8*>(&w); } while (0)
  PK4(p0, 0, pa0); PK4(p0, 8, pa1); PK4(p1, 0, pa2); PK4(p1, 8, pa3);
#undef PK4
}
__device__ __forceinline__ void qkt(f32x16& p0, f32x16& p1, const char* Ks, const bf16x8* qr, int r32, int hi) {
  p0 = f32x16{}; p1 = f32x16{};
#pragma unroll
  for (int d0 = 0; d0 < 8; ++d0) { int cb = (d0 * 16 + hi * 8) * 2;
    bf16x8 b0 = *reinterpret_cast<const bf16x8*>(Ks + KSWZ(r32, cb));
    bf16x8 b1 = *reinterpret_cast<const bf16x8*>(Ks + KSWZ(32 + r32, cb));
    p0 = __builtin_amdgcn_mfma_f32_32x32x16_bf16(b0, qr[d0], p0, 0, 0, 0);
    p1 = __builtin_amdgcn_mfma_f32_32x32x16_bf16(b1, qr[d0], p1, 0, 0, 0); }
}
__device__ __forceinline__ int v_st(int k, int c) { const int kk = (k & ~0xC) | ((k & 4) << 1) | ((k & 8) >> 1); return ((kk >> 3) * 4 + (c >> 5)) * 512 + ((kk & 7) * 32 + (c & 31)) * 2; }
__device__ __forceinline__ int v_rd_base(int lane) { return ((lane & 3) << 3) | (((lane >> 2) & 3) << 6) | (((lane >> 4) & 1) << 5) | (((lane >> 5) & 1) << 8); }
constexpr int v_rd_off(int d0, int ks, int half) { return d0 * 512 + ks * 4096 + half * 2048; }
template <int OFF> __device__ __forceinline__ s16x4 tr_read(int vb) {
  s16x4 r; asm volatile("ds_read_b64_tr_b16 %0, %1 offset:%2" : "=&v"(r) : "v"(vb), "i"(OFF) : "memory"); return r;
}
template <int D0> __device__ __forceinline__ void pv_one(f32x16& od, int vb, bf16x8 pa0, bf16x8 pa1, bf16x8 pa2, bf16x8 pa3) {
  const s16x4 l0 = tr_read<v_rd_off(D0, 0, 0)>(vb), h0 = tr_read<v_rd_off(D0, 0, 1)>(vb), l1 = tr_read<v_rd_off(D0, 1, 0)>(vb), h1 = tr_read<v_rd_off(D0, 1, 1)>(vb);
  const s16x4 l2 = tr_read<v_rd_off(D0, 2, 0)>(vb), h2 = tr_read<v_rd_off(D0, 2, 1)>(vb), l3 = tr_read<v_rd_off(D0, 3, 0)>(vb), h3 = tr_read<v_rd_off(D0, 3, 1)>(vb);
  asm volatile("s_waitcnt lgkmcnt(0)" ::: "memory"); SBAR();
#define PK(L, H) (bf16x8){L[0], L[1], L[2], L[3], H[0], H[1], H[2], H[3]}
  od = __builtin_amdgcn_mfma_f32_32x32x16_bf16(pa0, PK(l0, h0), od, 0, 0, 0);
  od = __builtin_amdgcn_mfma_f32_32x32x16_bf16(pa1, PK(l1, h1), od, 0, 0, 0);
  od = __builtin_amdgcn_mfma_f32_32x32x16_bf16(pa2, PK(l2, h2), od, 0, 0, 0);
  od = __builtin_amdgcn_mfma_f32_32x32x16_bf16(pa3, PK(l3, h3), od, 0, 0, 0);
#undef PK
}
__device__ __forceinline__ void pv_d0(f32x16* o, int vb, bf16x8 pa0, bf16x8 pa1, bf16x8 pa2, bf16x8 pa3) {
  pv_one<0>(o[0], vb, pa0, pa1, pa2, pa3); pv_one<1>(o[1], vb, pa0, pa1, pa2, pa3); pv_one<2>(o[2], vb, pa0, pa1, pa2, pa3); pv_one<3>(o[3], vb, pa0, pa1, pa2, pa3);
}

struct Job {
  const bf16* Q;
  const bf16* K; const bf16* V;
  int NT;
  int kb0;
  int mask;
  int dq;
  int use_sink; float sink_l2;
  void* O; float lam;
};

template <int LD, int OMODE>
__device__ __forceinline__ void attn_unit(const Job& J, char* lds) {
  constexpr int LDO = 2048;
  const int tid = threadIdx.x, wid = tid >> 6, lane = tid & 63, r32 = lane & 31, hi = lane >> 5;
  char* V_lds = lds; char* K_lds = lds + 2 * SHM_V;
  float* ws = (float*)(lds + 2 * SHM_V + 2 * SHM_K) + wid * 64; float* li_l = ws; float* al_l = ws + 32;
  float m_reg = -1e30f, l_reg = 0; f32x16 o[4] = {}; bf16x8 qr[8];
  const bf16* Qw = J.Q + (long)(wid * QBLK + r32) * LD + hi * 8;
#pragma unroll
  for (int d0 = 0; d0 < 8; ++d0) qr[d0] = *reinterpret_cast<const bf16x8*>(Qw + d0 * 16);
  const int sr = tid >> 4, sc = (tid & 15) * 8, vst0 = v_st(sr, sc), vst1 = v_st(32 + sr, sc);
  const int vb0 = (int)(uintptr_t)V_lds + v_rd_base(lane);
  const int toff = sr * LD + sc;
  constexpr int ldk = LD; const int kb0 = J.kb0, NT = J.NT;
  const bf16* Kh = J.K; const bf16* Vh = J.V;
  const bool msk = J.mask != 0;
  const int dml = J.dq - (wid * QBLK + r32);
  struct { bf16x8 vs0, vs1, ks0, ks1; } sr_[2];
#define KROWT(t) ((t) < 4 ? (t) * 64 : kb0 + ((t) - 4) * 64)
#define SLOAD(i, t) do { const int k0_ = KROWT(t); const bf16* vp_ = Vh + (size_t)k0_ * ldk + toff; const bf16* kp_ = Kh + (size_t)k0_ * ldk + toff; sr_[i].vs0 = *(const bf16x8*)vp_; sr_[i].vs1 = *(const bf16x8*)(vp_ + 32 * ldk); \
    sr_[i].ks0 = *(const bf16x8*)kp_; sr_[i].ks1 = *(const bf16x8*)(kp_ + 32 * ldk); } while (0)
#define SWRITE(b, i) do { *(bf16x8*)(V_lds + (b) * SHM_V + vst0) = sr_[i].vs0;          \
    *(bf16x8*)(V_lds + (b) * SHM_V + vst1) = sr_[i].vs1; int kc = sc * 2;               \
    *(bf16x8*)(K_lds + (b) * SHM_K + KSWZ(sr, kc)) = sr_[i].ks0;                       \
    *(bf16x8*)(K_lds + (b) * SHM_K + KSWZ(32 + sr, kc)) = sr_[i].ks1; } while (0)
#define SWAIT() asm volatile("s_waitcnt vmcnt(4)" ::: "memory")
#define RESC(a) do { if (__any((a) < 1.f)) { if (hi == 0) al_l[r32] = (a); asm volatile("s_waitcnt lgkmcnt(0)" ::: "memory"); \
    _Pragma("unroll") for (int d = 0; d < 4; ++d) _Pragma("unroll") for (int r = 0; r < 16; ++r) o[d][r] *= al_l[crow(r, hi)]; } } while (0)
#define MSK(t) (msk && (t) >= 4), (dml + ((t) - 4) * 64)
  f32x16 pA0, pA1, pB0, pB1; float mnA, mnB, alA, alB; bf16x8 pa0, pa1, pa2, pa3;
  constexpr int SE = 0, SO = 1;
  SLOAD(SE, 0); asm volatile("s_waitcnt vmcnt(0)" ::: "memory"); SWRITE(0, SE); __syncthreads();
  qkt(pA0, pA1, K_lds, qr, r32, hi); partialSM(pA0, pA1, m_reg, mnA, alA, false, 0, hi);
  SLOAD(SO, 1); if (2 < NT) SLOAD(SE, 2);
  SWAIT(); SWRITE(1, SO); __syncthreads();
  for (int j = 1; j + 1 < NT; j += 2) {
    SBAR(); qkt(pB0, pB1, K_lds + SHM_K, qr, r32, hi);
    finishSM(pA0, pA1, alA, l_reg, pa0, pa1, pa2, pa3); SBAR();
    SLOAD(SO, j + 2); SBAR();
    pv_d0(o, vb0, pa0, pa1, pa2, pa3); partialSM(pB0, pB1, m_reg, mnB, alB, MSK(j), hi);
    __syncthreads(); SWAIT(); SWRITE(0, SE);
    RESC(alB); __syncthreads();
    SBAR(); qkt(pA0, pA1, K_lds, qr, r32, hi);
    finishSM(pB0, pB1, alB, l_reg, pa0, pa1, pa2, pa3); SBAR();
    if (j + 3 < NT) SLOAD(SE, j + 3); SBAR();
    pv_d0(o, vb0 + SHM_V, pa0, pa1, pa2, pa3); partialSM(pA0, pA1, m_reg, mnA, alA, MSK(j + 1), hi);
    __syncthreads(); SWAIT(); SWRITE(1, SO);
    RESC(alA); __syncthreads();
  }
  SBAR(); qkt(pB0, pB1, K_lds + SHM_K, qr, r32, hi);
  finishSM(pA0, pA1, alA, l_reg, pa0, pa1, pa2, pa3); SBAR();
  pv_d0(o, vb0, pa0, pa1, pa2, pa3); partialSM(pB0, pB1, m_reg, mnB, alB, MSK(NT - 1), hi);
  __syncthreads(); RESC(alB);
  finishSM(pB0, pB1, alB, l_reg, pa0, pa1, pa2, pa3); SBAR();
  pv_d0(o, vb0 + SHM_V, pa0, pa1, pa2, pa3);
  if (J.use_sink) l_reg += __builtin_amdgcn_exp2f(J.sink_l2 - m_reg * (SCALE * 1.4426950408889634f));
  if (hi == 0) li_l[r32] = l_reg; asm volatile("s_waitcnt lgkmcnt(0)" ::: "memory");
  float rli[16];
#pragma unroll
  for (int r = 0; r < 16; ++r) rli[r] = __builtin_amdgcn_rcpf(li_l[crow(r, hi)]);
  if constexpr (OMODE == 0) {
    bf16* Ow = (bf16*)J.O + (long)(wid * QBLK) * LDO + r32;
#pragma unroll
    for (int r = 0; r < 16; ++r) { const int orow = crow(r, hi);
#pragma unroll
      for (int d0 = 0; d0 < 4; ++d0) Ow[orow * LDO + d0 * 32] = (bf16)(cvtpk(o[d0][r] * rli[r], 0.f) & 0xffffu); }
  } else if constexpr (OMODE == 1) {
    float* Ow = (float*)J.O + (long)(wid * QBLK) * LDO + r32;
#pragma unroll
    for (int r = 0; r < 16; ++r) { const int orow = crow(r, hi);
#pragma unroll
      for (int d0 = 0; d0 < 4; ++d0) Ow[orow * LDO + d0 * 32] = o[d0][r] * rli[r]; }
  }
#undef KROWT
#undef SLOAD
#undef SWRITE
#undef SWAIT
#undef RESC
#undef MSK
}
#undef KSWZ
#undef SBAR
}

constexpr int NWAVES = 8;
constexpr int DM = 2048, NBATCH = 2, SEQ = 4096, CTXL = 256, SB = SEQ + CTXL  , NROWS = NBATCH * SB  ;
constexpr int NEXP = 16, CAP_L = 512, CAP_C = 32, EROWS = 1280  ;
constexpr int NQKV0 = 3072, NQKV1 = 6144, NMOD = 6 * DM;
constexpr float EPS = 1e-6f;
constexpr float LAMBDA_INIT = 0.35550906759096926f;

constexpr size_t MiB = 1u << 20;
constexpr size_t WS_CTL = 0, CTL_ZERO_BYTES = 1 * MiB;
constexpr size_t WS_ROPE = 1 * MiB;
constexpr size_t WS_MODS = 2 * MiB;
constexpr size_t WS_AFF  = 3 * MiB;
constexpr size_t WS_RL   = 4 * MiB;
constexpr size_t WS_GATE = 5 * MiB;
constexpr size_t WS_INV  = 6 * MiB;
constexpr size_t WS_WIN0 = 8 * MiB;
constexpr size_t WS_WOUT0 = WS_WIN0 + 12 * MiB;
constexpr size_t WS_WIN1 = WS_WOUT0 + 8 * MiB;
constexpr size_t WS_WOUT1 = WS_WIN1 + 24 * MiB;
constexpr size_t WS_WGU = WS_WOUT1 + 8 * MiB;
constexpr size_t WS_WD  = WS_WGU + 512 * MiB;
constexpr size_t WS_H   = WS_WD + 256 * MiB;
constexpr size_t WS_QKV = WS_H + 34 * MiB;
constexpr size_t WS_Y   = WS_QKV + 102 * MiB;
constexpr size_t WS_YO  = WS_Y + 34 * MiB;
constexpr size_t WS_XL  = WS_YO + 68 * MiB;
constexpr size_t WS_XG  = WS_XL + 68 * MiB;
constexpr size_t WS_HM  = WS_XG + 80 * MiB;
constexpr size_t WS_YE  = WS_HM + 80 * MiB;
constexpr size_t WS_END = WS_YE + 80 * MiB;
constexpr int CW_BAR = 4096;

constexpr int RING_BYTES = 131072;
constexpr int LDSCTL_OFF = RING_BYTES, MISC_OFF = LDSCTL_OFF + 320;
constexpr int LDS_BYTES = 147456;

#define LAS __attribute__((address_space(3)))
typedef unsigned short bf16;
typedef unsigned v4u __attribute__((ext_vector_type(4)));
typedef unsigned v2u __attribute__((ext_vector_type(2)));
typedef int v4i __attribute__((ext_vector_type(4)));
typedef float f32x4 __attribute__((ext_vector_type(4)));
__device__ __forceinline__ unsigned f2bf(float f) { unsigned u = __builtin_bit_cast(unsigned, f); return (u + 0x7fffu + ((u >> 16) & 1u)) >> 16; }
__device__ __forceinline__ unsigned pk2(float lo, float hi) { return f2bf(lo) | (f2bf(hi) << 16); }
__device__ __forceinline__ float bf_lo(unsigned w) { return __builtin_bit_cast(float, w << 16); }
__device__ __forceinline__ float bf_hi(unsigned w) { return __builtin_bit_cast(float, w & 0xffff0000u); }

#define XB_TMO      128
#define XB_XCNT(j)  (256  + 64 * (j))
#define XB_XSUB(j)  (1280 + 64 * (j))
#define XB_XGEN(j)  (2304 + 64 * (j))
#define XB_TOP      3328
#define XB_TOPGEN   3392
#define XCD_BAR_WORDS 3456
#define XB_SPIN_CAP (1u << 18)
__device__ __forceinline__ unsigned xb_ld(unsigned* p)              { return __hip_atomic_load(p, __ATOMIC_RELAXED, __HIP_MEMORY_SCOPE_AGENT); }
__device__ __forceinline__ unsigned xb_add(unsigned* p, unsigned v) { return __hip_atomic_fetch_add(p, v, __ATOMIC_RELAXED, __HIP_MEMORY_SCOPE_AGENT); }
__device__ __forceinline__ unsigned xb_xcc_id() { return (unsigned)__builtin_amdgcn_s_getreg((3 << 11) | 20) & 0xFu; }
#define XB_SPIN(cond, bar) do { unsigned _sp = 0; while (cond) { __builtin_amdgcn_s_sleep(1); \
    if ((++_sp & 255u) == 0u) { if (xb_ld(&(bar)[XB_TMO])) break; if (_sp > XB_SPIN_CAP) { atomicAdd(&(bar)[XB_TMO], 1u); break; } } } } while (0)
struct XcdBarrier { unsigned* bar; unsigned x; volatile LAS unsigned* st; };
__device__ __forceinline__ XcdBarrier xcd_barrier_post(unsigned* bar, volatile LAS unsigned* st) {
    XcdBarrier b; b.bar = bar; b.x = xb_xcc_id(); b.st = st;
    if (threadIdx.x == 0) (void)xb_add(&bar[XB_XCNT(b.x)], 1u);
    return b;
}
__device__ __forceinline__ void xcd_barrier_complete(unsigned* bar, unsigned x, unsigned& nloc, unsigned& nx) {
    const unsigned G = gridDim.x * gridDim.y * gridDim.z;
    unsigned sum, cnt, mine, sp = 0u;
    for (;;) {
        sum = 0u; cnt = 0u; mine = 0u;
#pragma unroll
        for (unsigned j = 0; j < 16; ++j) { const unsigned c = xb_ld(&bar[XB_XCNT(j)]); sum += c; cnt += (c > 0u) ? 1u : 0u; mine = (j == x) ? c : mine; }
        if (sum == G) break;
        __builtin_amdgcn_s_sleep(1);
        if ((++sp & 255u) == 0u) { if (xb_ld(&bar[XB_TMO])) break; if (sp > XB_SPIN_CAP) { atomicAdd(&bar[XB_TMO], 1u); break; } }
    }
    nloc = mine > 0u ? mine : 1u; nx = cnt > 0u ? cnt : 1u;
}
__device__ __forceinline__ void xcd_barrier(const XcdBarrier& b) {
    asm volatile("s_waitcnt vmcnt(0)" ::: "memory");
    __syncthreads();
    if (threadIdx.x == 0) {
        unsigned* bar = b.bar;
        __builtin_amdgcn_s_waitcnt(0);
        unsigned nloc = b.st[0], nx = b.st[1];
        if (nloc == 0u) { xcd_barrier_complete(bar, b.x, nloc, nx); b.st[0] = nloc; b.st[1] = nx; }
        const unsigned old = xb_add(&bar[XB_XSUB(b.x)], 1u);
        const unsigned gen = old / nloc;
        if (old + 1u == (gen + 1u) * nloc) {
            __builtin_amdgcn_fence(__ATOMIC_RELEASE, "agent");
            asm volatile("s_waitcnt vmcnt(0)" ::: "memory");
            const unsigned og = xb_add(&bar[XB_TOP], 1u);
            const unsigned tg = og / nx;
            if (og + 1u == (tg + 1u) * nx) xb_add(&bar[XB_TOPGEN], 1u);
            else XB_SPIN(xb_ld(&bar[XB_TOPGEN]) == tg, bar);
            __builtin_amdgcn_fence(__ATOMIC_ACQUIRE, "agent");
            xb_add(&bar[XB_XGEN(b.x)], 1u);
            asm volatile("s_waitcnt vmcnt(0)" ::: "memory");
        } else {
            XB_SPIN(xb_ld(&bar[XB_XGEN(b.x)]) == gen, bar);
            __builtin_amdgcn_fence(__ATOMIC_ACQUIRE, "agent");
            asm volatile("s_waitcnt vmcnt(0)" ::: "memory");
        }
    }
    __syncthreads();
}

struct Args { const float* in[20]; float* out; unsigned char* ws; int ph_lo, ph_hi; };
struct Frame {
    LAS unsigned char* lds;
    int tid, lane, wave, G, gw, NGW;
    unsigned char* ws;
};
template <class T> __device__ __forceinline__ T* fresh(T* p) { asm volatile("" : "+s"(p)); return p; }
__device__ __forceinline__ float wave_sum(float v) {
#pragma unroll
    for (int o = 1; o < 64; o <<= 1) v += __shfl_xor(v, o);
    return v;
}
__device__ __forceinline__ int wave_incl_scan(int v, int lane) {
#pragma unroll
    for (int o = 1; o < 64; o <<= 1) { const int t = __shfl_up(v, o); if (lane >= o) v += t; }
    return v;
}
__device__ __forceinline__ void transpose_item(const float* W, int K, int N, bf16* WT, int k0, int n0, int drow0, LAS float* scr, int lane) {
#pragma unroll 8
    for (int i = 0; i < 32; ++i) { const int kk = 2 * i + (lane >> 5); scr[kk * 33 + (lane & 31)] = W[(size_t)(k0 + kk) * N + n0 + (lane & 31)]; }
    asm volatile("s_waitcnt lgkmcnt(0)" ::: "memory");
    const int c = lane & 7;
#pragma unroll
    for (int j = 0; j < 4; ++j) { const int n = (lane >> 3) + 8 * j; const LAS float* s = scr + (8 * c) * 33 + n;
        v4u o; o.x = pk2(s[0 * 33], s[1 * 33]); o.y = pk2(s[2 * 33], s[3 * 33]); o.z = pk2(s[4 * 33], s[5 * 33]); o.w = pk2(s[6 * 33], s[7 * 33]);
        *(v4u*)(WT + (size_t)(drow0 + n) * K + k0 + 8 * c) = o; }
    asm volatile("s_waitcnt lgkmcnt(0)" ::: "memory");
}
__device__ __forceinline__ void ld_row(const float* p, int lane, f32x4 (&v)[8]) {
#pragma unroll
    for (int j = 0; j < 8; ++j) v[j] = *(const f32x4*)(p + 4 * lane + 256 * j);
}
__device__ __forceinline__ float row_rstd(const f32x4 (&v)[8]) {
    float s = 0.f;
#pragma unroll
    for (int j = 0; j < 8; ++j) s += (v[j].x * v[j].x + v[j].y * v[j].y) + (v[j].z * v[j].z + v[j].w * v[j].w);
    return 1.0f / sqrtf(wave_sum(s) * (1.0f / DM) + EPS);
}
__device__ __forceinline__ void st_row_bf16(bf16* p, int lane, const f32x4 (&v)[8]) {
#pragma unroll
    for (int j = 0; j < 8; ++j) { v2u w; w.x = pk2(v[j].x, v[j].y); w.y = pk2(v[j].z, v[j].w); *(v2u*)(p + 4 * lane + 256 * j) = w; }
}
__device__ __forceinline__ void norm_mod(f32x4 (&h)[8], const f32x4 (&x)[8], float r, const float* g, const float* sc, const float* sh, int lane) {
#pragma unroll
    for (int j = 0; j < 8; ++j) { const int c = 4 * lane + 256 * j; const f32x4 gg = *(const f32x4*)(g + c), s1 = *(const f32x4*)(sc + c), s0 = *(const f32x4*)(sh + c);
        h[j] = x[j] * r * gg * (s1 + 1.0f) + s0; }
}
__device__ __forceinline__ const float* in_row_ptr(const float* x_in, const float* ctx_in, int row) {
    const int b = row / SB, s = row - b * SB;
    return s < CTXL ? ctx_in + ((size_t)(b * CTXL + s)) * DM : x_in + ((size_t)(b * SEQ + s - CTXL)) * DM;
}
__device__ __forceinline__ const float* mods_ptr(const Frame& F, int layer, int row, int chunk) {
    const int b = row / SB, s = row - b * SB; const int vec = s < CTXL ? 2 : b;
    return (const float*)(F.ws + WS_MODS) + ((size_t)(layer * 3 + vec)) * NMOD + chunk * DM;
}

__device__ __forceinline__ void p0_prologue(Frame& F, const float* c_in, const float* c_ctx, const float* mod_w, const float* mod_b, const float* ab_w_in, const float* ab_w_out,
                                            const float* dif_w_in, const float* dif_w_out, const float* w_gate, const float* w_up, const float* w_down) {
    LAS float* sc = (LAS float*)F.lds;
    LAS float* red = (LAS float*)(F.lds + 24576);
    for (int i = F.tid; i < 3 * DM; i += 512) { const int v = i / DM, k = i - v * DM; const float cv = v < 2 ? c_in[v * DM + k] : c_ctx[k]; sc[i] = cv / (1.0f + __expf(-cv)); }
    __syncthreads();
    const int tx = F.tid & 7, ty = F.tid >> 3;
    for (int it = blockIdx.x; it < 2 * 384; it += F.G) {
        const int l = it / 384, sl = it - l * 384;
        const float* wp = mod_w + (size_t)l * DM * NMOD + sl * 32 + tx * 4;
        f32x4 a0 = {0.f, 0.f, 0.f, 0.f}, a1 = a0, a2 = a0;
#pragma unroll 8
        for (int i = 0; i < 32; ++i) { const int k = ty + 64 * i; const f32x4 w = *(const f32x4*)(wp + (size_t)k * NMOD);
            a0 += w * sc[k]; a1 += w * sc[DM + k]; a2 += w * sc[2 * DM + k]; }
        LAS float* rp = red + F.tid * 12;
        rp[0] = a0.x; rp[1] = a0.y; rp[2] = a0.z; rp[3] = a0.w; rp[4] = a1.x; rp[5] = a1.y; rp[6] = a1.z; rp[7] = a1.w; rp[8] = a2.x; rp[9] = a2.y; rp[10] = a2.z; rp[11] = a2.w;
        __syncthreads();
        if (F.tid < 96) { const int v = F.tid >> 5, col = F.tid & 31, txx = col >> 2, jj = col & 3; float s = 0.f;
            for (int t = 0; t < 64; ++t) s += red[(t * 8 + txx) * 12 + v * 4 + jj];
            ((float*)(F.ws + WS_MODS))[((size_t)(l * 3 + v)) * NMOD + sl * 32 + col] = s + mod_b[l * NMOD + sl * 32 + col]; }
        __syncthreads();
    }
    { const int gi = blockIdx.x * 512 + F.tid;
      if (gi < 2048) { const int pos = gi >> 5, f = gi & 31; const float inv = __builtin_amdgcn_exp2f(-(float)f * (13.287712379549449f / 32.0f)); const float ang = (float)pos * inv;
          float* rt = (float*)(F.ws + WS_ROPE); rt[gi] = __cosf(ang); rt[2048 + gi] = __sinf(ang); } }
    __syncthreads();
    LAS float* scr = (LAS float*)(F.lds + F.wave * 16384);
    constexpr int I_IN0 = 32 * 96, I_OUT = 32 * 64, I_IN1 = 32 * 192, I_E = 32 * 64;
    constexpr int NITEMS = I_IN0 + I_OUT + I_IN1 + I_OUT + 2 * 16 * 3 * I_E;
    for (int it = F.gw; it < NITEMS; it += F.NGW) {
        int r = it;
        if (r < I_IN0) { const int kb = r / 96, nb = r % 96; transpose_item(ab_w_in, DM, NQKV0, (bf16*)(F.ws + WS_WIN0), 64 * kb, 32 * nb, 32 * nb, scr, F.lane); continue; } r -= I_IN0;
        if (r < I_OUT) { const int kb = r / 64, nb = r % 64; transpose_item(ab_w_out, DM, DM, (bf16*)(F.ws + WS_WOUT0), 64 * kb, 32 * nb, 32 * nb, scr, F.lane); continue; } r -= I_OUT;
        if (r < I_IN1) { const int kb = r / 192, nb = r % 192; transpose_item(dif_w_in, DM, NQKV1, (bf16*)(F.ws + WS_WIN1), 64 * kb, 32 * nb, 32 * nb, scr, F.lane); continue; } r -= I_IN1;
        if (r < I_OUT) { const int kb = r / 64, nb = r % 64; transpose_item(dif_w_out, DM, DM, (bf16*)(F.ws + WS_WOUT1), 64 * kb, 32 * nb, 32 * nb, scr, F.lane); continue; } r -= I_OUT;
        const int le = r / (3 * I_E), q = r - le * (3 * I_E), which = q / I_E, ii = q - which * I_E, kb = ii / 64, nb = ii % 64;
        const size_t woff = (size_t)le * DM * DM;
        if (which == 2) transpose_item(w_down + woff, DM, DM, (bf16*)(F.ws + WS_WD) + woff, 64 * kb, 32 * nb, 32 * nb, scr, F.lane);
        else { const int n0 = 32 * nb, drow = (n0 >> 7) * 256 + (n0 & 127) + which * 128;
               transpose_item((which ? w_up : w_gate) + woff, DM, DM, (bf16*)(F.ws + WS_WGU) + 2 * woff, 64 * kb, n0, drow, scr, F.lane); }
    }
}

__device__ __forceinline__ void t_norm0(Frame& F, const float* x_in, const float* ctx_in, const float* norm_g) {
    for (int row = F.gw; row < NROWS; row += F.NGW) {
        f32x4 x[8], h[8]; ld_row(in_row_ptr(x_in, ctx_in, row), F.lane, x);
        const float r = row_rstd(x);
        norm_mod(h, x, r, fresh(norm_g), mods_ptr(F, 0, row, 1), mods_ptr(F, 0, row, 0), F.lane);
        st_row_bf16((bf16*)(F.ws + WS_H) + (size_t)row * DM, F.lane, h);
    }
}
__device__ __forceinline__ void t_prep(Frame& F, int layer, const float* q_norm, const float* k_norm) {
    const int ld = layer == 0 ? NQKV0 : NQKV1;
    const float* rt = (const float*)(F.ws + WS_ROPE);
    const int f = F.lane & 31, d0 = (F.lane >> 5) * 64 + f;
    for (int row = F.gw; row < NROWS; row += F.NGW) {
        const int b = row / SB, s = row - b * SB; const bool lat = s >= CTXL;
        if (layer == 1 && !lat) continue;
        float cs = 1.f, sn = 0.f;
        if (lat) { const int t = s - CTXL; const int pos = (F.lane >> 5) ? (t & 63) : (t >> 6); cs = rt[pos * 32 + f]; sn = rt[2048 + pos * 32 + f]; }
        bf16* rp = (bf16*)(F.ws + WS_QKV) + (size_t)row * ld;
        const int nheads = layer == 0 ? 20 : 32;
        for (int hh = 0; hh < nheads; ++hh) {
            int col; const float* g = nullptr;
            if (layer == 0) {
                if (hh < 10) col = hh * 128; else if (hh < 18) { col = 1536 + (hh - 10) * 128; g = q_norm; } else { col = 2560 + (hh - 18) * 128; g = k_norm; }
                if (!lat && g == nullptr) continue;
            } else col = hh * 128;
            float a = bf_lo((unsigned)rp[col + d0]), c2 = bf_lo((unsigned)rp[col + d0 + 32]);
            if (g) { const float ss = wave_sum(a * a + c2 * c2); const float r = 1.0f / sqrtf(ss * (1.0f / 128.0f) + EPS); a = a * r * g[d0]; c2 = c2 * r * g[d0 + 32]; }
            const float o1 = a * cs - c2 * sn, o2 = c2 * cs + a * sn;
            rp[col + d0] = (bf16)f2bf(o1); rp[col + d0 + 32] = (bf16)f2bf(o2);
        }
    }
}
__device__ __forceinline__ void t_subln(Frame& F, const float* dif_lambda, const float* dif_subln) {
    const float* lp = dif_lambda;
    const float s01 = wave_sum(lp[F.lane] * lp[128 + F.lane] + lp[64 + F.lane] * lp[192 + F.lane]);
    const float s23 = wave_sum(lp[256 + F.lane] * lp[384 + F.lane] + lp[320 + F.lane] * lp[448 + F.lane]);
    const float lam = __expf(s01) - __expf(s23) + LAMBDA_INIT;
    for (int i = F.gw; i < NBATCH * SEQ; i += F.NGW) {
        const int b = i / SEQ, row = b * SB + CTXL + (i - b * SEQ);
        f32x4 v[8], w[8]; ld_row((const float*)(F.ws + WS_YO) + (size_t)row * DM, F.lane, v); ld_row((const float*)(F.ws + WS_XG) + (size_t)row * DM, F.lane, w);
        const f32x4 g = *(const f32x4*)(fresh(dif_subln) + 4 * F.lane);
#pragma unroll
        for (int j = 0; j < 8; ++j) { v[j] = v[j] - w[j] * lam;
            const float ss = wave_sum((v[j].x * v[j].x + v[j].y * v[j].y) + (v[j].z * v[j].z + v[j].w * v[j].w));
            const float r = (1.0f - LAMBDA_INIT) / sqrtf(ss * (1.0f / 256.0f) + EPS); v[j] = v[j] * r * g; }
        st_row_bf16((bf16*)(F.ws + WS_Y) + (size_t)row * DM, F.lane, v);
    }
}
__device__ __forceinline__ void t_post_attn(Frame& F, int layer, const float* x_in, const float* ctx_in, const float* norm_g, const float* router_w) {
    const float* ng0 = norm_g + (size_t)layer * 4 * DM;
    const float* wr0 = router_w + (size_t)layer * DM * NEXP;
    for (int row = F.gw; row < NROWS; row += F.NGW) {
        const int b = row / SB, s = row - b * SB;
        if (layer == 1 && s < CTXL) continue;
        const float* ng = fresh(ng0); const float* wr = fresh(wr0);
        f32x4 y[8], x[8], h[8];
        ld_row((const float*)(F.ws + WS_YO) + (size_t)row * DM, F.lane, y);
        ld_row(layer == 0 ? in_row_ptr(x_in, ctx_in, row) : (const float*)(F.ws + WS_XL) + (size_t)row * DM, F.lane, x);
        const float ry = row_rstd(y);
        const float* ga = mods_ptr(F, layer, row, 2);
#pragma unroll
        for (int j = 0; j < 8; ++j) { const int c = 4 * F.lane + 256 * j; x[j] = x[j] + *(const f32x4*)(ga + c) * (y[j] * ry * *(const f32x4*)(ng + DM + c)); }
        float* xl = (float*)(F.ws + WS_XL) + (size_t)row * DM;
#pragma unroll
        for (int j = 0; j < 8; ++j) *(f32x4*)(xl + 4 * F.lane + 256 * j) = x[j];
        const float rx = row_rstd(x);
        norm_mod(h, x, rx, ng + 2 * DM, mods_ptr(F, layer, row, 4), mods_ptr(F, layer, row, 3), F.lane);
        st_row_bf16((bf16*)(F.ws + WS_H) + (size_t)row * DM, F.lane, h);
        float lg[16];
#pragma unroll
        for (int e = 0; e < 16; ++e) lg[e] = 0.f;
#pragma unroll
        for (int j = 0; j < 8; ++j) {
            asm volatile("" ::: "memory");
#pragma unroll
            for (int i = 0; i < 4; ++i) { const float hv = h[j][i]; const float* wp = wr + (size_t)(4 * F.lane + 256 * j + i) * NEXP;
                const f32x4 w0 = *(const f32x4*)wp, w1 = *(const f32x4*)(wp + 4), w2 = *(const f32x4*)(wp + 8), w3 = *(const f32x4*)(wp + 12);
                lg[0] += hv * w0.x; lg[1] += hv * w0.y; lg[2] += hv * w0.z; lg[3] += hv * w0.w; lg[4] += hv * w1.x; lg[5] += hv * w1.y; lg[6] += hv * w1.z; lg[7] += hv * w1.w;
                lg[8] += hv * w2.x; lg[9] += hv * w2.y; lg[10] += hv * w2.z; lg[11] += hv * w2.w; lg[12] += hv * w3.x; lg[13] += hv * w3.y; lg[14] += hv * w3.z; lg[15] += hv * w3.w; } }
        float mx = -1e30f;
#pragma unroll
        for (int e = 0; e < 16; ++e) { lg[e] = wave_sum(lg[e]); mx = fmaxf(mx, lg[e]); }
        float sum = 0.f;
#pragma unroll
        for (int e = 0; e < 16; ++e) { lg[e] = __expf(lg[e] - mx); sum += lg[e]; }
        const float rs = 1.0f / sum;
        float* aff = (float*)(F.ws + WS_AFF) + (size_t)b * NEXP * SB + s;
#pragma unroll
        for (int e = 0; e < 16; ++e) if (F.lane == e) aff[(size_t)e * SB] = lg[e] * rs;
    }
}
template <int VPT>
__device__ __forceinline__ void topk_problem(Frame& F, const float* vals, int N, int cap, int e, int rowbase, int slotbase, bool write_inv) {
    LAS int* hist = (LAS int*)F.lds;
    LAS int* wt = (LAS int*)(F.lds + 1024);
    LAS int* selw = (LAS int*)(F.lds + 1280);
    float v[VPT]; unsigned key[VPT];
#pragma unroll
    for (int k = 0; k < VPT; ++k) { const int i = F.tid * VPT + k; const bool ok = i < N; v[k] = ok ? vals[i] : 0.f; const unsigned u = __builtin_bit_cast(unsigned, v[k]);
        key[k] = ok ? ((u & 0x80000000u) ? ~u : (u | 0x80000000u)) : 0u; }
    unsigned prefix = 0u, maskb = 0u; int need = cap;
    for (int pass = 0; pass < 4; ++pass) {
        const int shift = 24 - 8 * pass;
        if (F.tid < 256) hist[F.tid] = 0;
        __syncthreads();
#pragma unroll
        for (int k = 0; k < VPT; ++k) { const int i = F.tid * VPT + k; if (i < N && (key[k] & maskb) == prefix) __hip_atomic_fetch_add(&hist[(key[k] >> shift) & 255u], 1, __ATOMIC_RELAXED, __HIP_MEMORY_SCOPE_WORKGROUP); }
        __syncthreads();
        if (F.wave == 0) {
            const int l = F.lane; const int h0 = hist[255 - 4 * l], h1 = hist[254 - 4 * l], h2 = hist[253 - 4 * l], h3 = hist[252 - 4 * l];
            const int sm = h0 + h1 + h2 + h3; const int incl = wave_incl_scan(sm, l); const int excl = incl - sm;
            const unsigned long long m = __ballot(incl >= need); const int fl = m ? (__ffsll((long long)m) - 1) : 63;
            if (l == fl) { int c = excl, bin;
                if (c + h0 >= need) bin = 255 - 4 * l; else { c += h0; if (c + h1 >= need) bin = 254 - 4 * l; else { c += h1; if (c + h2 >= need) bin = 253 - 4 * l; else { c += h2; bin = 252 - 4 * l; } } }
                selw[0] = bin; selw[1] = need - c; }
        }
        __syncthreads();
        prefix |= ((unsigned)selw[0]) << shift; maskb |= 0xFFu << shift; need = selw[1];
        __syncthreads();
    }
    int ceq = 0;
#pragma unroll
    for (int k = 0; k < VPT; ++k) { const int i = F.tid * VPT + k; if (i < N && key[k] == prefix) ++ceq; }
    int incl = wave_incl_scan(ceq, F.lane);
    if (F.lane == 63) wt[F.wave] = incl;
    __syncthreads();
    int eqbase = incl - ceq;
    for (int w = 0; w < F.wave; ++w) eqbase += wt[w];
    int csel = 0; bool sel[VPT];
#pragma unroll
    for (int k = 0; k < VPT; ++k) { const int i = F.tid * VPT + k; const bool ok = i < N; const bool eq = ok && key[k] == prefix;
        sel[k] = ok && (key[k] > prefix || (eq && eqbase < need)); if (eq) ++eqbase; if (sel[k]) ++csel; }
    incl = wave_incl_scan(csel, F.lane);
    if (F.lane == 63) wt[8 + F.wave] = incl;
    __syncthreads();
    int sbase = incl - csel;
    for (int w = 0; w < F.wave; ++w) sbase += wt[8 + w];
    int* RL = (int*)(F.ws + WS_RL) + e * EROWS; float* GT = (float*)(F.ws + WS_GATE) + e * EROWS; int* INV = (int*)(F.ws + WS_INV);
#pragma unroll
    for (int k = 0; k < VPT; ++k) { const int i = F.tid * VPT + k;
        if (i < N) { const int grow = rowbase + i;
            if (sel[k]) { const int slot = slotbase + sbase; ++sbase; RL[slot] = grow; GT[slot] = v[k]; if (write_inv) INV[grow * 16 + e] = slot; }
            else if (write_inv) INV[grow * 16 + e] = -1; } }
    __syncthreads();
}
__device__ __forceinline__ void t_topk(Frame& F, int layer) {
    const int nprob = layer == 0 ? 64 : 32;
    for (int p = blockIdx.x; p < nprob; p += F.G) {
        const int kind = p >> 5, q = p & 31, b = q >> 4, e = q & 15;
        const float* aff = (const float*)(F.ws + WS_AFF) + ((size_t)(b * NEXP + e)) * SB;
        if (kind == 0) topk_problem<8>(F, aff + CTXL, SEQ, CAP_L, e, b * SB + CTXL, b * CAP_L, true);
        else           topk_problem<1>(F, aff, CTXL, CAP_C, e, b * SB, 2 * CAP_L + b * CAP_C, true);
    }
}
__device__ __forceinline__ void t_gather(Frame& F, int layer) {
    const int np = layer == 0 ? 1280 : 1024, nvalid = layer == 0 ? 1088 : 1024;
    const int* RL = (const int*)(F.ws + WS_RL);
    for (int i = F.gw; i < NEXP * np; i += F.NGW) {
        const int e = i / np, slot = i - e * np;
        v4u* dst = (v4u*)((bf16*)(F.ws + WS_XG) + ((size_t)(e * EROWS + slot)) * DM) + F.lane;
        if (slot < nvalid) { const int src = RL[e * EROWS + slot]; const v4u* sp = (const v4u*)((const bf16*)(F.ws + WS_H) + (size_t)src * DM) + F.lane;
#pragma unroll
            for (int j = 0; j < 4; ++j) dst[64 * j] = sp[64 * j];
        } else {
#pragma unroll
            for (int j = 0; j < 4; ++j) dst[64 * j] = (v4u){0u, 0u, 0u, 0u};
        }
    }
}
__device__ __forceinline__ void t_post_moe(Frame& F, int layer, const float* norm_g, float* out) {
    const float* ng0 = norm_g + (size_t)layer * 4 * DM;
    const int* INV = (const int*)(F.ws + WS_INV); const float* GT = (const float*)(F.ws + WS_GATE);
    for (int row = F.gw; row < NROWS; row += F.NGW) {
        const int b = row / SB, s = row - b * SB;
        if (layer == 1 && s < CTXL) continue;
        const float* ng = fresh(ng0); const float* ng1 = fresh(norm_g + 4 * DM);
        f32x4 mo[8], x[8];
#pragma unroll
        for (int j = 0; j < 8; ++j) mo[j] = (f32x4){0.f, 0.f, 0.f, 0.f};
        const v4i* ip = (const v4i*)(INV + (size_t)row * 16);
        const v4i i0 = ip[0], i1 = ip[1], i2 = ip[2], i3 = ip[3];
        const int sl[16] = {i0.x, i0.y, i0.z, i0.w, i1.x, i1.y, i1.z, i1.w, i2.x, i2.y, i2.z, i2.w, i3.x, i3.y, i3.z, i3.w};
#pragma unroll
        for (int e = 0; e < 16; ++e) { const int slot = sl[e];
            if (slot >= 0) { const float g = GT[e * EROWS + slot]; const bf16* yp = (const bf16*)(F.ws + WS_YE) + ((size_t)(e * EROWS + slot)) * DM + 4 * F.lane;
#pragma unroll
                for (int j = 0; j < 8; ++j) { const v2u w = *(const v2u*)(yp + 256 * j); mo[j].x += g * bf_lo(w.x); mo[j].y += g * bf_hi(w.x); mo[j].z += g * bf_lo(w.y); mo[j].w += g * bf_hi(w.y); } } }
        ld_row((const float*)(F.ws + WS_XL) + (size_t)row * DM, F.lane, x);
        const float rm = row_rstd(mo);
        const float* gf = mods_ptr(F, layer, row, 5);
#pragma unroll
        for (int j = 0; j < 8; ++j) { const int c = 4 * F.lane + 256 * j; x[j] = x[j] + *(const f32x4*)(gf + c) * (mo[j] * rm * *(const f32x4*)(ng + 3 * DM + c)); }
        if (layer == 0) {
            float* xl = (float*)(F.ws + WS_XL) + (size_t)row * DM;
#pragma unroll
            for (int j = 0; j < 8; ++j) *(f32x4*)(xl + 4 * F.lane + 256 * j) = x[j];
            f32x4 h[8]; const float rx = row_rstd(x);
            norm_mod(h, x, rx, ng1, mods_ptr(F, 1, row, 1), mods_ptr(F, 1, row, 0), F.lane);
            st_row_bf16((bf16*)(F.ws + WS_H) + (size_t)row * DM, F.lane, h);
        } else {
            float* op = out + ((size_t)(b * SEQ + s - CTXL)) * DM;
#pragma unroll
            for (int j = 0; j < 8; ++j) *(f32x4*)(op + 4 * F.lane + 256 * j) = x[j];
        }
    }
}

__device__ __forceinline__ void p_attn0(Frame& F, const float* ab_sink) {
    char* lds = (char*)F.lds;
    const bf16* QKV = (const bf16*)(F.ws + WS_QKV); bf16* Y = (bf16*)(F.ws + WS_Y);
    const int c = blockIdx.x;
    for (int u = c; u < 544; u += F.G) {
        att::Job J; J.kb0 = CTXL; J.mask = 0; J.dq = 0; J.use_sink = 0; J.sink_l2 = 0.f; J.lam = 0.f;
        int b, h, grpB; size_t qrow;
        if (u < 512) {
            const int uu = u & 255, x = uu & 7, i = uu >> 3, grp = x >> 1, idx = (x & 1) * 32 + i;
            b = grp >> 1; const int kv = grp & 1; h = kv * 4 + (idx >> 4); const int qb = idx & 15; grpB = u < 256;
            qrow = (size_t)b * SB + CTXL + qb * 256;
            if (grpB) J.NT = 68;
            else { const int q0 = qb * 256, lo = q0 - 128 < 0 ? 0 : q0 - 128, hiK = q0 + 384 > SEQ ? SEQ : q0 + 384;
                   J.NT = 4 + (hiK - lo) / 64; J.kb0 = CTXL + lo; J.mask = 1; J.dq = lo - q0; }
        } else { const int uu = u - 512; grpB = uu >> 4; b = (uu >> 3) & 1; h = uu & 7; qrow = (size_t)b * SB; J.NT = 4; }
        const int kv = h >> 2;
        if (!grpB) { J.use_sink = 1; J.sink_l2 = ab_sink[h] * 1.4426950408889634f; }
        const int qcol = grpB ? 1536 + h * 128 : h * 128, kcol = grpB ? 2560 + kv * 128 : 1024 + kv * 128, vcol = grpB ? 2816 + kv * 128 : 1280 + kv * 128;
        J.Q = QKV + qrow * NQKV0 + qcol; J.K = QKV + (size_t)b * SB * NQKV0 + kcol; J.V = QKV + (size_t)b * SB * NQKV0 + vcol;
        J.O = (void*)(Y + qrow * DM + (grpB ? 1024 : 0) + h * 128);
        __syncthreads();
        att::attn_unit<NQKV0, 0>(J, lds);
    }
}
__device__ __forceinline__ void p_attn1(Frame& F) {
    char* lds = (char*)F.lds;
    const bf16* QKV = (const bf16*)(F.ws + WS_QKV);
    for (int u = blockIdx.x; u < 1024; u += F.G) {
        const int x = u & 7, i = u >> 3;
        const int b = x >> 2, hp = x & 3, h = hp * 2 + ((i >> 6) & 1), m = (i >> 5) & 1, half = (i >> 4) & 1, qb = i & 15;
        const size_t qrow = (size_t)b * SB + CTXL + qb * 256;
        float* O = (float*)(F.ws + (m ? WS_XG : WS_YO));
        att::Job J; J.kb0 = CTXL; J.mask = 0; J.dq = 0; J.use_sink = 0; J.sink_l2 = 0.f; J.lam = 0.f; J.NT = 68;
        J.V = QKV + (size_t)b * SB * NQKV1 + 4096 + h * 256 + half * 128;
        J.O = (void*)(O + qrow * DM + h * 256 + half * 128);
        J.Q = QKV + qrow * NQKV1 + (2 * h + m) * 128; J.K = QKV + (size_t)b * SB * NQKV1 + 2048 + (2 * h + m) * 128;
        __syncthreads();
        att::attn_unit<NQKV1, 1>(J, lds);
    }
}

#define IN(k) (lo <= (k) && (k) < hi)
#define SEAM(k) do { if (IN((k) + 1)) xcd_barrier(bar); } while (0)
#define INP(k) ({ int k_ = (k); asm volatile("" : "+s"(k_)); args.in[k_]; })
#define FRESH() do { asm volatile("" : "+s"(F.ws)); } while (0)
template <int layer>
__device__ __forceinline__ void layer_phases(Frame& F, const Args& args, const int lo, const int hi, const XcdBarrier& bar) {

        const int pb = 2 + 11 * layer;
        if (IN(pb + 0)) {
            FRESH();
            pg8::Gemm g{(const pg8::bf16_t*)(F.ws + WS_H), (const pg8::bf16_t*)(F.ws + (layer == 0 ? WS_WIN0 : WS_WIN1)), NROWS, layer == 0 ? NQKV0 : NQKV1, DM};
            pg8::DenseOrder S; S.init(NROWS / 256, (layer == 0 ? NQKV0 : NQKV1) / 256, F.G, (int)blockIdx.x, 0);
            pg8::EpiStoreBf16 E{(pg8::bf16_t*)(F.ws + WS_QKV), layer == 0 ? NQKV0 : NQKV1, 1 << 20};
            pg8::gemm_phase<pg8::EpiStoreBf16, pg8::DenseOrder, true, true>(F.lds, g, S, E);
            SEAM(pb + 0);
        }
        if (IN(pb + 1)) { FRESH(); t_prep(F, layer, INP(10), INP(11)); SEAM(pb + 1); }
        if (IN(pb + 2)) { FRESH(); if (layer == 0) p_attn0(F, INP(9)); else p_attn1(F); SEAM(pb + 2); }
        if (IN(pb + 3)) { if (layer == 1) { FRESH(); t_subln(F, INP(14), INP(15)); SEAM(pb + 3); } }
        if (IN(pb + 4)) {
            FRESH();
            pg8::Gemm g{(const pg8::bf16_t*)(F.ws + WS_Y), (const pg8::bf16_t*)(F.ws + (layer == 0 ? WS_WOUT0 : WS_WOUT1)), NROWS, DM, DM};
            pg8::DenseOrder S; S.init(layer == 0 ? 34 : 32, DM / 256, F.G, (int)blockIdx.x, layer);
            pg8::EpiStoreF32 E{(float*)(F.ws + WS_YO), DM};
            pg8::gemm_phase<pg8::EpiStoreF32, pg8::DenseOrder, true, true>(F.lds, g, S, E);
            SEAM(pb + 4);
        }
        if (IN(pb + 5)) { FRESH(); t_post_attn(F, layer, INP(0), INP(2), INP(6), INP(16)); SEAM(pb + 5); }
        if (IN(pb + 6)) { FRESH(); t_topk(F, layer); SEAM(pb + 6); }
        if (IN(pb + 7)) { FRESH(); t_gather(F, layer); SEAM(pb + 7); }
        if (IN(pb + 8)) {
            FRESH();
            pg8::Gemm g{(const pg8::bf16_t*)(F.ws + WS_XG), (const pg8::bf16_t*)(F.ws + WS_WGU) + (size_t)layer * 16 * 4096 * DM, 16 * EROWS, 16 * 4096, DM};
            pg8::MoeOrder S; S.init(layer == 0 ? 5 : 4, 16, F.G, (int)blockIdx.x);
            pg8::EpiSwiGLU E{(pg8::bf16_t*)(F.ws + WS_HM), DM};
            pg8::gemm_phase<pg8::EpiSwiGLU, pg8::MoeOrder, true, true>(F.lds, g, S, E);
            SEAM(pb + 8);
        }
        if (IN(pb + 9)) {
            FRESH();
            pg8::Gemm g{(const pg8::bf16_t*)(F.ws + WS_HM), (const pg8::bf16_t*)(F.ws + WS_WD) + (size_t)layer * 16 * DM * DM, 16 * EROWS, 16 * DM, DM};
            pg8::MoeOrder S; S.init(layer == 0 ? 5 : 4, 8, F.G, (int)blockIdx.x);
            pg8::EpiStoreBf16 E{(pg8::bf16_t*)(F.ws + WS_YE), DM, 8};
            pg8::gemm_phase<pg8::EpiStoreBf16, pg8::MoeOrder, true, true>(F.lds, g, S, E);
            SEAM(pb + 9);
        }
        if (IN(pb + 10)) { FRESH(); t_post_moe(F, layer, INP(6), args.out); SEAM(pb + 10); }
}
constexpr int NPHASE = 24;
__global__ void __launch_bounds__(NWAVES * 64, 2) fwd(Args args) {
    extern __shared__ __attribute__((aligned(16))) unsigned char lds[];
    Frame F;
    F.lds = (LAS unsigned char*)lds;
    F.tid = threadIdx.x; F.lane = F.tid & 63; F.wave = __builtin_amdgcn_readfirstlane(F.tid >> 6);
    F.G = gridDim.x; F.gw = blockIdx.x * NWAVES + F.wave; F.NGW = F.G * NWAVES;
    F.ws = args.ws;
    volatile LAS unsigned* MISC = (volatile LAS unsigned*)(F.lds + MISC_OFF);
    for (int u = F.tid; u < (LDS_BYTES - LDSCTL_OFF) / 4; u += NWAVES * 64) ((LAS unsigned*)(F.lds + LDSCTL_OFF))[u] = 0u;
    __syncthreads();
    const int lo = args.ph_lo, hi = args.ph_hi;
    const bool multi = (hi - lo) > 1;
    XcdBarrier bar; bar.bar = (unsigned*)(F.ws + WS_CTL) + CW_BAR; bar.x = 0; bar.st = nullptr;
    if (multi) bar = xcd_barrier_post((unsigned*)(F.ws + WS_CTL) + CW_BAR, MISC + 8);

    if (IN(0)) { FRESH(); p0_prologue(F, INP(1), INP(3), INP(4), INP(5), INP(7), INP(8), INP(12), INP(13), INP(17), INP(18), INP(19)); SEAM(0); }
    if (IN(1)) { FRESH(); t_norm0(F, INP(0), INP(2), INP(6)); SEAM(1); }
    layer_phases<0>(F, args, lo, hi, bar);
    layer_phases<1>(F, args, lo, hi, bar);
}

extern "C" void kernel_launch(void* const* d_in, const int* in_sizes, int n_in, void* d_out, int out_size, void* d_ws, size_t ws_size, hipStream_t stream) {
    static int grid = 0;
    if (grid == 0) {
        if (n_in != 20 || out_size != NBATCH * SEQ * DM || ws_size < WS_END) { fprintf(stderr, "kernel_launch: shape mismatch (n_in %d out %d ws %zu need %zu)\n", n_in, out_size, ws_size, (size_t)WS_END); grid = -1; return; }
        int dev = 0, cus = 0, per_cu = 0;
        if (hipGetDevice(&dev) != hipSuccess || hipDeviceGetAttribute(&cus, hipDeviceAttributeMultiprocessorCount, dev) != hipSuccess) { grid = -1; return; }
        if (hipFuncSetAttribute((const void*)fwd, hipFuncAttributeMaxDynamicSharedMemorySize, LDS_BYTES) != hipSuccess) { fprintf(stderr, "kernel_launch: hipFuncSetAttribute failed\n"); grid = -1; return; }
        if (hipOccupancyMaxActiveBlocksPerMultiprocessor(&per_cu, (const void*)fwd, NWAVES * 64, LDS_BYTES) != hipSuccess || per_cu < 1)
            fprintf(stderr, "kernel_launch: note: occupancy query reports %d workgroups per CU\n", per_cu);
        (void)hipGetLastError();
        grid = cus;
    }
    if (grid < 0) return;
    if (hipMemsetAsync((char*)d_ws + WS_CTL, 0, CTL_ZERO_BYTES, stream) != hipSuccess) return;
    Args a{};
    for (int i = 0; i < 20; ++i) a.in[i] = (const float*)d_in[i];
    a.out = (float*)d_out; a.ws = (unsigned char*)d_ws;
#if MK_ONE_LAUNCH
    a.ph_lo = 0; a.ph_hi = NPHASE;
    hipLaunchKernelGGL(fwd, dim3(grid), dim3(NWAVES * 64), LDS_BYTES, stream, a);
#else
    for (int ph = 0; ph < NPHASE; ++ph) {
        if (ph == 5) continue;
        a.ph_lo = ph; a.ph_hi = ph + 1;
        hipLaunchKernelGGL(fwd, dim3(grid), dim3(NWAVES * 64), LDS_BYTES, stream, a);
    }
#endif
    const hipError_t le = hipPeekAtLastError();
    if (le != hipSuccess) fprintf(stderr, "kernel_launch: launch failed: %s\n", hipGetErrorName(le));
}
```

```cpp
#include <hip/hip_runtime.h>
#include <cstdio>
#include <cstdint>

#ifndef MK_ONE_LAUNCH
#define MK_ONE_LAUNCH 1
#endif

namespace pg8 {
#define PG8_LAS __attribute__((address_space(3)))
typedef unsigned short bf16_t;
typedef short bf16x8 __attribute__((ext_vector_type(8)));
typedef float f32x4 __attribute__((ext_vector_type(4)));
typedef unsigned u32x4 __attribute__((ext_vector_type(4)));
constexpr int BM = 256, BK = 64, HALF = 128, HTB = HALF * BK * 2  , STAGE_BYTES = 8 * HTB, NXCD = 8, WGM = 8;

__host__ __device__ __forceinline__ int lds_byte(int r, int c) { const int st = (r >> 4) * 2 + (c >> 5), rr = r & 15, cc = c & 31, ob = rr * 64 + cc * 2; return st * 1024 + (ob ^ (((ob >> 9) & 1) << 5)); }
__host__ __device__ __forceinline__ void stage_rc(int b, int& R, int& C) { const int st = b / 1024, sb = b % 1024, swz = sb ^ (((sb >> 9) & 1) << 5); R = (st >> 1) * 16 + swz / 64; C = (st & 1) * 32 + (swz % 64) / 2; }
__host__ __device__ __forceinline__ int perm32(int rho) { const int n = rho >> 4, i = rho & 15; return 8 * (i >> 2) + 4 * n + (i & 3); }

struct Unit { int pm, pn; };
struct Gemm { const bf16_t* A; const bf16_t* Bt; int M, N, K; };

struct StaticOrder {
    int nM, nN, nwg, G, c;
    __host__ __device__ void init(int M, int N, int G_, int c_) { nM = M / BM; nN = N / BM; nwg = nM * nN; G = G_; c = c_; }
    __host__ __device__ bool next(int i, Unit& u) const {
        const long L = (long)i * G + c; if (L >= nwg) return false;
        int wgid = (int)L; { const int q = nwg / NXCD, r = nwg % NXCD, xcd = wgid % NXCD, off = wgid / NXCD; wgid = (xcd < r ? xcd * (q + 1) : r * (q + 1) + (xcd - r) * q) + off; }
        const int nig = WGM * nN, gid = wgid / nig, fm = gid * WGM, gsz = (nM - fm) < WGM ? (nM - fm) : WGM;
        u.pm = fm + ((wgid % nig) % gsz); u.pn = (wgid % nig) / gsz; return true;
    }
    __device__ __forceinline__ void a_ready(const Unit&) const {}
    __device__ __forceinline__ void done(const Unit&) const {}
};

__device__ __forceinline__ unsigned cvt_pk_bf16(float lo, float hi) { unsigned r; asm volatile("v_cvt_pk_bf16_f32 %0, %1, %2" : "=v"(r) : "v"(lo), "v"(hi)); return r; }
struct DenseOrder {
    StaticOrder so; int kind;
    __device__ void init(int nM, int nN, int G_, int c_, int kind_) { so.init(nM * BM, nN * BM, G_, c_); kind = kind_; }
    __device__ bool next(int i, Unit& u) const {
        if (!so.next(i, u)) return false;
        if (kind == 1) { const int b = u.pm >> 4, j = u.pm & 15; u.pm = 17 * b + 1 + j; }
        return true;
    }
    __device__ __forceinline__ void a_ready(const Unit&) const {}
    __device__ __forceinline__ void done(const Unit&) const {}
};
struct MoeOrder {
    int NP, NJ, nU, G, c;
    __device__ void init(int NP_, int NJ_, int G_, int c_) { NP = NP_; NJ = NJ_; nU = 16 * NP_ * NJ_; G = G_; c = c_; }
    __device__ bool next(int i, Unit& u) const {
        const int L = i * G + c; if (L >= nU) return false;
        const int xcd = L & 7, off = L >> 3, id = xcd * (nU >> 3) + off;
        const int per = NJ * NP, e = id / per, rem = id - e * per, j = rem / NP, p = rem - j * NP;
        u.pm = 5 * e + p; u.pn = NJ * e + j; return true;
    }
    __device__ __forceinline__ void a_ready(const Unit&) const {}
    __device__ __forceinline__ void done(const Unit&) const {}
};

struct EpiStoreBf16 {
    static constexpr bool PERM = true, AFTER_DRAIN = false;
    bf16_t* O; int ldc; int nmod;
    __device__ __forceinline__ void operator()(const f32x4 (&acc)[2][2][4][2], const Unit& u, int wr, int wc, int fr, int fq) const {
        const int row0 = u.pm * BM + wr * 64 + fr, col0 = (u.pn % nmod) * BM + wc * 32 + 8 * fq;
#pragma unroll
        for (int ai = 0; ai < 2; ++ai)
#pragma unroll
            for (int m = 0; m < 4; ++m) { bf16_t* rowp = O + (size_t)(row0 + ai * HALF + m * 16) * ldc + col0;
#pragma unroll
                for (int bj = 0; bj < 2; ++bj) { const f32x4 v0 = acc[ai][bj][m][0], v1 = acc[ai][bj][m][1];
                    u32x4 w; w.x = cvt_pk_bf16(v0[0], v0[1]); w.y = cvt_pk_bf16(v0[2], v0[3]); w.z = cvt_pk_bf16(v1[0], v1[1]); w.w = cvt_pk_bf16(v1[2], v1[3]);
                    *(u32x4*)(rowp + bj * HALF) = w; } }
    }
};
struct EpiStoreF32 {
    static constexpr bool PERM = true, AFTER_DRAIN = false;
    float* O; int ldc;
    __device__ __forceinline__ void operator()(const f32x4 (&acc)[2][2][4][2], const Unit& u, int wr, int wc, int fr, int fq) const {
        const int row0 = u.pm * BM + wr * 64 + fr, col0 = u.pn * BM + wc * 32 + 8 * fq;
#pragma unroll
        for (int ai = 0; ai < 2; ++ai)
#pragma unroll
            for (int m = 0; m < 4; ++m) { float* rowp = O + (size_t)(row0 + ai * HALF + m * 16) * ldc + col0;
#pragma unroll
                for (int bj = 0; bj < 2; ++bj) { *(f32x4*)(rowp + bj * HALF) = acc[ai][bj][m][0]; *(f32x4*)(rowp + bj * HALF + 4) = acc[ai][bj][m][1]; } }
    }
};
__device__ __forceinline__ float silu_f(float g) { return g * __builtin_amdgcn_rcpf(1.0f + __builtin_amdgcn_exp2f(-1.4426950408889634f * g)); }
struct EpiSwiGLU {
    static constexpr bool PERM = true, AFTER_DRAIN = false;
    bf16_t* O; int ldc;
    __device__ __forceinline__ void operator()(const f32x4 (&acc)[2][2][4][2], const Unit& u, int wr, int wc, int fr, int fq) const {
        const int row0 = u.pm * BM + wr * 64 + fr, col0 = (u.pn & 15) * HALF + wc * 32 + 8 * fq;
#pragma unroll
        for (int ai = 0; ai < 2; ++ai)
#pragma unroll
            for (int m = 0; m < 4; ++m) { bf16_t* rowp = O + (size_t)(row0 + ai * HALF + m * 16) * ldc + col0;
                const f32x4 g0 = acc[ai][0][m][0], g1 = acc[ai][0][m][1], u0 = acc[ai][1][m][0], u1 = acc[ai][1][m][1];
                u32x4 w;
                w.x = cvt_pk_bf16(silu_f(g0[0]) * u0[0], silu_f(g0[1]) * u0[1]); w.y = cvt_pk_bf16(silu_f(g0[2]) * u0[2], silu_f(g0[3]) * u0[3]);
                w.z = cvt_pk_bf16(silu_f(g1[0]) * u1[0], silu_f(g1[1]) * u1[1]); w.w = cvt_pk_bf16(silu_f(g1[2]) * u1[2], silu_f(g1[3]) * u1[3]);
                *(u32x4*)rowp = w; }
    }
};

template <class Epi, class Sched, bool ALIGN_EPI = false, bool SP2 = false>
__device__ __forceinline__ void gemm_phase(PG8_LAS unsigned char* lds, const Gemm g, const Sched& S, const Epi& E) {
    const int tid = threadIdx.x, wid = __builtin_amdgcn_readfirstlane(tid >> 6), lane = tid & 63, wr = wid >> 2, wc = wid & 3, fr = lane & 15, fq = lane >> 4;
    const int K = g.K, nt = K / BK;
    unsigned voffA[2], voffB[2];
#pragma unroll
    for (int i = 0; i < 2; ++i) { int R, C; stage_rc(tid * 16 + i * 8192, R, C); const int Rb = Epi::PERM ? ((R & ~31) + perm32(R & 31)) : R;
        voffA[i] = (unsigned)(R * K + C) * 2u; voffB[i] = (unsigned)(Rb * K + C) * 2u; }
    const size_t kstep = (size_t)(BK * 2);
    const size_t hstep = (size_t)HALF * K * 2;
    const size_t tstep = 2 * hstep;
    const unsigned ldsw = (unsigned)wid * 1024u;
    const int aoff = lds_byte(wr * 64 + fr, fq * 8), boff = lds_byte(wc * 32 + fr, fq * 8);
#define PG8_SA(b, h) (((b) * 2 + (h)) * HTB)
#define PG8_SB(b, h) ((4 + (b) * 2 + (h)) * HTB)
#define PG8_STAGE(bufoff, gbase, voff) do { _Pragma("unroll") for (int _i = 0; _i < 2; ++_i) \
        __builtin_amdgcn_global_load_lds((const unsigned*)((const char*)(gbase) + (voff)[_i]), (PG8_LAS unsigned*)(lds + (bufoff) + ldsw + _i * 8192), 16, 0, 0); } while (0)
#define PG8_LDA(dst, b, h) do { _Pragma("unroll") for (int m = 0; m < 4; ++m) _Pragma("unroll") for (int k = 0; k < 2; ++k) dst[m][k] = *(const PG8_LAS bf16x8*)(lds + PG8_SA(b, h) + aoff + m * 2048 + k * 1024); } while (0)
#define PG8_LDB(dst, b, h) do { _Pragma("unroll") for (int n = 0; n < 2; ++n) _Pragma("unroll") for (int k = 0; k < 2; ++k) dst[n][k] = *(const PG8_LAS bf16x8*)(lds + PG8_SB(b, h) + boff + n * 2048 + k * 1024); } while (0)
#define PG8_MMA(ai, bj, At, Bt) do { __builtin_amdgcn_s_setprio(1); _Pragma("unroll") for (int m = 0; m < 4; ++m) _Pragma("unroll") for (int n = 0; n < 2; ++n) _Pragma("unroll") for (int k = 0; k < 2; ++k) \
        acc[ai][bj][m][n] = __builtin_amdgcn_mfma_f32_16x16x32_bf16(Bt[n][k], At[m][k], acc[ai][bj][m][n], 0, 0, 0); __builtin_amdgcn_s_setprio(0); } while (0)
#define PG8_WAIT_V(n) asm volatile("s_waitcnt vmcnt(" #n ")" ::: "memory")
#define PG8_WAIT_L(n) asm volatile("s_waitcnt lgkmcnt(" #n ")" ::: "memory")
#define PG8_BAR __builtin_amdgcn_s_barrier()
#define PG8_SCHED __builtin_amdgcn_sched_barrier(0)
    Unit cur, nxt; int ui = 0;
    if (!S.next(0, cur)) return;
    f32x4 acc[2][2][4][2];
#pragma unroll
    for (int a = 0; a < 2; ++a)
#pragma unroll
        for (int b = 0; b < 2; ++b)
#pragma unroll
            for (int m = 0; m < 4; ++m)
#pragma unroll
                for (int n = 0; n < 2; ++n) acc[a][b][m][n] = (f32x4){0.f, 0.f, 0.f, 0.f};
    bf16x8 At[4][2], B0[2][2], B1[2][2];
    const char* cA = (const char*)g.A + (size_t)cur.pm * tstep; const char* cB = (const char*)g.Bt + (size_t)cur.pn * tstep;
    S.a_ready(cur);
    if constexpr (SP2) {
        PG8_STAGE(PG8_SB(0, 0), cB, voffB); PG8_STAGE(PG8_SB(0, 1), cB + hstep, voffB); PG8_STAGE(PG8_SA(0, 0), cA, voffA); PG8_STAGE(PG8_SA(0, 1), cA + hstep, voffA);
        if (wr == 1) PG8_BAR;
        PG8_WAIT_V(2); PG8_BAR;
        PG8_STAGE(PG8_SB(1, 0), cB + kstep, voffB); PG8_STAGE(PG8_SA(1, 0), cA + kstep, voffA); PG8_STAGE(PG8_SB(1, 1), cB + hstep + kstep, voffB);
        PG8_WAIT_V(6); PG8_BAR;
    } else {
        PG8_STAGE(PG8_SB(0, 0), cB, voffB); PG8_STAGE(PG8_SA(0, 0), cA, voffA); PG8_STAGE(PG8_SB(0, 1), cB + hstep, voffB); PG8_STAGE(PG8_SA(0, 1), cA + hstep, voffA);
        if (wr == 1) PG8_BAR;
        PG8_WAIT_V(4); PG8_BAR;
        PG8_STAGE(PG8_SB(1, 0), cB + kstep, voffB); PG8_STAGE(PG8_SA(1, 0), cA + kstep, voffA); PG8_STAGE(PG8_SB(1, 1), cB + hstep + kstep, voffB);
        PG8_WAIT_V(6); PG8_BAR;
    }
    for (;;) {
        const bool has_next = S.next(ui + 1, nxt);
        const char* nA = has_next ? (const char*)g.A + (size_t)nxt.pm * tstep : cA; const char* nB = has_next ? (const char*)g.Bt + (size_t)nxt.pn * tstep : cB;
        for (int t = 0; t < nt; t += 2) {
            const bool last = (t == nt - 2);
            const char* a1 = cA + (size_t)(t + 1) * kstep;
            const char* a2 = last ? nA : cA + (size_t)(t + 2) * kstep; const char* b2 = last ? nB : cB + (size_t)(t + 2) * kstep;
            const char* a3 = a2 + kstep; const char* b3 = b2 + kstep;
            if (last && has_next) S.a_ready(nxt);
            if constexpr (SP2) {
            PG8_LDB(B0, 0, 0); PG8_LDB(B1, 0, 1); PG8_SCHED; PG8_LDA(At, 0, 0); PG8_STAGE(PG8_SA(1, 1), a1 + hstep, voffA);
            PG8_WAIT_V(8); PG8_WAIT_L(0); PG8_BAR; PG8_MMA(0, 0, At, B0); PG8_MMA(0, 1, At, B1); PG8_BAR; PG8_SCHED;
            PG8_LDA(At, 0, 1); PG8_STAGE(PG8_SB(0, 0), b2, voffB); PG8_STAGE(PG8_SB(0, 1), b2 + hstep, voffB); PG8_STAGE(PG8_SA(0, 0), a2, voffA);
            PG8_WAIT_V(8); PG8_WAIT_L(0); PG8_BAR; PG8_MMA(1, 0, At, B0); PG8_MMA(1, 1, At, B1); PG8_BAR; PG8_SCHED;
            PG8_LDB(B0, 1, 0); PG8_LDB(B1, 1, 1); PG8_SCHED; PG8_LDA(At, 1, 0); PG8_STAGE(PG8_SA(0, 1), a2 + hstep, voffA);
            PG8_WAIT_V(8); PG8_WAIT_L(0); PG8_BAR; PG8_MMA(0, 0, At, B0); PG8_MMA(0, 1, At, B1); PG8_BAR; PG8_SCHED;
            PG8_LDA(At, 1, 1); PG8_STAGE(PG8_SB(1, 0), b3, voffB); PG8_STAGE(PG8_SB(1, 1), b3 + hstep, voffB); PG8_STAGE(PG8_SA(1, 0), a3, voffA);
            PG8_WAIT_V(8); PG8_WAIT_L(0); PG8_BAR; PG8_MMA(1, 0, At, B0); PG8_MMA(1, 1, At, B1); PG8_BAR; PG8_SCHED;
            } else {
            PG8_LDB(B0, 0, 0); PG8_SCHED; PG8_LDA(At, 0, 0); PG8_STAGE(PG8_SA(1, 1), a1 + hstep, voffA);
            PG8_WAIT_L(8); PG8_BAR; PG8_WAIT_L(0); PG8_MMA(0, 0, At, B0); PG8_BAR; PG8_SCHED;
            PG8_LDB(B1, 0, 1); PG8_STAGE(PG8_SB(0, 0), b2, voffB);
            PG8_BAR; PG8_WAIT_L(0); PG8_MMA(0, 1, At, B1); PG8_BAR;
            PG8_LDA(At, 0, 1); PG8_STAGE(PG8_SA(0, 0), a2, voffA);
            PG8_BAR; PG8_WAIT_L(0); PG8_MMA(1, 0, At, B0); PG8_BAR; PG8_SCHED;
            PG8_STAGE(PG8_SB(0, 1), b2 + hstep, voffB);
            PG8_WAIT_V(6); PG8_BAR; PG8_MMA(1, 1, At, B1); PG8_BAR;
            PG8_LDB(B0, 1, 0); PG8_SCHED; PG8_LDA(At, 1, 0); PG8_STAGE(PG8_SA(0, 1), a2 + hstep, voffA);
            PG8_WAIT_L(8); PG8_BAR; PG8_WAIT_L(0); PG8_MMA(0, 0, At, B0); PG8_BAR; PG8_SCHED;
            PG8_LDB(B1, 1, 1); PG8_STAGE(PG8_SB(1, 0), b3, voffB);
            PG8_BAR; PG8_WAIT_L(0); PG8_MMA(0, 1, At, B1); PG8_BAR;
            PG8_LDA(At, 1, 1); PG8_STAGE(PG8_SA(1, 0), a3, voffA);
            PG8_BAR; PG8_WAIT_L(0); PG8_MMA(1, 0, At, B0); PG8_BAR; PG8_SCHED;
            PG8_STAGE(PG8_SB(1, 1), b3 + hstep, voffB);
            PG8_WAIT_V(6); PG8_BAR; PG8_MMA(1, 1, At, B1); PG8_BAR;
            }
        }
        if constexpr (ALIGN_EPI) { if (wr == 0) PG8_BAR; }
        if constexpr (!Epi::AFTER_DRAIN) { E(acc, cur, wr, wc, fr, fq); S.done(cur); }
        if (!has_next) break;
#pragma unroll
        for (int a = 0; a < 2; ++a)
#pragma unroll
            for (int b = 0; b < 2; ++b)
#pragma unroll
                for (int m = 0; m < 4; ++m)
#pragma unroll
                    for (int n = 0; n < 2; ++n) acc[a][b][m][n] = (f32x4){0.f, 0.f, 0.f, 0.f};
        cur = nxt; cA = nA; cB = nB; ++ui;
        if constexpr (ALIGN_EPI) { if (wr == 1) PG8_BAR; }
    }
    PG8_WAIT_V(0);
    if constexpr (!ALIGN_EPI) { if (wr == 0) PG8_BAR; }
    PG8_BAR;
    if constexpr (Epi::AFTER_DRAIN) { E.fused(acc, cur, wr, wc, fr, fq, lds, wid, lane); S.done(cur); }
#undef PG8_SA
#undef PG8_SB
#undef PG8_STAGE
#undef PG8_LDA
#undef PG8_LDB
#undef PG8_MMA
#undef PG8_WAIT_V
#undef PG8_WAIT_L
#undef PG8_BAR
#undef PG8_SCHED
}
template <int LDW_> struct BDense { static constexpr int LDW = LDW_; const float* W; __device__ __forceinline__ void ptrs(const Unit& u, const float*& b0, const float*& b1) const { b0 = W + (size_t)u.pn * 256; b1 = b0 + 128; } };
struct BMoeGU { static constexpr int LDW = 2048; const float* G; const float* U; __device__ __forceinline__ void ptrs(const Unit& u, const float*& b0, const float*& b1) const {
    const size_t o = (size_t)(u.pn >> 4) * 2048 * 2048 + (size_t)(u.pn & 15) * 128; b0 = G + o; b1 = U + o; } };
struct BMoeDn { static constexpr int LDW = 2048; const float* W; __device__ __forceinline__ void ptrs(const Unit& u, const float*& b0, const float*& b1) const {
    b0 = W + (size_t)(u.pn >> 3) * 2048 * 2048 + (size_t)(u.pn & 7) * 256; b1 = b0 + 128; } };
typedef float f32x2 __attribute__((ext_vector_type(2)));
typedef __bf16 bf16x2_t __attribute__((ext_vector_type(2)));
__device__ __forceinline__ unsigned cvt_pk_c(float lo, float hi) { f32x2 v = {lo, hi}; bf16x2_t b = __builtin_convertvector(v, bf16x2_t); return __builtin_bit_cast(unsigned, b); }

template <class Epi, class Sched, class BMap, bool ALIGN_EPI = true>
__device__ __forceinline__ void gemm_phase_w(PG8_LAS unsigned char* lds, const bf16_t* Ag, const int K, const BMap BM_, const Sched& S, const Epi& E) {
    static_assert(Epi::PERM && !Epi::AFTER_DRAIN, "gemm_phase_w: PERM epilogues only");
    const int tid = threadIdx.x, wid = __builtin_amdgcn_readfirstlane(tid >> 6), lane = tid & 63, wr = wid >> 2, wc = wid & 3, fr = lane & 15, fq = lane >> 4;
    const int nt = K / BK;
    unsigned voffA[2];
#pragma unroll
    for (int i = 0; i < 2; ++i) { int R, C; stage_rc(tid * 16 + i * 8192, R, C); voffA[i] = (unsigned)(R * K + C) * 2u; }
    const size_t kstep = (size_t)(BK * 2);
    const size_t hstep = (size_t)HALF * K * 2;
    const size_t tstep = 2 * hstep;
    const unsigned ldsw = (unsigned)wid * 1024u;
    const int aoff = lds_byte(wr * 64 + fr, fq * 8), boff = lds_byte(wc * 32 + fr, fq * 8);
    constexpr int ldw = BMap::LDW;
    const int bh = wid >> 2, cb = (wid >> 1) & 1, kh = wid & 1, bq = lane & 15, bch = lane >> 4;
    const unsigned blane = (unsigned)(bch * 8 * ldw + 4 * bq) * 4u;
    const size_t bkt = (size_t)BK * ldw;
    const int bslab = 64 * cb + 32 * kh * ldw;
    const int rho0 = 32 * (2 * cb + (bq >> 3)) + 16 * (bq & 1) + 4 * ((bq & 7) >> 1), bs = (bq & 1) + 2 * (bq >> 3);
    const bool rot1 = (bs & 1) != 0, rot2 = (bs & 2) != 0;
    unsigned wadr[4];
#pragma unroll
    for (int j = 0; j < 4; ++j) wadr[j] = (unsigned)(uintptr_t)lds + (unsigned)(4 * HTB + bh * HTB + lds_byte(rho0 + ((j + bs) & 3), 32 * kh + 8 * bch));
#define PG8_SA(b, h) (((b) * 2 + (h)) * HTB)
#define PG8_SB(b, h) ((4 + (b) * 2 + (h)) * HTB)
#define PG8_STAGE(bufoff, gbase, voff) do { _Pragma("unroll") for (int _i = 0; _i < 2; ++_i) \
        __builtin_amdgcn_global_load_lds((const unsigned*)((const char*)(gbase) + (voff)[_i]), (PG8_LAS unsigned*)(lds + (bufoff) + ldsw + _i * 8192), 16, 0, 0); } while (0)
#define PG8_LDA(dst, b, h) do { _Pragma("unroll") for (int m = 0; m < 4; ++m) _Pragma("unroll") for (int k = 0; k < 2; ++k) dst[m][k] = *(const PG8_LAS bf16x8*)(lds + PG8_SA(b, h) + aoff + m * 2048 + k * 1024); } while (0)
#define PG8_LDB(dst, b, h) do { _Pragma("unroll") for (int n = 0; n < 2; ++n) _Pragma("unroll") for (int k = 0; k < 2; ++k) dst[n][k] = *(const PG8_LAS bf16x8*)(lds + PG8_SB(b, h) + boff + n * 2048 + k * 1024); } while (0)
#define PG8_MMA(ai, bj, At, Bt) do { __builtin_amdgcn_s_setprio(1); _Pragma("unroll") for (int m = 0; m < 4; ++m) _Pragma("unroll") for (int n = 0; n < 2; ++n) _Pragma("unroll") for (int k = 0; k < 2; ++k) \
        acc[ai][bj][m][n] = __builtin_amdgcn_mfma_f32_16x16x32_bf16(Bt[n][k], At[m][k], acc[ai][bj][m][n], 0, 0, 0); __builtin_amdgcn_s_setprio(0); } while (0)
#define PG8_WAIT_V(n) asm volatile("s_waitcnt vmcnt(" #n ")" ::: "memory")
#define PG8_WAIT_L(n) asm volatile("s_waitcnt lgkmcnt(" #n ")" ::: "memory")
#define PG8_BAR __builtin_amdgcn_s_barrier()
#define PG8_SCHED __builtin_amdgcn_sched_barrier(0)
#define PG8_GAS __attribute__((address_space(1)))
#define PG8_BLOAD(sb) do { const PG8_GAS char* sb_ = (const PG8_GAS char*)(sb); _Pragma("unroll") for (int kk = 0; kk < 8; ++kk) { \
        const PG8_GAS char* p_ = sb_ + (size_t)(kk * ldw * 4); asm volatile("global_load_dwordx4 %0, %1, %2" : "=v"(breg[kk]) : "v"(blane), "s"(p_) : "memory"); } } while (0)
#define PG8_BWRITE(b) do { u32x4 d_[4]; _Pragma("unroll") for (int i = 0; i < 4; ++i) { \
        d_[i].x = cvt_pk_bf16(breg[0][i], breg[1][i]); d_[i].y = cvt_pk_bf16(breg[2][i], breg[3][i]); d_[i].z = cvt_pk_bf16(breg[4][i], breg[5][i]); d_[i].w = cvt_pk_bf16(breg[6][i], breg[7][i]); } \
        u32x4 t_[4]; _Pragma("unroll") for (int j = 0; j < 4; ++j) { const u32x4 a_ = d_[j], b_ = d_[(j + 1) & 3]; t_[j].x = rot1 ? b_.x : a_.x; t_[j].y = rot1 ? b_.y : a_.y; t_[j].z = rot1 ? b_.z : a_.z; t_[j].w = rot1 ? b_.w : a_.w; } \
        _Pragma("unroll") for (int j = 0; j < 4; ++j) { const u32x4 a_ = t_[j], b_ = t_[(j + 2) & 3]; u32x4 e_; e_.x = rot2 ? b_.x : a_.x; e_.y = rot2 ? b_.y : a_.y; e_.z = rot2 ? b_.z : a_.z; e_.w = rot2 ? b_.w : a_.w; \
            asm volatile("ds_write_b128 %0, %1 offset:%2" :: "v"(wadr[j]), "v"(e_), "i"((b) * 2 * HTB) : "memory"); } } while (0)
    Unit cur, nxt; int ui = 0;
    if (!S.next(0, cur)) return;
    f32x4 acc[2][2][4][2];
#pragma unroll
    for (int a = 0; a < 2; ++a)
#pragma unroll
        for (int b = 0; b < 2; ++b)
#pragma unroll
            for (int m = 0; m < 4; ++m)
#pragma unroll
                for (int n = 0; n < 2; ++n) acc[a][b][m][n] = (f32x4){0.f, 0.f, 0.f, 0.f};
    bf16x8 At[4][2], B0[2][2], B1[2][2];
    f32x4 breg[8];
    const char* cA = (const char*)Ag + (size_t)cur.pm * tstep;
    const float* cB; { const float *b0, *b1; BM_.ptrs(cur, b0, b1); cB = (bh ? b1 : b0) + bslab; }
    S.a_ready(cur);
    PG8_STAGE(PG8_SA(0, 0), cA, voffA); PG8_STAGE(PG8_SA(0, 1), cA + hstep, voffA);
    PG8_BLOAD(cB);
    PG8_WAIT_V(0); PG8_BWRITE(0);
    PG8_BLOAD(cB + bkt);
    PG8_STAGE(PG8_SA(1, 0), cA + kstep, voffA);
    PG8_WAIT_V(0); PG8_WAIT_L(0);
    if (wr == 1) PG8_BAR;
    PG8_BAR;
    PG8_BAR;
    for (;;) {
        const bool has_next = S.next(ui + 1, nxt);
        const char* nA = has_next ? (const char*)Ag + (size_t)nxt.pm * tstep : cA;
        const float* nB = cB; if (has_next) { const float *b0, *b1; BM_.ptrs(nxt, b0, b1); nB = (bh ? b1 : b0) + bslab; }
        for (int t = 0; t < nt; t += 2) {
            const bool last = (t == nt - 2);
            const char* a1 = cA + (size_t)(t + 1) * kstep;
            const char* a2 = last ? nA : cA + (size_t)(t + 2) * kstep;
            const char* a3 = a2 + kstep;
            const float* b2 = last ? nB : cB + (size_t)(t + 2) * bkt;
            const float* b3 = b2 + bkt;
            if (last && has_next) S.a_ready(nxt);
            PG8_LDB(B0, 0, 0); PG8_LDB(B1, 0, 1); PG8_SCHED; PG8_LDA(At, 0, 0); PG8_STAGE(PG8_SA(1, 1), a1 + hstep, voffA);
            PG8_WAIT_V(12); PG8_WAIT_L(0); PG8_BAR; PG8_MMA(0, 0, At, B0); PG8_MMA(0, 1, At, B1); PG8_BAR; PG8_SCHED;
            PG8_LDA(At, 0, 1); PG8_WAIT_V(4); PG8_BWRITE(1); PG8_BLOAD(b2); PG8_STAGE(PG8_SA(0, 0), a2, voffA);
            PG8_WAIT_V(12); PG8_WAIT_L(0); PG8_BAR; PG8_MMA(1, 0, At, B0); PG8_MMA(1, 1, At, B1); PG8_BAR; PG8_SCHED;
            PG8_LDB(B0, 1, 0); PG8_LDB(B1, 1, 1); PG8_SCHED; PG8_LDA(At, 1, 0); PG8_STAGE(PG8_SA(0, 1), a2 + hstep, voffA);
            PG8_WAIT_V(12); PG8_WAIT_L(0); PG8_BAR; PG8_MMA(0, 0, At, B0); PG8_MMA(0, 1, At, B1); PG8_BAR; PG8_SCHED;
            PG8_LDA(At, 1, 1); PG8_WAIT_V(4); PG8_BWRITE(0); PG8_BLOAD(b3); PG8_STAGE(PG8_SA(1, 0), a3, voffA);
            PG8_WAIT_V(12); PG8_WAIT_L(0); PG8_BAR; PG8_MMA(1, 0, At, B0); PG8_MMA(1, 1, At, B1); PG8_BAR; PG8_SCHED;
        }
        if constexpr (ALIGN_EPI) { if (wr == 0) PG8_BAR; }
        E(acc, cur, wr, wc, fr, fq); S.done(cur);
        if (!has_next) break;
#pragma unroll
        for (int a = 0; a < 2; ++a)
#pragma unroll
            for (int b = 0; b < 2; ++b)
#pragma unroll
                for (int m = 0; m < 4; ++m)
#pragma unroll
                    for (int n = 0; n < 2; ++n) acc[a][b][m][n] = (f32x4){0.f, 0.f, 0.f, 0.f};
        cur = nxt; cA = nA; cB = nB; ++ui;
        if constexpr (ALIGN_EPI) { if (wr == 1) PG8_BAR; }
    }
    PG8_WAIT_V(0);
    if constexpr (!ALIGN_EPI) { if (wr == 0) PG8_BAR; }
    PG8_BAR;
#undef PG8_SA
#undef PG8_SB
#undef PG8_STAGE
#undef PG8_LDA
#undef PG8_LDB
#undef PG8_MMA
#undef PG8_WAIT_V
#undef PG8_WAIT_L
#undef PG8_BAR
#undef PG8_SCHED
#undef PG8_BLOAD
#undef PG8_GAS
#undef PG8_BWRITE
}
}
namespace att {
using bf16x8 = __attribute__((ext_vector_type(8))) short;
using s16x4  = __attribute__((ext_vector_type(4))) short;
using f32x16 = __attribute__((ext_vector_type(16))) float;
using u32x4  = __attribute__((ext_vector_type(4))) unsigned;
typedef unsigned short bf16;
constexpr int D = 128, NW = 8, QBLK = 32, KVBLK = 64;
constexpr float SCALE = 0.088388347648318440f;
constexpr float THR = 8.f;
constexpr int SHM_V = KVBLK * D * 2, SHM_K = KVBLK * D * 2, SHM_ATTN = 2 * SHM_V + 2 * SHM_K + NW * 64 * 4;
#define KSWZ(row, colB) ((row) * 256 + ((colB) ^ (((row) & 7) << 4)))
#define SBAR() __builtin_amdgcn_sched_barrier(0)
__device__ __forceinline__ int crow(int r, int hi) { return (r & 3) + 8 * (r >> 2) + 4 * hi; }
__device__ __forceinline__ unsigned cvtpk(float lo, float hi) { unsigned r; asm volatile("v_cvt_pk_bf16_f32 %0, %1, %2" : "=v"(r) : "v"(lo), "v"(hi)); return r; }

__device__ __forceinline__ void partialSM(f32x16& p0, f32x16& p1, float& m_reg, float& mn, float& alpha, bool domask, int dm, int hi) {
  constexpr float C = SCALE * 1.4426950408889634f;
  if (domask) {
    const int db = dm + 4 * hi + 128;
#pragma unroll
    for (int r = 0; r < 16; ++r) { const int d0 = db + (r & 3) + 8 * (r >> 2);
      if ((unsigned)d0 > 256u) p0[r] = -1e30f; if ((unsigned)(d0 + 32) > 256u) p1[r] = -1e30f; }
  }
  float pmax = p0[0];
#pragma unroll
  for (int r = 1; r < 16; ++r) pmax = fmaxf(pmax, p0[r]);
#pragma unroll
  for (int r = 0; r < 16; ++r) pmax = fmaxf(pmax, p1[r]);
  { auto rr = __builtin_amdgcn_permlane32_swap(__float_as_uint(pmax), __float_as_uint(pmax), false, false);
    pmax = fmaxf(__uint_as_float(rr[0]), __uint_as_float(rr[1])); }
  if (__builtin_expect(__all(pmax - m_reg <= THR / SCALE), 1)) { mn = m_reg; alpha = 1.f; }
  else { mn = fmaxf(m_reg, pmax); alpha = __builtin_amdgcn_exp2f((m_reg - mn) * C); m_reg = mn; }
  float mnC = -mn * C;
#pragma unroll
  for (int r = 0; r < 16; ++r) p0[r] = fmaf(p0[r], C, mnC);
#pragma unroll
  for (int r = 0; r < 16; ++r) p1[r] = fmaf(p1[r], C, mnC);
#pragma unroll
  for (int r = 0; r < 16; ++r) p0[r] = __builtin_amdgcn_exp2f(p0[r]);
}
__device__ __forceinline__ void finishSM(f32x16& p0, f32x16& p1, float alpha, float& l_reg, bf16x8& pa0, bf16x8& pa1, bf16x8& pa2, bf16x8& pa3) {
#pragma unroll
  for (int r = 0; r < 16; ++r) p1[r] = __builtin_amdgcn_exp2f(p1[r]);
  float ps = 0;
#pragma unroll
  for (int r = 0; r < 16; ++r) ps += p0[r];
#pragma unroll
  for (int r = 0; r < 16; ++r) ps += p1[r];
  { auto rr = __builtin_amdgcn_permlane32_swap(__float_as_uint(ps), __float_as_uint(ps), false, false);
    ps = __uint_as_float(rr[0]) + __uint_as_float(rr[1]); }
  l_reg = l_reg * alpha + ps;
#define PK4(P, BASE, OUT) do { unsigned a0 = cvtpk(P[BASE + 0], P[BASE + 1]), a1 = cvtpk(P[BASE + 2], P[BASE + 3]);   \
    unsigned b0 = cvtpk(P[BASE + 4], P[BASE + 5]), b1 = cvtpk(P[BASE + 6], P[BASE + 7]);                              \
    auto r0 = __builtin_amdgcn_permlane32_swap(a0, b0, false, false); auto r1 = __builtin_amdgcn_permlane32_swap(a1, b1, false, false); \
    u32x4 w = {r0[0], r1[0], r0[1], r1[1]}; OUT = *reinterpret_cast<bf16x8*>(&w); } while (0)
  PK4(p0, 0, pa0); PK4(p0, 8, pa1); PK4(p1, 0, pa2); PK4(p1, 8, pa3);
#undef PK4
}
__device__ __forceinline__ void qkt(f32x16& p0, f32x16& p1, const char* Ks, const bf16x8* qr, int r32, int hi) {
  p0 = f32x16{}; p1 = f32x16{};
#pragma unroll
  for (int d0 = 0; d0 < 8; ++d0) { int cb = (d0 * 16 + hi * 8) * 2;
    bf16x8 b0 = *reinterpret_cast<const bf16x8*>(Ks + KSWZ(r32, cb));
    bf16x8 b1 = *reinterpret_cast<const bf16x8*>(Ks + KSWZ(32 + r32, cb));
    p0 = __builtin_amdgcn_mfma_f32_32x32x16_bf16(b0, qr[d0], p0, 0, 0, 0);
    p1 = __builtin_amdgcn_mfma_f32_32x32x16_bf16(b1, qr[d0], p1, 0, 0, 0); }
}
__device__ __forceinline__ int v_st(int k, int c) { const int kk = (k & ~0xC) | ((k & 4) << 1) | ((k & 8) >> 1); return ((kk >> 3) * 4 + (c >> 5)) * 512 + ((kk & 7) * 32 + (c & 31)) * 2; }
__device__ __forceinline__ int v_rd_base(int lane) { return ((lane & 3) << 3) | (((lane >> 2) & 3) << 6) | (((lane >> 4) & 1) << 5) | (((lane >> 5) & 1) << 8); }
constexpr int v_rd_off(int d0, int ks, int half) { return d0 * 512 + ks * 4096 + half * 2048; }
template <int OFF> __device__ __forceinline__ s16x4 tr_read(int vb) {
  s16x4 r; asm volatile("ds_read_b64_tr_b16 %0, %1 offset:%2" : "=&v"(r) : "v"(vb), "i"(OFF) : "memory"); return r;
}
template <int D0> __device__ __forceinline__ void pv_one(f32x16& od, int vb, bf16x8 pa0, bf16x8 pa1, bf16x8 pa2, bf16x8 pa3) {
  const s16x4 l0 = tr_read<v_rd_off(D0, 0, 0)>(vb), h0 = tr_read<v_rd_off(D0, 0, 1)>(vb), l1 = tr_read<v_rd_off(D0, 1, 0)>(vb), h1 = tr_read<v_rd_off(D0, 1, 1)>(vb);
  const s16x4 l2 = tr_read<v_rd_off(D0, 2, 0)>(vb), h2 = tr_read<v_rd_off(D0, 2, 1)>(vb), l3 = tr_read<v_rd_off(D0, 3, 0)>(vb), h3 = tr_read<v_rd_off(D0, 3, 1)>(vb);
  asm volatile("s_waitcnt lgkmcnt(0)" ::: "memory"); SBAR();
#define PK(L, H) (bf16x8){L[0], L[1], L[2], L[3], H[0], H[1], H[2], H[3]}
  od = __builtin_amdgcn_mfma_f32_32x32x16_bf16(pa0, PK(l0, h0), od, 0, 0, 0);
  od = __builtin_amdgcn_mfma_f32_32x32x16_bf16(pa1, PK(l1, h1), od, 0, 0, 0);
  od = __builtin_amdgcn_mfma_f32_32x32x16_bf16(pa2, PK(l2, h2), od, 0, 0, 0);
  od = __builtin_amdgcn_mfma_f32_32x32x16_bf16(pa3, PK(l3, h3), od, 0, 0, 0);
#undef PK
}
__device__ __forceinline__ void pv_d0(f32x16* o, int vb, bf16x8 pa0, bf16x8 pa1, bf16x8 pa2, bf16x8 pa3) {
  pv_one<0>(o[0], vb, pa0, pa1, pa2, pa3); pv_one<1>(o[1], vb, pa0, pa1, pa2, pa3); pv_one<2>(o[2], vb, pa0, pa1, pa2, pa3); pv_one<3>(o[3], vb, pa0, pa1, pa2, pa3);
}

struct Job {
  const bf16* Q;
  const bf16* K; const bf16* V;
  int NT;
  int kb0;
  int mask;
  int dq;
  int use_sink; float sink_l2;
  void* O; float lam;
};

template <int LD, int OMODE>
__device__ __forceinline__ void attn_unit(const Job& J, char* lds) {
  constexpr int LDO = 2048;
  const int tid = threadIdx.x, wid = tid >> 6, lane = tid & 63, r32 = lane & 31, hi = lane >> 5;
  char* V_lds = lds; char* K_lds = lds + 2 * SHM_V;
  float* ws = (float*)(lds + 2 * SHM_V + 2 * SHM_K) + wid * 64; float* li_l = ws; float* al_l = ws + 32;
  float m_reg = -1e30f, l_reg = 0; f32x16 o[4] = {}; bf16x8 qr[8];
  const bf16* Qw = J.Q + (long)(wid * QBLK + r32) * LD + hi * 8;
#pragma unroll
  for (int d0 = 0; d0 < 8; ++d0) qr[d0] = *reinterpret_cast<const bf16x8*>(Qw + d0 * 16);
  const int sr = tid >> 4, sc = (tid & 15) * 8, vst0 = v_st(sr, sc), vst1 = v_st(32 + sr, sc);
  const int vb0 = (int)(uintptr_t)V_lds + v_rd_base(lane);
  const int toff = sr * LD + sc;
  constexpr int ldk = LD; const int kb0 = J.kb0, NT = J.NT;
  const bf16* Kh = J.K; const bf16* Vh = J.V;
  const bool msk = J.mask != 0;
  const int dml = J.dq - (wid * QBLK + r32);
  struct { bf16x8 vs0, vs1, ks0, ks1; } sr_[2];
#define KROWT(t) ((t) < 4 ? (t) * 64 : kb0 + ((t) - 4) * 64)
#define SLOAD(i, t) do { const int k0_ = KROWT(t); const bf16* vp_ = Vh + (size_t)k0_ * ldk + toff; const bf16* kp_ = Kh + (size_t)k0_ * ldk + toff; sr_[i].vs0 = *(const bf16x8*)vp_; sr_[i].vs1 = *(const bf16x8*)(vp_ + 32 * ldk); \
    sr_[i].ks0 = *(const bf16x8*)kp_; sr_[i].ks1 = *(const bf16x8*)(kp_ + 32 * ldk); } while (0)
#define SWRITE(b, i) do { *(bf16x8*)(V_lds + (b) * SHM_V + vst0) = sr_[i].vs0;          \
    *(bf16x8*)(V_lds + (b) * SHM_V + vst1) = sr_[i].vs1; int kc = sc * 2;               \
    *(bf16x8*)(K_lds + (b) * SHM_K + KSWZ(sr, kc)) = sr_[i].ks0;                       \
    *(bf16x8*)(K_lds + (b) * SHM_K + KSWZ(32 + sr, kc)) = sr_[i].ks1; } while (0)
#define SWAIT() asm volatile("s_waitcnt vmcnt(4)" ::: "memory")
#define RESC(a) do { if (__any((a) < 1.f)) { if (hi == 0) al_l[r32] = (a); asm volatile("s_waitcnt lgkmcnt(0)" ::: "memory"); \
    _Pragma("unroll") for (int d = 0; d < 4; ++d) _Pragma("unroll") for (int r = 0; r < 16; ++r) o[d][r] *= al_l[crow(r, hi)]; } } while (0)
#define MSK(t) (msk && (t) >= 4), (dml + ((t) - 4) * 64)
  f32x16 pA0, pA1, pB0, pB1; float mnA, mnB, alA, alB; bf16x8 pa0, pa1, pa2, pa3;
  constexpr int SE = 0, SO = 1;
  SLOAD(SE, 0); asm volatile("s_waitcnt vmcnt(0)" ::: "memory"); SWRITE(0, SE); __syncthreads();
  qkt(pA0, pA1, K_lds, qr, r32, hi); partialSM(pA0, pA1, m_reg, mnA, alA, false, 0, hi);
  SLOAD(SO, 1); if (2 < NT) SLOAD(SE, 2);
  SWAIT(); SWRITE(1, SO); __syncthreads();
  for (int j = 1; j + 1 < NT; j += 2) {
    SBAR(); qkt(pB0, pB1, K_lds + SHM_K, qr, r32, hi);
    finishSM(pA0, pA1, alA, l_reg, pa0, pa1, pa2, pa3); SBAR();
    SLOAD(SO, j + 2); SBAR();
    pv_d0(o, vb0, pa0, pa1, pa2, pa3); partialSM(pB0, pB1, m_reg, mnB, alB, MSK(j), hi);
    __syncthreads(); SWAIT(); SWRITE(0, SE);
    RESC(alB); __syncthreads();
    SBAR(); qkt(pA0, pA1, K_lds, qr, r32, hi);
    finishSM(pB0, pB1, alB, l_reg, pa0, pa1, pa2, pa3); SBAR();
    if (j + 3 < NT) SLOAD(SE, j + 3); SBAR();
    pv_d0(o, vb0 + SHM_V, pa0, pa1, pa2, pa3); partialSM(pA0, pA1, m_reg, mnA, alA, MSK(j + 1), hi);
    __syncthreads(); SWAIT(); SWRITE(1, SO);
    RESC(alA); __syncthreads();
  }
  SBAR(); qkt(pB0, pB1, K_lds + SHM_K, qr, r32, hi);
  finishSM(pA0, pA1, alA, l_reg, pa0, pa1, pa2, pa3); SBAR();
  pv_d0(o, vb0, pa0, pa1, pa2, pa3); partialSM(pB0, pB1, m_reg, mnB, alB, MSK(NT - 1), hi);
  __syncthreads(); RESC(alB);
  finishSM(pB0, pB1, alB, l_reg, pa0, pa1, pa2, pa3); SBAR();
  pv_d0(o, vb0 + SHM_V, pa0, pa1, pa2, pa3);
  if (J.use_sink) l_reg += __builtin_amdgcn_exp2f(J.sink_l2 - m_reg * (SCALE * 1.4426950408889634f));
  if (hi == 0) li_l[r32] = l_reg; asm volatile("s_waitcnt lgkmcnt(0)" ::: "memory");
  float rli[16];
#pragma unroll
  for (int r = 0; r < 16; ++r) rli[r] = __builtin_amdgcn_rcpf(li_l[crow(r, hi)]);
  if constexpr (OMODE == 0) {
    bf16* Ow = (bf16*)J.O + (long)(wid * QBLK) * LDO + r32;
#pragma unroll
    for (int r = 0; r < 16; ++r) { const int orow = crow(r, hi);
#pragma unroll
      for (int d0 = 0; d0 < 4; ++d0) Ow[orow * LDO + d0 * 32] = (bf16)(cvtpk(o[d0][r] * rli[r], 0.f) & 0xffffu); }
  } else if constexpr (OMODE == 1) {
    float* Ow = (float*)J.O + (long)(wid * QBLK) * LDO + r32;
#pragma unroll
    for (int r = 0; r < 16; ++r) { const int orow = crow(r, hi);
#pragma unroll
      for (int d0 = 0; d0 < 4; ++d0) Ow[orow * LDO + d0 * 32] = o[d0][r] * rli[r]; }
  }
#undef KROWT
#undef SLOAD
#undef SWRITE
#undef SWAIT
#undef RESC
#undef MSK
}
#undef KSWZ
#undef SBAR
}

constexpr int NWAVES = 8;
constexpr int DM = 2048, NBATCH = 2, SEQ = 4096, CTXL = 256, SB = SEQ + CTXL  , NROWS = NBATCH * SB  ;
constexpr int NEXP = 16, CAP_L = 512, CAP_C = 32, EROWS = 1280  ;
constexpr int NQKV0 = 3072, NQKV1 = 6144, NMOD = 6 * DM;
constexpr float EPS = 1e-6f;
constexpr float LAMBDA_INIT = 0.35550906759096926f;

constexpr size_t MiB = 1u << 20;
constexpr size_t WS_CTL = 0, CTL_ZERO_BYTES = 1 * MiB;
constexpr size_t WS_ROPE = 1 * MiB;
constexpr size_t WS_MODS = 2 * MiB;
constexpr size_t WS_AFF  = 3 * MiB;
constexpr size_t WS_RL   = 4 * MiB;
constexpr size_t WS_GATE = 5 * MiB;
constexpr size_t WS_INV  = 6 * MiB;
constexpr size_t WS_WIN0 = 8 * MiB;
constexpr size_t WS_WOUT0 = WS_WIN0 + 12 * MiB;
constexpr size_t WS_WIN1 = WS_WOUT0 + 8 * MiB;
constexpr size_t WS_WOUT1 = WS_WIN1 + 24 * MiB;
constexpr size_t WS_WGU = WS_WOUT1 + 8 * MiB;
constexpr size_t WS_WD  = WS_WGU + 512 * MiB;
constexpr size_t WS_H   = WS_WD + 256 * MiB;
constexpr size_t WS_QKV = WS_H + 34 * MiB;
constexpr size_t WS_Y   = WS_QKV + 102 * MiB;
constexpr size_t WS_YO  = WS_Y + 34 * MiB;
constexpr size_t WS_XL  = WS_YO + 68 * MiB;
constexpr size_t WS_XG  = WS_XL + 68 * MiB;
constexpr size_t WS_HM  = WS_XG + 80 * MiB;
constexpr size_t WS_YE  = WS_HM + 80 * MiB;
constexpr size_t WS_END = WS_YE + 80 * MiB;
constexpr int CW_BAR = 4096;

constexpr int RING_BYTES = 131072;
constexpr int LDSCTL_OFF = RING_BYTES, MISC_OFF = LDSCTL_OFF + 320;
constexpr int LDS_BYTES = 147456;

#define LAS __attribute__((address_space(3)))
typedef unsigned short bf16;
typedef unsigned v4u __attribute__((ext_vector_type(4)));
typedef unsigned v2u __attribute__((ext_vector_type(2)));
typedef int v4i __attribute__((ext_vector_type(4)));
typedef float f32x4 __attribute__((ext_vector_type(4)));
__device__ __forceinline__ unsigned f2bf(float f) { unsigned u = __builtin_bit_cast(unsigned, f); return (u + 0x7fffu + ((u >> 16) & 1u)) >> 16; }
__device__ __forceinline__ unsigned pk2(float lo, float hi) { return f2bf(lo) | (f2bf(hi) << 16); }
__device__ __forceinline__ float bf_lo(unsigned w) { return __builtin_bit_cast(float, w << 16); }
__device__ __forceinline__ float bf_hi(unsigned w) { return __builtin_bit_cast(float, w & 0xffff0000u); }

#define XB_TMO      128
#define XB_XCNT(j)  (256  + 64 * (j))
#define XB_XSUB(j)  (1280 + 64 * (j))
#define XB_XGEN(j)  (2304 + 64 * (j))
#define XB_TOP      3328
#define XB_TOPGEN   3392
#define XCD_BAR_WORDS 3456
#define XB_SPIN_CAP (1u << 18)
__device__ __forceinline__ unsigned xb_ld(unsigned* p)              { return __hip_atomic_load(p, __ATOMIC_RELAXED, __HIP_MEMORY_SCOPE_AGENT); }
__device__ __forceinline__ unsigned xb_add(unsigned* p, unsigned v) { return __hip_atomic_fetch_add(p, v, __ATOMIC_RELAXED, __HIP_MEMORY_SCOPE_AGENT); }
__device__ __forceinline__ unsigned xb_xcc_id() { return (unsigned)__builtin_amdgcn_s_getreg((3 << 11) | 20) & 0xFu; }
#define XB_SPIN(cond, bar) do { unsigned _sp = 0; while (cond) { __builtin_amdgcn_s_sleep(1); \
    if ((++_sp & 255u) == 0u) { if (xb_ld(&(bar)[XB_TMO])) break; if (_sp > XB_SPIN_CAP) { atomicAdd(&(bar)[XB_TMO], 1u); break; } } } } while (0)
struct XcdBarrier { unsigned* bar; unsigned x; volatile LAS unsigned* st; };
__device__ __forceinline__ XcdBarrier xcd_barrier_post(unsigned* bar, volatile LAS unsigned* st) {
    XcdBarrier b; b.bar = bar; b.x = xb_xcc_id(); b.st = st;
    if (threadIdx.x == 0) (void)xb_add(&bar[XB_XCNT(b.x)], 1u);
    return b;
}
__device__ __forceinline__ void xcd_barrier_complete(unsigned* bar, unsigned x, unsigned& nloc, unsigned& nx) {
    const unsigned G = gridDim.x * gridDim.y * gridDim.z;
    unsigned sum, cnt, mine, sp = 0u;
    for (;;) {
        sum = 0u; cnt = 0u; mine = 0u;
#pragma unroll
        for (unsigned j = 0; j < 16; ++j) { const unsigned c = xb_ld(&bar[XB_XCNT(j)]); sum += c; cnt += (c > 0u) ? 1u : 0u; mine = (j == x) ? c : mine; }
        if (sum == G) break;
        __builtin_amdgcn_s_sleep(1);
        if ((++sp & 255u) == 0u) { if (xb_ld(&bar[XB_TMO])) break; if (sp > XB_SPIN_CAP) { atomicAdd(&bar[XB_TMO], 1u); break; } }
    }
    nloc = mine > 0u ? mine : 1u; nx = cnt > 0u ? cnt : 1u;
}
__device__ __forceinline__ void xcd_barrier(const XcdBarrier& b) {
    asm volatile("s_waitcnt vmcnt(0)" ::: "memory");
    __syncthreads();
    if (threadIdx.x == 0) {
        unsigned* bar = b.bar;
        __builtin_amdgcn_s_waitcnt(0);
        unsigned nloc = b.st[0], nx = b.st[1];
        if (nloc == 0u) { xcd_barrier_complete(bar, b.x, nloc, nx); b.st[0] = nloc; b.st[1] = nx; }
        const unsigned old = xb_add(&bar[XB_XSUB(b.x)], 1u);
        const unsigned gen = old / nloc;
        if (old + 1u == (gen + 1u) * nloc) {
            __builtin_amdgcn_fence(__ATOMIC_RELEASE, "agent");
            asm volatile("s_waitcnt vmcnt(0)" ::: "memory");
            const unsigned og = xb_add(&bar[XB_TOP], 1u);
            const unsigned tg = og / nx;
            if (og + 1u == (tg + 1u) * nx) xb_add(&bar[XB_TOPGEN], 1u);
            else XB_SPIN(xb_ld(&bar[XB_TOPGEN]) == tg, bar);
            __builtin_amdgcn_fence(__ATOMIC_ACQUIRE, "agent");
            xb_add(&bar[XB_XGEN(b.x)], 1u);
            asm volatile("s_waitcnt vmcnt(0)" ::: "memory");
        } else {
            XB_SPIN(xb_ld(&bar[XB_XGEN(b.x)]) == gen, bar);
            __builtin_amdgcn_fence(__ATOMIC_ACQUIRE, "agent");
            asm volatile("s_waitcnt vmcnt(0)" ::: "memory");
        }
    }
    __syncthreads();
}

struct Args { const float* in[20]; float* out; unsigned char* ws; int ph_lo, ph_hi; };
struct Frame {
    LAS unsigned char* lds;
    int tid, lane, wave, G, gw, NGW;
    __attribute__((address_space(1))) unsigned char* ws;
};
template <class T> __device__ __forceinline__ T* fresh(T* p) { __attribute__((address_space(1))) T* q = (__attribute__((address_space(1))) T*)p; asm volatile("" : "+s"(q)); return (T*)q; }
__device__ __forceinline__ float wave_sum(float v) {
#pragma unroll
    for (int o = 1; o < 64; o <<= 1) v += __shfl_xor(v, o);
    return v;
}
__device__ __forceinline__ int wave_incl_scan(int v, int lane) {
#pragma unroll
    for (int o = 1; o < 64; o <<= 1) { const int t = __shfl_up(v, o); if (lane >= o) v += t; }
    return v;
}
__device__ __forceinline__ void transpose_item(const float* W, int K, int N, bf16* WT, int k0, int n0, int drow0, LAS float* scr, int lane) {
#pragma unroll 8
    for (int i = 0; i < 32; ++i) { const int kk = 2 * i + (lane >> 5); scr[kk * 33 + (lane & 31)] = W[(size_t)(k0 + kk) * N + n0 + (lane & 31)]; }
    asm volatile("s_waitcnt lgkmcnt(0)" ::: "memory");
    const int c = lane & 7;
#pragma unroll
    for (int j = 0; j < 4; ++j) { const int n = (lane >> 3) + 8 * j; const LAS float* s = scr + (8 * c) * 33 + n;
        v4u o; o.x = pk2(s[0 * 33], s[1 * 33]); o.y = pk2(s[2 * 33], s[3 * 33]); o.z = pk2(s[4 * 33], s[5 * 33]); o.w = pk2(s[6 * 33], s[7 * 33]);
        *(v4u*)(WT + (size_t)(drow0 + n) * K + k0 + 8 * c) = o; }
    asm volatile("s_waitcnt lgkmcnt(0)" ::: "memory");
}
__device__ __forceinline__ void ld_row(const float* p, int lane, f32x4 (&v)[8]) {
#pragma unroll
    for (int j = 0; j < 8; ++j) v[j] = *(const f32x4*)(p + 4 * lane + 256 * j);
}
__device__ __forceinline__ float row_rstd(const f32x4 (&v)[8]) {
    float s = 0.f;
#pragma unroll
    for (int j = 0; j < 8; ++j) s += (v[j].x * v[j].x + v[j].y * v[j].y) + (v[j].z * v[j].z + v[j].w * v[j].w);
    return 1.0f / sqrtf(wave_sum(s) * (1.0f / DM) + EPS);
}
__device__ __forceinline__ void st_row_bf16(bf16* p, int lane, const f32x4 (&v)[8]) {
#pragma unroll
    for (int j = 0; j < 8; ++j) { v2u w; w.x = pk2(v[j].x, v[j].y); w.y = pk2(v[j].z, v[j].w); *(v2u*)(p + 4 * lane + 256 * j) = w; }
}
__device__ __forceinline__ void norm_mod(f32x4 (&h)[8], const f32x4 (&x)[8], float r, const float* g, const float* sc, const float* sh, int lane) {
#pragma unroll
    for (int j = 0; j < 8; ++j) { const int c = 4 * lane + 256 * j; const f32x4 gg = *(const f32x4*)(g + c), s1 = *(const f32x4*)(sc + c), s0 = *(const f32x4*)(sh + c);
        h[j] = x[j] * r * gg * (s1 + 1.0f) + s0; }
}
__device__ __forceinline__ const float* in_row_ptr(const float* x_in, const float* ctx_in, int row) {
    const int b = row / SB, s = row - b * SB;
    return s < CTXL ? ctx_in + ((size_t)(b * CTXL + s)) * DM : x_in + ((size_t)(b * SEQ + s - CTXL)) * DM;
}
__device__ __forceinline__ const float* mods_ptr(const Frame& F, int layer, int row, int chunk) {
    const int b = row / SB, s = row - b * SB; const int vec = s < CTXL ? 2 : b;
    return (const float*)(F.ws + WS_MODS) + ((size_t)(layer * 3 + vec)) * NMOD + chunk * DM;
}

__device__ __forceinline__ void p0_prologue(Frame& F, const float* c_in, const float* c_ctx, const float* mod_w, const float* mod_b) {
    LAS float* sc = (LAS float*)F.lds;
    LAS float* red = (LAS float*)(F.lds + 24576);
    for (int i = F.tid; i < 3 * DM; i += 512) { const int v = i / DM, k = i - v * DM; const float cv = v < 2 ? c_in[v * DM + k] : c_ctx[k]; sc[i] = cv / (1.0f + __expf(-cv)); }
    __syncthreads();
    const int tx = F.tid & 7, ty = F.tid >> 3;
    for (int it = blockIdx.x; it < 2 * 384; it += F.G) {
        const int l = it / 384, sl = it - l * 384;
        const float* wp = mod_w + (size_t)l * DM * NMOD + sl * 32 + tx * 4;
        f32x4 a0 = {0.f, 0.f, 0.f, 0.f}, a1 = a0, a2 = a0;
#pragma unroll 8
        for (int i = 0; i < 32; ++i) { const int k = ty + 64 * i; const f32x4 w = *(const f32x4*)(wp + (size_t)k * NMOD);
            a0 += w * sc[k]; a1 += w * sc[DM + k]; a2 += w * sc[2 * DM + k]; }
        LAS float* rp = red + F.tid * 12;
        rp[0] = a0.x; rp[1] = a0.y; rp[2] = a0.z; rp[3] = a0.w; rp[4] = a1.x; rp[5] = a1.y; rp[6] = a1.z; rp[7] = a1.w; rp[8] = a2.x; rp[9] = a2.y; rp[10] = a2.z; rp[11] = a2.w;
        __syncthreads();
        if (F.tid < 96) { const int v = F.tid >> 5, col = F.tid & 31, txx = col >> 2, jj = col & 3; float s = 0.f;
            for (int t = 0; t < 64; ++t) s += red[(t * 8 + txx) * 12 + v * 4 + jj];
            ((float*)(F.ws + WS_MODS))[((size_t)(l * 3 + v)) * NMOD + sl * 32 + col] = s + mod_b[l * NMOD + sl * 32 + col]; }
        __syncthreads();
    }
    { const int gi = blockIdx.x * 512 + F.tid;
      if (gi < 2048) { const int pos = gi >> 5, f = gi & 31; const float inv = __builtin_amdgcn_exp2f(-(float)f * (13.287712379549449f / 32.0f)); const float ang = (float)pos * inv;
          float* rt = (float*)(F.ws + WS_ROPE); rt[gi] = __cosf(ang); rt[2048 + gi] = __sinf(ang); } }
    __syncthreads();
}

__device__ __forceinline__ void t_norm0(Frame& F, const float* x_in, const float* ctx_in, const float* norm_g) {
    for (int row = F.gw; row < NROWS; row += F.NGW) {
        f32x4 x[8], h[8]; ld_row(in_row_ptr(x_in, ctx_in, row), F.lane, x);
        const float r = row_rstd(x);
        norm_mod(h, x, r, fresh(norm_g), mods_ptr(F, 0, row, 1), mods_ptr(F, 0, row, 0), F.lane);
        st_row_bf16((bf16*)(F.ws + WS_H) + (size_t)row * DM, F.lane, h);
    }
}
__device__ __forceinline__ void t_prep(Frame& F, int layer, const float* q_norm, const float* k_norm) {
    const int ld = layer == 0 ? NQKV0 : NQKV1;
    const float* rt = (const float*)(F.ws + WS_ROPE);
    const int f = F.lane & 31, d0 = (F.lane >> 5) * 64 + f;
    for (int row = F.gw; row < NROWS; row += F.NGW) {
        const int b = row / SB, s = row - b * SB; const bool lat = s >= CTXL;
        if (layer == 1 && !lat) continue;
        float cs = 1.f, sn = 0.f;
        if (lat) { const int t = s - CTXL; const int pos = (F.lane >> 5) ? (t & 63) : (t >> 6); cs = rt[pos * 32 + f]; sn = rt[2048 + pos * 32 + f]; }
        bf16* rp = (bf16*)(F.ws + WS_QKV) + (size_t)row * ld;
        const int nheads = layer == 0 ? 20 : 32;
        for (int hh = 0; hh < nheads; ++hh) {
            int col; const float* g = nullptr;
            if (layer == 0) {
                if (hh < 10) col = hh * 128; else if (hh < 18) { col = 1536 + (hh - 10) * 128; g = q_norm; } else { col = 2560 + (hh - 18) * 128; g = k_norm; }
                if (!lat && g == nullptr) continue;
            } else col = hh * 128;
            float a = bf_lo((unsigned)rp[col + d0]), c2 = bf_lo((unsigned)rp[col + d0 + 32]);
            if (g) { const float ss = wave_sum(a * a + c2 * c2); const float r = 1.0f / sqrtf(ss * (1.0f / 128.0f) + EPS); a = a * r * g[d0]; c2 = c2 * r * g[d0 + 32]; }
            const float o1 = a * cs - c2 * sn, o2 = c2 * cs + a * sn;
            rp[col + d0] = (bf16)f2bf(o1); rp[col + d0 + 32] = (bf16)f2bf(o2);
        }
    }
}
__device__ __forceinline__ void t_subln(Frame& F, const float* dif_lambda, const float* dif_subln) {
    const float* lp = dif_lambda;
    const float s01 = wave_sum(lp[F.lane] * lp[128 + F.lane] + lp[64 + F.lane] * lp[192 + F.lane]);
    const float s23 = wave_sum(lp[256 + F.lane] * lp[384 + F.lane] + lp[320 + F.lane] * lp[448 + F.lane]);
    const float lam = __expf(s01) - __expf(s23) + LAMBDA_INIT;
    for (int i = F.gw; i < NBATCH * SEQ; i += F.NGW) {
        const int b = i / SEQ, row = b * SB + CTXL + (i - b * SEQ);
        f32x4 v[8], w[8]; ld_row((const float*)(F.ws + WS_YO) + (size_t)row * DM, F.lane, v); ld_row((const float*)(F.ws + WS_XG) + (size_t)row * DM, F.lane, w);
        const f32x4 g = *(const f32x4*)(fresh(dif_subln) + 4 * F.lane);
#pragma unroll
        for (int j = 0; j < 8; ++j) { v[j] = v[j] - w[j] * lam;
            const float ss = wave_sum((v[j].x * v[j].x + v[j].y * v[j].y) + (v[j].z * v[j].z + v[j].w * v[j].w));
            const float r = (1.0f - LAMBDA_INIT) / sqrtf(ss * (1.0f / 256.0f) + EPS); v[j] = v[j] * r * g; }
        st_row_bf16((bf16*)(F.ws + WS_Y) + (size_t)row * DM, F.lane, v);
    }
}
__device__ __forceinline__ void t_post_attn(Frame& F, int layer, const float* x_in, const float* ctx_in, const float* norm_g, const float* router_w) {
    const float* ng0 = norm_g + (size_t)layer * 4 * DM;
    const float* wr0 = router_w + (size_t)layer * DM * NEXP;
    for (int row = F.gw; row < NROWS; row += F.NGW) {
        const int b = row / SB, s = row - b * SB;
        if (layer == 1 && s < CTXL) continue;
        const float* ng = fresh(ng0); const float* wr = fresh(wr0);
        f32x4 y[8], x[8], h[8];
        ld_row((const float*)(F.ws + WS_YO) + (size_t)row * DM, F.lane, y);
        ld_row(layer == 0 ? in_row_ptr(x_in, ctx_in, row) : (const float*)(F.ws + WS_XL) + (size_t)row * DM, F.lane, x);
        const float ry = row_rstd(y);
        const float* ga = mods_ptr(F, layer, row, 2);
#pragma unroll
        for (int j = 0; j < 8; ++j) { const int c = 4 * F.lane + 256 * j; x[j] = x[j] + *(const f32x4*)(ga + c) * (y[j] * ry * *(const f32x4*)(ng + DM + c)); }
        float* xl = (float*)(F.ws + WS_XL) + (size_t)row * DM;
#pragma unroll
        for (int j = 0; j < 8; ++j) *(f32x4*)(xl + 4 * F.lane + 256 * j) = x[j];
        const float rx = row_rstd(x);
        norm_mod(h, x, rx, ng + 2 * DM, mods_ptr(F, layer, row, 4), mods_ptr(F, layer, row, 3), F.lane);
        st_row_bf16((bf16*)(F.ws + WS_H) + (size_t)row * DM, F.lane, h);
        float lg[16];
#pragma unroll
        for (int e = 0; e < 16; ++e) lg[e] = 0.f;
#pragma unroll
        for (int j = 0; j < 8; ++j) {
            asm volatile("" ::: "memory");
#pragma unroll
            for (int i = 0; i < 4; ++i) { const float hv = h[j][i]; const float* wp = wr + (size_t)(4 * F.lane + 256 * j + i) * NEXP;
                const f32x4 w0 = *(const f32x4*)wp, w1 = *(const f32x4*)(wp + 4), w2 = *(const f32x4*)(wp + 8), w3 = *(const f32x4*)(wp + 12);
                lg[0] += hv * w0.x; lg[1] += hv * w0.y; lg[2] += hv * w0.z; lg[3] += hv * w0.w; lg[4] += hv * w1.x; lg[5] += hv * w1.y; lg[6] += hv * w1.z; lg[7] += hv * w1.w;
                lg[8] += hv * w2.x; lg[9] += hv * w2.y; lg[10] += hv * w2.z; lg[11] += hv * w2.w; lg[12] += hv * w3.x; lg[13] += hv * w3.y; lg[14] += hv * w3.z; lg[15] += hv * w3.w; } }
        float mx = -1e30f;
#pragma unroll
        for (int e = 0; e < 16; ++e) { lg[e] = wave_sum(lg[e]); mx = fmaxf(mx, lg[e]); }
        float sum = 0.f;
#pragma unroll
        for (int e = 0; e < 16; ++e) { lg[e] = __expf(lg[e] - mx); sum += lg[e]; }
        const float rs = 1.0f / sum;
        float* aff = (float*)(F.ws + WS_AFF) + (size_t)b * NEXP * SB + s;
#pragma unroll
        for (int e = 0; e < 16; ++e) if (F.lane == e) aff[(size_t)e * SB] = lg[e] * rs;
    }
}
template <int VPT>
__device__ __forceinline__ void topk_problem(Frame& F, const float* vals, int N, int cap, int e, int rowbase, int slotbase, bool write_inv) {
    LAS int* hist = (LAS int*)F.lds;
    LAS int* wt = (LAS int*)(F.lds + 1024);
    LAS int* selw = (LAS int*)(F.lds + 1280);
    float v[VPT]; unsigned key[VPT];
#pragma unroll
    for (int k = 0; k < VPT; ++k) { const int i = F.tid * VPT + k; const bool ok = i < N; v[k] = ok ? vals[i] : 0.f; const unsigned u = __builtin_bit_cast(unsigned, v[k]);
        key[k] = ok ? ((u & 0x80000000u) ? ~u : (u | 0x80000000u)) : 0u; }
    unsigned prefix = 0u, maskb = 0u; int need = cap;
    for (int pass = 0; pass < 4; ++pass) {
        const int shift = 24 - 8 * pass;
        if (F.tid < 256) hist[F.tid] = 0;
        __syncthreads();
#pragma unroll
        for (int k = 0; k < VPT; ++k) { const int i = F.tid * VPT + k; if (i < N && (key[k] & maskb) == prefix) __hip_atomic_fetch_add(&hist[(key[k] >> shift) & 255u], 1, __ATOMIC_RELAXED, __HIP_MEMORY_SCOPE_WORKGROUP); }
        __syncthreads();
        if (F.wave == 0) {
            const int l = F.lane; const int h0 = hist[255 - 4 * l], h1 = hist[254 - 4 * l], h2 = hist[253 - 4 * l], h3 = hist[252 - 4 * l];
            const int sm = h0 + h1 + h2 + h3; const int incl = wave_incl_scan(sm, l); const int excl = incl - sm;
            const unsigned long long m = __ballot(incl >= need); const int fl = m ? (__ffsll((long long)m) - 1) : 63;
            if (l == fl) { int c = excl, bin;
                if (c + h0 >= need) bin = 255 - 4 * l; else { c += h0; if (c + h1 >= need) bin = 254 - 4 * l; else { c += h1; if (c + h2 >= need) bin = 253 - 4 * l; else { c += h2; bin = 252 - 4 * l; } } }
                selw[0] = bin; selw[1] = need - c; }
        }
        __syncthreads();
        prefix |= ((unsigned)selw[0]) << shift; maskb |= 0xFFu << shift; need = selw[1];
        __syncthreads();
    }
    int ceq = 0;
#pragma unroll
    for (int k = 0; k < VPT; ++k) { const int i = F.tid * VPT + k; if (i < N && key[k] == prefix) ++ceq; }
    int incl = wave_incl_scan(ceq, F.lane);
    if (F.lane == 63) wt[F.wave] = incl;
    __syncthreads();
    int eqbase = incl - ceq;
    for (int w = 0; w < F.wave; ++w) eqbase += wt[w];
    int csel = 0; bool sel[VPT];
#pragma unroll
    for (int k = 0; k < VPT; ++k) { const int i = F.tid * VPT + k; const bool ok = i < N; const bool eq = ok && key[k] == prefix;
        sel[k] = ok && (key[k] > prefix || (eq && eqbase < need)); if (eq) ++eqbase; if (sel[k]) ++csel; }
    incl = wave_incl_scan(csel, F.lane);
    if (F.lane == 63) wt[8 + F.wave] = incl;
    __syncthreads();
    int sbase = incl - csel;
    for (int w = 0; w < F.wave; ++w) sbase += wt[8 + w];
    int* RL = (int*)(F.ws + WS_RL) + e * EROWS; float* GT = (float*)(F.ws + WS_GATE) + e * EROWS; int* INV = (int*)(F.ws + WS_INV);
#pragma unroll
    for (int k = 0; k < VPT; ++k) { const int i = F.tid * VPT + k;
        if (i < N) { const int grow = rowbase + i;
            if (sel[k]) { const int slot = slotbase + sbase; ++sbase; RL[slot] = grow; GT[slot] = v[k]; if (write_inv) INV[grow * 16 + e] = slot; }
            else if (write_inv) INV[grow * 16 + e] = -1; } }
    __syncthreads();
}
__device__ __forceinline__ void t_topk(Frame& F, int layer) {
    const int nprob = layer == 0 ? 64 : 32;
    for (int p = blockIdx.x; p < nprob; p += F.G) {
        const int kind = p >> 5, q = p & 31, b = q >> 4, e = q & 15;
        const float* aff = (const float*)(F.ws + WS_AFF) + ((size_t)(b * NEXP + e)) * SB;
        if (kind == 0) topk_problem<8>(F, aff + CTXL, SEQ, CAP_L, e, b * SB + CTXL, b * CAP_L, true);
        else           topk_problem<1>(F, aff, CTXL, CAP_C, e, b * SB, 2 * CAP_L + b * CAP_C, true);
    }
}
__device__ __forceinline__ void t_gather(Frame& F, int layer) {
    const int np = layer == 0 ? 1280 : 1024, nvalid = layer == 0 ? 1088 : 1024;
    const int* RL = (const int*)(F.ws + WS_RL);
    for (int i = F.gw; i < NEXP * np; i += F.NGW) {
        const int e = i / np, slot = i - e * np;
        v4u* dst = (v4u*)((bf16*)(F.ws + WS_XG) + ((size_t)(e * EROWS + slot)) * DM) + F.lane;
        if (slot < nvalid) { const int src = RL[e * EROWS + slot]; const v4u* sp = (const v4u*)((const bf16*)(F.ws + WS_H) + (size_t)src * DM) + F.lane;
#pragma unroll
            for (int j = 0; j < 4; ++j) dst[64 * j] = sp[64 * j];
        } else {
#pragma unroll
            for (int j = 0; j < 4; ++j) dst[64 * j] = (v4u){0u, 0u, 0u, 0u};
        }
    }
}
__device__ __forceinline__ void t_post_moe(Frame& F, int layer, const float* norm_g, float* out) {
    const float* ng0 = norm_g + (size_t)layer * 4 * DM;
    const int* INV = (const int*)(F.ws + WS_INV); const float* GT = (const float*)(F.ws + WS_GATE);
    for (int row = F.gw; row < NROWS; row += F.NGW) {
        const int b = row / SB, s = row - b * SB;
        if (layer == 1 && s < CTXL) continue;
        const float* ng = fresh(ng0); const float* ng1 = fresh(norm_g + 4 * DM);
        f32x4 mo[8], x[8];
#pragma unroll
        for (int j = 0; j < 8; ++j) mo[j] = (f32x4){0.f, 0.f, 0.f, 0.f};
        const v4i* ip = (const v4i*)(INV + (size_t)row * 16);
        const v4i i0 = ip[0], i1 = ip[1], i2 = ip[2], i3 = ip[3];
        const int sl[16] = {i0.x, i0.y, i0.z, i0.w, i1.x, i1.y, i1.z, i1.w, i2.x, i2.y, i2.z, i2.w, i3.x, i3.y, i3.z, i3.w};
#pragma unroll
        for (int e = 0; e < 16; ++e) { const int slot = sl[e];
            if (slot >= 0) { const float g = GT[e * EROWS + slot]; const bf16* yp = (const bf16*)(F.ws + WS_YE) + ((size_t)(e * EROWS + slot)) * DM + 4 * F.lane;
#pragma unroll
                for (int j = 0; j < 8; ++j) { const v2u w = *(const v2u*)(yp + 256 * j); mo[j].x += g * bf_lo(w.x); mo[j].y += g * bf_hi(w.x); mo[j].z += g * bf_lo(w.y); mo[j].w += g * bf_hi(w.y); } } }
        ld_row((const float*)(F.ws + WS_XL) + (size_t)row * DM, F.lane, x);
        const float rm = row_rstd(mo);
        const float* gf = mods_ptr(F, layer, row, 5);
#pragma unroll
        for (int j = 0; j < 8; ++j) { const int c = 4 * F.lane + 256 * j; x[j] = x[j] + *(const f32x4*)(gf + c) * (mo[j] * rm * *(const f32x4*)(ng + 3 * DM + c)); }
        if (layer == 0) {
            float* xl = (float*)(F.ws + WS_XL) + (size_t)row * DM;
#pragma unroll
            for (int j = 0; j < 8; ++j) *(f32x4*)(xl + 4 * F.lane + 256 * j) = x[j];
            f32x4 h[8]; const float rx = row_rstd(x);
            norm_mod(h, x, rx, ng1, mods_ptr(F, 1, row, 1), mods_ptr(F, 1, row, 0), F.lane);
            st_row_bf16((bf16*)(F.ws + WS_H) + (size_t)row * DM, F.lane, h);
        } else {
            float* op = out + ((size_t)(b * SEQ + s - CTXL)) * DM;
#pragma unroll
            for (int j = 0; j < 8; ++j) *(f32x4*)(op + 4 * F.lane + 256 * j) = x[j];
        }
    }
}

__device__ __forceinline__ void p_attn0(Frame& F, const float* ab_sink) {
    char* lds = (char*)F.lds;
    const bf16* QKV = (const bf16*)(F.ws + WS_QKV); bf16* Y = (bf16*)(F.ws + WS_Y);
    const int c = blockIdx.x;
    for (int u = c; u < 544; u += F.G) {
        att::Job J; J.kb0 = CTXL; J.mask = 0; J.dq = 0; J.use_sink = 0; J.sink_l2 = 0.f; J.lam = 0.f;
        int b, h, grpB; size_t qrow;
        if (u < 512) {
            const int uu = u & 255, x = uu & 7, i = uu >> 3, grp = x >> 1, idx = (x & 1) * 32 + i;
            b = grp >> 1; const int kv = grp & 1; h = kv * 4 + (idx >> 4); const int qb = idx & 15; grpB = u < 256;
            qrow = (size_t)b * SB + CTXL + qb * 256;
            if (grpB) J.NT = 68;
            else { const int q0 = qb * 256, lo = q0 - 128 < 0 ? 0 : q0 - 128, hiK = q0 + 384 > SEQ ? SEQ : q0 + 384;
                   J.NT = 4 + (hiK - lo) / 64; J.kb0 = CTXL + lo; J.mask = 1; J.dq = lo - q0; }
        } else { const int uu = u - 512; grpB = uu >> 4; b = (uu >> 3) & 1; h = uu & 7; qrow = (size_t)b * SB; J.NT = 4; }
        const int kv = h >> 2;
        if (!grpB) { J.use_sink = 1; J.sink_l2 = ab_sink[h] * 1.4426950408889634f; }
        const int qcol = grpB ? 1536 + h * 128 : h * 128, kcol = grpB ? 2560 + kv * 128 : 1024 + kv * 128, vcol = grpB ? 2816 + kv * 128 : 1280 + kv * 128;
        J.Q = QKV + qrow * NQKV0 + qcol; J.K = QKV + (size_t)b * SB * NQKV0 + kcol; J.V = QKV + (size_t)b * SB * NQKV0 + vcol;
        J.O = (void*)(Y + qrow * DM + (grpB ? 1024 : 0) + h * 128);
        __syncthreads();
        att::attn_unit<NQKV0, 0>(J, lds);
    }
}
__device__ __forceinline__ void p_attn1(Frame& F) {
    char* lds = (char*)F.lds;
    const bf16* QKV = (const bf16*)(F.ws + WS_QKV);
    for (int u = blockIdx.x; u < 1024; u += F.G) {
        const int x = u & 7, i = u >> 3;
        const int b = x >> 2, hp = x & 3, h = hp * 2 + ((i >> 6) & 1), m = (i >> 5) & 1, half = (i >> 4) & 1, qb = i & 15;
        const size_t qrow = (size_t)b * SB + CTXL + qb * 256;
        float* O = (float*)(F.ws + (m ? WS_XG : WS_YO));
        att::Job J; J.kb0 = CTXL; J.mask = 0; J.dq = 0; J.use_sink = 0; J.sink_l2 = 0.f; J.lam = 0.f; J.NT = 68;
        J.V = QKV + (size_t)b * SB * NQKV1 + 4096 + h * 256 + half * 128;
        J.O = (void*)(O + qrow * DM + h * 256 + half * 128);
        J.Q = QKV + qrow * NQKV1 + (2 * h + m) * 128; J.K = QKV + (size_t)b * SB * NQKV1 + 2048 + (2 * h + m) * 128;
        __syncthreads();
        att::attn_unit<NQKV1, 1>(J, lds);
    }
}

#define IN(k) (lo <= (k) && (k) < hi)
#define SEAM(k) do { if (IN((k) + 1)) xcd_barrier(bar); } while (0)
#define INP(k) ({ int k_ = (k); asm volatile("" : "+s"(k_)); (const float*)(const __attribute__((address_space(1))) float*)args.in[k_]; })
#ifndef PROBE_MASK
#define PROBE_MASK 0
#endif
#define REP(k) for (int rep_ = 0; rep_ < (((k) >= 0 && ((PROBE_MASK >> ((k) < 0 ? 0 : (k))) & 1)) ? 2 : 1); ++rep_, __syncthreads())
#define FRESH() do { asm volatile("" : "+s"(F.ws)); } while (0)
template <int layer>
__device__ __forceinline__ void layer_phases(Frame& F, const Args& args, const int lo, const int hi, const XcdBarrier& bar) {

        const int pb = 2 + 11 * layer;
        if (IN(pb + 0)) {
            FRESH();
            pg8::BDense<(layer == 0 ? NQKV0 : NQKV1)> Bm{INP(layer == 0 ? 7 : 12)};
            pg8::DenseOrder S; S.init(NROWS / 256, (layer == 0 ? NQKV0 : NQKV1) / 256, F.G, (int)blockIdx.x, 0);
            pg8::EpiStoreBf16 E{(pg8::bf16_t*)(F.ws + WS_QKV), layer == 0 ? NQKV0 : NQKV1, 1 << 20};
            REP(pb + 0) pg8::gemm_phase_w<pg8::EpiStoreBf16, pg8::DenseOrder, pg8::BDense<(layer == 0 ? NQKV0 : NQKV1)>>(F.lds, (const pg8::bf16_t*)(F.ws + WS_H), DM, Bm, S, E);
            SEAM(pb + 0);
        }
        if (IN(pb + 1)) { FRESH(); t_prep(F, layer, INP(10), INP(11)); SEAM(pb + 1); }
        if (IN(pb + 2)) { FRESH(); REP(pb + 2) { if (layer == 0) p_attn0(F, INP(9)); else p_attn1(F); } SEAM(pb + 2); }
        if (IN(pb + 3)) { if (layer == 1) { FRESH(); REP(pb + 3) t_subln(F, INP(14), INP(15)); SEAM(pb + 3); } }
        if (IN(pb + 4)) {
            FRESH();
            pg8::BDense<DM> Bm{INP(layer == 0 ? 8 : 13)};
            pg8::DenseOrder S; S.init(layer == 0 ? 34 : 32, DM / 256, F.G, (int)blockIdx.x, layer);
            pg8::EpiStoreF32 E{(float*)(F.ws + WS_YO), DM};
            REP(pb + 4) pg8::gemm_phase_w<pg8::EpiStoreF32, pg8::DenseOrder, pg8::BDense<DM>>(F.lds, (const pg8::bf16_t*)(F.ws + WS_Y), DM, Bm, S, E);
            SEAM(pb + 4);
        }
        if (IN(pb + 5)) { FRESH(); REP(layer == 0 ? pb + 5 : -2) t_post_attn(F, layer, INP(0), INP(2), INP(6), INP(16)); SEAM(pb + 5); }
        if (IN(pb + 6)) { FRESH(); REP(pb + 6) t_topk(F, layer); SEAM(pb + 6); }
        if (IN(pb + 7)) { FRESH(); REP(pb + 7) t_gather(F, layer); SEAM(pb + 7); }
        if (IN(pb + 8)) {
            FRESH();
            pg8::BMoeGU Bm{INP(17) + (size_t)layer * 16 * DM * DM, INP(18) + (size_t)layer * 16 * DM * DM};
            pg8::MoeOrder S; S.init(layer == 0 ? 5 : 4, 16, F.G, (int)blockIdx.x);
            pg8::EpiSwiGLU E{(pg8::bf16_t*)(F.ws + WS_HM), DM};
            REP(pb + 8) pg8::gemm_phase_w<pg8::EpiSwiGLU, pg8::MoeOrder, pg8::BMoeGU>(F.lds, (const pg8::bf16_t*)(F.ws + WS_XG), DM, Bm, S, E);
            SEAM(pb + 8);
        }
        if (IN(pb + 9)) {
            FRESH();
            pg8::BMoeDn Bm{INP(19) + (size_t)layer * 16 * DM * DM};
            pg8::MoeOrder S; S.init(layer == 0 ? 5 : 4, 8, F.G, (int)blockIdx.x);
            pg8::EpiStoreBf16 E{(pg8::bf16_t*)(F.ws + WS_YE), DM, 8};
            REP(pb + 9) pg8::gemm_phase_w<pg8::EpiStoreBf16, pg8::MoeOrder, pg8::BMoeDn>(F.lds, (const pg8::bf16_t*)(F.ws + WS_HM), DM, Bm, S, E);
            SEAM(pb + 9);
        }
        if (IN(pb + 10)) { FRESH(); REP(layer == 1 ? pb + 10 : -2) t_post_moe(F, layer, INP(6), args.out); SEAM(pb + 10); }
}
constexpr int NPHASE = 24;
__global__ void __launch_bounds__(NWAVES * 64, 2) fwd(Args args) {
    extern __shared__ __attribute__((aligned(16))) unsigned char lds[];
    Frame F;
    F.lds = (LAS unsigned char*)lds;
    F.tid = threadIdx.x; F.lane = F.tid & 63; F.wave = __builtin_amdgcn_readfirstlane(F.tid >> 6);
    F.G = gridDim.x; F.gw = blockIdx.x * NWAVES + F.wave; F.NGW = F.G * NWAVES;
    F.ws = (__attribute__((address_space(1))) unsigned char*)args.ws;
    volatile LAS unsigned* MISC = (volatile LAS unsigned*)(F.lds + MISC_OFF);
    for (int u = F.tid; u < (LDS_BYTES - LDSCTL_OFF) / 4; u += NWAVES * 64) ((LAS unsigned*)(F.lds + LDSCTL_OFF))[u] = 0u;
    __syncthreads();
    const int lo = args.ph_lo, hi = args.ph_hi;
    const bool multi = (hi - lo) > 1;
    XcdBarrier bar; bar.bar = (unsigned*)(F.ws + WS_CTL) + CW_BAR; bar.x = 0; bar.st = nullptr;
    if (multi) bar = xcd_barrier_post((unsigned*)(F.ws + WS_CTL) + CW_BAR, MISC + 8);

    if (IN(0)) { FRESH(); REP(0) p0_prologue(F, INP(1), INP(3), INP(4), INP(5)); SEAM(0); }
    if (IN(1)) { FRESH(); REP(1) t_norm0(F, INP(0), INP(2), INP(6)); SEAM(1); }
    layer_phases<0>(F, args, lo, hi, bar);
    layer_phases<1>(F, args, lo, hi, bar);
}

extern "C" void kernel_launch(void* const* d_in, const int* in_sizes, int n_in, void* d_out, int out_size, void* d_ws, size_t ws_size, hipStream_t stream) {
    static int grid = 0;
    if (grid == 0) {
        if (n_in != 20 || out_size != NBATCH * SEQ * DM || ws_size < WS_END) { fprintf(stderr, "kernel_launch: shape mismatch (n_in %d out %d ws %zu need %zu)\n", n_in, out_size, ws_size, (size_t)WS_END); grid = -1; return; }
        int dev = 0, cus = 0, per_cu = 0;
        if (hipGetDevice(&dev) != hipSuccess || hipDeviceGetAttribute(&cus, hipDeviceAttributeMultiprocessorCount, dev) != hipSuccess) { grid = -1; return; }
        if (hipFuncSetAttribute((const void*)fwd, hipFuncAttributeMaxDynamicSharedMemorySize, LDS_BYTES) != hipSuccess) { fprintf(stderr, "kernel_launch: hipFuncSetAttribute failed\n"); grid = -1; return; }
        if (hipOccupancyMaxActiveBlocksPerMultiprocessor(&per_cu, (const void*)fwd, NWAVES * 64, LDS_BYTES) != hipSuccess || per_cu < 1)
            fprintf(stderr, "kernel_launch: note: occupancy query reports %d workgroups per CU\n", per_cu);
        (void)hipGetLastError();
        grid = cus;
    }
    if (grid < 0) return;
    if (hipMemsetAsync((char*)d_ws + WS_CTL, 0, CTL_ZERO_BYTES, stream) != hipSuccess) return;
    Args a{};
    for (int i = 0; i < 20; ++i) a.in[i] = (const float*)d_in[i];
    a.out = (float*)d_out; a.ws = (unsigned char*)d_ws;
#if MK_ONE_LAUNCH
    a.ph_lo = 0; a.ph_hi = NPHASE;
    hipLaunchKernelGGL(fwd, dim3(grid), dim3(NWAVES * 64), LDS_BYTES, stream, a);
#else
    for (int ph = 0; ph < NPHASE; ++ph) {
        if (ph == 5) continue;
        a.ph_lo = ph; a.ph_hi = ph + 1;
        hipLaunchKernelGGL(fwd, dim3(grid), dim3(NWAVES * 64), LDS_BYTES, stream, a);
    }
#endif
    const hipError_t le = hipPeekAtLastError();
    if (le != hipSuccess) fprintf(stderr, "kernel_launch: launch failed: %s\n", hipGetErrorName(le));
}
```

```cpp
#include <hip/hip_runtime.h>
#include <cstdio>
#include <cstdint>

#ifndef MK_ONE_LAUNCH
#define MK_ONE_LAUNCH 1
#endif

namespace pg8 {
#define PG8_LAS __attribute__((address_space(3)))
typedef unsigned short bf16_t;
typedef short bf16x8 __attribute__((ext_vector_type(8)));
typedef float f32x4 __attribute__((ext_vector_type(4)));
typedef unsigned u32x4 __attribute__((ext_vector_type(4)));
constexpr int BM = 256, BK = 64, HALF = 128, HTB = HALF * BK * 2  , STAGE_BYTES = 8 * HTB, NXCD = 8, WGM = 8;

__host__ __device__ __forceinline__ int lds_byte(int r, int c) { const int st = (r >> 4) * 2 + (c >> 5), rr = r & 15, cc = c & 31, ob = rr * 64 + cc * 2; return st * 1024 + (ob ^ (((ob >> 9) & 1) << 5)); }
__host__ __device__ __forceinline__ void stage_rc(int b, int& R, int& C) { const int st = b / 1024, sb = b % 1024, swz = sb ^ (((sb >> 9) & 1) << 5); R = (st >> 1) * 16 + swz / 64; C = (st & 1) * 32 + (swz % 64) / 2; }
__host__ __device__ __forceinline__ int perm32(int rho) { const int n = rho >> 4, i = rho & 15; return 8 * (i >> 2) + 4 * n + (i & 3); }

struct Unit { int pm, pn; };
struct Gemm { const bf16_t* A; const bf16_t* Bt; int M, N, K; };

struct StaticOrder {
    int nM, nN, nwg, G, c;
    __host__ __device__ void init(int M, int N, int G_, int c_) { nM = M / BM; nN = N / BM; nwg = nM * nN; G = G_; c = c_; }
    __host__ __device__ bool next(int i, Unit& u) const {
        const long L = (long)i * G + c; if (L >= nwg) return false;
        int wgid = (int)L; { const int q = nwg / NXCD, r = nwg % NXCD, xcd = wgid % NXCD, off = wgid / NXCD; wgid = (xcd < r ? xcd * (q + 1) : r * (q + 1) + (xcd - r) * q) + off; }
        const int nig = WGM * nN, gid = wgid / nig, fm = gid * WGM, gsz = (nM - fm) < WGM ? (nM - fm) : WGM;
        u.pm = fm + ((wgid % nig) % gsz); u.pn = (wgid % nig) / gsz; return true;
    }
    __device__ __forceinline__ void a_ready(const Unit&) const {}
    __device__ __forceinline__ void done(const Unit&) const {}
};

__device__ __forceinline__ unsigned cvt_pk_bf16(float lo, float hi) { unsigned r; asm volatile("v_cvt_pk_bf16_f32 %0, %1, %2" : "=v"(r) : "v"(lo), "v"(hi)); return r; }
struct DenseOrder {
    StaticOrder so; int kind;
    __device__ void init(int nM, int nN, int G_, int c_, int kind_) { so.init(nM * BM, nN * BM, G_, c_); kind = kind_; }
    __device__ bool next(int i, Unit& u) const {
        if (!so.next(i, u)) return false;
        if (kind == 1) { const int b = u.pm >> 4, j = u.pm & 15; u.pm = 17 * b + 1 + j; }
        return true;
    }
    __device__ __forceinline__ int krot(const Unit& u) const { return (u.pm & 3) * 8; }
    __device__ __forceinline__ void a_ready(const Unit&) const {}
    __device__ __forceinline__ void done(const Unit&) const {}
};
struct MoeOrder {
    int NP, NJ, nU, G, c;
    __device__ void init(int NP_, int NJ_, int G_, int c_) { NP = NP_; NJ = NJ_; nU = 16 * NP_ * NJ_; G = G_; c = c_; }
    __device__ bool next(int i, Unit& u) const {
        const int L = i * G + c; if (L >= nU) return false;
        const int xcd = L & 7, off = L >> 3, id = xcd * (nU >> 3) + off;
        const int per = NJ * NP, e = id / per, rem = id - e * per, j = rem / NP, p = rem - j * NP;
        u.pm = 5 * e + p; u.pn = NJ * e + j; return true;
    }
    __device__ __forceinline__ int krot(const Unit& u) const { const int p = u.pm % 5; return NP == 4 ? p * 8 : p * 6; }
    __device__ __forceinline__ void a_ready(const Unit&) const {}
    __device__ __forceinline__ void done(const Unit&) const {}
};

struct EpiStoreBf16 {
    static constexpr bool PERM = true, AFTER_DRAIN = false;
    bf16_t* O; int ldc; int nmod;
    __device__ __forceinline__ void operator()(const f32x4 (&acc)[2][2][4][2], const Unit& u, int wr, int wc, int fr, int fq) const {
        const int row0 = u.pm * BM + wr * 64 + fr, col0 = (u.pn % nmod) * BM + wc * 32 + 8 * fq;
#pragma unroll
        for (int ai = 0; ai < 2; ++ai)
#pragma unroll
            for (int m = 0; m < 4; ++m) { bf16_t* rowp = O + (size_t)(row0 + ai * HALF + m * 16) * ldc + col0;
#pragma unroll
                for (int bj = 0; bj < 2; ++bj) { const f32x4 v0 = acc[ai][bj][m][0], v1 = acc[ai][bj][m][1];
                    u32x4 w; w.x = cvt_pk_bf16(v0[0], v0[1]); w.y = cvt_pk_bf16(v0[2], v0[3]); w.z = cvt_pk_bf16(v1[0], v1[1]); w.w = cvt_pk_bf16(v1[2], v1[3]);
                    *(u32x4*)(rowp + bj * HALF) = w; } }
    }
};
struct EpiStoreF32 {
    static constexpr bool PERM = true, AFTER_DRAIN = false;
    float* O; int ldc;
    __device__ __forceinline__ void operator()(const f32x4 (&acc)[2][2][4][2], const Unit& u, int wr, int wc, int fr, int fq) const {
        const int row0 = u.pm * BM + wr * 64 + fr, col0 = u.pn * BM + wc * 32 + 8 * fq;
#pragma unroll
        for (int ai = 0; ai < 2; ++ai)
#pragma unroll
            for (int m = 0; m < 4; ++m) { float* rowp = O + (size_t)(row0 + ai * HALF + m * 16) * ldc + col0;
#pragma unroll
                for (int bj = 0; bj < 2; ++bj) { *(f32x4*)(rowp + bj * HALF) = acc[ai][bj][m][0]; *(f32x4*)(rowp + bj * HALF + 4) = acc[ai][bj][m][1]; } }
    }
};
__device__ __forceinline__ float silu_f(float g) { return g * __builtin_amdgcn_rcpf(1.0f + __builtin_amdgcn_exp2f(-1.4426950408889634f * g)); }
struct EpiSwiGLU {
    static constexpr bool PERM = true, AFTER_DRAIN = false;
    bf16_t* O; int ldc;
    __device__ __forceinline__ void operator()(const f32x4 (&acc)[2][2][4][2], const Unit& u, int wr, int wc, int fr, int fq) const {
        const int row0 = u.pm * BM + wr * 64 + fr, col0 = (u.pn & 15) * HALF + wc * 32 + 8 * fq;
#pragma unroll
        for (int ai = 0; ai < 2; ++ai)
#pragma unroll
            for (int m = 0; m < 4; ++m) { bf16_t* rowp = O + (size_t)(row0 + ai * HALF + m * 16) * ldc + col0;
                const f32x4 g0 = acc[ai][0][m][0], g1 = acc[ai][0][m][1], u0 = acc[ai][1][m][0], u1 = acc[ai][1][m][1];
                u32x4 w;
                w.x = cvt_pk_bf16(silu_f(g0[0]) * u0[0], silu_f(g0[1]) * u0[1]); w.y = cvt_pk_bf16(silu_f(g0[2]) * u0[2], silu_f(g0[3]) * u0[3]);
                w.z = cvt_pk_bf16(silu_f(g1[0]) * u1[0], silu_f(g1[1]) * u1[1]); w.w = cvt_pk_bf16(silu_f(g1[2]) * u1[2], silu_f(g1[3]) * u1[3]);
                *(u32x4*)rowp = w; }
    }
};

template <class Epi, class Sched, bool ALIGN_EPI = false, bool SP2 = false>
__device__ __forceinline__ void gemm_phase(PG8_LAS unsigned char* lds, const Gemm g, const Sched& S, const Epi& E) {
    const int tid = threadIdx.x, wid = __builtin_amdgcn_readfirstlane(tid >> 6), lane = tid & 63, wr = wid >> 2, wc = wid & 3, fr = lane & 15, fq = lane >> 4;
    const int K = g.K, nt = K / BK;
    unsigned voffA[2], voffB[2];
#pragma unroll
    for (int i = 0; i < 2; ++i) { int R, C; stage_rc(tid * 16 + i * 8192, R, C); const int Rb = Epi::PERM ? ((R & ~31) + perm32(R & 31)) : R;
        voffA[i] = (unsigned)(R * K + C) * 2u; voffB[i] = (unsigned)(Rb * K + C) * 2u; }
    const size_t kstep = (size_t)(BK * 2);
    const size_t hstep = (size_t)HALF * K * 2;
    const size_t tstep = 2 * hstep;
    const unsigned ldsw = (unsigned)wid * 1024u;
    const int aoff = lds_byte(wr * 64 + fr, fq * 8), boff = lds_byte(wc * 32 + fr, fq * 8);
#define PG8_SA(b, h) (((b) * 2 + (h)) * HTB)
#define PG8_SB(b, h) ((4 + (b) * 2 + (h)) * HTB)
#define PG8_STAGE(bufoff, gbase, voff) do { _Pragma("unroll") for (int _i = 0; _i < 2; ++_i) \
        __builtin_amdgcn_global_load_lds((const unsigned*)((const char*)(gbase) + (voff)[_i]), (PG8_LAS unsigned*)(lds + (bufoff) + ldsw + _i * 8192), 16, 0, 0); } while (0)
#define PG8_LDA(dst, b, h) do { _Pragma("unroll") for (int m = 0; m < 4; ++m) _Pragma("unroll") for (int k = 0; k < 2; ++k) dst[m][k] = *(const PG8_LAS bf16x8*)(lds + PG8_SA(b, h) + aoff + m * 2048 + k * 1024); } while (0)
#define PG8_LDB(dst, b, h) do { _Pragma("unroll") for (int n = 0; n < 2; ++n) _Pragma("unroll") for (int k = 0; k < 2; ++k) dst[n][k] = *(const PG8_LAS bf16x8*)(lds + PG8_SB(b, h) + boff + n * 2048 + k * 1024); } while (0)
#define PG8_MMA(ai, bj, At, Bt) do { __builtin_amdgcn_s_setprio(1); _Pragma("unroll") for (int m = 0; m < 4; ++m) _Pragma("unroll") for (int n = 0; n < 2; ++n) _Pragma("unroll") for (int k = 0; k < 2; ++k) \
        acc[ai][bj][m][n] = __builtin_amdgcn_mfma_f32_16x16x32_bf16(Bt[n][k], At[m][k], acc[ai][bj][m][n], 0, 0, 0); __builtin_amdgcn_s_setprio(0); } while (0)
#define PG8_WAIT_V(n) asm volatile("s_waitcnt vmcnt(" #n ")" ::: "memory")
#define PG8_WAIT_L(n) asm volatile("s_waitcnt lgkmcnt(" #n ")" ::: "memory")
#define PG8_BAR __builtin_amdgcn_s_barrier()
#define PG8_SCHED __builtin_amdgcn_sched_barrier(0)
    Unit cur, nxt; int ui = 0;
    if (!S.next(0, cur)) return;
    f32x4 acc[2][2][4][2];
#pragma unroll
    for (int a = 0; a < 2; ++a)
#pragma unroll
        for (int b = 0; b < 2; ++b)
#pragma unroll
            for (int m = 0; m < 4; ++m)
#pragma unroll
                for (int n = 0; n < 2; ++n) acc[a][b][m][n] = (f32x4){0.f, 0.f, 0.f, 0.f};
    bf16x8 At[4][2], B0[2][2], B1[2][2];
    const char* cA = (const char*)g.A + (size_t)cur.pm * tstep; const char* cB = (const char*)g.Bt + (size_t)cur.pn * tstep;
    S.a_ready(cur);
    if constexpr (SP2) {
        PG8_STAGE(PG8_SB(0, 0), cB, voffB); PG8_STAGE(PG8_SB(0, 1), cB + hstep, voffB); PG8_STAGE(PG8_SA(0, 0), cA, voffA); PG8_STAGE(PG8_SA(0, 1), cA + hstep, voffA);
        if (wr == 1) PG8_BAR;
        PG8_WAIT_V(2); PG8_BAR;
        PG8_STAGE(PG8_SB(1, 0), cB + kstep, voffB); PG8_STAGE(PG8_SA(1, 0), cA + kstep, voffA); PG8_STAGE(PG8_SB(1, 1), cB + hstep + kstep, voffB);
        PG8_WAIT_V(6); PG8_BAR;
    } else {
        PG8_STAGE(PG8_SB(0, 0), cB, voffB); PG8_STAGE(PG8_SA(0, 0), cA, voffA); PG8_STAGE(PG8_SB(0, 1), cB + hstep, voffB); PG8_STAGE(PG8_SA(0, 1), cA + hstep, voffA);
        if (wr == 1) PG8_BAR;
        PG8_WAIT_V(4); PG8_BAR;
        PG8_STAGE(PG8_SB(1, 0), cB + kstep, voffB); PG8_STAGE(PG8_SA(1, 0), cA + kstep, voffA); PG8_STAGE(PG8_SB(1, 1), cB + hstep + kstep, voffB);
        PG8_WAIT_V(6); PG8_BAR;
    }
    for (;;) {
        const bool has_next = S.next(ui + 1, nxt);
        const char* nA = has_next ? (const char*)g.A + (size_t)nxt.pm * tstep : cA; const char* nB = has_next ? (const char*)g.Bt + (size_t)nxt.pn * tstep : cB;
        for (int t = 0; t < nt; t += 2) {
            const bool last = (t == nt - 2);
            const char* a1 = cA + (size_t)(t + 1) * kstep;
            const char* a2 = last ? nA : cA + (size_t)(t + 2) * kstep; const char* b2 = last ? nB : cB + (size_t)(t + 2) * kstep;
            const char* a3 = a2 + kstep; const char* b3 = b2 + kstep;
            if (last && has_next) S.a_ready(nxt);
            if constexpr (SP2) {
            PG8_LDB(B0, 0, 0); PG8_LDB(B1, 0, 1); PG8_SCHED; PG8_LDA(At, 0, 0); PG8_STAGE(PG8_SA(1, 1), a1 + hstep, voffA);
            PG8_WAIT_V(8); PG8_WAIT_L(0); PG8_BAR; PG8_MMA(0, 0, At, B0); PG8_MMA(0, 1, At, B1); PG8_BAR; PG8_SCHED;
            PG8_LDA(At, 0, 1); PG8_STAGE(PG8_SB(0, 0), b2, voffB); PG8_STAGE(PG8_SB(0, 1), b2 + hstep, voffB); PG8_STAGE(PG8_SA(0, 0), a2, voffA);
            PG8_WAIT_V(8); PG8_WAIT_L(0); PG8_BAR; PG8_MMA(1, 0, At, B0); PG8_MMA(1, 1, At, B1); PG8_BAR; PG8_SCHED;
            PG8_LDB(B0, 1, 0); PG8_LDB(B1, 1, 1); PG8_SCHED; PG8_LDA(At, 1, 0); PG8_STAGE(PG8_SA(0, 1), a2 + hstep, voffA);
            PG8_WAIT_V(8); PG8_WAIT_L(0); PG8_BAR; PG8_MMA(0, 0, At, B0); PG8_MMA(0, 1, At, B1); PG8_BAR; PG8_SCHED;
            PG8_LDA(At, 1, 1); PG8_STAGE(PG8_SB(1, 0), b3, voffB); PG8_STAGE(PG8_SB(1, 1), b3 + hstep, voffB); PG8_STAGE(PG8_SA(1, 0), a3, voffA);
            PG8_WAIT_V(8); PG8_WAIT_L(0); PG8_BAR; PG8_MMA(1, 0, At, B0); PG8_MMA(1, 1, At, B1); PG8_BAR; PG8_SCHED;
            } else {
            PG8_LDB(B0, 0, 0); PG8_SCHED; PG8_LDA(At, 0, 0); PG8_STAGE(PG8_SA(1, 1), a1 + hstep, voffA);
            PG8_WAIT_L(8); PG8_BAR; PG8_WAIT_L(0); PG8_MMA(0, 0, At, B0); PG8_BAR; PG8_SCHED;
            PG8_LDB(B1, 0, 1); PG8_STAGE(PG8_SB(0, 0), b2, voffB);
            PG8_BAR; PG8_WAIT_L(0); PG8_MMA(0, 1, At, B1); PG8_BAR;
            PG8_LDA(At, 0, 1); PG8_STAGE(PG8_SA(0, 0), a2, voffA);
            PG8_BAR; PG8_WAIT_L(0); PG8_MMA(1, 0, At, B0); PG8_BAR; PG8_SCHED;
            PG8_STAGE(PG8_SB(0, 1), b2 + hstep, voffB);
            PG8_WAIT_V(6); PG8_BAR; PG8_MMA(1, 1, At, B1); PG8_BAR;
            PG8_LDB(B0, 1, 0); PG8_SCHED; PG8_LDA(At, 1, 0); PG8_STAGE(PG8_SA(0, 1), a2 + hstep, voffA);
            PG8_WAIT_L(8); PG8_BAR; PG8_WAIT_L(0); PG8_MMA(0, 0, At, B0); PG8_BAR; PG8_SCHED;
            PG8_LDB(B1, 1, 1); PG8_STAGE(PG8_SB(1, 0), b3, voffB);
            PG8_BAR; PG8_WAIT_L(0); PG8_MMA(0, 1, At, B1); PG8_BAR;
            PG8_LDA(At, 1, 1); PG8_STAGE(PG8_SA(1, 0), a3, voffA);
            PG8_BAR; PG8_WAIT_L(0); PG8_MMA(1, 0, At, B0); PG8_BAR; PG8_SCHED;
            PG8_STAGE(PG8_SB(1, 1), b3 + hstep, voffB);
            PG8_WAIT_V(6); PG8_BAR; PG8_MMA(1, 1, At, B1); PG8_BAR;
            }
        }
        if constexpr (ALIGN_EPI) { if (wr == 0) PG8_BAR; }
        if constexpr (!Epi::AFTER_DRAIN) { E(acc, cur, wr, wc, fr, fq); S.done(cur); }
        if (!has_next) break;
#pragma unroll
        for (int a = 0; a < 2; ++a)
#pragma unroll
            for (int b = 0; b < 2; ++b)
#pragma unroll
                for (int m = 0; m < 4; ++m)
#pragma unroll
                    for (int n = 0; n < 2; ++n) acc[a][b][m][n] = (f32x4){0.f, 0.f, 0.f, 0.f};
        cur = nxt; cA = nA; cB = nB; ++ui;
        if constexpr (ALIGN_EPI) { if (wr == 1) PG8_BAR; }
    }
    PG8_WAIT_V(0);
    if constexpr (!ALIGN_EPI) { if (wr == 0) PG8_BAR; }
    PG8_BAR;
    if constexpr (Epi::AFTER_DRAIN) { E.fused(acc, cur, wr, wc, fr, fq, lds, wid, lane); S.done(cur); }
#undef PG8_SA
#undef PG8_SB
#undef PG8_STAGE
#undef PG8_LDA
#undef PG8_LDB
#undef PG8_MMA
#undef PG8_WAIT_V
#undef PG8_WAIT_L
#undef PG8_BAR
#undef PG8_SCHED
}
#ifndef PG8_KROT
#define PG8_KROT 0
#endif
#ifndef PG8_PF_DIST
#define PG8_PF_DIST 0
#endif
template <int LDW_> struct BDense { static constexpr int LDW = LDW_; const float* W; __device__ __forceinline__ void ptrs(const Unit& u, const float*& b0, const float*& b1) const { b0 = W + (size_t)u.pn * 256; b1 = b0 + 128; } };
struct BMoeGU { static constexpr int LDW = 2048; const float* G; const float* U; __device__ __forceinline__ void ptrs(const Unit& u, const float*& b0, const float*& b1) const {
    const size_t o = (size_t)(u.pn >> 4) * 2048 * 2048 + (size_t)(u.pn & 15) * 128; b0 = G + o; b1 = U + o; } };
struct BMoeDn { static constexpr int LDW = 2048; const float* W; __device__ __forceinline__ void ptrs(const Unit& u, const float*& b0, const float*& b1) const {
    b0 = W + (size_t)(u.pn >> 3) * 2048 * 2048 + (size_t)(u.pn & 7) * 256; b1 = b0 + 128; } };
typedef float f32x2 __attribute__((ext_vector_type(2)));
typedef __bf16 bf16x2_t __attribute__((ext_vector_type(2)));
__device__ __forceinline__ unsigned cvt_pk_c(float lo, float hi) { f32x2 v = {lo, hi}; bf16x2_t b = __builtin_convertvector(v, bf16x2_t); return __builtin_bit_cast(unsigned, b); }

template <class Epi, class Sched, class BMap, bool ALIGN_EPI = true>
__device__ __forceinline__ void gemm_phase_w(PG8_LAS unsigned char* lds, const bf16_t* Ag, const int K, const BMap BM_, const Sched& S, const Epi& E) {
    static_assert(Epi::PERM && !Epi::AFTER_DRAIN, "gemm_phase_w: PERM epilogues only");
    const int tid = threadIdx.x, wid = __builtin_amdgcn_readfirstlane(tid >> 6), lane = tid & 63, wr = wid >> 2, wc = wid & 3, fr = lane & 15, fq = lane >> 4;
    const int nt = K / BK;
    unsigned voffA[2];
#pragma unroll
    for (int i = 0; i < 2; ++i) { int R, C; stage_rc(tid * 16 + i * 8192, R, C); voffA[i] = (unsigned)(R * K + C) * 2u; }
    const size_t kstep = (size_t)(BK * 2);
    const size_t hstep = (size_t)HALF * K * 2;
    const size_t tstep = 2 * hstep;
    const unsigned ldsw = (unsigned)wid * 1024u;
    const int aoff = lds_byte(wr * 64 + fr, fq * 8), boff = lds_byte(wc * 32 + fr, fq * 8);
    constexpr int ldw = BMap::LDW;
    const int bh = wid >> 2, cb = (wid >> 1) & 1, kh = wid & 1, bq = lane & 15, bch = lane >> 4;
    const unsigned blane = (unsigned)(bch * 8 * ldw + 4 * bq) * 4u;
    const size_t bkt = (size_t)BK * ldw;
    const int bslab = 64 * cb + 32 * kh * ldw;
    const int rho0 = 32 * (2 * cb + (bq >> 3)) + 16 * (bq & 1) + 4 * ((bq & 7) >> 1), bs = (bq & 1);
    const bool rot1 = (bs & 1) != 0;
    constexpr int PFD = PG8_PF_DIST;
    const unsigned pfv = (unsigned)((16 * (wid & 3) + 4 * (lane >> 4)) * ldw * 4 + ((lane >> 2) & 3) * 128);
    unsigned pfd = 0u;
    unsigned wadr[4];
#pragma unroll
    for (int j = 0; j < 4; ++j) wadr[j] = (unsigned)(uintptr_t)lds + (unsigned)(4 * HTB + bh * HTB + lds_byte(rho0 + ((j + bs) & 3), 32 * kh + 8 * bch));
#define PG8_SA(b, h) (((b) * 2 + (h)) * HTB)
#define PG8_SB(b, h) ((4 + (b) * 2 + (h)) * HTB)
#define PG8_STAGE(bufoff, gbase, voff) do { _Pragma("unroll") for (int _i = 0; _i < 2; ++_i) \
        __builtin_amdgcn_global_load_lds((const unsigned*)((const char*)(gbase) + (voff)[_i]), (PG8_LAS unsigned*)(lds + (bufoff) + ldsw + _i * 8192), 16, 0, 0); } while (0)
#define PG8_LDA(dst, b, h) do { _Pragma("unroll") for (int m = 0; m < 4; ++m) _Pragma("unroll") for (int k = 0; k < 2; ++k) dst[m][k] = *(const PG8_LAS bf16x8*)(lds + PG8_SA(b, h) + aoff + m * 2048 + k * 1024); } while (0)
#define PG8_LDB(dst, b, h) do { _Pragma("unroll") for (int n = 0; n < 2; ++n) _Pragma("unroll") for (int k = 0; k < 2; ++k) dst[n][k] = *(const PG8_LAS bf16x8*)(lds + PG8_SB(b, h) + boff + n * 2048 + k * 1024); } while (0)
#define PG8_MMA(ai, bj, At, Bt) do { __builtin_amdgcn_s_setprio(1); _Pragma("unroll") for (int m = 0; m < 4; ++m) _Pragma("unroll") for (int n = 0; n < 2; ++n) _Pragma("unroll") for (int k = 0; k < 2; ++k) \
        acc[ai][bj][m][n] = __builtin_amdgcn_mfma_f32_16x16x32_bf16(Bt[n][k], At[m][k], acc[ai][bj][m][n], 0, 0, 0); __builtin_amdgcn_s_setprio(0); } while (0)
#define PG8_WAIT_V(n) asm volatile("s_waitcnt vmcnt(" #n ")" ::: "memory")
#if PG8_PF_DIST > 0
#define PG8_WAIT_VA PG8_WAIT_V(13)
#define PG8_WAIT_VB PG8_WAIT_V(5)
#define PG8_WAIT_VC PG8_WAIT_V(14)
#else
#define PG8_WAIT_VA PG8_WAIT_V(12)
#define PG8_WAIT_VB PG8_WAIT_V(4)
#define PG8_WAIT_VC PG8_WAIT_V(12)
#endif
#define PG8_WAIT_L(n) asm volatile("s_waitcnt lgkmcnt(" #n ")" ::: "memory")
#define PG8_BAR __builtin_amdgcn_s_barrier()
#define PG8_SCHED __builtin_amdgcn_sched_barrier(0)
#define PG8_GAS __attribute__((address_space(1)))
#define PG8_BLOAD(sb) do { const PG8_GAS char* sb_ = (const PG8_GAS char*)(sb); _Pragma("unroll") for (int kk = 0; kk < 8; ++kk) { \
        const PG8_GAS char* p_ = sb_ + (size_t)(kk * ldw * 4); asm volatile("global_load_dwordx4 %0, %1, %2" : "=v"(breg[kk]) : "v"(blane), "s"(p_) : "memory"); } } while (0)
#define PG8_BWRITE(b) do { u32x4 d_[4]; _Pragma("unroll") for (int i = 0; i < 4; ++i) { \
        d_[i].x = cvt_pk_bf16(breg[0][i], breg[1][i]); d_[i].y = cvt_pk_bf16(breg[2][i], breg[3][i]); d_[i].z = cvt_pk_bf16(breg[4][i], breg[5][i]); d_[i].w = cvt_pk_bf16(breg[6][i], breg[7][i]); } \
        u32x4 t_[4]; _Pragma("unroll") for (int j = 0; j < 4; ++j) { const u32x4 a_ = d_[j], b_ = d_[(j + 1) & 3]; t_[j].x = rot1 ? b_.x : a_.x; t_[j].y = rot1 ? b_.y : a_.y; t_[j].z = rot1 ? b_.z : a_.z; t_[j].w = rot1 ? b_.w : a_.w; } \
        _Pragma("unroll") for (int j = 0; j < 4; ++j) { \
            asm volatile("ds_write_b128 %0, %1 offset:%2" :: "v"(wadr[j]), "v"(t_[j]), "i"((b) * 2 * HTB) : "memory"); } } while (0)
#define PG8_PF(p) do { if constexpr (PFD > 0) { const PG8_GAS char* q_ = (p); asm volatile("global_load_dword %0, %1, %2" : "+v"(pfd) : "v"(pfv), "s"(q_) : "memory"); } } while (0)
    Unit cur, nxt; int ui = 0;
    if (!S.next(0, cur)) return;
    f32x4 acc[2][2][4][2];
#pragma unroll
    for (int a = 0; a < 2; ++a)
#pragma unroll
        for (int b = 0; b < 2; ++b)
#pragma unroll
            for (int m = 0; m < 4; ++m)
#pragma unroll
                for (int n = 0; n < 2; ++n) acc[a][b][m][n] = (f32x4){0.f, 0.f, 0.f, 0.f};
    bf16x8 At[4][2], B0[2][2], B1[2][2];
    f32x4 breg[8];
    const char* cA = (const char*)Ag + (size_t)cur.pm * tstep;
    const float* cB; const PG8_GAS char* cP; { const float *b0, *b1; BM_.ptrs(cur, b0, b1); cB = (bh ? b1 : b0) + bslab; cP = (const PG8_GAS char*)(bh ? b1 : b0) + (size_t)((cur.pm & 3) * ldw * 4); }
    int crot = PG8_KROT ? S.krot(cur) : 0;
#define PG8_KT(i, rot) (((i) + (rot)) & (nt - 1))
    S.a_ready(cur);
    PG8_STAGE(PG8_SA(0, 0), cA + (size_t)PG8_KT(0, crot) * kstep, voffA); PG8_STAGE(PG8_SA(0, 1), cA + (size_t)PG8_KT(0, crot) * kstep + hstep, voffA);
    PG8_BLOAD(cB + (size_t)PG8_KT(0, crot) * bkt);
    PG8_WAIT_V(0); PG8_BWRITE(0);
    PG8_BLOAD(cB + (size_t)PG8_KT(1, crot) * bkt);
    PG8_STAGE(PG8_SA(1, 0), cA + (size_t)PG8_KT(1, crot) * kstep, voffA);
    PG8_WAIT_V(0); PG8_WAIT_L(0);
    if (wr == 1) PG8_BAR;
    PG8_BAR;
    PG8_BAR;
    for (;;) {
        const bool has_next = S.next(ui + 1, nxt);
        const char* nA = has_next ? (const char*)Ag + (size_t)nxt.pm * tstep : cA;
        const int nrot = (has_next && PG8_KROT) ? S.krot(nxt) : crot;
        const float* nB = cB; const PG8_GAS char* nP = cP; if (has_next) { const float *b0, *b1; BM_.ptrs(nxt, b0, b1); nB = (bh ? b1 : b0) + bslab; nP = (const PG8_GAS char*)(bh ? b1 : b0) + (size_t)((nxt.pm & 3) * ldw * 4); }
        for (int t = 0; t < nt; t += 2) {
            const bool last = (t == nt - 2);
            const int k1 = PG8_KT(t + 1, crot), k2 = last ? PG8_KT(0, nrot) : PG8_KT(t + 2, crot), k3 = last ? PG8_KT(1, nrot) : PG8_KT(t + 3, crot);
            const char* a1 = cA + (size_t)k1 * kstep;
            const char* a2 = (last ? nA : cA) + (size_t)k2 * kstep;
            const char* a3 = (last ? nA : cA) + (size_t)k3 * kstep;
            const float* b2 = (last ? nB : cB) + (size_t)k2 * bkt;
            const float* b3 = (last ? nB : cB) + (size_t)k3 * bkt;
            const int i2 = t + 2 + PFD, i3 = i2 + 1;
            const PG8_GAS char* pf2 = i2 < nt ? cP + (size_t)i2 * (bkt * 4) : nP + (size_t)(i2 - nt) * (bkt * 4);
            const PG8_GAS char* pf3 = i3 < nt ? cP + (size_t)i3 * (bkt * 4) : nP + (size_t)(i3 - nt) * (bkt * 4);
            if (last && has_next) S.a_ready(nxt);
            PG8_LDB(B0, 0, 0); PG8_LDB(B1, 0, 1); PG8_SCHED; PG8_LDA(At, 0, 0); PG8_STAGE(PG8_SA(1, 1), a1 + hstep, voffA);
            PG8_WAIT_VA; PG8_WAIT_L(0); PG8_BAR; PG8_MMA(0, 0, At, B0); PG8_MMA(0, 1, At, B1); PG8_BAR; PG8_SCHED;
            PG8_LDA(At, 0, 1); PG8_WAIT_VB; PG8_BWRITE(1); PG8_BLOAD(b2); PG8_STAGE(PG8_SA(0, 0), a2, voffA); PG8_PF(pf2);
            PG8_WAIT_VC; PG8_WAIT_L(0); PG8_BAR; PG8_MMA(1, 0, At, B0); PG8_MMA(1, 1, At, B1); PG8_BAR; PG8_SCHED;
            PG8_LDB(B0, 1, 0); PG8_LDB(B1, 1, 1); PG8_SCHED; PG8_LDA(At, 1, 0); PG8_STAGE(PG8_SA(0, 1), a2 + hstep, voffA);
            PG8_WAIT_VA; PG8_WAIT_L(0); PG8_BAR; PG8_MMA(0, 0, At, B0); PG8_MMA(0, 1, At, B1); PG8_BAR; PG8_SCHED;
            PG8_LDA(At, 1, 1); PG8_WAIT_VB; PG8_BWRITE(0); PG8_BLOAD(b3); PG8_STAGE(PG8_SA(1, 0), a3, voffA); PG8_PF(pf3);
            PG8_WAIT_VC; PG8_WAIT_L(0); PG8_BAR; PG8_MMA(1, 0, At, B0); PG8_MMA(1, 1, At, B1); PG8_BAR; PG8_SCHED;
        }
        if constexpr (ALIGN_EPI) { if (wr == 0) PG8_BAR; }
        E(acc, cur, wr, wc, fr, fq); S.done(cur);
        if (!has_next) break;
#pragma unroll
        for (int a = 0; a < 2; ++a)
#pragma unroll
            for (int b = 0; b < 2; ++b)
#pragma unroll
                for (int m = 0; m < 4; ++m)
#pragma unroll
                    for (int n = 0; n < 2; ++n) acc[a][b][m][n] = (f32x4){0.f, 0.f, 0.f, 0.f};
        cur = nxt; cA = nA; cB = nB; cP = nP; crot = nrot; ++ui;
        if constexpr (ALIGN_EPI) { if (wr == 1) PG8_BAR; }
    }
    PG8_WAIT_V(0);
    asm volatile("" :: "v"(pfd));
    if constexpr (!ALIGN_EPI) { if (wr == 0) PG8_BAR; }
    PG8_BAR;
#undef PG8_PF
#undef PG8_KT
#undef PG8_WAIT_VA
#undef PG8_WAIT_VB
#undef PG8_WAIT_VC
#undef PG8_SA
#undef PG8_SB
#undef PG8_STAGE
#undef PG8_LDA
#undef PG8_LDB
#undef PG8_MMA
#undef PG8_WAIT_V
#undef PG8_WAIT_L
#undef PG8_BAR
#undef PG8_SCHED
#undef PG8_BLOAD
#undef PG8_GAS
#undef PG8_BWRITE
}
}
namespace att {
using bf16x8 = __attribute__((ext_vector_type(8))) short;
using s16x4  = __attribute__((ext_vector_type(4))) short;
using f32x16 = __attribute__((ext_vector_type(16))) float;
using u32x4  = __attribute__((ext_vector_type(4))) unsigned;
typedef unsigned short bf16;
constexpr int D = 128, NW = 8, QBLK = 32, KVBLK = 64;
constexpr float SCALE = 0.088388347648318440f;
constexpr float THR = 8.f;
constexpr int SHM_V = KVBLK * D * 2, SHM_K = KVBLK * D * 2, SHM_ATTN = 2 * SHM_V + 2 * SHM_K + NW * 64 * 4;
#define KSWZ(row, colB) ((row) * 256 + ((colB) ^ (((row) & 7) << 4)))
#define SBAR() __builtin_amdgcn_sched_barrier(0)
__device__ __forceinline__ int crow(int r, int hi) { return (r & 3) + 8 * (r >> 2) + 4 * hi; }
__device__ __forceinline__ unsigned cvtpk(float lo, float hi) { unsigned r; asm volatile("v_cvt_pk_bf16_f32 %0, %1, %2" : "=v"(r) : "v"(lo), "v"(hi)); return r; }

__device__ __forceinline__ void partialSM(f32x16& p0, f32x16& p1, float& m_reg, float& mn, float& alpha, bool domask, int dm, int hi) {
  constexpr float C = SCALE * 1.4426950408889634f;
  if (domask) {
    const int db = dm + 4 * hi + 128;
#pragma unroll
    for (int r = 0; r < 16; ++r) { const int d0 = db + (r & 3) + 8 * (r >> 2);
      if ((unsigned)d0 > 256u) p0[r] = -1e30f; if ((unsigned)(d0 + 32) > 256u) p1[r] = -1e30f; }
  }
  float pmax = p0[0];
#pragma unroll
  for (int r = 1; r < 16; ++r) pmax = fmaxf(pmax, p0[r]);
#pragma unroll
  for (int r = 0; r < 16; ++r) pmax = fmaxf(pmax, p1[r]);
  { auto rr = __builtin_amdgcn_permlane32_swap(__float_as_uint(pmax), __float_as_uint(pmax), false, false);
    pmax = fmaxf(__uint_as_float(rr[0]), __uint_as_float(rr[1])); }
  if (__builtin_expect(__all(pmax - m_reg <= THR / SCALE), 1)) { mn = m_reg; alpha = 1.f; }
  else { mn = fmaxf(m_reg, pmax); alpha = __builtin_amdgcn_exp2f((m_reg - mn) * C); m_reg = mn; }
  float mnC = -mn * C;
#pragma unroll
  for (int r = 0; r < 16; ++r) p0[r] = fmaf(p0[r], C, mnC);
#pragma unroll
  for (int r = 0; r < 16; ++r) p1[r] = fmaf(p1[r], C, mnC);
#pragma unroll
  for (int r = 0; r < 16; ++r) p0[r] = __builtin_amdgcn_exp2f(p0[r]);
}
__device__ __forceinline__ void finishSM(f32x16& p0, f32x16& p1, float alpha, float& l_reg, bf16x8& pa0, bf16x8& pa1, bf16x8& pa2, bf16x8& pa3) {
#pragma unroll
  for (int r = 0; r < 16; ++r) p1[r] = __builtin_amdgcn_exp2f(p1[r]);
  float ps = 0;
#pragma unroll
  for (int r = 0; r < 16; ++r) ps += p0[r];
#pragma unroll
  for (int r = 0; r < 16; ++r) ps += p1[r];
  { auto rr = __builtin_amdgcn_permlane32_swap(__float_as_uint(ps), __float_as_uint(ps), false, false);
    ps = __uint_as_float(rr[0]) + __uint_as_float(rr[1]); }
  l_reg = l_reg * alpha + ps;
#define PK4(P, BASE, OUT) do { unsigned a0 = cvtpk(P[BASE + 0], P[BASE + 1]), a1 = cvtpk(P[BASE + 2], P[BASE + 3]);   \
    unsigned b0 = cvtpk(P[BASE + 4], P[BASE + 5]), b1 = cvtpk(P[BASE + 6], P[BASE + 7]);                              \
    auto r0 = __builtin_amdgcn_permlane32_swap(a0, b0, false, false); auto r1 = __builtin_amdgcn_permlane32_swap(a1, b1, false, false); \
    u32x4 w = {r0[0], r1[0], r0[1], r1[1]}; OUT = *reinterpret_cast<bf16x8*>(&w); } while (0)
  PK4(p0, 0, pa0); PK4(p0, 8, pa1); PK4(p1, 0, pa2); PK4(p1, 8, pa3);
#undef PK4
}
__device__ __forceinline__ void qkt(f32x16& p0, f32x16& p1, const char* Ks, const bf16x8* qr, int r32, int hi) {
  p0 = f32x16{}; p1 = f32x16{};
#pragma unroll
  for (int d0 = 0; d0 < 8; ++d0) { int cb = (d0 * 16 + hi * 8) * 2;
    bf16x8 b0 = *reinterpret_cast<const bf16x8*>(Ks + KSWZ(r32, cb));
    bf16x8 b1 = *reinterpret_cast<const bf16x8*>(Ks + KSWZ(32 + r32, cb));
    p0 = __builtin_amdgcn_mfma_f32_32x32x16_bf16(b0, qr[d0], p0, 0, 0, 0);
    p1 = __builtin_amdgcn_mfma_f32_32x32x16_bf16(b1, qr[d0], p1, 0, 0, 0); }
}
__device__ __forceinline__ int v_st(int k, int c) { const int kk = (k & ~0xC) | ((k & 4) << 1) | ((k & 8) >> 1); return ((kk >> 3) * 4 + (c >> 5)) * 512 + ((kk & 7) * 32 + (c & 31)) * 2; }
__device__ __forceinline__ int v_rd_base(int lane) { return ((lane & 3) << 3) | (((lane >> 2) & 3) << 6) | (((lane >> 4) & 1) << 5) | (((lane >> 5) & 1) << 8); }
constexpr int v_rd_off(int d0, int ks, int half) { return d0 * 512 + ks * 4096 + half * 2048; }
template <int OFF> __device__ __forceinline__ s16x4 tr_read(int vb) {
  s16x4 r; asm volatile("ds_read_b64_tr_b16 %0, %1 offset:%2" : "=&v"(r) : "v"(vb), "i"(OFF) : "memory"); return r;
}
template <int D0> __device__ __forceinline__ void pv_one(f32x16& od, int vb, bf16x8 pa0, bf16x8 pa1, bf16x8 pa2, bf16x8 pa3) {
  const s16x4 l0 = tr_read<v_rd_off(D0, 0, 0)>(vb), h0 = tr_read<v_rd_off(D0, 0, 1)>(vb), l1 = tr_read<v_rd_off(D0, 1, 0)>(vb), h1 = tr_read<v_rd_off(D0, 1, 1)>(vb);
  const s16x4 l2 = tr_read<v_rd_off(D0, 2, 0)>(vb), h2 = tr_read<v_rd_off(D0, 2, 1)>(vb), l3 = tr_read<v_rd_off(D0, 3, 0)>(vb), h3 = tr_read<v_rd_off(D0, 3, 1)>(vb);
  asm volatile("s_waitcnt lgkmcnt(0)" ::: "memory"); SBAR();
#define PK(L, H) (bf16x8){L[0], L[1], L[2], L[3], H[0], H[1], H[2], H[3]}
  od = __builtin_amdgcn_mfma_f32_32x32x16_bf16(pa0, PK(l0, h0), od, 0, 0, 0);
  od = __builtin_amdgcn_mfma_f32_32x32x16_bf16(pa1, PK(l1, h1), od, 0, 0, 0);
  od = __builtin_amdgcn_mfma_f32_32x32x16_bf16(pa2, PK(l2, h2), od, 0, 0, 0);
  od = __builtin_amdgcn_mfma_f32_32x32x16_bf16(pa3, PK(l3, h3), od, 0, 0, 0);
#undef PK
}
__device__ __forceinline__ void pv_d0(f32x16* o, int vb, bf16x8 pa0, bf16x8 pa1, bf16x8 pa2, bf16x8 pa3) {
  pv_one<0>(o[0], vb, pa0, pa1, pa2, pa3); pv_one<1>(o[1], vb, pa0, pa1, pa2, pa3); pv_one<2>(o[2], vb, pa0, pa1, pa2, pa3); pv_one<3>(o[3], vb, pa0, pa1, pa2, pa3);
}

struct Job {
  const bf16* Q;
  const bf16* K; const bf16* V;
  int NT;
  int kb0;
  int mask;
  int dq;
  int use_sink; float sink_l2;
  void* O; float lam;
};

template <int LD, int OMODE>
__device__ __forceinline__ void attn_unit(const Job& J, char* lds) {
  constexpr int LDO = 2048;
  const int tid = threadIdx.x, wid = tid >> 6, lane = tid & 63, r32 = lane & 31, hi = lane >> 5;
  char* V_lds = lds; char* K_lds = lds + 2 * SHM_V;
  float* ws = (float*)(lds + 2 * SHM_V + 2 * SHM_K) + wid * 64; float* li_l = ws; float* al_l = ws + 32;
  float m_reg = -1e30f, l_reg = 0; f32x16 o[4] = {}; bf16x8 qr[8];
  const bf16* Qw = J.Q + (long)(wid * QBLK + r32) * LD + hi * 8;
#pragma unroll
  for (int d0 = 0; d0 < 8; ++d0) qr[d0] = *reinterpret_cast<const bf16x8*>(Qw + d0 * 16);
  const int sr = tid >> 4, sc = (tid & 15) * 8, vst0 = v_st(sr, sc), vst1 = v_st(32 + sr, sc);
  const int vb0 = (int)(uintptr_t)V_lds + v_rd_base(lane);
  const int toff = sr * LD + sc;
  constexpr int ldk = LD; const int kb0 = J.kb0, NT = J.NT;
  const bf16* Kh = J.K; const bf16* Vh = J.V;
  const bool msk = J.mask != 0;
  const int dml = J.dq - (wid * QBLK + r32);
  struct { bf16x8 vs0, vs1, ks0, ks1; } sr_[2];
#define KROWT(t) ((t) < 4 ? (t) * 64 : kb0 + ((t) - 4) * 64)
#define SLOAD(i, t) do { const int k0_ = KROWT(t); const bf16* vp_ = Vh + (size_t)k0_ * ldk + toff; const bf16* kp_ = Kh + (size_t)k0_ * ldk + toff; sr_[i].vs0 = *(const bf16x8*)vp_; sr_[i].vs1 = *(const bf16x8*)(vp_ + 32 * ldk); \
    sr_[i].ks0 = *(const bf16x8*)kp_; sr_[i].ks1 = *(const bf16x8*)(kp_ + 32 * ldk); } while (0)
#define SWRITE(b, i) do { *(bf16x8*)(V_lds + (b) * SHM_V + vst0) = sr_[i].vs0;          \
    *(bf16x8*)(V_lds + (b) * SHM_V + vst1) = sr_[i].vs1; int kc = sc * 2;               \
    *(bf16x8*)(K_lds + (b) * SHM_K + KSWZ(sr, kc)) = sr_[i].ks0;                       \
    *(bf16x8*)(K_lds + (b) * SHM_K + KSWZ(32 + sr, kc)) = sr_[i].ks1; } while (0)
#define SWAIT() asm volatile("s_waitcnt vmcnt(4)" ::: "memory")
#define RESC(a) do { if (__any((a) < 1.f)) { if (hi == 0) al_l[r32] = (a); asm volatile("s_waitcnt lgkmcnt(0)" ::: "memory"); \
    _Pragma("unroll") for (int d = 0; d < 4; ++d) _Pragma("unroll") for (int r = 0; r < 16; ++r) o[d][r] *= al_l[crow(r, hi)]; } } while (0)
#define MSK(t) (msk && (t) >= 4), (dml + ((t) - 4) * 64)
  f32x16 pA0, pA1, pB0, pB1; float mnA, mnB, alA, alB; bf16x8 pa0, pa1, pa2, pa3;
  constexpr int SE = 0, SO = 1;
  SLOAD(SE, 0); asm volatile("s_waitcnt vmcnt(0)" ::: "memory"); SWRITE(0, SE); __syncthreads();
  qkt(pA0, pA1, K_lds, qr, r32, hi); partialSM(pA0, pA1, m_reg, mnA, alA, false, 0, hi);
  SLOAD(SO, 1); if (2 < NT) SLOAD(SE, 2);
  SWAIT(); SWRITE(1, SO); __syncthreads();
  for (int j = 1; j + 1 < NT; j += 2) {
    SBAR(); qkt(pB0, pB1, K_lds + SHM_K, qr, r32, hi);
    finishSM(pA0, pA1, alA, l_reg, pa0, pa1, pa2, pa3); SBAR();
    SLOAD(SO, j + 2); SBAR();
    pv_d0(o, vb0, pa0, pa1, pa2, pa3); partialSM(pB0, pB1, m_reg, mnB, alB, MSK(j), hi);
    __syncthreads(); SWAIT(); SWRITE(0, SE);
    RESC(alB); __syncthreads();
    SBAR(); qkt(pA0, pA1, K_lds, qr, r32, hi);
    finishSM(pB0, pB1, alB, l_reg, pa0, pa1, pa2, pa3); SBAR();
    if (j + 3 < NT) SLOAD(SE, j + 3); SBAR();
    pv_d0(o, vb0 + SHM_V, pa0, pa1, pa2, pa3); partialSM(pA0, pA1, m_reg, mnA, alA, MSK(j + 1), hi);
    __syncthreads(); SWAIT(); SWRITE(1, SO);
    RESC(alA); __syncthreads();
  }
  SBAR(); qkt(pB0, pB1, K_lds + SHM_K, qr, r32, hi);
  finishSM(pA0, pA1, alA, l_reg, pa0, pa1, pa2, pa3); SBAR();
  pv_d0(o, vb0, pa0, pa1, pa2, pa3); partialSM(pB0, pB1, m_reg, mnB, alB, MSK(NT - 1), hi);
  __syncthreads(); RESC(alB);
  finishSM(pB0, pB1, alB, l_reg, pa0, pa1, pa2, pa3); SBAR();
  pv_d0(o, vb0 + SHM_V, pa0, pa1, pa2, pa3);
  if (J.use_sink) l_reg += __builtin_amdgcn_exp2f(J.sink_l2 - m_reg * (SCALE * 1.4426950408889634f));
  if (hi == 0) li_l[r32] = l_reg; asm volatile("s_waitcnt lgkmcnt(0)" ::: "memory");
  float rli[16];
#pragma unroll
  for (int r = 0; r < 16; ++r) rli[r] = __builtin_amdgcn_rcpf(li_l[crow(r, hi)]);
  if constexpr (OMODE == 0) {
    bf16* Ow = (bf16*)J.O + (long)(wid * QBLK) * LDO + r32;
#pragma unroll
    for (int r = 0; r < 16; ++r) { const int orow = crow(r, hi);
#pragma unroll
      for (int d0 = 0; d0 < 4; ++d0) Ow[orow * LDO + d0 * 32] = (bf16)(cvtpk(o[d0][r] * rli[r], 0.f) & 0xffffu); }
  } else if constexpr (OMODE == 1) {
    float* Ow = (float*)J.O + (long)(wid * QBLK) * LDO + r32;
#pragma unroll
    for (int r = 0; r < 16; ++r) { const int orow = crow(r, hi);
#pragma unroll
      for (int d0 = 0; d0 < 4; ++d0) Ow[orow * LDO + d0 * 32] = o[d0][r] * rli[r]; }
  }
#undef KROWT
#undef SLOAD
#undef SWRITE
#undef SWAIT
#undef RESC
#undef MSK
}
#undef KSWZ
#undef SBAR
}

constexpr int NWAVES = 8;
constexpr int DM = 2048, NBATCH = 2, SEQ = 4096, CTXL = 256, SB = SEQ + CTXL  , NROWS = NBATCH * SB  ;
constexpr int NEXP = 16, CAP_L = 512, CAP_C = 32, EROWS = 1280  ;
constexpr int NQKV0 = 3072, NQKV1 = 6144, NMOD = 6 * DM;
constexpr float EPS = 1e-6f;
constexpr float LAMBDA_INIT = 0.35550906759096926f;

constexpr size_t MiB = 1u << 20;
constexpr size_t WS_CTL = 0, CTL_ZERO_BYTES = 1 * MiB;
constexpr size_t WS_ROPE = 1 * MiB;
constexpr size_t WS_MODS = 2 * MiB;
constexpr size_t WS_AFF  = 3 * MiB;
constexpr size_t WS_RL   = 4 * MiB;
constexpr size_t WS_GATE = 5 * MiB;
constexpr size_t WS_INV  = 6 * MiB;
constexpr size_t WS_WIN0 = 8 * MiB;
constexpr size_t WS_WOUT0 = WS_WIN0 + 12 * MiB;
constexpr size_t WS_WIN1 = WS_WOUT0 + 8 * MiB;
constexpr size_t WS_WOUT1 = WS_WIN1 + 24 * MiB;
constexpr size_t WS_WGU = WS_WOUT1 + 8 * MiB;
constexpr size_t WS_WD  = WS_WGU + 512 * MiB;
constexpr size_t WS_H   = WS_WD + 256 * MiB;
constexpr size_t WS_QKV = WS_H + 34 * MiB;
constexpr size_t WS_Y   = WS_QKV + 102 * MiB;
constexpr size_t WS_YO  = WS_Y + 34 * MiB;
constexpr size_t WS_XL  = WS_YO + 68 * MiB;
constexpr size_t WS_XG  = WS_XL + 68 * MiB;
constexpr size_t WS_HM  = WS_XG + 80 * MiB;
constexpr size_t WS_YE  = WS_HM + 80 * MiB;
constexpr size_t WS_END = WS_YE + 80 * MiB;
constexpr int CW_BAR = 4096;

constexpr int RING_BYTES = 131072;
constexpr int LDSCTL_OFF = RING_BYTES, MISC_OFF = LDSCTL_OFF + 320;
constexpr int LDS_BYTES = 147456;

#define LAS __attribute__((address_space(3)))
typedef unsigned short bf16;
typedef unsigned v4u __attribute__((ext_vector_type(4)));
typedef unsigned v2u __attribute__((ext_vector_type(2)));
typedef int v4i __attribute__((ext_vector_type(4)));
typedef float f32x4 __attribute__((ext_vector_type(4)));
__device__ __forceinline__ unsigned f2bf(float f) { unsigned u = __builtin_bit_cast(unsigned, f); return (u + 0x7fffu + ((u >> 16) & 1u)) >> 16; }
__device__ __forceinline__ unsigned pk2(float lo, float hi) { return f2bf(lo) | (f2bf(hi) << 16); }
__device__ __forceinline__ float bf_lo(unsigned w) { return __builtin_bit_cast(float, w << 16); }
__device__ __forceinline__ float bf_hi(unsigned w) { return __builtin_bit_cast(float, w & 0xffff0000u); }

#define XB_TMO      128
#define XB_XCNT(j)  (256  + 64 * (j))
#define XB_XSUB(j)  (1280 + 64 * (j))
#define XB_XGEN(j)  (2304 + 64 * (j))
#define XB_TOP      3328
#define XB_TOPGEN   3392
#define XCD_BAR_WORDS 3456
#define XB_SPIN_CAP (1u << 18)
__device__ __forceinline__ unsigned xb_ld(unsigned* p)              { return __hip_atomic_load(p, __ATOMIC_RELAXED, __HIP_MEMORY_SCOPE_AGENT); }
__device__ __forceinline__ unsigned xb_add(unsigned* p, unsigned v) { return __hip_atomic_fetch_add(p, v, __ATOMIC_RELAXED, __HIP_MEMORY_SCOPE_AGENT); }
__device__ __forceinline__ unsigned xb_xcc_id() { return (unsigned)__builtin_amdgcn_s_getreg((3 << 11) | 20) & 0xFu; }
#define XB_SPIN(cond, bar) do { unsigned _sp = 0; while (cond) { __builtin_amdgcn_s_sleep(1); \
    if ((++_sp & 255u) == 0u) { if (xb_ld(&(bar)[XB_TMO])) break; if (_sp > XB_SPIN_CAP) { atomicAdd(&(bar)[XB_TMO], 1u); break; } } } } while (0)
struct XcdBarrier { unsigned* bar; unsigned x; volatile LAS unsigned* st; };
__device__ __forceinline__ XcdBarrier xcd_barrier_post(unsigned* bar, volatile LAS unsigned* st) {
    XcdBarrier b; b.bar = bar; b.x = xb_xcc_id(); b.st = st;
    if (threadIdx.x == 0) (void)xb_add(&bar[XB_XCNT(b.x)], 1u);
    return b;
}
__device__ __forceinline__ void xcd_barrier_complete(unsigned* bar, unsigned x, unsigned& nloc, unsigned& nx) {
    const unsigned G = gridDim.x * gridDim.y * gridDim.z;
    unsigned sum, cnt, mine, sp = 0u;
    for (;;) {
        sum = 0u; cnt = 0u; mine = 0u;
#pragma unroll
        for (unsigned j = 0; j < 16; ++j) { const unsigned c = xb_ld(&bar[XB_XCNT(j)]); sum += c; cnt += (c > 0u) ? 1u : 0u; mine = (j == x) ? c : mine; }
        if (sum == G) break;
        __builtin_amdgcn_s_sleep(1);
        if ((++sp & 255u) == 0u) { if (xb_ld(&bar[XB_TMO])) break; if (sp > XB_SPIN_CAP) { atomicAdd(&bar[XB_TMO], 1u); break; } }
    }
    nloc = mine > 0u ? mine : 1u; nx = cnt > 0u ? cnt : 1u;
}
__device__ __forceinline__ void xcd_barrier(const XcdBarrier& b) {
    asm volatile("s_waitcnt vmcnt(0)" ::: "memory");
    __syncthreads();
    if (threadIdx.x == 0) {
        unsigned* bar = b.bar;
        __builtin_amdgcn_s_waitcnt(0);
        unsigned nloc = b.st[0], nx = b.st[1];
        if (nloc == 0u) { xcd_barrier_complete(bar, b.x, nloc, nx); b.st[0] = nloc; b.st[1] = nx; }
        const unsigned old = xb_add(&bar[XB_XSUB(b.x)], 1u);
        const unsigned gen = old / nloc;
        if (old + 1u == (gen + 1u) * nloc) {
            __builtin_amdgcn_fence(__ATOMIC_RELEASE, "agent");
            asm volatile("s_waitcnt vmcnt(0)" ::: "memory");
            const unsigned og = xb_add(&bar[XB_TOP], 1u);
            const unsigned tg = og / nx;
            if (og + 1u == (tg + 1u) * nx) xb_add(&bar[XB_TOPGEN], 1u);
            else XB_SPIN(xb_ld(&bar[XB_TOPGEN]) == tg, bar);
            __builtin_amdgcn_fence(__ATOMIC_ACQUIRE, "agent");
            xb_add(&bar[XB_XGEN(b.x)], 1u);
            asm volatile("s_waitcnt vmcnt(0)" ::: "memory");
        } else {
            XB_SPIN(xb_ld(&bar[XB_XGEN(b.x)]) == gen, bar);
            __builtin_amdgcn_fence(__ATOMIC_ACQUIRE, "agent");
            asm volatile("s_waitcnt vmcnt(0)" ::: "memory");
        }
    }
    __syncthreads();
}

struct Args { const float* in[20]; float* out; unsigned char* ws; int ph_lo, ph_hi; };
struct Frame {
    LAS unsigned char* lds;
    int tid, lane, wave, G, gw, NGW;
    __attribute__((address_space(1))) unsigned char* ws;
};
template <class T> __device__ __forceinline__ T* fresh(T* p) { __attribute__((address_space(1))) T* q = (__attribute__((address_space(1))) T*)p; asm volatile("" : "+s"(q)); return (T*)q; }
__device__ __forceinline__ float wave_sum(float v) {
#pragma unroll
    for (int o = 1; o < 64; o <<= 1) v += __shfl_xor(v, o);
    return v;
}
__device__ __forceinline__ int wave_incl_scan(int v, int lane) {
#pragma unroll
    for (int o = 1; o < 64; o <<= 1) { const int t = __shfl_up(v, o); if (lane >= o) v += t; }
    return v;
}
__device__ __forceinline__ void transpose_item(const float* W, int K, int N, bf16* WT, int k0, int n0, int drow0, LAS float* scr, int lane) {
#pragma unroll 8
    for (int i = 0; i < 32; ++i) { const int kk = 2 * i + (lane >> 5); scr[kk * 33 + (lane & 31)] = W[(size_t)(k0 + kk) * N + n0 + (lane & 31)]; }
    asm volatile("s_waitcnt lgkmcnt(0)" ::: "memory");
    const int c = lane & 7;
#pragma unroll
    for (int j = 0; j < 4; ++j) { const int n = (lane >> 3) + 8 * j; const LAS float* s = scr + (8 * c) * 33 + n;
        v4u o; o.x = pk2(s[0 * 33], s[1 * 33]); o.y = pk2(s[2 * 33], s[3 * 33]); o.z = pk2(s[4 * 33], s[5 * 33]); o.w = pk2(s[6 * 33], s[7 * 33]);
        *(v4u*)(WT + (size_t)(drow0 + n) * K + k0 + 8 * c) = o; }
    asm volatile("s_waitcnt lgkmcnt(0)" ::: "memory");
}
__device__ __forceinline__ void ld_row(const float* p, int lane, f32x4 (&v)[8]) {
#pragma unroll
    for (int j = 0; j < 8; ++j) v[j] = *(const f32x4*)(p + 4 * lane + 256 * j);
}
__device__ __forceinline__ float row_rstd(const f32x4 (&v)[8]) {
    float s = 0.f;
#pragma unroll
    for (int j = 0; j < 8; ++j) s += (v[j].x * v[j].x + v[j].y * v[j].y) + (v[j].z * v[j].z + v[j].w * v[j].w);
    return 1.0f / sqrtf(wave_sum(s) * (1.0f / DM) + EPS);
}
__device__ __forceinline__ void st_row_bf16(bf16* p, int lane, const f32x4 (&v)[8]) {
#pragma unroll
    for (int j = 0; j < 8; ++j) { v2u w; w.x = pk2(v[j].x, v[j].y); w.y = pk2(v[j].z, v[j].w); *(v2u*)(p + 4 * lane + 256 * j) = w; }
}
__device__ __forceinline__ void norm_mod(f32x4 (&h)[8], const f32x4 (&x)[8], float r, const float* g, const float* sc, const float* sh, int lane) {
#pragma unroll
    for (int j = 0; j < 8; ++j) { const int c = 4 * lane + 256 * j; const f32x4 gg = *(const f32x4*)(g + c), s1 = *(const f32x4*)(sc + c), s0 = *(const f32x4*)(sh + c);
        h[j] = x[j] * r * gg * (s1 + 1.0f) + s0; }
}
__device__ __forceinline__ const float* in_row_ptr(const float* x_in, const float* ctx_in, int row) {
    const int b = row / SB, s = row - b * SB;
    return s < CTXL ? ctx_in + ((size_t)(b * CTXL + s)) * DM : x_in + ((size_t)(b * SEQ + s - CTXL)) * DM;
}
__device__ __forceinline__ const float* mods_ptr(const Frame& F, int layer, int row, int chunk) {
    const int b = row / SB, s = row - b * SB; const int vec = s < CTXL ? 2 : b;
    return (const float*)(F.ws + WS_MODS) + ((size_t)(layer * 3 + vec)) * NMOD + chunk * DM;
}

__device__ __forceinline__ void p0_prologue(Frame& F, const float* c_in, const float* c_ctx, const float* mod_w, const float* mod_b, const float* ab_w_in, const float* ab_w_out, const float* dif_w_in, const float* dif_w_out) {
    LAS float* sc = (LAS float*)F.lds;
    LAS float* red = (LAS float*)(F.lds + 24576);
    for (int i = F.tid; i < 3 * DM; i += 512) { const int v = i / DM, k = i - v * DM; const float cv = v < 2 ? c_in[v * DM + k] : c_ctx[k]; sc[i] = cv / (1.0f + __expf(-cv)); }
    __syncthreads();
    const int tx = F.tid & 7, ty = F.tid >> 3;
    for (int it = blockIdx.x; it < 2 * 384; it += F.G) {
        const int l = it / 384, sl = it - l * 384;
        const float* wp = mod_w + (size_t)l * DM * NMOD + sl * 32 + tx * 4;
        f32x4 a0 = {0.f, 0.f, 0.f, 0.f}, a1 = a0, a2 = a0;
#pragma unroll 8
        for (int i = 0; i < 32; ++i) { const int k = ty + 64 * i; const f32x4 w = *(const f32x4*)(wp + (size_t)k * NMOD);
            a0 += w * sc[k]; a1 += w * sc[DM + k]; a2 += w * sc[2 * DM + k]; }
        LAS float* rp = red + F.tid * 12;
        rp[0] = a0.x; rp[1] = a0.y; rp[2] = a0.z; rp[3] = a0.w; rp[4] = a1.x; rp[5] = a1.y; rp[6] = a1.z; rp[7] = a1.w; rp[8] = a2.x; rp[9] = a2.y; rp[10] = a2.z; rp[11] = a2.w;
        __syncthreads();
        if (F.tid < 96) { const int v = F.tid >> 5, col = F.tid & 31, txx = col >> 2, jj = col & 3; float s = 0.f;
            for (int t = 0; t < 64; ++t) s += red[(t * 8 + txx) * 12 + v * 4 + jj];
            ((float*)(F.ws + WS_MODS))[((size_t)(l * 3 + v)) * NMOD + sl * 32 + col] = s + mod_b[l * NMOD + sl * 32 + col]; }
        __syncthreads();
    }
    { const int gi = blockIdx.x * 512 + F.tid;
      if (gi < 2048) { const int pos = gi >> 5, f = gi & 31; const float inv = __builtin_amdgcn_exp2f(-(float)f * (13.287712379549449f / 32.0f)); const float ang = (float)pos * inv;
          float* rt = (float*)(F.ws + WS_ROPE); rt[gi] = __cosf(ang); rt[2048 + gi] = __sinf(ang); } }
    __syncthreads();
    __syncthreads();
    LAS float* scr = (LAS float*)(F.lds + F.wave * 16384);
    constexpr int I_IN0 = 32 * 96, I_OUT = 32 * 64, I_IN1 = 32 * 192;
    constexpr int NITEMS = I_IN0 + I_OUT + I_IN1 + I_OUT;
    for (int it = F.gw; it < NITEMS; it += F.NGW) {
        int r = it;
        if (r < I_IN0) { const int kb = r / 96, nb = r % 96; transpose_item(ab_w_in, DM, NQKV0, (bf16*)(F.ws + WS_WIN0), 64 * kb, 32 * nb, 32 * nb, scr, F.lane); continue; } r -= I_IN0;
        if (r < I_OUT) { const int kb = r / 64, nb = r % 64; transpose_item(ab_w_out, DM, DM, (bf16*)(F.ws + WS_WOUT0), 64 * kb, 32 * nb, 32 * nb, scr, F.lane); continue; } r -= I_OUT;
        if (r < I_IN1) { const int kb = r / 192, nb = r % 192; transpose_item(dif_w_in, DM, NQKV1, (bf16*)(F.ws + WS_WIN1), 64 * kb, 32 * nb, 32 * nb, scr, F.lane); continue; } r -= I_IN1;
        { const int kb = r / 64, nb = r % 64; transpose_item(dif_w_out, DM, DM, (bf16*)(F.ws + WS_WOUT1), 64 * kb, 32 * nb, 32 * nb, scr, F.lane); }
    }
}

__device__ __forceinline__ void t_norm0(Frame& F, const float* x_in, const float* ctx_in, const float* norm_g) {
    for (int row = F.gw; row < NROWS; row += F.NGW) {
        f32x4 x[8], h[8]; ld_row(in_row_ptr(x_in, ctx_in, row), F.lane, x);
        const float r = row_rstd(x);
        norm_mod(h, x, r, fresh(norm_g), mods_ptr(F, 0, row, 1), mods_ptr(F, 0, row, 0), F.lane);
        st_row_bf16((bf16*)(F.ws + WS_H) + (size_t)row * DM, F.lane, h);
    }
}
__device__ __forceinline__ void t_prep(Frame& F, int layer, const float* q_norm, const float* k_norm) {
    const int ld = layer == 0 ? NQKV0 : NQKV1;
    const float* rt = (const float*)(F.ws + WS_ROPE);
    const int f = F.lane & 31, d0 = (F.lane >> 5) * 64 + f;
    for (int row = F.gw; row < NROWS; row += F.NGW) {
        const int b = row / SB, s = row - b * SB; const bool lat = s >= CTXL;
        if (layer == 1 && !lat) continue;
        float cs = 1.f, sn = 0.f;
        if (lat) { const int t = s - CTXL; const int pos = (F.lane >> 5) ? (t & 63) : (t >> 6); cs = rt[pos * 32 + f]; sn = rt[2048 + pos * 32 + f]; }
        bf16* rp = (bf16*)(F.ws + WS_QKV) + (size_t)row * ld;
        const int nheads = layer == 0 ? 20 : 32;
        for (int hh = 0; hh < nheads; ++hh) {
            int col; const float* g = nullptr;
            if (layer == 0) {
                if (hh < 10) col = hh * 128; else if (hh < 18) { col = 1536 + (hh - 10) * 128; g = q_norm; } else { col = 2560 + (hh - 18) * 128; g = k_norm; }
                if (!lat && g == nullptr) continue;
            } else col = hh * 128;
            float a = bf_lo((unsigned)rp[col + d0]), c2 = bf_lo((unsigned)rp[col + d0 + 32]);
            if (g) { const float ss = wave_sum(a * a + c2 * c2); const float r = 1.0f / sqrtf(ss * (1.0f / 128.0f) + EPS); a = a * r * g[d0]; c2 = c2 * r * g[d0 + 32]; }
            const float o1 = a * cs - c2 * sn, o2 = c2 * cs + a * sn;
            rp[col + d0] = (bf16)f2bf(o1); rp[col + d0 + 32] = (bf16)f2bf(o2);
        }
    }
}
__device__ __forceinline__ void t_subln(Frame& F, const float* dif_lambda, const float* dif_subln) {
    const float* lp = dif_lambda;
    const float s01 = wave_sum(lp[F.lane] * lp[128 + F.lane] + lp[64 + F.lane] * lp[192 + F.lane]);
    const float s23 = wave_sum(lp[256 + F.lane] * lp[384 + F.lane] + lp[320 + F.lane] * lp[448 + F.lane]);
    const float lam = __expf(s01) - __expf(s23) + LAMBDA_INIT;
    for (int i = F.gw; i < NBATCH * SEQ; i += F.NGW) {
        const int b = i / SEQ, row = b * SB + CTXL + (i - b * SEQ);
        f32x4 v[8], w[8]; ld_row((const float*)(F.ws + WS_YO) + (size_t)row * DM, F.lane, v); ld_row((const float*)(F.ws + WS_XG) + (size_t)row * DM, F.lane, w);
        const f32x4 g = *(const f32x4*)(fresh(dif_subln) + 4 * F.lane);
#pragma unroll
        for (int j = 0; j < 8; ++j) { v[j] = v[j] - w[j] * lam;
            const float ss = wave_sum((v[j].x * v[j].x + v[j].y * v[j].y) + (v[j].z * v[j].z + v[j].w * v[j].w));
            const float r = (1.0f - LAMBDA_INIT) / sqrtf(ss * (1.0f / 256.0f) + EPS); v[j] = v[j] * r * g; }
        st_row_bf16((bf16*)(F.ws + WS_Y) + (size_t)row * DM, F.lane, v);
    }
}
__device__ __forceinline__ void t_post_attn(Frame& F, int layer, const float* x_in, const float* ctx_in, const float* norm_g, const float* router_w) {
    const float* ng0 = norm_g + (size_t)layer * 4 * DM;
    const float* wr0 = router_w + (size_t)layer * DM * NEXP;
    for (int row = F.gw; row < NROWS; row += F.NGW) {
        const int b = row / SB, s = row - b * SB;
        if (layer == 1 && s < CTXL) continue;
        const float* ng = fresh(ng0); const float* wr = fresh(wr0);
        f32x4 y[8], x[8], h[8];
        ld_row((const float*)(F.ws + WS_YO) + (size_t)row * DM, F.lane, y);
        ld_row(layer == 0 ? in_row_ptr(x_in, ctx_in, row) : (const float*)(F.ws + WS_XL) + (size_t)row * DM, F.lane, x);
        const float ry = row_rstd(y);
        const float* ga = mods_ptr(F, layer, row, 2);
#pragma unroll
        for (int j = 0; j < 8; ++j) { const int c = 4 * F.lane + 256 * j; x[j] = x[j] + *(const f32x4*)(ga + c) * (y[j] * ry * *(const f32x4*)(ng + DM + c)); }
        float* xl = (float*)(F.ws + WS_XL) + (size_t)row * DM;
#pragma unroll
        for (int j = 0; j < 8; ++j) *(f32x4*)(xl + 4 * F.lane + 256 * j) = x[j];
        const float rx = row_rstd(x);
        norm_mod(h, x, rx, ng + 2 * DM, mods_ptr(F, layer, row, 4), mods_ptr(F, layer, row, 3), F.lane);
        st_row_bf16((bf16*)(F.ws + WS_H) + (size_t)row * DM, F.lane, h);
        float lg[16];
#pragma unroll
        for (int e = 0; e < 16; ++e) lg[e] = 0.f;
#pragma unroll
        for (int j = 0; j < 8; ++j) {
            asm volatile("" ::: "memory");
#pragma unroll
            for (int i = 0; i < 4; ++i) { const float hv = h[j][i]; const float* wp = wr + (size_t)(4 * F.lane + 256 * j + i) * NEXP;
                const f32x4 w0 = *(const f32x4*)wp, w1 = *(const f32x4*)(wp + 4), w2 = *(const f32x4*)(wp + 8), w3 = *(const f32x4*)(wp + 12);
                lg[0] += hv * w0.x; lg[1] += hv * w0.y; lg[2] += hv * w0.z; lg[3] += hv * w0.w; lg[4] += hv * w1.x; lg[5] += hv * w1.y; lg[6] += hv * w1.z; lg[7] += hv * w1.w;
                lg[8] += hv * w2.x; lg[9] += hv * w2.y; lg[10] += hv * w2.z; lg[11] += hv * w2.w; lg[12] += hv * w3.x; lg[13] += hv * w3.y; lg[14] += hv * w3.z; lg[15] += hv * w3.w; } }
        float mx = -1e30f;
#pragma unroll
        for (int e = 0; e < 16; ++e) { lg[e] = wave_sum(lg[e]); mx = fmaxf(mx, lg[e]); }
        float sum = 0.f;
#pragma unroll
        for (int e = 0; e < 16; ++e) { lg[e] = __expf(lg[e] - mx); sum += lg[e]; }
        const float rs = 1.0f / sum;
        float* aff = (float*)(F.ws + WS_AFF) + (size_t)b * NEXP * SB + s;
#pragma unroll
        for (int e = 0; e < 16; ++e) if (F.lane == e) aff[(size_t)e * SB] = lg[e] * rs;
    }
}
template <int VPT>
__device__ __forceinline__ void topk_problem(Frame& F, const float* vals, int N, int cap, int e, int rowbase, int slotbase, bool write_inv) {
    LAS int* hist = (LAS int*)F.lds;
    LAS int* wt = (LAS int*)(F.lds + 1024);
    LAS int* selw = (LAS int*)(F.lds + 1280);
    float v[VPT]; unsigned key[VPT];
#pragma unroll
    for (int k = 0; k < VPT; ++k) { const int i = F.tid * VPT + k; const bool ok = i < N; v[k] = ok ? vals[i] : 0.f; const unsigned u = __builtin_bit_cast(unsigned, v[k]);
        key[k] = ok ? ((u & 0x80000000u) ? ~u : (u | 0x80000000u)) : 0u; }
    unsigned prefix = 0u, maskb = 0u; int need = cap;
    for (int pass = 0; pass < 4; ++pass) {
        const int shift = 24 - 8 * pass;
        if (F.tid < 256) hist[F.tid] = 0;
        __syncthreads();
#pragma unroll
        for (int k = 0; k < VPT; ++k) { const int i = F.tid * VPT + k; if (i < N && (key[k] & maskb) == prefix) __hip_atomic_fetch_add(&hist[(key[k] >> shift) & 255u], 1, __ATOMIC_RELAXED, __HIP_MEMORY_SCOPE_WORKGROUP); }
        __syncthreads();
        if (F.wave == 0) {
            const int l = F.lane; const int h0 = hist[255 - 4 * l], h1 = hist[254 - 4 * l], h2 = hist[253 - 4 * l], h3 = hist[252 - 4 * l];
            const int sm = h0 + h1 + h2 + h3; const int incl = wave_incl_scan(sm, l); const int excl = incl - sm;
            const unsigned long long m = __ballot(incl >= need); const int fl = m ? (__ffsll((long long)m) - 1) : 63;
            if (l == fl) { int c = excl, bin;
                if (c + h0 >= need) bin = 255 - 4 * l; else { c += h0; if (c + h1 >= need) bin = 254 - 4 * l; else { c += h1; if (c + h2 >= need) bin = 253 - 4 * l; else { c += h2; bin = 252 - 4 * l; } } }
                selw[0] = bin; selw[1] = need - c; }
        }
        __syncthreads();
        prefix |= ((unsigned)selw[0]) << shift; maskb |= 0xFFu << shift; need = selw[1];
        __syncthreads();
    }
    int ceq = 0;
#pragma unroll
    for (int k = 0; k < VPT; ++k) { const int i = F.tid * VPT + k; if (i < N && key[k] == prefix) ++ceq; }
    int incl = wave_incl_scan(ceq, F.lane);
    if (F.lane == 63) wt[F.wave] = incl;
    __syncthreads();
    int eqbase = incl - ceq;
    for (int w = 0; w < F.wave; ++w) eqbase += wt[w];
    int csel = 0; bool sel[VPT];
#pragma unroll
    for (int k = 0; k < VPT; ++k) { const int i = F.tid * VPT + k; const bool ok = i < N; const bool eq = ok && key[k] == prefix;
        sel[k] = ok && (key[k] > prefix || (eq && eqbase < need)); if (eq) ++eqbase; if (sel[k]) ++csel; }
    incl = wave_incl_scan(csel, F.lane);
    if (F.lane == 63) wt[8 + F.wave] = incl;
    __syncthreads();
    int sbase = incl - csel;
    for (int w = 0; w < F.wave; ++w) sbase += wt[8 + w];
    int* RL = (int*)(F.ws + WS_RL) + e * EROWS; float* GT = (float*)(F.ws + WS_GATE) + e * EROWS; int* INV = (int*)(F.ws + WS_INV);
#pragma unroll
    for (int k = 0; k < VPT; ++k) { const int i = F.tid * VPT + k;
        if (i < N) { const int grow = rowbase + i;
            if (sel[k]) { const int slot = slotbase + sbase; ++sbase; RL[slot] = grow; GT[slot] = v[k]; if (write_inv) INV[grow * 16 + e] = slot; }
            else if (write_inv) INV[grow * 16 + e] = -1; } }
    __syncthreads();
}
__device__ __forceinline__ void t_topk(Frame& F, int layer) {
    const int nprob = layer == 0 ? 64 : 32;
    for (int p = blockIdx.x; p < nprob; p += F.G) {
        const int kind = p >> 5, q = p & 31, b = q >> 4, e = q & 15;
        const float* aff = (const float*)(F.ws + WS_AFF) + ((size_t)(b * NEXP + e)) * SB;
        if (kind == 0) topk_problem<8>(F, aff + CTXL, SEQ, CAP_L, e, b * SB + CTXL, b * CAP_L, true);
        else           topk_problem<1>(F, aff, CTXL, CAP_C, e, b * SB, 2 * CAP_L + b * CAP_C, true);
    }
}
__device__ __forceinline__ void t_gather(Frame& F, int layer) {
    const int np = layer == 0 ? 1280 : 1024, nvalid = layer == 0 ? 1088 : 1024;
    const int* RL = (const int*)(F.ws + WS_RL);
    for (int i = F.gw; i < NEXP * np; i += F.NGW) {
        const int e = i / np, slot = i - e * np;
        v4u* dst = (v4u*)((bf16*)(F.ws + WS_XG) + ((size_t)(e * EROWS + slot)) * DM) + F.lane;
        if (slot < nvalid) { const int src = RL[e * EROWS + slot]; const v4u* sp = (const v4u*)((const bf16*)(F.ws + WS_H) + (size_t)src * DM) + F.lane;
#pragma unroll
            for (int j = 0; j < 4; ++j) dst[64 * j] = sp[64 * j];
        } else {
#pragma unroll
            for (int j = 0; j < 4; ++j) dst[64 * j] = (v4u){0u, 0u, 0u, 0u};
        }
    }
}
__device__ __forceinline__ void t_post_moe(Frame& F, int layer, const float* norm_g, float* out) {
    const float* ng0 = norm_g + (size_t)layer * 4 * DM;
    const int* INV = (const int*)(F.ws + WS_INV); const float* GT = (const float*)(F.ws + WS_GATE);
    for (int row = F.gw; row < NROWS; row += F.NGW) {
        const int b = row / SB, s = row - b * SB;
        if (layer == 1 && s < CTXL) continue;
        const float* ng = fresh(ng0); const float* ng1 = fresh(norm_g + 4 * DM);
        f32x4 mo[8], x[8];
#pragma unroll
        for (int j = 0; j < 8; ++j) mo[j] = (f32x4){0.f, 0.f, 0.f, 0.f};
        const v4i* ip = (const v4i*)(INV + (size_t)row * 16);
        const v4i i0 = ip[0], i1 = ip[1], i2 = ip[2], i3 = ip[3];
        const int sl[16] = {i0.x, i0.y, i0.z, i0.w, i1.x, i1.y, i1.z, i1.w, i2.x, i2.y, i2.z, i2.w, i3.x, i3.y, i3.z, i3.w};
#pragma unroll
        for (int e = 0; e < 16; ++e) { const int slot = sl[e];
            if (slot >= 0) { const float g = GT[e * EROWS + slot]; const bf16* yp = (const bf16*)(F.ws + WS_YE) + ((size_t)(e * EROWS + slot)) * DM + 4 * F.lane;
#pragma unroll
                for (int j = 0; j < 8; ++j) { const v2u w = *(const v2u*)(yp + 256 * j); mo[j].x += g * bf_lo(w.x); mo[j].y += g * bf_hi(w.x); mo[j].z += g * bf_lo(w.y); mo[j].w += g * bf_hi(w.y); } } }
        ld_row((const float*)(F.ws + WS_XL) + (size_t)row * DM, F.lane, x);
        const float rm = row_rstd(mo);
        const float* gf = mods_ptr(F, layer, row, 5);
#pragma unroll
        for (int j = 0; j < 8; ++j) { const int c = 4 * F.lane + 256 * j; x[j] = x[j] + *(const f32x4*)(gf + c) * (mo[j] * rm * *(const f32x4*)(ng + 3 * DM + c)); }
        if (layer == 0) {
            float* xl = (float*)(F.ws + WS_XL) + (size_t)row * DM;
#pragma unroll
            for (int j = 0; j < 8; ++j) *(f32x4*)(xl + 4 * F.lane + 256 * j) = x[j];
            f32x4 h[8]; const float rx = row_rstd(x);
            norm_mod(h, x, rx, ng1, mods_ptr(F, 1, row, 1), mods_ptr(F, 1, row, 0), F.lane);
            st_row_bf16((bf16*)(F.ws + WS_H) + (size_t)row * DM, F.lane, h);
        } else {
            float* op = out + ((size_t)(b * SEQ + s - CTXL)) * DM;
#pragma unroll
            for (int j = 0; j < 8; ++j) *(f32x4*)(op + 4 * F.lane + 256 * j) = x[j];
        }
    }
}

__device__ __forceinline__ void p_attn0(Frame& F, const float* ab_sink) {
    char* lds = (char*)F.lds;
    const bf16* QKV = (const bf16*)(F.ws + WS_QKV); bf16* Y = (bf16*)(F.ws + WS_Y);
    const int c = blockIdx.x;
    for (int u = c; u < 544; u += F.G) {
        att::Job J; J.kb0 = CTXL; J.mask = 0; J.dq = 0; J.use_sink = 0; J.sink_l2 = 0.f; J.lam = 0.f;
        int b, h, grpB; size_t qrow;
        if (u < 512) {
            const int uu = u & 255, x = uu & 7, i = uu >> 3, grp = x >> 1, idx = (x & 1) * 32 + i;
            b = grp >> 1; const int kv = grp & 1; h = kv * 4 + (idx >> 4); const int qb = idx & 15; grpB = u < 256;
            qrow = (size_t)b * SB + CTXL + qb * 256;
            if (grpB) J.NT = 68;
            else { const int q0 = qb * 256, lo = q0 - 128 < 0 ? 0 : q0 - 128, hiK = q0 + 384 > SEQ ? SEQ : q0 + 384;
                   J.NT = 4 + (hiK - lo) / 64; J.kb0 = CTXL + lo; J.mask = 1; J.dq = lo - q0; }
        } else { const int uu = u - 512; grpB = uu >> 4; b = (uu >> 3) & 1; h = uu & 7; qrow = (size_t)b * SB; J.NT = 4; }
        const int kv = h >> 2;
        if (!grpB) { J.use_sink = 1; J.sink_l2 = ab_sink[h] * 1.4426950408889634f; }
        const int qcol = grpB ? 1536 + h * 128 : h * 128, kcol = grpB ? 2560 + kv * 128 : 1024 + kv * 128, vcol = grpB ? 2816 + kv * 128 : 1280 + kv * 128;
        J.Q = QKV + qrow * NQKV0 + qcol; J.K = QKV + (size_t)b * SB * NQKV0 + kcol; J.V = QKV + (size_t)b * SB * NQKV0 + vcol;
        J.O = (void*)(Y + qrow * DM + (grpB ? 1024 : 0) + h * 128);
        __syncthreads();
        att::attn_unit<NQKV0, 0>(J, lds);
    }
}
__device__ __forceinline__ void p_attn1(Frame& F) {
    char* lds = (char*)F.lds;
    const bf16* QKV = (const bf16*)(F.ws + WS_QKV);
    for (int u = blockIdx.x; u < 1024; u += F.G) {
        const int x = u & 7, i = u >> 3;
        const int b = x >> 2, hp = x & 3, h = hp * 2 + ((i >> 6) & 1), m = (i >> 5) & 1, half = (i >> 4) & 1, qb = i & 15;
        const size_t qrow = (size_t)b * SB + CTXL + qb * 256;
        float* O = (float*)(F.ws + (m ? WS_XG : WS_YO));
        att::Job J; J.kb0 = CTXL; J.mask = 0; J.dq = 0; J.use_sink = 0; J.sink_l2 = 0.f; J.lam = 0.f; J.NT = 68;
        J.V = QKV + (size_t)b * SB * NQKV1 + 4096 + h * 256 + half * 128;
        J.O = (void*)(O + qrow * DM + h * 256 + half * 128);
        J.Q = QKV + qrow * NQKV1 + (2 * h + m) * 128; J.K = QKV + (size_t)b * SB * NQKV1 + 2048 + (2 * h + m) * 128;
        __syncthreads();
        att::attn_unit<NQKV1, 1>(J, lds);
    }
}

#define IN(k) (lo <= (k) && (k) < hi)
#define SEAM(k) do { if (IN((k) + 1)) xcd_barrier(bar); } while (0)
#define INP(k) ({ int k_ = (k); asm volatile("" : "+s"(k_)); (const float*)(const __attribute__((address_space(1))) float*)args.in[k_]; })
#ifndef PROBE_MASK
#define PROBE_MASK 0
#endif
#define PROBED(k) ((k) >= 0 && ((PROBE_MASK >> ((k) < 0 ? 0 : (k))) & 1))
#define REP2(k, ...) do { __VA_ARGS__; if constexpr (PROBED(k)) { __syncthreads(); __VA_ARGS__; } } while (0)
#define REP(k) for (int rep_ = 0; rep_ < (((k) >= 0 && ((PROBE_MASK >> ((k) < 0 ? 0 : (k))) & 1)) ? 2 : 1); ++rep_, __syncthreads())
#define FRESH() do { asm volatile("" : "+s"(F.ws)); } while (0)
template <int layer>
__device__ __forceinline__ void layer_phases(Frame& F, const Args& args, const int lo, const int hi, const XcdBarrier& bar) {

        const int pb = 2 + 11 * layer;
        if (IN(pb + 0)) {
            FRESH();
            pg8::Gemm g{(const pg8::bf16_t*)(F.ws + WS_H), (const pg8::bf16_t*)(F.ws + (layer == 0 ? WS_WIN0 : WS_WIN1)), NROWS, layer == 0 ? NQKV0 : NQKV1, DM};
            pg8::DenseOrder S; S.init(NROWS / 256, (layer == 0 ? NQKV0 : NQKV1) / 256, F.G, (int)blockIdx.x, 0);
            pg8::EpiStoreBf16 E{(pg8::bf16_t*)(F.ws + WS_QKV), layer == 0 ? NQKV0 : NQKV1, 1 << 20};
            pg8::gemm_phase<pg8::EpiStoreBf16, pg8::DenseOrder, true, true>(F.lds, g, S, E);
            SEAM(pb + 0);
        }
        if (IN(pb + 1)) { FRESH(); t_prep(F, layer, INP(10), INP(11)); SEAM(pb + 1); }
        if (IN(pb + 2)) { FRESH(); REP(pb + 2) { if (layer == 0) p_attn0(F, INP(9)); else p_attn1(F); } SEAM(pb + 2); }
        if (IN(pb + 3)) { if (layer == 1) { FRESH(); REP(pb + 3) t_subln(F, INP(14), INP(15)); SEAM(pb + 3); } }
        if (IN(pb + 4)) {
            FRESH();
            pg8::Gemm g{(const pg8::bf16_t*)(F.ws + WS_Y), (const pg8::bf16_t*)(F.ws + (layer == 0 ? WS_WOUT0 : WS_WOUT1)), NROWS, DM, DM};
            pg8::DenseOrder S; S.init(layer == 0 ? 34 : 32, DM / 256, F.G, (int)blockIdx.x, layer);
            pg8::EpiStoreF32 E{(float*)(F.ws + WS_YO), DM};
            pg8::gemm_phase<pg8::EpiStoreF32, pg8::DenseOrder, true, true>(F.lds, g, S, E);
            SEAM(pb + 4);
        }
        if (IN(pb + 5)) { FRESH(); REP(layer == 0 ? pb + 5 : -2) t_post_attn(F, layer, INP(0), INP(2), INP(6), INP(16)); SEAM(pb + 5); }
        if (IN(pb + 6)) { FRESH(); REP(pb + 6) t_topk(F, layer); SEAM(pb + 6); }
        if (IN(pb + 7)) { FRESH(); REP(pb + 7) t_gather(F, layer); SEAM(pb + 7); }
        if (IN(pb + 8)) {
            FRESH();
            pg8::BMoeGU Bm{INP(17) + (size_t)layer * 16 * DM * DM, INP(18) + (size_t)layer * 16 * DM * DM};
            pg8::MoeOrder S; S.init(layer == 0 ? 5 : 4, 16, F.G, (int)blockIdx.x);
            pg8::EpiSwiGLU E{(pg8::bf16_t*)(F.ws + WS_HM), DM};
            REP2(pb + 8, pg8::gemm_phase_w<pg8::EpiSwiGLU, pg8::MoeOrder, pg8::BMoeGU>(F.lds, (const pg8::bf16_t*)(F.ws + WS_XG), DM, Bm, S, E));
            SEAM(pb + 8);
        }
        if (IN(pb + 9)) {
            FRESH();
            pg8::BMoeDn Bm{INP(19) + (size_t)layer * 16 * DM * DM};
            pg8::MoeOrder S; S.init(layer == 0 ? 5 : 4, 8, F.G, (int)blockIdx.x);
            pg8::EpiStoreBf16 E{(pg8::bf16_t*)(F.ws + WS_YE), DM, 8};
            REP2(pb + 9, pg8::gemm_phase_w<pg8::EpiStoreBf16, pg8::MoeOrder, pg8::BMoeDn>(F.lds, (const pg8::bf16_t*)(F.ws + WS_HM), DM, Bm, S, E));
            SEAM(pb + 9);
        }
        if (IN(pb + 10)) { FRESH(); REP(layer == 1 ? pb + 10 : -2) t_post_moe(F, layer, INP(6), args.out); SEAM(pb + 10); }
}
constexpr int NPHASE = 24;
__global__ void __launch_bounds__(NWAVES * 64, 2) fwd(Args args) {
    extern __shared__ __attribute__((aligned(16))) unsigned char lds[];
    Frame F;
    F.lds = (LAS unsigned char*)lds;
    F.tid = threadIdx.x; F.lane = F.tid & 63; F.wave = __builtin_amdgcn_readfirstlane(F.tid >> 6);
    F.G = gridDim.x; F.gw = blockIdx.x * NWAVES + F.wave; F.NGW = F.G * NWAVES;
    F.ws = (__attribute__((address_space(1))) unsigned char*)args.ws;
    volatile LAS unsigned* MISC = (volatile LAS unsigned*)(F.lds + MISC_OFF);
    for (int u = F.tid; u < (LDS_BYTES - LDSCTL_OFF) / 4; u += NWAVES * 64) ((LAS unsigned*)(F.lds + LDSCTL_OFF))[u] = 0u;
    __syncthreads();
    const int lo = args.ph_lo, hi = args.ph_hi;
    const bool multi = (hi - lo) > 1;
    XcdBarrier bar; bar.bar = (unsigned*)(F.ws + WS_CTL) + CW_BAR; bar.x = 0; bar.st = nullptr;
    if (multi) bar = xcd_barrier_post((unsigned*)(F.ws + WS_CTL) + CW_BAR, MISC + 8);

    if (IN(0)) { FRESH(); REP(0) p0_prologue(F, INP(1), INP(3), INP(4), INP(5), INP(7), INP(8), INP(12), INP(13)); SEAM(0); }
    if (IN(1)) { FRESH(); REP(1) t_norm0(F, INP(0), INP(2), INP(6)); SEAM(1); }
    layer_phases<0>(F, args, lo, hi, bar);
    layer_phases<1>(F, args, lo, hi, bar);
}

extern "C" void kernel_launch(void* const* d_in, const int* in_sizes, int n_in, void* d_out, int out_size, void* d_ws, size_t ws_size, hipStream_t stream) {
    static int grid = 0;
    if (grid == 0) {
        if (n_in != 20 || out_size != NBATCH * SEQ * DM || ws_size < WS_END) { fprintf(stderr, "kernel_launch: shape mismatch (n_in %d out %d ws %zu need %zu)\n", n_in, out_size, ws_size, (size_t)WS_END); grid = -1; return; }
        int dev = 0, cus = 0, per_cu = 0;
        if (hipGetDevice(&dev) != hipSuccess || hipDeviceGetAttribute(&cus, hipDeviceAttributeMultiprocessorCount, dev) != hipSuccess) { grid = -1; return; }
        if (hipFuncSetAttribute((const void*)fwd, hipFuncAttributeMaxDynamicSharedMemorySize, LDS_BYTES) != hipSuccess) { fprintf(stderr, "kernel_launch: hipFuncSetAttribute failed\n"); grid = -1; return; }
        if (hipOccupancyMaxActiveBlocksPerMultiprocessor(&per_cu, (const void*)fwd, NWAVES * 64, LDS_BYTES) != hipSuccess || per_cu < 1)
            fprintf(stderr, "kernel_launch: note: occupancy query reports %d workgroups per CU\n", per_cu);
        (void)hipGetLastError();
        grid = cus;
    }
    if (grid < 0) return;
    if (hipMemsetAsync((char*)d_ws + WS_CTL, 0, CTL_ZERO_BYTES, stream) != hipSuccess) return;
    Args a{};
    for (int i = 0; i < 20; ++i) a.in[i] = (const float*)d_in[i];
    a.out = (float*)d_out; a.ws = (unsigned char*)d_ws;
#if MK_ONE_LAUNCH
    a.ph_lo = 0; a.ph_hi = NPHASE;
    hipLaunchKernelGGL(fwd, dim3(grid), dim3(NWAVES * 64), LDS_BYTES, stream, a);
#if defined(PROBE_EXTRA)
    { const int extra[] = {PROBE_EXTRA}; for (int ph : extra) { a.ph_lo = ph; a.ph_hi = ph + 1; hipLaunchKernelGGL(fwd, dim3(grid), dim3(NWAVES * 64), LDS_BYTES, stream, a); } }
#endif
#else
    for (int ph = 0; ph < NPHASE; ++ph) {
        if (ph == 5) continue;
        a.ph_lo = ph; a.ph_hi = ph + 1;
        hipLaunchKernelGGL(fwd, dim3(grid), dim3(NWAVES * 64), LDS_BYTES, stream, a);
    }
#endif
    const hipError_t le = hipPeekAtLastError();
    if (le != hipSuccess) fprintf(stderr, "kernel_launch: launch failed: %s\n", hipGetErrorName(le));
}
```

```cpp
#include <hip/hip_runtime.h>
#include <cstdio>
#include <cstdint>

#ifndef MK_ONE_LAUNCH
#define MK_ONE_LAUNCH 1
#endif

namespace pg8 {
#define PG8_LAS __attribute__((address_space(3)))
typedef unsigned short bf16_t;
typedef short bf16x8 __attribute__((ext_vector_type(8)));
typedef float f32x4 __attribute__((ext_vector_type(4)));
typedef unsigned u32x4 __attribute__((ext_vector_type(4)));
constexpr int BM = 256, BK = 64, HALF = 128, HTB = HALF * BK * 2  , STAGE_BYTES = 8 * HTB, NXCD = 8, WGM = 8;

__host__ __device__ __forceinline__ int lds_byte(int r, int c) { const int st = (r >> 4) * 2 + (c >> 5), rr = r & 15, cc = c & 31, ob = rr * 64 + cc * 2; return st * 1024 + (ob ^ (((ob >> 9) & 1) << 5)); }
__host__ __device__ __forceinline__ void stage_rc(int b, int& R, int& C) { const int st = b / 1024, sb = b % 1024, swz = sb ^ (((sb >> 9) & 1) << 5); R = (st >> 1) * 16 + swz / 64; C = (st & 1) * 32 + (swz % 64) / 2; }
__host__ __device__ __forceinline__ int perm32(int rho) { const int n = rho >> 4, i = rho & 15; return 8 * (i >> 2) + 4 * n + (i & 3); }

struct Unit { int pm, pn; };
struct Gemm { const bf16_t* A; const bf16_t* Bt; int M, N, K; };

struct StaticOrder {
    int nM, nN, nwg, G, c;
    __host__ __device__ void init(int M, int N, int G_, int c_) { nM = M / BM; nN = N / BM; nwg = nM * nN; G = G_; c = c_; }
    __host__ __device__ bool next(int i, Unit& u) const {
        const long L = (long)i * G + c; if (L >= nwg) return false;
        int wgid = (int)L; { const int q = nwg / NXCD, r = nwg % NXCD, xcd = wgid % NXCD, off = wgid / NXCD; wgid = (xcd < r ? xcd * (q + 1) : r * (q + 1) + (xcd - r) * q) + off; }
        const int nig = WGM * nN, gid = wgid / nig, fm = gid * WGM, gsz = (nM - fm) < WGM ? (nM - fm) : WGM;
        u.pm = fm + ((wgid % nig) % gsz); u.pn = (wgid % nig) / gsz; return true;
    }
    __device__ __forceinline__ void a_ready(const Unit&) const {}
    __device__ __forceinline__ void done(const Unit&) const {}
};

__device__ __forceinline__ unsigned cvt_pk_bf16(float lo, float hi) { unsigned r; asm volatile("v_cvt_pk_bf16_f32 %0, %1, %2" : "=v"(r) : "v"(lo), "v"(hi)); return r; }
struct DenseOrder {
    StaticOrder so; int kind;
    __device__ void init(int nM, int nN, int G_, int c_, int kind_) { so.init(nM * BM, nN * BM, G_, c_); kind = kind_; }
    __device__ bool next(int i, Unit& u) const {
        if (!so.next(i, u)) return false;
        if (kind == 1) { const int b = u.pm >> 4, j = u.pm & 15; u.pm = 17 * b + 1 + j; }
        return true;
    }
    __device__ __forceinline__ int krot(const Unit& u) const { return (u.pm & 3) * 8; }
    __device__ __forceinline__ void a_ready(const Unit&) const {}
    __device__ __forceinline__ void done(const Unit&) const {}
};
struct MoeOrder {
    int NP, NJ, nU, G, c;
    __device__ void init(int NP_, int NJ_, int G_, int c_) { NP = NP_; NJ = NJ_; nU = 16 * NP_ * NJ_; G = G_; c = c_; }
    __device__ bool next(int i, Unit& u) const {
        const int L = i * G + c; if (L >= nU) return false;
        const int xcd = L & 7, off = L >> 3, id = xcd * (nU >> 3) + off;
        const int per = NJ * NP, e = id / per, rem = id - e * per, j = rem / NP, p = rem - j * NP;
        u.pm = 5 * e + p; u.pn = NJ * e + j; return true;
    }
    __device__ __forceinline__ int krot(const Unit& u) const { const int p = u.pm % 5; return NP == 4 ? p * 8 : p * 6; }
    __device__ __forceinline__ void a_ready(const Unit&) const {}
    __device__ __forceinline__ void done(const Unit&) const {}
};

struct EpiStoreBf16 {
    static constexpr bool PERM = true, AFTER_DRAIN = false;
    bf16_t* O; int ldc; int nmod;
    __device__ __forceinline__ void operator()(const f32x4 (&acc)[2][2][4][2], const Unit& u, int wr, int wc, int fr, int fq) const {
        const int row0 = u.pm * BM + wr * 64 + fr, col0 = (u.pn % nmod) * BM + wc * 32 + 8 * fq;
#pragma unroll
        for (int ai = 0; ai < 2; ++ai)
#pragma unroll
            for (int m = 0; m < 4; ++m) { bf16_t* rowp = O + (size_t)(row0 + ai * HALF + m * 16) * ldc + col0;
#pragma unroll
                for (int bj = 0; bj < 2; ++bj) { const f32x4 v0 = acc[ai][bj][m][0], v1 = acc[ai][bj][m][1];
                    u32x4 w; w.x = cvt_pk_bf16(v0[0], v0[1]); w.y = cvt_pk_bf16(v0[2], v0[3]); w.z = cvt_pk_bf16(v1[0], v1[1]); w.w = cvt_pk_bf16(v1[2], v1[3]);
                    *(u32x4*)(rowp + bj * HALF) = w; } }
    }
};
struct EpiStoreF32 {
    static constexpr bool PERM = true, AFTER_DRAIN = false;
    float* O; int ldc;
    __device__ __forceinline__ void operator()(const f32x4 (&acc)[2][2][4][2], const Unit& u, int wr, int wc, int fr, int fq) const {
        const int row0 = u.pm * BM + wr * 64 + fr, col0 = u.pn * BM + wc * 32 + 8 * fq;
#pragma unroll
        for (int ai = 0; ai < 2; ++ai)
#pragma unroll
            for (int m = 0; m < 4; ++m) { float* rowp = O + (size_t)(row0 + ai * HALF + m * 16) * ldc + col0;
#pragma unroll
                for (int bj = 0; bj < 2; ++bj) { *(f32x4*)(rowp + bj * HALF) = acc[ai][bj][m][0]; *(f32x4*)(rowp + bj * HALF + 4) = acc[ai][bj][m][1]; } }
    }
};
__device__ __forceinline__ float silu_f(float g) { return g * __builtin_amdgcn_rcpf(1.0f + __builtin_amdgcn_exp2f(-1.4426950408889634f * g)); }
struct EpiSwiGLU {
    static constexpr bool PERM = true, AFTER_DRAIN = false;
    bf16_t* O; int ldc;
    __device__ __forceinline__ void operator()(const f32x4 (&acc)[2][2][4][2], const Unit& u, int wr, int wc, int fr, int fq) const {
        const int row0 = u.pm * BM + wr * 64 + fr, col0 = (u.pn & 15) * HALF + wc * 32 + 8 * fq;
#pragma unroll
        for (int ai = 0; ai < 2; ++ai)
#pragma unroll
            for (int m = 0; m < 4; ++m) { bf16_t* rowp = O + (size_t)(row0 + ai * HALF + m * 16) * ldc + col0;
                const f32x4 g0 = acc[ai][0][m][0], g1 = acc[ai][0][m][1], u0 = acc[ai][1][m][0], u1 = acc[ai][1][m][1];
                u32x4 w;
                w.x = cvt_pk_bf16(silu_f(g0[0]) * u0[0], silu_f(g0[1]) * u0[1]); w.y = cvt_pk_bf16(silu_f(g0[2]) * u0[2], silu_f(g0[3]) * u0[3]);
                w.z = cvt_pk_bf16(silu_f(g1[0]) * u1[0], silu_f(g1[1]) * u1[1]); w.w = cvt_pk_bf16(silu_f(g1[2]) * u1[2], silu_f(g1[3]) * u1[3]);
                *(u32x4*)rowp = w; }
    }
};

template <class Epi, class Sched, bool ALIGN_EPI = false, bool SP2 = false>
__device__ __forceinline__ void gemm_phase(PG8_LAS unsigned char* lds, const Gemm g, const Sched& S, const Epi& E) {
    const int tid = threadIdx.x, wid = __builtin_amdgcn_readfirstlane(tid >> 6), lane = tid & 63, wr = wid >> 2, wc = wid & 3, fr = lane & 15, fq = lane >> 4;
    const int K = g.K, nt = K / BK;
    unsigned voffA[2], voffB[2];
#pragma unroll
    for (int i = 0; i < 2; ++i) { int R, C; stage_rc(tid * 16 + i * 8192, R, C); const int Rb = Epi::PERM ? ((R & ~31) + perm32(R & 31)) : R;
        voffA[i] = (unsigned)(R * K + C) * 2u; voffB[i] = (unsigned)(Rb * K + C) * 2u; }
    const size_t kstep = (size_t)(BK * 2);
    const size_t hstep = (size_t)HALF * K * 2;
    const size_t tstep = 2 * hstep;
    const unsigned ldsw = (unsigned)wid * 1024u;
    const int aoff = lds_byte(wr * 64 + fr, fq * 8), boff = lds_byte(wc * 32 + fr, fq * 8);
#define PG8_SA(b, h) (((b) * 2 + (h)) * HTB)
#define PG8_SB(b, h) ((4 + (b) * 2 + (h)) * HTB)
#define PG8_STAGE(bufoff, gbase, voff) do { _Pragma("unroll") for (int _i = 0; _i < 2; ++_i) \
        __builtin_amdgcn_global_load_lds((const unsigned*)((const char*)(gbase) + (voff)[_i]), (PG8_LAS unsigned*)(lds + (bufoff) + ldsw + _i * 8192), 16, 0, 0); } while (0)
#define PG8_LDA(dst, b, h) do { _Pragma("unroll") for (int m = 0; m < 4; ++m) _Pragma("unroll") for (int k = 0; k < 2; ++k) dst[m][k] = *(const PG8_LAS bf16x8*)(lds + PG8_SA(b, h) + aoff + m * 2048 + k * 1024); } while (0)
#define PG8_LDB(dst, b, h) do { _Pragma("unroll") for (int n = 0; n < 2; ++n) _Pragma("unroll") for (int k = 0; k < 2; ++k) dst[n][k] = *(const PG8_LAS bf16x8*)(lds + PG8_SB(b, h) + boff + n * 2048 + k * 1024); } while (0)
#define PG8_MMA(ai, bj, At, Bt) do { __builtin_amdgcn_s_setprio(1); _Pragma("unroll") for (int m = 0; m < 4; ++m) _Pragma("unroll") for (int n = 0; n < 2; ++n) _Pragma("unroll") for (int k = 0; k < 2; ++k) \
        acc[ai][bj][m][n] = __builtin_amdgcn_mfma_f32_16x16x32_bf16(Bt[n][k], At[m][k], acc[ai][bj][m][n], 0, 0, 0); __builtin_amdgcn_s_setprio(0); } while (0)
#define PG8_WAIT_V(n) asm volatile("s_waitcnt vmcnt(" #n ")" ::: "memory")
#define PG8_WAIT_L(n) asm volatile("s_waitcnt lgkmcnt(" #n ")" ::: "memory")
#define PG8_BAR __builtin_amdgcn_s_barrier()
#define PG8_SCHED __builtin_amdgcn_sched_barrier(0)
    Unit cur, nxt; int ui = 0;
    if (!S.next(0, cur)) return;
    f32x4 acc[2][2][4][2];
#pragma unroll
    for (int a = 0; a < 2; ++a)
#pragma unroll
        for (int b = 0; b < 2; ++b)
#pragma unroll
            for (int m = 0; m < 4; ++m)
#pragma unroll
                for (int n = 0; n < 2; ++n) acc[a][b][m][n] = (f32x4){0.f, 0.f, 0.f, 0.f};
    bf16x8 At[4][2], B0[2][2], B1[2][2];
    const char* cA = (const char*)g.A + (size_t)cur.pm * tstep; const char* cB = (const char*)g.Bt + (size_t)cur.pn * tstep;
    S.a_ready(cur);
    if constexpr (SP2) {
        PG8_STAGE(PG8_SB(0, 0), cB, voffB); PG8_STAGE(PG8_SB(0, 1), cB + hstep, voffB); PG8_STAGE(PG8_SA(0, 0), cA, voffA); PG8_STAGE(PG8_SA(0, 1), cA + hstep, voffA);
        if (wr == 1) PG8_BAR;
        PG8_WAIT_V(2); PG8_BAR;
        PG8_STAGE(PG8_SB(1, 0), cB + kstep, voffB); PG8_STAGE(PG8_SA(1, 0), cA + kstep, voffA); PG8_STAGE(PG8_SB(1, 1), cB + hstep + kstep, voffB);
        PG8_WAIT_V(6); PG8_BAR;
    } else {
        PG8_STAGE(PG8_SB(0, 0), cB, voffB); PG8_STAGE(PG8_SA(0, 0), cA, voffA); PG8_STAGE(PG8_SB(0, 1), cB + hstep, voffB); PG8_STAGE(PG8_SA(0, 1), cA + hstep, voffA);
        if (wr == 1) PG8_BAR;
        PG8_WAIT_V(4); PG8_BAR;
        PG8_STAGE(PG8_SB(1, 0), cB + kstep, voffB); PG8_STAGE(PG8_SA(1, 0), cA + kstep, voffA); PG8_STAGE(PG8_SB(1, 1), cB + hstep + kstep, voffB);
        PG8_WAIT_V(6); PG8_BAR;
    }
    for (;;) {
        const bool has_next = S.next(ui + 1, nxt);
        const char* nA = has_next ? (const char*)g.A + (size_t)nxt.pm * tstep : cA; const char* nB = has_next ? (const char*)g.Bt + (size_t)nxt.pn * tstep : cB;
        for (int t = 0; t < nt; t += 2) {
            const bool last = (t == nt - 2);
            const char* a1 = cA + (size_t)(t + 1) * kstep;
            const char* a2 = last ? nA : cA + (size_t)(t + 2) * kstep; const char* b2 = last ? nB : cB + (size_t)(t + 2) * kstep;
            const char* a3 = a2 + kstep; const char* b3 = b2 + kstep;
            if (last && has_next) S.a_ready(nxt);
            if constexpr (SP2) {
            PG8_LDB(B0, 0, 0); PG8_LDB(B1, 0, 1); PG8_SCHED; PG8_LDA(At, 0, 0); PG8_STAGE(PG8_SA(1, 1), a1 + hstep, voffA);
            PG8_WAIT_V(8); PG8_WAIT_L(0); PG8_BAR; PG8_MMA(0, 0, At, B0); PG8_MMA(0, 1, At, B1); PG8_BAR; PG8_SCHED;
            PG8_LDA(At, 0, 1); PG8_STAGE(PG8_SB(0, 0), b2, voffB); PG8_STAGE(PG8_SB(0, 1), b2 + hstep, voffB); PG8_STAGE(PG8_SA(0, 0), a2, voffA);
            PG8_WAIT_V(8); PG8_WAIT_L(0); PG8_BAR; PG8_MMA(1, 0, At, B0); PG8_MMA(1, 1, At, B1); PG8_BAR; PG8_SCHED;
            PG8_LDB(B0, 1, 0); PG8_LDB(B1, 1, 1); PG8_SCHED; PG8_LDA(At, 1, 0); PG8_STAGE(PG8_SA(0, 1), a2 + hstep, voffA);
            PG8_WAIT_V(8); PG8_WAIT_L(0); PG8_BAR; PG8_MMA(0, 0, At, B0); PG8_MMA(0, 1, At, B1); PG8_BAR; PG8_SCHED;
            PG8_LDA(At, 1, 1); PG8_STAGE(PG8_SB(1, 0), b3, voffB); PG8_STAGE(PG8_SB(1, 1), b3 + hstep, voffB); PG8_STAGE(PG8_SA(1, 0), a3, voffA);
            PG8_WAIT_V(8); PG8_WAIT_L(0); PG8_BAR; PG8_MMA(1, 0, At, B0); PG8_MMA(1, 1, At, B1); PG8_BAR; PG8_SCHED;
            } else {
            PG8_LDB(B0, 0, 0); PG8_SCHED; PG8_LDA(At, 0, 0); PG8_STAGE(PG8_SA(1, 1), a1 + hstep, voffA);
            PG8_WAIT_L(8); PG8_BAR; PG8_WAIT_L(0); PG8_MMA(0, 0, At, B0); PG8_BAR; PG8_SCHED;
            PG8_LDB(B1, 0, 1); PG8_STAGE(PG8_SB(0, 0), b2, voffB);
            PG8_BAR; PG8_WAIT_L(0); PG8_MMA(0, 1, At, B1); PG8_BAR;
            PG8_LDA(At, 0, 1); PG8_STAGE(PG8_SA(0, 0), a2, voffA);
            PG8_BAR; PG8_WAIT_L(0); PG8_MMA(1, 0, At, B0); PG8_BAR; PG8_SCHED;
            PG8_STAGE(PG8_SB(0, 1), b2 + hstep, voffB);
            PG8_WAIT_V(6); PG8_BAR; PG8_MMA(1, 1, At, B1); PG8_BAR;
            PG8_LDB(B0, 1, 0); PG8_SCHED; PG8_LDA(At, 1, 0); PG8_STAGE(PG8_SA(0, 1), a2 + hstep, voffA);
            PG8_WAIT_L(8); PG8_BAR; PG8_WAIT_L(0); PG8_MMA(0, 0, At, B0); PG8_BAR; PG8_SCHED;
            PG8_LDB(B1, 1, 1); PG8_STAGE(PG8_SB(1, 0), b3, voffB);
            PG8_BAR; PG8_WAIT_L(0); PG8_MMA(0, 1, At, B1); PG8_BAR;
            PG8_LDA(At, 1, 1); PG8_STAGE(PG8_SA(1, 0), a3, voffA);
            PG8_BAR; PG8_WAIT_L(0); PG8_MMA(1, 0, At, B0); PG8_BAR; PG8_SCHED;
            PG8_STAGE(PG8_SB(1, 1), b3 + hstep, voffB);
            PG8_WAIT_V(6); PG8_BAR; PG8_MMA(1, 1, At, B1); PG8_BAR;
            }
        }
        if constexpr (ALIGN_EPI) { if (wr == 0) PG8_BAR; }
        if constexpr (!Epi::AFTER_DRAIN) { E(acc, cur, wr, wc, fr, fq); S.done(cur); }
        if (!has_next) break;
#pragma unroll
        for (int a = 0; a < 2; ++a)
#pragma unroll
            for (int b = 0; b < 2; ++b)
#pragma unroll
                for (int m = 0; m < 4; ++m)
#pragma unroll
                    for (int n = 0; n < 2; ++n) acc[a][b][m][n] = (f32x4){0.f, 0.f, 0.f, 0.f};
        cur = nxt; cA = nA; cB = nB; ++ui;
        if constexpr (ALIGN_EPI) { if (wr == 1) PG8_BAR; }
    }
    PG8_WAIT_V(0);
    if constexpr (!ALIGN_EPI) { if (wr == 0) PG8_BAR; }
    PG8_BAR;
    if constexpr (Epi::AFTER_DRAIN) { E.fused(acc, cur, wr, wc, fr, fq, lds, wid, lane); S.done(cur); }
#undef PG8_SA
#undef PG8_SB
#undef PG8_STAGE
#undef PG8_LDA
#undef PG8_LDB
#undef PG8_MMA
#undef PG8_WAIT_V
#undef PG8_WAIT_L
#undef PG8_BAR
#undef PG8_SCHED
}
#ifndef PG8_KROT
#define PG8_KROT 0
#endif
#ifndef PG8_PF_DIST
#define PG8_PF_DIST 0
#endif
template <int LDW_> struct BDense { static constexpr int LDW = LDW_; const float* W; __device__ __forceinline__ void ptrs(const Unit& u, const float*& b0, const float*& b1) const { b0 = W + (size_t)u.pn * 256; b1 = b0 + 128; } };
struct BMoeGU { static constexpr int LDW = 2048; const float* G; const float* U; __device__ __forceinline__ void ptrs(const Unit& u, const float*& b0, const float*& b1) const {
    const size_t o = (size_t)(u.pn >> 4) * 2048 * 2048 + (size_t)(u.pn & 15) * 128; b0 = G + o; b1 = U + o; } };
struct BMoeDn { static constexpr int LDW = 2048; const float* W; __device__ __forceinline__ void ptrs(const Unit& u, const float*& b0, const float*& b1) const {
    b0 = W + (size_t)(u.pn >> 3) * 2048 * 2048 + (size_t)(u.pn & 7) * 256; b1 = b0 + 128; } };
typedef float f32x2 __attribute__((ext_vector_type(2)));
typedef unsigned u32x2 __attribute__((ext_vector_type(2)));
typedef __bf16 bf16x2_t __attribute__((ext_vector_type(2)));
__device__ __forceinline__ unsigned cvt_pk_c(float lo, float hi) { f32x2 v = {lo, hi}; bf16x2_t b = __builtin_convertvector(v, bf16x2_t); return __builtin_bit_cast(unsigned, b); }

template <class Epi, class Sched, class BMap, bool ALIGN_EPI = true>
__device__ __forceinline__ void gemm_phase_w(PG8_LAS unsigned char* lds, const bf16_t* Ag, const int K, const BMap BM_, const Sched& S, const Epi& E) {
    static_assert(Epi::PERM && !Epi::AFTER_DRAIN, "gemm_phase_w: PERM epilogues only");
    const int tid = threadIdx.x, wid = __builtin_amdgcn_readfirstlane(tid >> 6), lane = tid & 63, wr = wid >> 2, wc = wid & 3, fr = lane & 15, fq = lane >> 4;
    const int nt = K / BK;
    unsigned voffA[2];
#pragma unroll
    for (int i = 0; i < 2; ++i) { int R, C; stage_rc(tid * 16 + i * 8192, R, C); voffA[i] = (unsigned)(R * K + C) * 2u; }
    const size_t kstep = (size_t)(BK * 2);
    const size_t hstep = (size_t)HALF * K * 2;
    const size_t tstep = 2 * hstep;
    const unsigned ldsw = (unsigned)wid * 1024u;
    const int aoff = lds_byte(wr * 64 + fr, fq * 8), boff = lds_byte(wc * 32 + fr, fq * 8);
    constexpr int ldw = BMap::LDW;
    const int bh = wid >> 2, cb = (wid >> 1) & 1, kh = wid & 1, bq = lane & 15, bch = lane >> 4;
    const unsigned blane = (unsigned)(bch * 8 * ldw + 4 * bq) * 4u;
    const size_t bkt = (size_t)BK * ldw;
    const int bslab = 64 * cb + 32 * kh * ldw;
    const int rho0 = 32 * (2 * cb + (bq >> 3)) + 16 * (bq & 1) + 4 * ((bq & 7) >> 1), bs = (bq & 1);
    const bool rot1 = (bs & 1) != 0;
    constexpr int PFD = PG8_PF_DIST;
    const unsigned pfv = (unsigned)((16 * (wid & 3) + 4 * (lane >> 4)) * ldw * 4 + ((lane >> 2) & 3) * 128);
    unsigned pfd = 0u;
    unsigned wadr[4];
#pragma unroll
    for (int j = 0; j < 4; ++j) wadr[j] = (unsigned)(uintptr_t)lds + (unsigned)(4 * HTB + bh * HTB + lds_byte(rho0 + ((j + bs) & 3), 32 * kh + 8 * bch));
#define PG8_SA(b, h) (((b) * 2 + (h)) * HTB)
#define PG8_SB(b, h) ((4 + (b) * 2 + (h)) * HTB)
#define PG8_STAGE(bufoff, gbase, voff) do { _Pragma("unroll") for (int _i = 0; _i < 2; ++_i) \
        __builtin_amdgcn_global_load_lds((const unsigned*)((const char*)(gbase) + (voff)[_i]), (PG8_LAS unsigned*)(lds + (bufoff) + ldsw + _i * 8192), 16, 0, 0); } while (0)
#define PG8_LDA(dst, b, h) do { _Pragma("unroll") for (int m = 0; m < 4; ++m) _Pragma("unroll") for (int k = 0; k < 2; ++k) dst[m][k] = *(const PG8_LAS bf16x8*)(lds + PG8_SA(b, h) + aoff + m * 2048 + k * 1024); } while (0)
#define PG8_LDB(dst, b, h) do { _Pragma("unroll") for (int n = 0; n < 2; ++n) _Pragma("unroll") for (int k = 0; k < 2; ++k) dst[n][k] = *(const PG8_LAS bf16x8*)(lds + PG8_SB(b, h) + boff + n * 2048 + k * 1024); } while (0)
#define PG8_MMA(ai, bj, At, Bt) do { __builtin_amdgcn_s_setprio(1); _Pragma("unroll") for (int m = 0; m < 4; ++m) _Pragma("unroll") for (int n = 0; n < 2; ++n) _Pragma("unroll") for (int k = 0; k < 2; ++k) \
        acc[ai][bj][m][n] = __builtin_amdgcn_mfma_f32_16x16x32_bf16(Bt[n][k], At[m][k], acc[ai][bj][m][n], 0, 0, 0); __builtin_amdgcn_s_setprio(0); } while (0)
#define PG8_WAIT_V(n) asm volatile("s_waitcnt vmcnt(" #n ")" ::: "memory")
#if PG8_PF_DIST > 0
#define PG8_WAIT_VA PG8_WAIT_V(13)
#define PG8_WAIT_VB PG8_WAIT_V(5)
#define PG8_WAIT_VC PG8_WAIT_V(14)
#else
#define PG8_WAIT_VA PG8_WAIT_V(12)
#define PG8_WAIT_VB PG8_WAIT_V(8)
#define PG8_WAIT_VC PG8_WAIT_V(12)
#endif
#define PG8_WAIT_L(n) asm volatile("s_waitcnt lgkmcnt(" #n ")" ::: "memory")
#define PG8_BAR __builtin_amdgcn_s_barrier()
#define PG8_SCHED __builtin_amdgcn_sched_barrier(0)
#define PG8_GAS __attribute__((address_space(1)))
#define PG8_BLOADH(R, sb, K0) do { const PG8_GAS char* sb_ = (const PG8_GAS char*)(sb); _Pragma("unroll") for (int kk = 0; kk < 4; ++kk) { \
        const PG8_GAS char* p_ = sb_ + (size_t)(((K0) + kk) * ldw * 4); asm volatile("global_load_dwordx4 %0, %1, %2" : "=v"(R[kk]) : "v"(blane), "s"(p_) : "memory"); } } while (0)
#define PG8_BWRITEH(R, b, HOFF) do { u32x2 d_[4]; _Pragma("unroll") for (int i = 0; i < 4; ++i) { d_[i].x = cvt_pk_bf16(R[0][i], R[1][i]); d_[i].y = cvt_pk_bf16(R[2][i], R[3][i]); } \
        _Pragma("unroll") for (int j = 0; j < 4; ++j) { const u32x2 a_ = d_[j], b_ = d_[(j + 1) & 3]; u32x2 t_; t_.x = rot1 ? b_.x : a_.x; t_.y = rot1 ? b_.y : a_.y; \
            asm volatile("ds_write_b64 %0, %1 offset:%2" :: "v"(wadr[j]), "v"(t_), "i"((b) * 2 * HTB + (HOFF)) : "memory"); } } while (0)
#define PG8_PF(p) do { if constexpr (PFD > 0) { const PG8_GAS char* q_ = (p); asm volatile("global_load_dword %0, %1, %2" : "+v"(pfd) : "v"(pfv), "s"(q_) : "memory"); } } while (0)
    Unit cur, nxt; int ui = 0;
    if (!S.next(0, cur)) return;
    f32x4 acc[2][2][4][2];
#pragma unroll
    for (int a = 0; a < 2; ++a)
#pragma unroll
        for (int b = 0; b < 2; ++b)
#pragma unroll
            for (int m = 0; m < 4; ++m)
#pragma unroll
                for (int n = 0; n < 2; ++n) acc[a][b][m][n] = (f32x4){0.f, 0.f, 0.f, 0.f};
    bf16x8 At[4][2], B0[2][2], B1[2][2];
    f32x4 bx[4], by[4];
    const char* cA = (const char*)Ag + (size_t)cur.pm * tstep;
    const float* cB; const PG8_GAS char* cP; { const float *b0, *b1; BM_.ptrs(cur, b0, b1); cB = (bh ? b1 : b0) + bslab; cP = (const PG8_GAS char*)(bh ? b1 : b0) + (size_t)((cur.pm & 3) * ldw * 4); }
    int crot = PG8_KROT ? S.krot(cur) : 0;
#define PG8_KT(i, rot) (((i) + (rot)) & (nt - 1))
    S.a_ready(cur);
    PG8_STAGE(PG8_SA(0, 0), cA + (size_t)PG8_KT(0, crot) * kstep, voffA); PG8_STAGE(PG8_SA(0, 1), cA + (size_t)PG8_KT(0, crot) * kstep + hstep, voffA);
    PG8_BLOADH(bx, cB + (size_t)PG8_KT(0, crot) * bkt, 0); PG8_BLOADH(by, cB + (size_t)PG8_KT(0, crot) * bkt, 4);
    PG8_WAIT_V(0); PG8_BWRITEH(bx, 0, 0); PG8_BWRITEH(by, 0, 8);
    PG8_BLOADH(bx, cB + (size_t)PG8_KT(1, crot) * bkt, 0); PG8_BLOADH(by, cB + (size_t)PG8_KT(1, crot) * bkt, 4);
    PG8_STAGE(PG8_SA(1, 0), cA + (size_t)PG8_KT(1, crot) * kstep, voffA);
    PG8_WAIT_V(0); PG8_WAIT_L(0);
    if (wr == 1) PG8_BAR;
    PG8_BAR;
    PG8_BAR;
    for (;;) {
        const bool has_next = S.next(ui + 1, nxt);
        const char* nA = has_next ? (const char*)Ag + (size_t)nxt.pm * tstep : cA;
        const int nrot = (has_next && PG8_KROT) ? S.krot(nxt) : crot;
        const float* nB = cB; const PG8_GAS char* nP = cP; if (has_next) { const float *b0, *b1; BM_.ptrs(nxt, b0, b1); nB = (bh ? b1 : b0) + bslab; nP = (const PG8_GAS char*)(bh ? b1 : b0) + (size_t)((nxt.pm & 3) * ldw * 4); }
        for (int t = 0; t < nt; t += 2) {
            const bool last = (t == nt - 2);
            const int k1 = PG8_KT(t + 1, crot), k2 = last ? PG8_KT(0, nrot) : PG8_KT(t + 2, crot), k3 = last ? PG8_KT(1, nrot) : PG8_KT(t + 3, crot);
            const char* a1 = cA + (size_t)k1 * kstep;
            const char* a2 = (last ? nA : cA) + (size_t)k2 * kstep;
            const char* a3 = (last ? nA : cA) + (size_t)k3 * kstep;
            const float* b2 = (last ? nB : cB) + (size_t)k2 * bkt;
            const float* b3 = (last ? nB : cB) + (size_t)k3 * bkt;
            const int i2 = t + 2 + PFD, i3 = i2 + 1;
            const PG8_GAS char* pf2 = i2 < nt ? cP + (size_t)i2 * (bkt * 4) : nP + (size_t)(i2 - nt) * (bkt * 4);
            const PG8_GAS char* pf3 = i3 < nt ? cP + (size_t)i3 * (bkt * 4) : nP + (size_t)(i3 - nt) * (bkt * 4);
            if (last && has_next) S.a_ready(nxt);
            PG8_LDB(B0, 0, 0); PG8_LDB(B1, 0, 1); PG8_SCHED; PG8_LDA(At, 0, 0); PG8_WAIT_VB; PG8_BWRITEH(bx, 1, 0); PG8_BLOADH(bx, b2, 0); PG8_STAGE(PG8_SA(1, 1), a1 + hstep, voffA);
            PG8_WAIT_VA; PG8_WAIT_L(0); PG8_BAR; PG8_MMA(0, 0, At, B0); PG8_MMA(0, 1, At, B1); PG8_BAR; PG8_SCHED;
            PG8_LDA(At, 0, 1); PG8_WAIT_VB; PG8_BWRITEH(by, 1, 8); PG8_BLOADH(by, b2, 4); PG8_STAGE(PG8_SA(0, 0), a2, voffA); PG8_PF(pf2);
            PG8_WAIT_VC; PG8_WAIT_L(0); PG8_BAR; PG8_MMA(1, 0, At, B0); PG8_MMA(1, 1, At, B1); PG8_BAR; PG8_SCHED;
            PG8_LDB(B0, 1, 0); PG8_LDB(B1, 1, 1); PG8_SCHED; PG8_LDA(At, 1, 0); PG8_WAIT_VB; PG8_BWRITEH(bx, 0, 0); PG8_BLOADH(bx, b3, 0); PG8_STAGE(PG8_SA(0, 1), a2 + hstep, voffA);
            PG8_WAIT_VA; PG8_WAIT_L(0); PG8_BAR; PG8_MMA(0, 0, At, B0); PG8_MMA(0, 1, At, B1); PG8_BAR; PG8_SCHED;
            PG8_LDA(At, 1, 1); PG8_WAIT_VB; PG8_BWRITEH(by, 0, 8); PG8_BLOADH(by, b3, 4); PG8_STAGE(PG8_SA(1, 0), a3, voffA); PG8_PF(pf3);
            PG8_WAIT_VC; PG8_WAIT_L(0); PG8_BAR; PG8_MMA(1, 0, At, B0); PG8_MMA(1, 1, At, B1); PG8_BAR; PG8_SCHED;
        }
        if constexpr (ALIGN_EPI) { if (wr == 0) PG8_BAR; }
        E(acc, cur, wr, wc, fr, fq); S.done(cur);
        if (!has_next) break;
#pragma unroll
        for (int a = 0; a < 2; ++a)
#pragma unroll
            for (int b = 0; b < 2; ++b)
#pragma unroll
                for (int m = 0; m < 4; ++m)
#pragma unroll
                    for (int n = 0; n < 2; ++n) acc[a][b][m][n] = (f32x4){0.f, 0.f, 0.f, 0.f};
        cur = nxt; cA = nA; cB = nB; cP = nP; crot = nrot; ++ui;
        if constexpr (ALIGN_EPI) { if (wr == 1) PG8_BAR; }
    }
    PG8_WAIT_V(0);
    asm volatile("" :: "v"(pfd));
    if constexpr (!ALIGN_EPI) { if (wr == 0) PG8_BAR; }
    PG8_BAR;
#undef PG8_PF
#undef PG8_KT
#undef PG8_WAIT_VA
#undef PG8_WAIT_VB
#undef PG8_WAIT_VC
#undef PG8_SA
#undef PG8_SB
#undef PG8_STAGE
#undef PG8_LDA
#undef PG8_LDB
#undef PG8_MMA
#undef PG8_WAIT_V
#undef PG8_WAIT_L
#undef PG8_BAR
#undef PG8_SCHED
#undef PG8_BLOADH
#undef PG8_BWRITEH
#undef PG8_GAS
}
}
namespace att {
using bf16x8 = __attribute__((ext_vector_type(8))) short;
using s16x4  = __attribute__((ext_vector_type(4))) short;
using f32x16 = __attribute__((ext_vector_type(16))) float;
using u32x4  = __attribute__((ext_vector_type(4))) unsigned;
typedef unsigned short bf16;
constexpr int D = 128, NW = 8, QBLK = 32, KVBLK = 64;
constexpr float SCALE = 0.088388347648318440f;
constexpr float THR = 8.f;
constexpr int SHM_V = KVBLK * D * 2, SHM_K = KVBLK * D * 2, SHM_ATTN = 2 * SHM_V + 2 * SHM_K + NW * 64 * 4;
#define KSWZ(row, colB) ((row) * 256 + ((colB) ^ (((row) & 7) << 4)))
#define SBAR() __builtin_amdgcn_sched_barrier(0)
__device__ __forceinline__ int crow(int r, int hi) { return (r & 3) + 8 * (r >> 2) + 4 * hi; }
__device__ __forceinline__ unsigned cvtpk(float lo, float hi) { unsigned r; asm volatile("v_cvt_pk_bf16_f32 %0, %1, %2" : "=v"(r) : "v"(lo), "v"(hi)); return r; }

__device__ __forceinline__ void partialSM(f32x16& p0, f32x16& p1, float& m_reg, float& mn, float& alpha, bool domask, int dm, int hi) {
  constexpr float C = SCALE * 1.4426950408889634f;
  if (domask) {
    const int db = dm + 4 * hi + 128;
#pragma unroll
    for (int r = 0; r < 16; ++r) { const int d0 = db + (r & 3) + 8 * (r >> 2);
      if ((unsigned)d0 > 256u) p0[r] = -1e30f; if ((unsigned)(d0 + 32) > 256u) p1[r] = -1e30f; }
  }
  float pmax = p0[0];
#pragma unroll
  for (int r = 1; r < 16; ++r) pmax = fmaxf(pmax, p0[r]);
#pragma unroll
  for (int r = 0; r < 16; ++r) pmax = fmaxf(pmax, p1[r]);
  { auto rr = __builtin_amdgcn_permlane32_swap(__float_as_uint(pmax), __float_as_uint(pmax), false, false);
    pmax = fmaxf(__uint_as_float(rr[0]), __uint_as_float(rr[1])); }
  if (__builtin_expect(__all(pmax - m_reg <= THR / SCALE), 1)) { mn = m_reg; alpha = 1.f; }
  else { mn = fmaxf(m_reg, pmax); alpha = __builtin_amdgcn_exp2f((m_reg - mn) * C); m_reg = mn; }
  float mnC = -mn * C;
#pragma unroll
  for (int r = 0; r < 16; ++r) p0[r] = fmaf(p0[r], C, mnC);
#pragma unroll
  for (int r = 0; r < 16; ++r) p1[r] = fmaf(p1[r], C, mnC);
#pragma unroll
  for (int r = 0; r < 16; ++r) p0[r] = __builtin_amdgcn_exp2f(p0[r]);
}
__device__ __forceinline__ void finishSM(f32x16& p0, f32x16& p1, float alpha, float& l_reg, bf16x8& pa0, bf16x8& pa1, bf16x8& pa2, bf16x8& pa3) {
#pragma unroll
  for (int r = 0; r < 16; ++r) p1[r] = __builtin_amdgcn_exp2f(p1[r]);
  float ps = 0;
#pragma unroll
  for (int r = 0; r < 16; ++r) ps += p0[r];
#pragma unroll
  for (int r = 0; r < 16; ++r) ps += p1[r];
  { auto rr = __builtin_amdgcn_permlane32_swap(__float_as_uint(ps), __float_as_uint(ps), false, false);
    ps = __uint_as_float(rr[0]) + __uint_as_float(rr[1]); }
  l_reg = l_reg * alpha + ps;
#define PK4(P, BASE, OUT) do { unsigned a0 = cvtpk(P[BASE + 0], P[BASE + 1]), a1 = cvtpk(P[BASE + 2], P[BASE + 3]);   \
    unsigned b0 = cvtpk(P[BASE + 4], P[BASE + 5]), b1 = cvtpk(P[BASE + 6], P[BASE + 7]);                              \
    auto r0 = __builtin_amdgcn_permlane32_swap(a0, b0, false, false); auto r1 = __builtin_amdgcn_permlane32_swap(a1, b1, false, false); \
    u32x4 w = {r0[0], r1[0], r0[1], r1[1]}; OUT = *reinterpret_cast<bf16x8*>(&w); } while (0)
  PK4(p0, 0, pa0); PK4(p0, 8, pa1); PK4(p1, 0, pa2); PK4(p1, 8, pa3);
#undef PK4
}
__device__ __forceinline__ void qkt(f32x16& p0, f32x16& p1, const char* Ks, const bf16x8* qr, int r32, int hi) {
  p0 = f32x16{}; p1 = f32x16{};
#pragma unroll
  for (int d0 = 0; d0 < 8; ++d0) { int cb = (d0 * 16 + hi * 8) * 2;
    bf16x8 b0 = *reinterpret_cast<const bf16x8*>(Ks + KSWZ(r32, cb));
    bf16x8 b1 = *reinterpret_cast<const bf16x8*>(Ks + KSWZ(32 + r32, cb));
    p0 = __builtin_amdgcn_mfma_f32_32x32x16_bf16(b0, qr[d0], p0, 0, 0, 0);
    p1 = __builtin_amdgcn_mfma_f32_32x32x16_bf16(b1, qr[d0], p1, 0, 0, 0); }
}
__device__ __forceinline__ int v_st(int k, int c) { const int kk = (k & ~0xC) | ((k & 4) << 1) | ((k & 8) >> 1); return ((kk >> 3) * 4 + (c >> 5)) * 512 + ((kk & 7) * 32 + (c & 31)) * 2; }
__device__ __forceinline__ int v_rd_base(int lane) { return ((lane & 3) << 3) | (((lane >> 2) & 3) << 6) | (((lane >> 4) & 1) << 5) | (((lane >> 5) & 1) << 8); }
constexpr int v_rd_off(int d0, int ks, int half) { return d0 * 512 + ks * 4096 + half * 2048; }
template <int OFF> __device__ __forceinline__ s16x4 tr_read(int vb) {
  s16x4 r; asm volatile("ds_read_b64_tr_b16 %0, %1 offset:%2" : "=&v"(r) : "v"(vb), "i"(OFF) : "memory"); return r;
}
template <int D0> __device__ __forceinline__ void pv_one(f32x16& od, int vb, bf16x8 pa0, bf16x8 pa1, bf16x8 pa2, bf16x8 pa3) {
  const s16x4 l0 = tr_read<v_rd_off(D0, 0, 0)>(vb), h0 = tr_read<v_rd_off(D0, 0, 1)>(vb), l1 = tr_read<v_rd_off(D0, 1, 0)>(vb), h1 = tr_read<v_rd_off(D0, 1, 1)>(vb);
  const s16x4 l2 = tr_read<v_rd_off(D0, 2, 0)>(vb), h2 = tr_read<v_rd_off(D0, 2, 1)>(vb), l3 = tr_read<v_rd_off(D0, 3, 0)>(vb), h3 = tr_read<v_rd_off(D0, 3, 1)>(vb);
  asm volatile("s_waitcnt lgkmcnt(0)" ::: "memory"); SBAR();
#define PK(L, H) (bf16x8){L[0], L[1], L[2], L[3], H[0], H[1], H[2], H[3]}
  od = __builtin_amdgcn_mfma_f32_32x32x16_bf16(pa0, PK(l0, h0), od, 0, 0, 0);
  od = __builtin_amdgcn_mfma_f32_32x32x16_bf16(pa1, PK(l1, h1), od, 0, 0, 0);
  od = __builtin_amdgcn_mfma_f32_32x32x16_bf16(pa2, PK(l2, h2), od, 0, 0, 0);
  od = __builtin_amdgcn_mfma_f32_32x32x16_bf16(pa3, PK(l3, h3), od, 0, 0, 0);
#undef PK
}
__device__ __forceinline__ void pv_d0(f32x16* o, int vb, bf16x8 pa0, bf16x8 pa1, bf16x8 pa2, bf16x8 pa3) {
  pv_one<0>(o[0], vb, pa0, pa1, pa2, pa3); pv_one<1>(o[1], vb, pa0, pa1, pa2, pa3); pv_one<2>(o[2], vb, pa0, pa1, pa2, pa3); pv_one<3>(o[3], vb, pa0, pa1, pa2, pa3);
}

struct Job {
  const bf16* Q;
  const bf16* K; const bf16* V;
  int NT;
  int kb0;
  int mask;
  int dq;
  int use_sink; float sink_l2;
  void* O; float lam;
};

template <int LD, int OMODE>
__device__ __forceinline__ void attn_unit(const Job& J, char* lds) {
  constexpr int LDO = 2048;
  const int tid = threadIdx.x, wid = tid >> 6, lane = tid & 63, r32 = lane & 31, hi = lane >> 5;
  char* V_lds = lds; char* K_lds = lds + 2 * SHM_V;
  float* ws = (float*)(lds + 2 * SHM_V + 2 * SHM_K) + wid * 64; float* li_l = ws; float* al_l = ws + 32;
  float m_reg = -1e30f, l_reg = 0; f32x16 o[4] = {}; bf16x8 qr[8];
  const bf16* Qw = J.Q + (long)(wid * QBLK + r32) * LD + hi * 8;
#pragma unroll
  for (int d0 = 0; d0 < 8; ++d0) qr[d0] = *reinterpret_cast<const bf16x8*>(Qw + d0 * 16);
  const int sr = tid >> 4, sc = (tid & 15) * 8, vst0 = v_st(sr, sc), vst1 = v_st(32 + sr, sc);
  const int vb0 = (int)(uintptr_t)V_lds + v_rd_base(lane);
  const int toff = sr * LD + sc;
  constexpr int ldk = LD; const int kb0 = J.kb0, NT = J.NT;
  const bf16* Kh = J.K; const bf16* Vh = J.V;
  const bool msk = J.mask != 0;
  const int dml = J.dq - (wid * QBLK + r32);
  struct { bf16x8 vs0, vs1, ks0, ks1; } sr_[2];
#define KROWT(t) ((t) < 4 ? (t) * 64 : kb0 + ((t) - 4) * 64)
#define SLOAD(i, t) do { const int k0_ = KROWT(t); const bf16* vp_ = Vh + (size_t)k0_ * ldk + toff; const bf16* kp_ = Kh + (size_t)k0_ * ldk + toff; sr_[i].vs0 = *(const bf16x8*)vp_; sr_[i].vs1 = *(const bf16x8*)(vp_ + 32 * ldk); \
    sr_[i].ks0 = *(const bf16x8*)kp_; sr_[i].ks1 = *(const bf16x8*)(kp_ + 32 * ldk); } while (0)
#define SWRITE(b, i) do { *(bf16x8*)(V_lds + (b) * SHM_V + vst0) = sr_[i].vs0;          \
    *(bf16x8*)(V_lds + (b) * SHM_V + vst1) = sr_[i].vs1; int kc = sc * 2;               \
    *(bf16x8*)(K_lds + (b) * SHM_K + KSWZ(sr, kc)) = sr_[i].ks0;                       \
    *(bf16x8*)(K_lds + (b) * SHM_K + KSWZ(32 + sr, kc)) = sr_[i].ks1; } while (0)
#define SWAIT() asm volatile("s_waitcnt vmcnt(4)" ::: "memory")
#define RESC(a) do { if (__any((a) < 1.f)) { if (hi == 0) al_l[r32] = (a); asm volatile("s_waitcnt lgkmcnt(0)" ::: "memory"); \
    _Pragma("unroll") for (int d = 0; d < 4; ++d) _Pragma("unroll") for (int r = 0; r < 16; ++r) o[d][r] *= al_l[crow(r, hi)]; } } while (0)
#define MSK(t) (msk && (t) >= 4), (dml + ((t) - 4) * 64)
  f32x16 pA0, pA1, pB0, pB1; float mnA, mnB, alA, alB; bf16x8 pa0, pa1, pa2, pa3;
  constexpr int SE = 0, SO = 1;
  SLOAD(SE, 0); asm volatile("s_waitcnt vmcnt(0)" ::: "memory"); SWRITE(0, SE); __syncthreads();
  qkt(pA0, pA1, K_lds, qr, r32, hi); partialSM(pA0, pA1, m_reg, mnA, alA, false, 0, hi);
  SLOAD(SO, 1); if (2 < NT) SLOAD(SE, 2);
  SWAIT(); SWRITE(1, SO); __syncthreads();
  for (int j = 1; j + 1 < NT; j += 2) {
    SBAR(); qkt(pB0, pB1, K_lds + SHM_K, qr, r32, hi);
    finishSM(pA0, pA1, alA, l_reg, pa0, pa1, pa2, pa3); SBAR();
    SLOAD(SO, j + 2); SBAR();
    pv_d0(o, vb0, pa0, pa1, pa2, pa3); partialSM(pB0, pB1, m_reg, mnB, alB, MSK(j), hi);
    __syncthreads(); SWAIT(); SWRITE(0, SE);
    RESC(alB); __syncthreads();
    SBAR(); qkt(pA0, pA1, K_lds, qr, r32, hi);
    finishSM(pB0, pB1, alB, l_reg, pa0, pa1, pa2, pa3); SBAR();
    if (j + 3 < NT) SLOAD(SE, j + 3); SBAR();
    pv_d0(o, vb0 + SHM_V, pa0, pa1, pa2, pa3); partialSM(pA0, pA1, m_reg, mnA, alA, MSK(j + 1), hi);
    __syncthreads(); SWAIT(); SWRITE(1, SO);
    RESC(alA); __syncthreads();
  }
  SBAR(); qkt(pB0, pB1, K_lds + SHM_K, qr, r32, hi);
  finishSM(pA0, pA1, alA, l_reg, pa0, pa1, pa2, pa3); SBAR();
  pv_d0(o, vb0, pa0, pa1, pa2, pa3); partialSM(pB0, pB1, m_reg, mnB, alB, MSK(NT - 1), hi);
  __syncthreads(); RESC(alB);
  finishSM(pB0, pB1, alB, l_reg, pa0, pa1, pa2, pa3); SBAR();
  pv_d0(o, vb0 + SHM_V, pa0, pa1, pa2, pa3);
  if (J.use_sink) l_reg += __builtin_amdgcn_exp2f(J.sink_l2 - m_reg * (SCALE * 1.4426950408889634f));
  if (hi == 0) li_l[r32] = l_reg; asm volatile("s_waitcnt lgkmcnt(0)" ::: "memory");
  float rli[16];
#pragma unroll
  for (int r = 0; r < 16; ++r) rli[r] = __builtin_amdgcn_rcpf(li_l[crow(r, hi)]);
  if constexpr (OMODE == 0) {
    bf16* Ow = (bf16*)J.O + (long)(wid * QBLK) * LDO + r32;
#pragma unroll
    for (int r = 0; r < 16; ++r) { const int orow = crow(r, hi);
#pragma unroll
      for (int d0 = 0; d0 < 4; ++d0) Ow[orow * LDO + d0 * 32] = (bf16)(cvtpk(o[d0][r] * rli[r], 0.f) & 0xffffu); }
  } else if constexpr (OMODE == 1) {
    float* Ow = (float*)J.O + (long)(wid * QBLK) * LDO + r32;
#pragma unroll
    for (int r = 0; r < 16; ++r) { const int orow = crow(r, hi);
#pragma unroll
      for (int d0 = 0; d0 < 4; ++d0) Ow[orow * LDO + d0 * 32] = o[d0][r] * rli[r]; }
  }
#undef KROWT
#undef SLOAD
#undef SWRITE
#undef SWAIT
#undef RESC
#undef MSK
}
#undef KSWZ
#undef SBAR
}

constexpr int NWAVES = 8;
constexpr int DM = 2048, NBATCH = 2, SEQ = 4096, CTXL = 256, SB = SEQ + CTXL  , NROWS = NBATCH * SB  ;
constexpr int NEXP = 16, CAP_L = 512, CAP_C = 32, EROWS = 1280  ;
constexpr int NQKV0 = 3072, NQKV1 = 6144, NMOD = 6 * DM;
constexpr float EPS = 1e-6f;
constexpr float LAMBDA_INIT = 0.35550906759096926f;

constexpr size_t MiB = 1u << 20;
constexpr size_t WS_CTL = 0, CTL_ZERO_BYTES = 1 * MiB;
constexpr size_t WS_ROPE = 1 * MiB;
constexpr size_t WS_MODS = 2 * MiB;
constexpr size_t WS_AFF  = 3 * MiB;
constexpr size_t WS_RL   = 4 * MiB;
constexpr size_t WS_GATE = 5 * MiB;
constexpr size_t WS_INV  = 6 * MiB;
constexpr size_t WS_WIN0 = 8 * MiB;
constexpr size_t WS_WOUT0 = WS_WIN0 + 12 * MiB;
constexpr size_t WS_WIN1 = WS_WOUT0 + 8 * MiB;
constexpr size_t WS_WOUT1 = WS_WIN1 + 24 * MiB;
constexpr size_t WS_WGU = WS_WOUT1 + 8 * MiB;
constexpr size_t WS_WD  = WS_WGU + 512 * MiB;
constexpr size_t WS_H   = WS_WD + 256 * MiB;
constexpr size_t WS_QKV = WS_H + 34 * MiB;
constexpr size_t WS_Y   = WS_QKV + 102 * MiB;
constexpr size_t WS_YO  = WS_Y + 34 * MiB;
constexpr size_t WS_XL  = WS_YO + 68 * MiB;
constexpr size_t WS_XG  = WS_XL + 68 * MiB;
constexpr size_t WS_HM  = WS_XG + 80 * MiB;
constexpr size_t WS_YE  = WS_HM + 80 * MiB;
constexpr size_t WS_END = WS_YE + 80 * MiB;
constexpr int CW_BAR = 4096;

constexpr int RING_BYTES = 131072;
constexpr int LDSCTL_OFF = RING_BYTES, MISC_OFF = LDSCTL_OFF + 320;
constexpr int LDS_BYTES = 147456;

#define LAS __attribute__((address_space(3)))
typedef unsigned short bf16;
typedef unsigned v4u __attribute__((ext_vector_type(4)));
typedef unsigned v2u __attribute__((ext_vector_type(2)));
typedef int v4i __attribute__((ext_vector_type(4)));
typedef float f32x4 __attribute__((ext_vector_type(4)));
__device__ __forceinline__ unsigned f2bf(float f) { unsigned u = __builtin_bit_cast(unsigned, f); return (u + 0x7fffu + ((u >> 16) & 1u)) >> 16; }
__device__ __forceinline__ unsigned pk2(float lo, float hi) { return f2bf(lo) | (f2bf(hi) << 16); }
__device__ __forceinline__ float bf_lo(unsigned w) { return __builtin_bit_cast(float, w << 16); }
__device__ __forceinline__ float bf_hi(unsigned w) { return __builtin_bit_cast(float, w & 0xffff0000u); }

#define XB_TMO      128
#define XB_XCNT(j)  (256  + 64 * (j))
#define XB_XSUB(j)  (1280 + 64 * (j))
#define XB_XGEN(j)  (2304 + 64 * (j))
#define XB_TOP      3328
#define XB_TOPGEN   3392
#define XCD_BAR_WORDS 3456
#define XB_SPIN_CAP (1u << 18)
__device__ __forceinline__ unsigned xb_ld(unsigned* p)              { return __hip_atomic_load(p, __ATOMIC_RELAXED, __HIP_MEMORY_SCOPE_AGENT); }
__device__ __forceinline__ unsigned xb_add(unsigned* p, unsigned v) { return __hip_atomic_fetch_add(p, v, __ATOMIC_RELAXED, __HIP_MEMORY_SCOPE_AGENT); }
__device__ __forceinline__ unsigned xb_xcc_id() { return (unsigned)__builtin_amdgcn_s_getreg((3 << 11) | 20) & 0xFu; }
#define XB_SPIN(cond, bar) do { unsigned _sp = 0; while (cond) { __builtin_amdgcn_s_sleep(1); \
    if ((++_sp & 255u) == 0u) { if (xb_ld(&(bar)[XB_TMO])) break; if (_sp > XB_SPIN_CAP) { atomicAdd(&(bar)[XB_TMO], 1u); break; } } } } while (0)
struct XcdBarrier { unsigned* bar; unsigned x; volatile LAS unsigned* st; };
__device__ __forceinline__ XcdBarrier xcd_barrier_post(unsigned* bar, volatile LAS unsigned* st) {
    XcdBarrier b; b.bar = bar; b.x = xb_xcc_id(); b.st = st;
    if (threadIdx.x == 0) (void)xb_add(&bar[XB_XCNT(b.x)], 1u);
    return b;
}
__device__ __forceinline__ void xcd_barrier_complete(unsigned* bar, unsigned x, unsigned& nloc, unsigned& nx) {
    const unsigned G = gridDim.x * gridDim.y * gridDim.z;
    unsigned sum, cnt, mine, sp = 0u;
    for (;;) {
        sum = 0u; cnt = 0u; mine = 0u;
#pragma unroll
        for (unsigned j = 0; j < 16; ++j) { const unsigned c = xb_ld(&bar[XB_XCNT(j)]); sum += c; cnt += (c > 0u) ? 1u : 0u; mine = (j == x) ? c : mine; }
        if (sum == G) break;
        __builtin_amdgcn_s_sleep(1);
        if ((++sp & 255u) == 0u) { if (xb_ld(&bar[XB_TMO])) break; if (sp > XB_SPIN_CAP) { atomicAdd(&bar[XB_TMO], 1u); break; } }
    }
    nloc = mine > 0u ? mine : 1u; nx = cnt > 0u ? cnt : 1u;
}
__device__ __forceinline__ void xcd_barrier(const XcdBarrier& b) {
    asm volatile("s_waitcnt vmcnt(0)" ::: "memory");
    __syncthreads();
    if (threadIdx.x == 0) {
        unsigned* bar = b.bar;
        __builtin_amdgcn_s_waitcnt(0);
        unsigned nloc = b.st[0], nx = b.st[1];
        if (nloc == 0u) { xcd_barrier_complete(bar, b.x, nloc, nx); b.st[0] = nloc; b.st[1] = nx; }
        const unsigned old = xb_add(&bar[XB_XSUB(b.x)], 1u);
        const unsigned gen = old / nloc;
        if (old + 1u == (gen + 1u) * nloc) {
            __builtin_amdgcn_fence(__ATOMIC_RELEASE, "agent");
            asm volatile("s_waitcnt vmcnt(0)" ::: "memory");
            const unsigned og = xb_add(&bar[XB_TOP], 1u);
            const unsigned tg = og / nx;
            if (og + 1u == (tg + 1u) * nx) xb_add(&bar[XB_TOPGEN], 1u);
            else XB_SPIN(xb_ld(&bar[XB_TOPGEN]) == tg, bar);
            __builtin_amdgcn_fence(__ATOMIC_ACQUIRE, "agent");
            xb_add(&bar[XB_XGEN(b.x)], 1u);
            asm volatile("s_waitcnt vmcnt(0)" ::: "memory");
        } else {
            XB_SPIN(xb_ld(&bar[XB_XGEN(b.x)]) == gen, bar);
            __builtin_amdgcn_fence(__ATOMIC_ACQUIRE, "agent");
            asm volatile("s_waitcnt vmcnt(0)" ::: "memory");
        }
    }
    __syncthreads();
}

struct Args { const float* in[20]; float* out; unsigned char* ws; int ph_lo, ph_hi; };
struct Frame {
    LAS unsigned char* lds;
    int tid, lane, wave, G, gw, NGW;
    __attribute__((address_space(1))) unsigned char* ws;
};
template <class T> __device__ __forceinline__ T* fresh(T* p) { __attribute__((address_space(1))) T* q = (__attribute__((address_space(1))) T*)p; asm volatile("" : "+s"(q)); return (T*)q; }
__device__ __forceinline__ float wave_sum(float v) {
#pragma unroll
    for (int o = 1; o < 64; o <<= 1) v += __shfl_xor(v, o);
    return v;
}
__device__ __forceinline__ int wave_incl_scan(int v, int lane) {
#pragma unroll
    for (int o = 1; o < 64; o <<= 1) { const int t = __shfl_up(v, o); if (lane >= o) v += t; }
    return v;
}
__device__ __forceinline__ void transpose_item(const float* W, int K, int N, bf16* WT, int k0, int n0, int drow0, LAS float* scr, int lane) {
#pragma unroll 8
    for (int i = 0; i < 32; ++i) { const int kk = 2 * i + (lane >> 5); scr[kk * 33 + (lane & 31)] = W[(size_t)(k0 + kk) * N + n0 + (lane & 31)]; }
    asm volatile("s_waitcnt lgkmcnt(0)" ::: "memory");
    const int c = lane & 7;
#pragma unroll
    for (int j = 0; j < 4; ++j) { const int n = (lane >> 3) + 8 * j; const LAS float* s = scr + (8 * c) * 33 + n;
        v4u o; o.x = pk2(s[0 * 33], s[1 * 33]); o.y = pk2(s[2 * 33], s[3 * 33]); o.z = pk2(s[4 * 33], s[5 * 33]); o.w = pk2(s[6 * 33], s[7 * 33]);
        *(v4u*)(WT + (size_t)(drow0 + n) * K + k0 + 8 * c) = o; }
    asm volatile("s_waitcnt lgkmcnt(0)" ::: "memory");
}
__device__ __forceinline__ void ld_row(const float* p, int lane, f32x4 (&v)[8]) {
#pragma unroll
    for (int j = 0; j < 8; ++j) v[j] = *(const f32x4*)(p + 4 * lane + 256 * j);
}
__device__ __forceinline__ float row_rstd(const f32x4 (&v)[8]) {
    float s = 0.f;
#pragma unroll
    for (int j = 0; j < 8; ++j) s += (v[j].x * v[j].x + v[j].y * v[j].y) + (v[j].z * v[j].z + v[j].w * v[j].w);
    return 1.0f / sqrtf(wave_sum(s) * (1.0f / DM) + EPS);
}
__device__ __forceinline__ void st_row_bf16(bf16* p, int lane, const f32x4 (&v)[8]) {
#pragma unroll
    for (int j = 0; j < 8; ++j) { v2u w; w.x = pk2(v[j].x, v[j].y); w.y = pk2(v[j].z, v[j].w); *(v2u*)(p + 4 * lane + 256 * j) = w; }
}
__device__ __forceinline__ void norm_mod(f32x4 (&h)[8], const f32x4 (&x)[8], float r, const float* g, const float* sc, const float* sh, int lane) {
#pragma unroll
    for (int j = 0; j < 8; ++j) { const int c = 4 * lane + 256 * j; const f32x4 gg = *(const f32x4*)(g + c), s1 = *(const f32x4*)(sc + c), s0 = *(const f32x4*)(sh + c);
        h[j] = x[j] * r * gg * (s1 + 1.0f) + s0; }
}
__device__ __forceinline__ const float* in_row_ptr(const float* x_in, const float* ctx_in, int row) {
    const int b = row / SB, s = row - b * SB;
    return s < CTXL ? ctx_in + ((size_t)(b * CTXL + s)) * DM : x_in + ((size_t)(b * SEQ + s - CTXL)) * DM;
}
__device__ __forceinline__ const float* mods_ptr(const Frame& F, int layer, int row, int chunk) {
    const int b = row / SB, s = row - b * SB; const int vec = s < CTXL ? 2 : b;
    return (const float*)(F.ws + WS_MODS) + ((size_t)(layer * 3 + vec)) * NMOD + chunk * DM;
}

__device__ __forceinline__ void p0_prologue(Frame& F, const float* c_in, const float* c_ctx, const float* mod_w, const float* mod_b, const float* ab_w_in, const float* ab_w_out, const float* dif_w_in, const float* dif_w_out) {
    LAS float* sc = (LAS float*)F.lds;
    LAS float* red = (LAS float*)(F.lds + 24576);
    for (int i = F.tid; i < 3 * DM; i += 512) { const int v = i / DM, k = i - v * DM; const float cv = v < 2 ? c_in[v * DM + k] : c_ctx[k]; sc[i] = cv / (1.0f + __expf(-cv)); }
    __syncthreads();
    const int tx = F.tid & 7, ty = F.tid >> 3;
    for (int it = blockIdx.x; it < 2 * 384; it += F.G) {
        const int l = it / 384, sl = it - l * 384;
        const float* wp = mod_w + (size_t)l * DM * NMOD + sl * 32 + tx * 4;
        f32x4 a0 = {0.f, 0.f, 0.f, 0.f}, a1 = a0, a2 = a0;
#pragma unroll 8
        for (int i = 0; i < 32; ++i) { const int k = ty + 64 * i; const f32x4 w = *(const f32x4*)(wp + (size_t)k * NMOD);
            a0 += w * sc[k]; a1 += w * sc[DM + k]; a2 += w * sc[2 * DM + k]; }
        LAS float* rp = red + F.tid * 12;
        rp[0] = a0.x; rp[1] = a0.y; rp[2] = a0.z; rp[3] = a0.w; rp[4] = a1.x; rp[5] = a1.y; rp[6] = a1.z; rp[7] = a1.w; rp[8] = a2.x; rp[9] = a2.y; rp[10] = a2.z; rp[11] = a2.w;
        __syncthreads();
        if (F.tid < 96) { const int v = F.tid >> 5, col = F.tid & 31, txx = col >> 2, jj = col & 3; float s = 0.f;
            for (int t = 0; t < 64; ++t) s += red[(t * 8 + txx) * 12 + v * 4 + jj];
            ((float*)(F.ws + WS_MODS))[((size_t)(l * 3 + v)) * NMOD + sl * 32 + col] = s + mod_b[l * NMOD + sl * 32 + col]; }
        __syncthreads();
    }
    { const int gi = blockIdx.x * 512 + F.tid;
      if (gi < 2048) { const int pos = gi >> 5, f = gi & 31; const float inv = __builtin_amdgcn_exp2f(-(float)f * (13.287712379549449f / 32.0f)); const float ang = (float)pos * inv;
          float* rt = (float*)(F.ws + WS_ROPE); rt[gi] = __cosf(ang); rt[2048 + gi] = __sinf(ang); } }
    __syncthreads();
    __syncthreads();
    LAS float* scr = (LAS float*)(F.lds + F.wave * 16384);
    constexpr int I_IN0 = 32 * 96, I_OUT = 32 * 64, I_IN1 = 32 * 192;
    constexpr int NITEMS = I_IN0 + I_OUT + I_IN1 + I_OUT;
    for (int it = F.gw; it < NITEMS; it += F.NGW) {
        int r = it;
        if (r < I_IN0) { const int kb = r / 96, nb = r % 96; transpose_item(ab_w_in, DM, NQKV0, (bf16*)(F.ws + WS_WIN0), 64 * kb, 32 * nb, 32 * nb, scr, F.lane); continue; } r -= I_IN0;
        if (r < I_OUT) { const int kb = r / 64, nb = r % 64; transpose_item(ab_w_out, DM, DM, (bf16*)(F.ws + WS_WOUT0), 64 * kb, 32 * nb, 32 * nb, scr, F.lane); continue; } r -= I_OUT;
        if (r < I_IN1) { const int kb = r / 192, nb = r % 192; transpose_item(dif_w_in, DM, NQKV1, (bf16*)(F.ws + WS_WIN1), 64 * kb, 32 * nb, 32 * nb, scr, F.lane); continue; } r -= I_IN1;
        { const int kb = r / 64, nb = r % 64; transpose_item(dif_w_out, DM, DM, (bf16*)(F.ws + WS_WOUT1), 64 * kb, 32 * nb, 32 * nb, scr, F.lane); }
    }
}

__device__ __forceinline__ void t_norm0(Frame& F, const float* x_in, const float* ctx_in, const float* norm_g) {
    for (int row = F.gw; row < NROWS; row += F.NGW) {
        f32x4 x[8], h[8]; ld_row(in_row_ptr(x_in, ctx_in, row), F.lane, x);
        const float r = row_rstd(x);
        norm_mod(h, x, r, fresh(norm_g), mods_ptr(F, 0, row, 1), mods_ptr(F, 0, row, 0), F.lane);
        st_row_bf16((bf16*)(F.ws + WS_H) + (size_t)row * DM, F.lane, h);
    }
}
__device__ __forceinline__ void t_prep(Frame& F, int layer, const float* q_norm, const float* k_norm) {
    const int ld = layer == 0 ? NQKV0 : NQKV1;
    const float* rt = (const float*)(F.ws + WS_ROPE);
    const int f = F.lane & 31, d0 = (F.lane >> 5) * 64 + f;
    for (int row = F.gw; row < NROWS; row += F.NGW) {
        const int b = row / SB, s = row - b * SB; const bool lat = s >= CTXL;
        if (layer == 1 && !lat) continue;
        float cs = 1.f, sn = 0.f;
        if (lat) { const int t = s - CTXL; const int pos = (F.lane >> 5) ? (t & 63) : (t >> 6); cs = rt[pos * 32 + f]; sn = rt[2048 + pos * 32 + f]; }
        bf16* rp = (bf16*)(F.ws + WS_QKV) + (size_t)row * ld;
        const int nheads = layer == 0 ? 20 : 32;
        for (int hh = 0; hh < nheads; ++hh) {
            int col; const float* g = nullptr;
            if (layer == 0) {
                if (hh < 10) col = hh * 128; else if (hh < 18) { col = 1536 + (hh - 10) * 128; g = q_norm; } else { col = 2560 + (hh - 18) * 128; g = k_norm; }
                if (!lat && g == nullptr) continue;
            } else col = hh * 128;
            float a = bf_lo((unsigned)rp[col + d0]), c2 = bf_lo((unsigned)rp[col + d0 + 32]);
            if (g) { const float ss = wave_sum(a * a + c2 * c2); const float r = 1.0f / sqrtf(ss * (1.0f / 128.0f) + EPS); a = a * r * g[d0]; c2 = c2 * r * g[d0 + 32]; }
            const float o1 = a * cs - c2 * sn, o2 = c2 * cs + a * sn;
            rp[col + d0] = (bf16)f2bf(o1); rp[col + d0 + 32] = (bf16)f2bf(o2);
        }
    }
}
__device__ __forceinline__ void t_subln(Frame& F, const float* dif_lambda, const float* dif_subln) {
    const float* lp = dif_lambda;
    const float s01 = wave_sum(lp[F.lane] * lp[128 + F.lane] + lp[64 + F.lane] * lp[192 + F.lane]);
    const float s23 = wave_sum(lp[256 + F.lane] * lp[384 + F.lane] + lp[320 + F.lane] * lp[448 + F.lane]);
    const float lam = __expf(s01) - __expf(s23) + LAMBDA_INIT;
    for (int i = F.gw; i < NBATCH * SEQ; i += F.NGW) {
        const int b = i / SEQ, row = b * SB + CTXL + (i - b * SEQ);
        f32x4 v[8], w[8]; ld_row((const float*)(F.ws + WS_YO) + (size_t)row * DM, F.lane, v); ld_row((const float*)(F.ws + WS_XG) + (size_t)row * DM, F.lane, w);
        const f32x4 g = *(const f32x4*)(fresh(dif_subln) + 4 * F.lane);
#pragma unroll
        for (int j = 0; j < 8; ++j) { v[j] = v[j] - w[j] * lam;
            const float ss = wave_sum((v[j].x * v[j].x + v[j].y * v[j].y) + (v[j].z * v[j].z + v[j].w * v[j].w));
            const float r = (1.0f - LAMBDA_INIT) / sqrtf(ss * (1.0f / 256.0f) + EPS); v[j] = v[j] * r * g; }
        st_row_bf16((bf16*)(F.ws + WS_Y) + (size_t)row * DM, F.lane, v);
    }
}
__device__ __forceinline__ void t_post_attn(Frame& F, int layer, const float* x_in, const float* ctx_in, const float* norm_g, const float* router_w) {
    const float* ng0 = norm_g + (size_t)layer * 4 * DM;
    const float* wr0 = router_w + (size_t)layer * DM * NEXP;
    for (int row = F.gw; row < NROWS; row += F.NGW) {
        const int b = row / SB, s = row - b * SB;
        if (layer == 1 && s < CTXL) continue;
        const float* ng = fresh(ng0); const float* wr = fresh(wr0);
        f32x4 y[8], x[8], h[8];
        ld_row((const float*)(F.ws + WS_YO) + (size_t)row * DM, F.lane, y);
        ld_row(layer == 0 ? in_row_ptr(x_in, ctx_in, row) : (const float*)(F.ws + WS_XL) + (size_t)row * DM, F.lane, x);
        const float ry = row_rstd(y);
        const float* ga = mods_ptr(F, layer, row, 2);
#pragma unroll
        for (int j = 0; j < 8; ++j) { const int c = 4 * F.lane + 256 * j; x[j] = x[j] + *(const f32x4*)(ga + c) * (y[j] * ry * *(const f32x4*)(ng + DM + c)); }
        float* xl = (float*)(F.ws + WS_XL) + (size_t)row * DM;
#pragma unroll
        for (int j = 0; j < 8; ++j) *(f32x4*)(xl + 4 * F.lane + 256 * j) = x[j];
        const float rx = row_rstd(x);
        norm_mod(h, x, rx, ng + 2 * DM, mods_ptr(F, layer, row, 4), mods_ptr(F, layer, row, 3), F.lane);
        st_row_bf16((bf16*)(F.ws + WS_H) + (size_t)row * DM, F.lane, h);
        float lg[16];
#pragma unroll
        for (int e = 0; e < 16; ++e) lg[e] = 0.f;
#pragma unroll
        for (int j = 0; j < 8; ++j) {
            asm volatile("" ::: "memory");
#pragma unroll
            for (int i = 0; i < 4; ++i) { const float hv = h[j][i]; const float* wp = wr + (size_t)(4 * F.lane + 256 * j + i) * NEXP;
                const f32x4 w0 = *(const f32x4*)wp, w1 = *(const f32x4*)(wp + 4), w2 = *(const f32x4*)(wp + 8), w3 = *(const f32x4*)(wp + 12);
                lg[0] += hv * w0.x; lg[1] += hv * w0.y; lg[2] += hv * w0.z; lg[3] += hv * w0.w; lg[4] += hv * w1.x; lg[5] += hv * w1.y; lg[6] += hv * w1.z; lg[7] += hv * w1.w;
                lg[8] += hv * w2.x; lg[9] += hv * w2.y; lg[10] += hv * w2.z; lg[11] += hv * w2.w; lg[12] += hv * w3.x; lg[13] += hv * w3.y; lg[14] += hv * w3.z; lg[15] += hv * w3.w; } }
        float mx = -1e30f;
#pragma unroll
        for (int e = 0; e < 16; ++e) { lg[e] = wave_sum(lg[e]); mx = fmaxf(mx, lg[e]); }
        float sum = 0.f;
#pragma unroll
        for (int e = 0; e < 16; ++e) { lg[e] = __expf(lg[e] - mx); sum += lg[e]; }
        const float rs = 1.0f / sum;
        float* aff = (float*)(F.ws + WS_AFF) + (size_t)b * NEXP * SB + s;
#pragma unroll
        for (int e = 0; e < 16; ++e) if (F.lane == e) aff[(size_t)e * SB] = lg[e] * rs;
    }
}
template <int VPT>
__device__ __forceinline__ void topk_problem(Frame& F, const float* vals, int N, int cap, int e, int rowbase, int slotbase, bool write_inv) {
    LAS int* hist = (LAS int*)F.lds;
    LAS int* wt = (LAS int*)(F.lds + 1024);
    LAS int* selw = (LAS int*)(F.lds + 1280);
    float v[VPT]; unsigned key[VPT];
#pragma unroll
    for (int k = 0; k < VPT; ++k) { const int i = F.tid * VPT + k; const bool ok = i < N; v[k] = ok ? vals[i] : 0.f; const unsigned u = __builtin_bit_cast(unsigned, v[k]);
        key[k] = ok ? ((u & 0x80000000u) ? ~u : (u | 0x80000000u)) : 0u; }
    unsigned prefix = 0u, maskb = 0u; int need = cap;
    for (int pass = 0; pass < 4; ++pass) {
        const int shift = 24 - 8 * pass;
        if (F.tid < 256) hist[F.tid] = 0;
        __syncthreads();
#pragma unroll
        for (int k = 0; k < VPT; ++k) { const int i = F.tid * VPT + k; if (i < N && (key[k] & maskb) == prefix) __hip_atomic_fetch_add(&hist[(key[k] >> shift) & 255u], 1, __ATOMIC_RELAXED, __HIP_MEMORY_SCOPE_WORKGROUP); }
        __syncthreads();
        if (F.wave == 0) {
            const int l = F.lane; const int h0 = hist[255 - 4 * l], h1 = hist[254 - 4 * l], h2 = hist[253 - 4 * l], h3 = hist[252 - 4 * l];
            const int sm = h0 + h1 + h2 + h3; const int incl = wave_incl_scan(sm, l); const int excl = incl - sm;
            const unsigned long long m = __ballot(incl >= need); const int fl = m ? (__ffsll((long long)m) - 1) : 63;
            if (l == fl) { int c = excl, bin;
                if (c + h0 >= need) bin = 255 - 4 * l; else { c += h0; if (c + h1 >= need) bin = 254 - 4 * l; else { c += h1; if (c + h2 >= need) bin = 253 - 4 * l; else { c += h2; bin = 252 - 4 * l; } } }
                selw[0] = bin; selw[1] = need - c; }
        }
        __syncthreads();
        prefix |= ((unsigned)selw[0]) << shift; maskb |= 0xFFu << shift; need = selw[1];
        __syncthreads();
    }
    int ceq = 0;
#pragma unroll
    for (int k = 0; k < VPT; ++k) { const int i = F.tid * VPT + k; if (i < N && key[k] == prefix) ++ceq; }
    int incl = wave_incl_scan(ceq, F.lane);
    if (F.lane == 63) wt[F.wave] = incl;
    __syncthreads();
    int eqbase = incl - ceq;
    for (int w = 0; w < F.wave; ++w) eqbase += wt[w];
    int csel = 0; bool sel[VPT];
#pragma unroll
    for (int k = 0; k < VPT; ++k) { const int i = F.tid * VPT + k; const bool ok = i < N; const bool eq = ok && key[k] == prefix;
        sel[k] = ok && (key[k] > prefix || (eq && eqbase < need)); if (eq) ++eqbase; if (sel[k]) ++csel; }
    incl = wave_incl_scan(csel, F.lane);
    if (F.lane == 63) wt[8 + F.wave] = incl;
    __syncthreads();
    int sbase = incl - csel;
    for (int w = 0; w < F.wave; ++w) sbase += wt[8 + w];
    int* RL = (int*)(F.ws + WS_RL) + e * EROWS; float* GT = (float*)(F.ws + WS_GATE) + e * EROWS; int* INV = (int*)(F.ws + WS_INV);
#pragma unroll
    for (int k = 0; k < VPT; ++k) { const int i = F.tid * VPT + k;
        if (i < N) { const int grow = rowbase + i;
            if (sel[k]) { const int slot = slotbase + sbase; ++sbase; RL[slot] = grow; GT[slot] = v[k]; if (write_inv) INV[grow * 16 + e] = slot; }
            else if (write_inv) INV[grow * 16 + e] = -1; } }
    __syncthreads();
}
__device__ __forceinline__ void t_topk(Frame& F, int layer) {
    const int nprob = layer == 0 ? 64 : 32;
    for (int p = blockIdx.x; p < nprob; p += F.G) {
        const int kind = p >> 5, q = p & 31, b = q >> 4, e = q & 15;
        const float* aff = (const float*)(F.ws + WS_AFF) + ((size_t)(b * NEXP + e)) * SB;
        if (kind == 0) topk_problem<8>(F, aff + CTXL, SEQ, CAP_L, e, b * SB + CTXL, b * CAP_L, true);
        else           topk_problem<1>(F, aff, CTXL, CAP_C, e, b * SB, 2 * CAP_L + b * CAP_C, true);
    }
}
__device__ __forceinline__ void t_gather(Frame& F, int layer) {
    const int np = layer == 0 ? 1280 : 1024, nvalid = layer == 0 ? 1088 : 1024;
    const int* RL = (const int*)(F.ws + WS_RL);
    for (int i = F.gw; i < NEXP * np; i += F.NGW) {
        const int e = i / np, slot = i - e * np;
        v4u* dst = (v4u*)((bf16*)(F.ws + WS_XG) + ((size_t)(e * EROWS + slot)) * DM) + F.lane;
        if (slot < nvalid) { const int src = RL[e * EROWS + slot]; const v4u* sp = (const v4u*)((const bf16*)(F.ws + WS_H) + (size_t)src * DM) + F.lane;
#pragma unroll
            for (int j = 0; j < 4; ++j) dst[64 * j] = sp[64 * j];
        } else {
#pragma unroll
            for (int j = 0; j < 4; ++j) dst[64 * j] = (v4u){0u, 0u, 0u, 0u};
        }
    }
}
__device__ __forceinline__ void t_post_moe(Frame& F, int layer, const float* norm_g, float* out) {
    const float* ng0 = norm_g + (size_t)layer * 4 * DM;
    const int* INV = (const int*)(F.ws + WS_INV); const float* GT = (const float*)(F.ws + WS_GATE);
    for (int row = F.gw; row < NROWS; row += F.NGW) {
        const int b = row / SB, s = row - b * SB;
        if (layer == 1 && s < CTXL) continue;
        const float* ng = fresh(ng0); const float* ng1 = fresh(norm_g + 4 * DM);
        f32x4 mo[8], x[8];
#pragma unroll
        for (int j = 0; j < 8; ++j) mo[j] = (f32x4){0.f, 0.f, 0.f, 0.f};
        const v4i* ip = (const v4i*)(INV + (size_t)row * 16);
        const v4i i0 = ip[0], i1 = ip[1], i2 = ip[2], i3 = ip[3];
        const int sl[16] = {i0.x, i0.y, i0.z, i0.w, i1.x, i1.y, i1.z, i1.w, i2.x, i2.y, i2.z, i2.w, i3.x, i3.y, i3.z, i3.w};
#pragma unroll
        for (int e = 0; e < 16; ++e) { const int slot = sl[e];
            if (slot >= 0) { const float g = GT[e * EROWS + slot]; const bf16* yp = (const bf16*)(F.ws + WS_YE) + ((size_t)(e * EROWS + slot)) * DM + 4 * F.lane;
#pragma unroll
                for (int j = 0; j < 8; ++j) { const v2u w = *(const v2u*)(yp + 256 * j); mo[j].x += g * bf_lo(w.x); mo[j].y += g * bf_hi(w.x); mo[j].z += g * bf_lo(w.y); mo[j].w += g * bf_hi(w.y); } } }
        ld_row((const float*)(F.ws + WS_XL) + (size_t)row * DM, F.lane, x);
        const float rm = row_rstd(mo);
        const float* gf = mods_ptr(F, layer, row, 5);
#pragma unroll
        for (int j = 0; j < 8; ++j) { const int c = 4 * F.lane + 256 * j; x[j] = x[j] + *(const f32x4*)(gf + c) * (mo[j] * rm * *(const f32x4*)(ng + 3 * DM + c)); }
        if (layer == 0) {
            float* xl = (float*)(F.ws + WS_XL) + (size_t)row * DM;
#pragma unroll
            for (int j = 0; j < 8; ++j) *(f32x4*)(xl + 4 * F.lane + 256 * j) = x[j];
            f32x4 h[8]; const float rx = row_rstd(x);
            norm_mod(h, x, rx, ng1, mods_ptr(F, 1, row, 1), mods_ptr(F, 1, row, 0), F.lane);
            st_row_bf16((bf16*)(F.ws + WS_H) + (size_t)row * DM, F.lane, h);
        } else {
            float* op = out + ((size_t)(b * SEQ + s - CTXL)) * DM;
#pragma unroll
            for (int j = 0; j < 8; ++j) *(f32x4*)(op + 4 * F.lane + 256 * j) = x[j];
        }
    }
}

__device__ __forceinline__ void p_attn0(Frame& F, const float* ab_sink) {
    char* lds = (char*)F.lds;
    const bf16* QKV = (const bf16*)(F.ws + WS_QKV); bf16* Y = (bf16*)(F.ws + WS_Y);
    const int c = blockIdx.x;
    for (int u = c; u < 544; u += F.G) {
        att::Job J; J.kb0 = CTXL; J.mask = 0; J.dq = 0; J.use_sink = 0; J.sink_l2 = 0.f; J.lam = 0.f;
        int b, h, grpB; size_t qrow;
        if (u < 512) {
            const int uu = u & 255, x = uu & 7, i = uu >> 3, grp = x >> 1, idx = (x & 1) * 32 + i;
            b = grp >> 1; const int kv = grp & 1; h = kv * 4 + (idx >> 4); const int qb = idx & 15; grpB = u < 256;
            qrow = (size_t)b * SB + CTXL + qb * 256;
            if (grpB) J.NT = 68;
            else { const int q0 = qb * 256, lo = q0 - 128 < 0 ? 0 : q0 - 128, hiK = q0 + 384 > SEQ ? SEQ : q0 + 384;
                   J.NT = 4 + (hiK - lo) / 64; J.kb0 = CTXL + lo; J.mask = 1; J.dq = lo - q0; }
        } else { const int uu = u - 512; grpB = uu >> 4; b = (uu >> 3) & 1; h = uu & 7; qrow = (size_t)b * SB; J.NT = 4; }
        const int kv = h >> 2;
        if (!grpB) { J.use_sink = 1; J.sink_l2 = ab_sink[h] * 1.4426950408889634f; }
        const int qcol = grpB ? 1536 + h * 128 : h * 128, kcol = grpB ? 2560 + kv * 128 : 1024 + kv * 128, vcol = grpB ? 2816 + kv * 128 : 1280 + kv * 128;
        J.Q = QKV + qrow * NQKV0 + qcol; J.K = QKV + (size_t)b * SB * NQKV0 + kcol; J.V = QKV + (size_t)b * SB * NQKV0 + vcol;
        J.O = (void*)(Y + qrow * DM + (grpB ? 1024 : 0) + h * 128);
        __syncthreads();
        att::attn_unit<NQKV0, 0>(J, lds);
    }
}
__device__ __forceinline__ void p_attn1(Frame& F) {
    char* lds = (char*)F.lds;
    const bf16* QKV = (const bf16*)(F.ws + WS_QKV);
    for (int u = blockIdx.x; u < 1024; u += F.G) {
        const int x = u & 7, i = u >> 3;
        const int b = x >> 2, hp = x & 3, h = hp * 2 + ((i >> 6) & 1), m = (i >> 5) & 1, half = (i >> 4) & 1, qb = i & 15;
        const size_t qrow = (size_t)b * SB + CTXL + qb * 256;
        float* O = (float*)(F.ws + (m ? WS_XG : WS_YO));
        att::Job J; J.kb0 = CTXL; J.mask = 0; J.dq = 0; J.use_sink = 0; J.sink_l2 = 0.f; J.lam = 0.f; J.NT = 68;
        J.V = QKV + (size_t)b * SB * NQKV1 + 4096 + h * 256 + half * 128;
        J.O = (void*)(O + qrow * DM + h * 256 + half * 128);
        J.Q = QKV + qrow * NQKV1 + (2 * h + m) * 128; J.K = QKV + (size_t)b * SB * NQKV1 + 2048 + (2 * h + m) * 128;
        __syncthreads();
        att::attn_unit<NQKV1, 1>(J, lds);
    }
}

#define IN(k) (lo <= (k) && (k) < hi)
#define SEAM(k) do { if (IN((k) + 1)) xcd_barrier(bar); } while (0)
#define INP(k) ({ int k_ = (k); asm volatile("" : "+s"(k_)); (const float*)(const __attribute__((address_space(1))) float*)args.in[k_]; })
#ifndef PROBE_MASK
#define PROBE_MASK 0
#endif
#define PROBED(k) ((k) >= 0 && ((PROBE_MASK >> ((k) < 0 ? 0 : (k))) & 1))
#define REP2(k, ...) do { __VA_ARGS__; if constexpr (PROBED(k)) { __syncthreads(); __VA_ARGS__; } } while (0)
#define REP(k) for (int rep_ = 0; rep_ < (((k) >= 0 && ((PROBE_MASK >> ((k) < 0 ? 0 : (k))) & 1)) ? 2 : 1); ++rep_, __syncthreads())
#define FRESH() do { asm volatile("" : "+s"(F.ws)); } while (0)
template <int layer>
__device__ __forceinline__ void layer_phases(Frame& F, const Args& args, const int lo, const int hi, const XcdBarrier& bar) {

        const int pb = 2 + 11 * layer;
        if (IN(pb + 0)) {
            FRESH();
            pg8::Gemm g{(const pg8::bf16_t*)(F.ws + WS_H), (const pg8::bf16_t*)(F.ws + (layer == 0 ? WS_WIN0 : WS_WIN1)), NROWS, layer == 0 ? NQKV0 : NQKV1, DM};
            pg8::DenseOrder S; S.init(NROWS / 256, (layer == 0 ? NQKV0 : NQKV1) / 256, F.G, (int)blockIdx.x, 0);
            pg8::EpiStoreBf16 E{(pg8::bf16_t*)(F.ws + WS_QKV), layer == 0 ? NQKV0 : NQKV1, 1 << 20};
            pg8::gemm_phase<pg8::EpiStoreBf16, pg8::DenseOrder, true, true>(F.lds, g, S, E);
            SEAM(pb + 0);
        }
        if (IN(pb + 1)) { FRESH(); t_prep(F, layer, INP(10), INP(11)); SEAM(pb + 1); }
        if (IN(pb + 2)) { FRESH(); REP(pb + 2) { if (layer == 0) p_attn0(F, INP(9)); else p_attn1(F); } SEAM(pb + 2); }
        if (IN(pb + 3)) { if (layer == 1) { FRESH(); REP(pb + 3) t_subln(F, INP(14), INP(15)); SEAM(pb + 3); } }
        if (IN(pb + 4)) {
            FRESH();
            pg8::Gemm g{(const pg8::bf16_t*)(F.ws + WS_Y), (const pg8::bf16_t*)(F.ws + (layer == 0 ? WS_WOUT0 : WS_WOUT1)), NROWS, DM, DM};
            pg8::DenseOrder S; S.init(layer == 0 ? 34 : 32, DM / 256, F.G, (int)blockIdx.x, layer);
            pg8::EpiStoreF32 E{(float*)(F.ws + WS_YO), DM};
            pg8::gemm_phase<pg8::EpiStoreF32, pg8::DenseOrder, true, true>(F.lds, g, S, E);
            SEAM(pb + 4);
        }
        if (IN(pb + 5)) { FRESH(); REP(layer == 0 ? pb + 5 : -2) t_post_attn(F, layer, INP(0), INP(2), INP(6), INP(16)); SEAM(pb + 5); }
        if (IN(pb + 6)) { FRESH(); REP(pb + 6) t_topk(F, layer); SEAM(pb + 6); }
        if (IN(pb + 7)) { FRESH(); REP(pb + 7) t_gather(F, layer); SEAM(pb + 7); }
        if (IN(pb + 8)) {
            FRESH();
            pg8::BMoeGU Bm{INP(17) + (size_t)layer * 16 * DM * DM, INP(18) + (size_t)layer * 16 * DM * DM};
            pg8::MoeOrder S; S.init(layer == 0 ? 5 : 4, 16, F.G, (int)blockIdx.x);
            pg8::EpiSwiGLU E{(pg8::bf16_t*)(F.ws + WS_HM), DM};
            REP2(pb + 8, pg8::gemm_phase_w<pg8::EpiSwiGLU, pg8::MoeOrder, pg8::BMoeGU>(F.lds, (const pg8::bf16_t*)(F.ws + WS_XG), DM, Bm, S, E));
            SEAM(pb + 8);
        }
        if (IN(pb + 9)) {
            FRESH();
            pg8::BMoeDn Bm{INP(19) + (size_t)layer * 16 * DM * DM};
            pg8::MoeOrder S; S.init(layer == 0 ? 5 : 4, 8, F.G, (int)blockIdx.x);
            pg8::EpiStoreBf16 E{(pg8::bf16_t*)(F.ws + WS_YE), DM, 8};
            REP2(pb + 9, pg8::gemm_phase_w<pg8::EpiStoreBf16, pg8::MoeOrder, pg8::BMoeDn>(F.lds, (const pg8::bf16_t*)(F.ws + WS_HM), DM, Bm, S, E));
            SEAM(pb + 9);
        }
        if (IN(pb + 10)) { FRESH(); REP(layer == 1 ? pb + 10 : -2) t_post_moe(F, layer, INP(6), args.out); SEAM(pb + 10); }
}
constexpr int NPHASE = 24;
__global__ void __launch_bounds__(NWAVES * 64, 2) fwd(Args args) {
    extern __shared__ __attribute__((aligned(16))) unsigned char lds[];
    Frame F;
    F.lds = (LAS unsigned char*)lds;
    F.tid = threadIdx.x; F.lane = F.tid & 63; F.wave = __builtin_amdgcn_readfirstlane(F.tid >> 6);
    F.G = gridDim.x; F.gw = blockIdx.x * NWAVES + F.wave; F.NGW = F.G * NWAVES;
    F.ws = (__attribute__((address_space(1))) unsigned char*)args.ws;
    volatile LAS unsigned* MISC = (volatile LAS unsigned*)(F.lds + MISC_OFF);
    for (int u = F.tid; u < (LDS_BYTES - LDSCTL_OFF) / 4; u += NWAVES * 64) ((LAS unsigned*)(F.lds + LDSCTL_OFF))[u] = 0u;
    __syncthreads();
    const int lo = args.ph_lo, hi = args.ph_hi;
    const bool multi = (hi - lo) > 1;
    XcdBarrier bar; bar.bar = (unsigned*)(F.ws + WS_CTL) + CW_BAR; bar.x = 0; bar.st = nullptr;
    if (multi) bar = xcd_barrier_post((unsigned*)(F.ws + WS_CTL) + CW_BAR, MISC + 8);

    if (IN(0)) { FRESH(); REP(0) p0_prologue(F, INP(1), INP(3), INP(4), INP(5), INP(7), INP(8), INP(12), INP(13)); SEAM(0); }
    if (IN(1)) { FRESH(); REP(1) t_norm0(F, INP(0), INP(2), INP(6)); SEAM(1); }
    layer_phases<0>(F, args, lo, hi, bar);
    layer_phases<1>(F, args, lo, hi, bar);
}

extern "C" void kernel_launch(void* const* d_in, const int* in_sizes, int n_in, void* d_out, int out_size, void* d_ws, size_t ws_size, hipStream_t stream) {
    static int grid = 0;
    if (grid == 0) {
        if (n_in != 20 || out_size != NBATCH * SEQ * DM || ws_size < WS_END) { fprintf(stderr, "kernel_launch: shape mismatch (n_in %d out %d ws %zu need %zu)\n", n_in, out_size, ws_size, (size_t)WS_END); grid = -1; return; }
        int dev = 0, cus = 0, per_cu = 0;
        if (hipGetDevice(&dev) != hipSuccess || hipDeviceGetAttribute(&cus, hipDeviceAttributeMultiprocessorCount, dev) != hipSuccess) { grid = -1; return; }
        if (hipFuncSetAttribute((const void*)fwd, hipFuncAttributeMaxDynamicSharedMemorySize, LDS_BYTES) != hipSuccess) { fprintf(stderr, "kernel_launch: hipFuncSetAttribute failed\n"); grid = -1; return; }
        if (hipOccupancyMaxActiveBlocksPerMultiprocessor(&per_cu, (const void*)fwd, NWAVES * 64, LDS_BYTES) != hipSuccess || per_cu < 1)
            fprintf(stderr, "kernel_launch: note: occupancy query reports %d workgroups per CU\n", per_cu);
        (void)hipGetLastError();
        grid = cus;
    }
    if (grid < 0) return;
    if (hipMemsetAsync((char*)d_ws + WS_CTL, 0, CTL_ZERO_BYTES, stream) != hipSuccess) return;
    Args a{};
    for (int i = 0; i < 20; ++i) a.in[i] = (const float*)d_in[i];
    a.out = (float*)d_out; a.ws = (unsigned char*)d_ws;
#if MK_ONE_LAUNCH
    a.ph_lo = 0; a.ph_hi = NPHASE;
    hipLaunchKernelGGL(fwd, dim3(grid), dim3(NWAVES * 64), LDS_BYTES, stream, a);
#if defined(PROBE_EXTRA)
    { const int extra[] = {PROBE_EXTRA}; for (int ph : extra) { a.ph_lo = ph; a.ph_hi = ph + 1; hipLaunchKernelGGL(fwd, dim3(grid), dim3(NWAVES * 64), LDS_BYTES, stream, a); } }
#endif
#else
    for (int ph = 0; ph < NPHASE; ++ph) {
        if (ph == 5) continue;
        a.ph_lo = ph; a.ph_hi = ph + 1;
        hipLaunchKernelGGL(fwd, dim3(grid), dim3(NWAVES * 64), LDS_BYTES, stream, a);
    }
#endif
    const hipError_t le = hipPeekAtLastError();
    if (le != hipSuccess) fprintf(stderr, "kernel_launch: launch failed: %s\n", hipGetErrorName(le));
}
```

```cpp
#include <hip/hip_runtime.h>
#include <cstdio>
#include <cstdint>

#ifndef MK_ONE_LAUNCH
#define MK_ONE_LAUNCH 1
#endif

namespace pg8 {
#define PG8_LAS __attribute__((address_space(3)))
typedef unsigned short bf16_t;
typedef short bf16x8 __attribute__((ext_vector_type(8)));
typedef float f32x4 __attribute__((ext_vector_type(4)));
typedef unsigned u32x4 __attribute__((ext_vector_type(4)));
constexpr int BM = 256, BK = 64, HALF = 128, HTB = HALF * BK * 2  , STAGE_BYTES = 8 * HTB, NXCD = 8, WGM = 8;

__host__ __device__ __forceinline__ int lds_byte(int r, int c) { const int st = (r >> 4) * 2 + (c >> 5), rr = r & 15, cc = c & 31, ob = rr * 64 + cc * 2; return st * 1024 + (ob ^ (((ob >> 9) & 1) << 5)); }
__host__ __device__ __forceinline__ void stage_rc(int b, int& R, int& C) { const int st = b / 1024, sb = b % 1024, swz = sb ^ (((sb >> 9) & 1) << 5); R = (st >> 1) * 16 + swz / 64; C = (st & 1) * 32 + (swz % 64) / 2; }
__host__ __device__ __forceinline__ int perm32(int rho) { const int n = rho >> 4, i = rho & 15; return 8 * (i >> 2) + 4 * n + (i & 3); }

struct Unit { int pm, pn; };
struct Gemm { const bf16_t* A; const bf16_t* Bt; int M, N, K; };

struct StaticOrder {
    int nM, nN, nwg, G, c;
    __host__ __device__ void init(int M, int N, int G_, int c_) { nM = M / BM; nN = N / BM; nwg = nM * nN; G = G_; c = c_; }
    __host__ __device__ bool next(int i, Unit& u) const {
        const long L = (long)i * G + c; if (L >= nwg) return false;
        int wgid = (int)L; { const int q = nwg / NXCD, r = nwg % NXCD, xcd = wgid % NXCD, off = wgid / NXCD; wgid = (xcd < r ? xcd * (q + 1) : r * (q + 1) + (xcd - r) * q) + off; }
        const int nig = WGM * nN, gid = wgid / nig, fm = gid * WGM, gsz = (nM - fm) < WGM ? (nM - fm) : WGM;
        u.pm = fm + ((wgid % nig) % gsz); u.pn = (wgid % nig) / gsz; return true;
    }
    __device__ __forceinline__ void a_ready(const Unit&) const {}
    __device__ __forceinline__ void done(const Unit&) const {}
};

__device__ __forceinline__ unsigned cvt_pk_bf16(float lo, float hi) { unsigned r; asm volatile("v_cvt_pk_bf16_f32 %0, %1, %2" : "=v"(r) : "v"(lo), "v"(hi)); return r; }
struct DenseOrder {
    StaticOrder so; int kind;
    __device__ void init(int nM, int nN, int G_, int c_, int kind_) { so.init(nM * BM, nN * BM, G_, c_); kind = kind_; }
    __device__ bool next(int i, Unit& u) const {
        if (!so.next(i, u)) return false;
        if (kind == 1) { const int b = u.pm >> 4, j = u.pm & 15; u.pm = 17 * b + 1 + j; }
        return true;
    }
    __device__ __forceinline__ int krot(const Unit& u) const { return (u.pm & 3) * 8; }
    __device__ __forceinline__ void a_ready(const Unit&) const {}
    __device__ __forceinline__ void done(const Unit&) const {}
};
struct MoeOrder {
    int NP, NJ, nU, G, c;
    __device__ void init(int NP_, int NJ_, int G_, int c_) { NP = NP_; NJ = NJ_; nU = 16 * NP_ * NJ_; G = G_; c = c_; }
    __device__ bool next(int i, Unit& u) const {
        const int L = i * G + c; if (L >= nU) return false;
        const int xcd = L & 7, off = L >> 3, id = xcd * (nU >> 3) + off;
        const int per = NJ * NP, e = id / per, rem = id - e * per, j = rem / NP, p = rem - j * NP;
        u.pm = 5 * e + p; u.pn = NJ * e + j; return true;
    }
    __device__ __forceinline__ int krot(const Unit& u) const { const int p = u.pm % 5; return NP == 4 ? p * 8 : p * 6; }
    __device__ __forceinline__ void a_ready(const Unit&) const {}
    __device__ __forceinline__ void done(const Unit&) const {}
};

struct EpiStoreBf16 {
    static constexpr bool PERM = true, AFTER_DRAIN = false;
    bf16_t* O; int ldc; int nmod;
    __device__ __forceinline__ void operator()(const f32x4 (&acc)[2][2][4][2], const Unit& u, int wr, int wc, int fr, int fq) const {
        const int row0 = u.pm * BM + wr * 64 + fr, col0 = (u.pn % nmod) * BM + wc * 32 + 8 * fq;
#pragma unroll
        for (int ai = 0; ai < 2; ++ai)
#pragma unroll
            for (int m = 0; m < 4; ++m) { bf16_t* rowp = O + (size_t)(row0 + ai * HALF + m * 16) * ldc + col0;
#pragma unroll
                for (int bj = 0; bj < 2; ++bj) { const f32x4 v0 = acc[ai][bj][m][0], v1 = acc[ai][bj][m][1];
                    u32x4 w; w.x = cvt_pk_bf16(v0[0], v0[1]); w.y = cvt_pk_bf16(v0[2], v0[3]); w.z = cvt_pk_bf16(v1[0], v1[1]); w.w = cvt_pk_bf16(v1[2], v1[3]);
                    *(u32x4*)(rowp + bj * HALF) = w; } }
    }
};
struct EpiStoreF32 {
    static constexpr bool PERM = true, AFTER_DRAIN = false;
    float* O; int ldc;
    __device__ __forceinline__ void operator()(const f32x4 (&acc)[2][2][4][2], const Unit& u, int wr, int wc, int fr, int fq) const {
        const int row0 = u.pm * BM + wr * 64 + fr, col0 = u.pn * BM + wc * 32 + 8 * fq;
#pragma unroll
        for (int ai = 0; ai < 2; ++ai)
#pragma unroll
            for (int m = 0; m < 4; ++m) { float* rowp = O + (size_t)(row0 + ai * HALF + m * 16) * ldc + col0;
#pragma unroll
                for (int bj = 0; bj < 2; ++bj) { *(f32x4*)(rowp + bj * HALF) = acc[ai][bj][m][0]; *(f32x4*)(rowp + bj * HALF + 4) = acc[ai][bj][m][1]; } }
    }
};
__device__ __forceinline__ float silu_f(float g) { return g * __builtin_amdgcn_rcpf(1.0f + __builtin_amdgcn_exp2f(-1.4426950408889634f * g)); }
struct EpiSwiGLU {
    static constexpr bool PERM = true, AFTER_DRAIN = false;
    bf16_t* O; int ldc;
    __device__ __forceinline__ void operator()(const f32x4 (&acc)[2][2][4][2], const Unit& u, int wr, int wc, int fr, int fq) const {
        const int row0 = u.pm * BM + wr * 64 + fr, col0 = (u.pn & 15) * HALF + wc * 32 + 8 * fq;
#pragma unroll
        for (int ai = 0; ai < 2; ++ai)
#pragma unroll
            for (int m = 0; m < 4; ++m) { bf16_t* rowp = O + (size_t)(row0 + ai * HALF + m * 16) * ldc + col0;
                const f32x4 g0 = acc[ai][0][m][0], g1 = acc[ai][0][m][1], u0 = acc[ai][1][m][0], u1 = acc[ai][1][m][1];
                u32x4 w;
                w.x = cvt_pk_bf16(silu_f(g0[0]) * u0[0], silu_f(g0[1]) * u0[1]); w.y = cvt_pk_bf16(silu_f(g0[2]) * u0[2], silu_f(g0[3]) * u0[3]);
                w.z = cvt_pk_bf16(silu_f(g1[0]) * u1[0], silu_f(g1[1]) * u1[1]); w.w = cvt_pk_bf16(silu_f(g1[2]) * u1[2], silu_f(g1[3]) * u1[3]);
                *(u32x4*)rowp = w; }
    }
};

template <class Epi, class Sched, bool ALIGN_EPI = false, bool SP2 = false>
__device__ __forceinline__ void gemm_phase(PG8_LAS unsigned char* lds, const Gemm g, const Sched& S, const Epi& E) {
    const int tid = threadIdx.x, wid = __builtin_amdgcn_readfirstlane(tid >> 6), lane = tid & 63, wr = wid >> 2, wc = wid & 3, fr = lane & 15, fq = lane >> 4;
    const int K = g.K, nt = K / BK;
    unsigned voffA[2], voffB[2];
#pragma unroll
    for (int i = 0; i < 2; ++i) { int R, C; stage_rc(tid * 16 + i * 8192, R, C); const int Rb = Epi::PERM ? ((R & ~31) + perm32(R & 31)) : R;
        voffA[i] = (unsigned)(R * K + C) * 2u; voffB[i] = (unsigned)(Rb * K + C) * 2u; }
    const size_t kstep = (size_t)(BK * 2);
    const size_t hstep = (size_t)HALF * K * 2;
    const size_t tstep = 2 * hstep;
    const unsigned ldsw = (unsigned)wid * 1024u;
    const int aoff = lds_byte(wr * 64 + fr, fq * 8), boff = lds_byte(wc * 32 + fr, fq * 8);
#define PG8_SA(b, h) (((b) * 2 + (h)) * HTB)
#define PG8_SB(b, h) ((4 + (b) * 2 + (h)) * HTB)
#define PG8_STAGE(bufoff, gbase, voff) do { _Pragma("unroll") for (int _i = 0; _i < 2; ++_i) \
        __builtin_amdgcn_global_load_lds((const unsigned*)((const char*)(gbase) + (voff)[_i]), (PG8_LAS unsigned*)(lds + (bufoff) + ldsw + _i * 8192), 16, 0, 0); } while (0)
#define PG8_LDA(dst, b, h) do { _Pragma("unroll") for (int m = 0; m < 4; ++m) _Pragma("unroll") for (int k = 0; k < 2; ++k) dst[m][k] = *(const PG8_LAS bf16x8*)(lds + PG8_SA(b, h) + aoff + m * 2048 + k * 1024); } while (0)
#define PG8_LDB(dst, b, h) do { _Pragma("unroll") for (int n = 0; n < 2; ++n) _Pragma("unroll") for (int k = 0; k < 2; ++k) dst[n][k] = *(const PG8_LAS bf16x8*)(lds + PG8_SB(b, h) + boff + n * 2048 + k * 1024); } while (0)
#define PG8_MMA(ai, bj, At, Bt) do { __builtin_amdgcn_s_setprio(1); _Pragma("unroll") for (int m = 0; m < 4; ++m) _Pragma("unroll") for (int n = 0; n < 2; ++n) _Pragma("unroll") for (int k = 0; k < 2; ++k) \
        acc[ai][bj][m][n] = __builtin_amdgcn_mfma_f32_16x16x32_bf16(Bt[n][k], At[m][k], acc[ai][bj][m][n], 0, 0, 0); __builtin_amdgcn_s_setprio(0); } while (0)
#define PG8_WAIT_V(n) asm volatile("s_waitcnt vmcnt(" #n ")" ::: "memory")
#define PG8_WAIT_L(n) asm volatile("s_waitcnt lgkmcnt(" #n ")" ::: "memory")
#define PG8_BAR __builtin_amdgcn_s_barrier()
#define PG8_SCHED __builtin_amdgcn_sched_barrier(0)
    Unit cur, nxt; int ui = 0;
    if (!S.next(0, cur)) return;
    f32x4 acc[2][2][4][2];
#pragma unroll
    for (int a = 0; a < 2; ++a)
#pragma unroll
        for (int b = 0; b < 2; ++b)
#pragma unroll
            for (int m = 0; m < 4; ++m)
#pragma unroll
                for (int n = 0; n < 2; ++n) acc[a][b][m][n] = (f32x4){0.f, 0.f, 0.f, 0.f};
    bf16x8 At[4][2], B0[2][2], B1[2][2];
    const char* cA = (const char*)g.A + (size_t)cur.pm * tstep; const char* cB = (const char*)g.Bt + (size_t)cur.pn * tstep;
    S.a_ready(cur);
    if constexpr (SP2) {
        PG8_STAGE(PG8_SB(0, 0), cB, voffB); PG8_STAGE(PG8_SB(0, 1), cB + hstep, voffB); PG8_STAGE(PG8_SA(0, 0), cA, voffA); PG8_STAGE(PG8_SA(0, 1), cA + hstep, voffA);
        if (wr == 1) PG8_BAR;
        PG8_WAIT_V(2); PG8_BAR;
        PG8_STAGE(PG8_SB(1, 0), cB + kstep, voffB); PG8_STAGE(PG8_SA(1, 0), cA + kstep, voffA); PG8_STAGE(PG8_SB(1, 1), cB + hstep + kstep, voffB);
        PG8_WAIT_V(6); PG8_BAR;
    } else {
        PG8_STAGE(PG8_SB(0, 0), cB, voffB); PG8_STAGE(PG8_SA(0, 0), cA, voffA); PG8_STAGE(PG8_SB(0, 1), cB + hstep, voffB); PG8_STAGE(PG8_SA(0, 1), cA + hstep, voffA);
        if (wr == 1) PG8_BAR;
        PG8_WAIT_V(4); PG8_BAR;
        PG8_STAGE(PG8_SB(1, 0), cB + kstep, voffB); PG8_STAGE(PG8_SA(1, 0), cA + kstep, voffA); PG8_STAGE(PG8_SB(1, 1), cB + hstep + kstep, voffB);
        PG8_WAIT_V(6); PG8_BAR;
    }
    for (;;) {
        const bool has_next = S.next(ui + 1, nxt);
        const char* nA = has_next ? (const char*)g.A + (size_t)nxt.pm * tstep : cA; const char* nB = has_next ? (const char*)g.Bt + (size_t)nxt.pn * tstep : cB;
        for (int t = 0; t < nt; t += 2) {
            const bool last = (t == nt - 2);
            const char* a1 = cA + (size_t)(t + 1) * kstep;
            const char* a2 = last ? nA : cA + (size_t)(t + 2) * kstep; const char* b2 = last ? nB : cB + (size_t)(t + 2) * kstep;
            const char* a3 = a2 + kstep; const char* b3 = b2 + kstep;
            if (last && has_next) S.a_ready(nxt);
            if constexpr (SP2) {
            PG8_LDB(B0, 0, 0); PG8_LDB(B1, 0, 1); PG8_SCHED; PG8_LDA(At, 0, 0); PG8_STAGE(PG8_SA(1, 1), a1 + hstep, voffA);
            PG8_WAIT_V(8); PG8_WAIT_L(0); PG8_BAR; PG8_MMA(0, 0, At, B0); PG8_MMA(0, 1, At, B1); PG8_BAR; PG8_SCHED;
            PG8_LDA(At, 0, 1); PG8_STAGE(PG8_SB(0, 0), b2, voffB); PG8_STAGE(PG8_SB(0, 1), b2 + hstep, voffB); PG8_STAGE(PG8_SA(0, 0), a2, voffA);
            PG8_WAIT_V(8); PG8_WAIT_L(0); PG8_BAR; PG8_MMA(1, 0, At, B0); PG8_MMA(1, 1, At, B1); PG8_BAR; PG8_SCHED;
            PG8_LDB(B0, 1, 0); PG8_LDB(B1, 1, 1); PG8_SCHED; PG8_LDA(At, 1, 0); PG8_STAGE(PG8_SA(0, 1), a2 + hstep, voffA);
            PG8_WAIT_V(8); PG8_WAIT_L(0); PG8_BAR; PG8_MMA(0, 0, At, B0); PG8_MMA(0, 1, At, B1); PG8_BAR; PG8_SCHED;
            PG8_LDA(At, 1, 1); PG8_STAGE(PG8_SB(1, 0), b3, voffB); PG8_STAGE(PG8_SB(1, 1), b3 + hstep, voffB); PG8_STAGE(PG8_SA(1, 0), a3, voffA);
            PG8_WAIT_V(8); PG8_WAIT_L(0); PG8_BAR; PG8_MMA(1, 0, At, B0); PG8_MMA(1, 1, At, B1); PG8_BAR; PG8_SCHED;
            } else {
            PG8_LDB(B0, 0, 0); PG8_SCHED; PG8_LDA(At, 0, 0); PG8_STAGE(PG8_SA(1, 1), a1 + hstep, voffA);
            PG8_WAIT_L(8); PG8_BAR; PG8_WAIT_L(0); PG8_MMA(0, 0, At, B0); PG8_BAR; PG8_SCHED;
            PG8_LDB(B1, 0, 1); PG8_STAGE(PG8_SB(0, 0), b2, voffB);
            PG8_BAR; PG8_WAIT_L(0); PG8_MMA(0, 1, At, B1); PG8_BAR;
            PG8_LDA(At, 0, 1); PG8_STAGE(PG8_SA(0, 0), a2, voffA);
            PG8_BAR; PG8_WAIT_L(0); PG8_MMA(1, 0, At, B0); PG8_BAR; PG8_SCHED;
            PG8_STAGE(PG8_SB(0, 1), b2 + hstep, voffB);
            PG8_WAIT_V(6); PG8_BAR; PG8_MMA(1, 1, At, B1); PG8_BAR;
            PG8_LDB(B0, 1, 0); PG8_SCHED; PG8_LDA(At, 1, 0); PG8_STAGE(PG8_SA(0, 1), a2 + hstep, voffA);
            PG8_WAIT_L(8); PG8_BAR; PG8_WAIT_L(0); PG8_MMA(0, 0, At, B0); PG8_BAR; PG8_SCHED;
            PG8_LDB(B1, 1, 1); PG8_STAGE(PG8_SB(1, 0), b3, voffB);
            PG8_BAR; PG8_WAIT_L(0); PG8_MMA(0, 1, At, B1); PG8_BAR;
            PG8_LDA(At, 1, 1); PG8_STAGE(PG8_SA(1, 0), a3, voffA);
            PG8_BAR; PG8_WAIT_L(0); PG8_MMA(1, 0, At, B0); PG8_BAR; PG8_SCHED;
            PG8_STAGE(PG8_SB(1, 1), b3 + hstep, voffB);
            PG8_WAIT_V(6); PG8_BAR; PG8_MMA(1, 1, At, B1); PG8_BAR;
            }
        }
        if constexpr (ALIGN_EPI) { if (wr == 0) PG8_BAR; }
        if constexpr (!Epi::AFTER_DRAIN) { E(acc, cur, wr, wc, fr, fq); S.done(cur); }
        if (!has_next) break;
#pragma unroll
        for (int a = 0; a < 2; ++a)
#pragma unroll
            for (int b = 0; b < 2; ++b)
#pragma unroll
                for (int m = 0; m < 4; ++m)
#pragma unroll
                    for (int n = 0; n < 2; ++n) acc[a][b][m][n] = (f32x4){0.f, 0.f, 0.f, 0.f};
        cur = nxt; cA = nA; cB = nB; ++ui;
        if constexpr (ALIGN_EPI) { if (wr == 1) PG8_BAR; }
    }
    PG8_WAIT_V(0);
    if constexpr (!ALIGN_EPI) { if (wr == 0) PG8_BAR; }
    PG8_BAR;
    if constexpr (Epi::AFTER_DRAIN) { E.fused(acc, cur, wr, wc, fr, fq, lds, wid, lane); S.done(cur); }
#undef PG8_SA
#undef PG8_SB
#undef PG8_STAGE
#undef PG8_LDA
#undef PG8_LDB
#undef PG8_MMA
#undef PG8_WAIT_V
#undef PG8_WAIT_L
#undef PG8_BAR
#undef PG8_SCHED
}
#ifndef PG8_KROT
#define PG8_KROT 0
#endif
#ifndef PG8_PF_DIST
#define PG8_PF_DIST 0
#endif
template <int LDW_> struct BDense { static constexpr int LDW = LDW_; const float* W; __device__ __forceinline__ void ptrs(const Unit& u, const float*& b0, const float*& b1) const { b0 = W + (size_t)u.pn * 256; b1 = b0 + 128; } };
struct BMoeGU { static constexpr int LDW = 2048; const float* G; const float* U; __device__ __forceinline__ void ptrs(const Unit& u, const float*& b0, const float*& b1) const {
    const size_t o = (size_t)(u.pn >> 4) * 2048 * 2048 + (size_t)(u.pn & 15) * 128; b0 = G + o; b1 = U + o; } };
struct BMoeDn { static constexpr int LDW = 2048; const float* W; __device__ __forceinline__ void ptrs(const Unit& u, const float*& b0, const float*& b1) const {
    b0 = W + (size_t)(u.pn >> 3) * 2048 * 2048 + (size_t)(u.pn & 7) * 256; b1 = b0 + 128; } };
typedef float f32x2 __attribute__((ext_vector_type(2)));
typedef unsigned u32x2 __attribute__((ext_vector_type(2)));
typedef __bf16 bf16x2_t __attribute__((ext_vector_type(2)));
__device__ __forceinline__ unsigned cvt_pk_c(float lo, float hi) { f32x2 v = {lo, hi}; bf16x2_t b = __builtin_convertvector(v, bf16x2_t); return __builtin_bit_cast(unsigned, b); }

template <class Epi, class Sched, class BMap, bool ALIGN_EPI = true>
__device__ __forceinline__ void gemm_phase_w(PG8_LAS unsigned char* lds, const bf16_t* Ag, const int K, const BMap BM_, const Sched& S, const Epi& E) {
    static_assert(Epi::PERM && !Epi::AFTER_DRAIN, "gemm_phase_w: PERM epilogues only");
    const int tid = threadIdx.x, wid = __builtin_amdgcn_readfirstlane(tid >> 6), lane = tid & 63, wr = wid >> 2, wc = wid & 3, fr = lane & 15, fq = lane >> 4;
    const int nt = K / BK;
    unsigned voffA[2];
#pragma unroll
    for (int i = 0; i < 2; ++i) { int R, C; stage_rc(tid * 16 + i * 8192, R, C); voffA[i] = (unsigned)(R * K + C) * 2u; }
    const size_t kstep = (size_t)(BK * 2);
    const size_t hstep = (size_t)HALF * K * 2;
    const size_t tstep = 2 * hstep;
    const unsigned ldsw = (unsigned)wid * 1024u;
    const int aoff = lds_byte(wr * 64 + fr, fq * 8), boff = lds_byte(wc * 32 + fr, fq * 8);
    constexpr int ldw = BMap::LDW;
    const int bh = wid >> 2, cb = (wid >> 1) & 1, kh = wid & 1, bq = lane & 15, bch = lane >> 4;
    const unsigned blane = (unsigned)(bch * 8 * ldw + 4 * bq) * 4u;
    const size_t bkt = (size_t)BK * ldw;
    const int bslab = 64 * cb + 32 * kh * ldw;
    const int rho0 = 32 * (2 * cb + (bq >> 3)) + 16 * (bq & 1) + 4 * ((bq & 7) >> 1), bs = (bq & 1);
    const bool rot1 = (bs & 1) != 0;
    constexpr int PFD = PG8_PF_DIST;
    const unsigned pfv = (unsigned)((16 * (wid & 3) + 4 * (lane >> 4)) * ldw * 4 + ((lane >> 2) & 3) * 128);
    unsigned pfd = 0u;
    unsigned wadr[4];
#pragma unroll
    for (int j = 0; j < 4; ++j) wadr[j] = (unsigned)(uintptr_t)lds + (unsigned)(4 * HTB + bh * HTB + lds_byte(rho0 + ((j + bs) & 3), 32 * kh + 8 * bch));
#define PG8_SA(b, h) (((b) * 2 + (h)) * HTB)
#define PG8_SB(b, h) ((4 + (b) * 2 + (h)) * HTB)
#define PG8_STAGE(bufoff, gbase, voff) do { _Pragma("unroll") for (int _i = 0; _i < 2; ++_i) \
        __builtin_amdgcn_global_load_lds((const unsigned*)((const char*)(gbase) + (voff)[_i]), (PG8_LAS unsigned*)(lds + (bufoff) + ldsw + _i * 8192), 16, 0, 0); } while (0)
#define PG8_LDA(dst, b, h) do { _Pragma("unroll") for (int m = 0; m < 4; ++m) _Pragma("unroll") for (int k = 0; k < 2; ++k) dst[m][k] = *(const PG8_LAS bf16x8*)(lds + PG8_SA(b, h) + aoff + m * 2048 + k * 1024); } while (0)
#define PG8_LDB(dst, b, h) do { _Pragma("unroll") for (int n = 0; n < 2; ++n) _Pragma("unroll") for (int k = 0; k < 2; ++k) dst[n][k] = *(const PG8_LAS bf16x8*)(lds + PG8_SB(b, h) + boff + n * 2048 + k * 1024); } while (0)
#define PG8_MMA(ai, bj, At, Bt) do { __builtin_amdgcn_s_setprio(1); _Pragma("unroll") for (int m = 0; m < 4; ++m) _Pragma("unroll") for (int n = 0; n < 2; ++n) _Pragma("unroll") for (int k = 0; k < 2; ++k) \
        acc[ai][bj][m][n] = __builtin_amdgcn_mfma_f32_16x16x32_bf16(Bt[n][k], At[m][k], acc[ai][bj][m][n], 0, 0, 0); __builtin_amdgcn_s_setprio(0); } while (0)
#define PG8_WAIT_V(n) asm volatile("s_waitcnt vmcnt(" #n ")" ::: "memory")
#if PG8_PF_DIST > 0
#define PG8_WAIT_VA PG8_WAIT_V(13)
#define PG8_WAIT_VB PG8_WAIT_V(5)
#define PG8_WAIT_VC PG8_WAIT_V(14)
#else
#define PG8_WAIT_VA PG8_WAIT_V(12)
#define PG8_WAIT_VB PG8_WAIT_V(8)
#define PG8_WAIT_VC PG8_WAIT_V(12)
#endif
#define PG8_WAIT_L(n) asm volatile("s_waitcnt lgkmcnt(" #n ")" ::: "memory")
#define PG8_BAR __builtin_amdgcn_s_barrier()
#define PG8_SCHED __builtin_amdgcn_sched_barrier(0)
#define PG8_GAS __attribute__((address_space(1)))
#define PG8_BLOADH(R, sb, K0) do { const PG8_GAS char* sb_ = (const PG8_GAS char*)(sb); _Pragma("unroll") for (int kk = 0; kk < 4; ++kk) { \
        const PG8_GAS char* p_ = sb_ + (size_t)(((K0) + kk) * ldw * 4); asm volatile("global_load_dwordx4 %0, %1, %2" : "=v"(R[kk]) : "v"(blane), "s"(p_) : "memory"); } } while (0)
#define PG8_BWRITEH(R, b, HOFF) do { u32x2 d_[4]; _Pragma("unroll") for (int i = 0; i < 4; ++i) { d_[i].x = cvt_pk_bf16(R[0][i], R[1][i]); d_[i].y = cvt_pk_bf16(R[2][i], R[3][i]); } \
        _Pragma("unroll") for (int j = 0; j < 4; ++j) { const u32x2 a_ = d_[j], b_ = d_[(j + 1) & 3]; u32x2 t_; t_.x = rot1 ? b_.x : a_.x; t_.y = rot1 ? b_.y : a_.y; \
            asm volatile("ds_write_b64 %0, %1 offset:%2" :: "v"(wadr[j]), "v"(t_), "i"((b) * 2 * HTB + (HOFF)) : "memory"); } } while (0)
#define PG8_PF(p) do { if constexpr (PFD > 0) { const PG8_GAS char* q_ = (p); asm volatile("global_load_dword %0, %1, %2" : "+v"(pfd) : "v"(pfv), "s"(q_) : "memory"); } } while (0)
    Unit cur, nxt; int ui = 0;
    if (!S.next(0, cur)) return;
    f32x4 acc[2][2][4][2];
#pragma unroll
    for (int a = 0; a < 2; ++a)
#pragma unroll
        for (int b = 0; b < 2; ++b)
#pragma unroll
            for (int m = 0; m < 4; ++m)
#pragma unroll
                for (int n = 0; n < 2; ++n) acc[a][b][m][n] = (f32x4){0.f, 0.f, 0.f, 0.f};
    bf16x8 At[4][2], B0[2][2], B1[2][2];
    f32x4 bx[4], by[4];
    const char* cA = (const char*)Ag + (size_t)cur.pm * tstep;
    const float* cB; const PG8_GAS char* cP; { const float *b0, *b1; BM_.ptrs(cur, b0, b1); cB = (bh ? b1 : b0) + bslab; cP = (const PG8_GAS char*)(bh ? b1 : b0) + (size_t)((cur.pm & 3) * ldw * 4); }
    int crot = PG8_KROT ? S.krot(cur) : 0;
#define PG8_KT(i, rot) (((i) + (rot)) & (nt - 1))
    S.a_ready(cur);
    PG8_STAGE(PG8_SA(0, 0), cA + (size_t)PG8_KT(0, crot) * kstep, voffA); PG8_STAGE(PG8_SA(0, 1), cA + (size_t)PG8_KT(0, crot) * kstep + hstep, voffA);
    PG8_BLOADH(bx, cB + (size_t)PG8_KT(0, crot) * bkt, 0); PG8_BLOADH(by, cB + (size_t)PG8_KT(0, crot) * bkt, 4);
    PG8_WAIT_V(0); PG8_BWRITEH(bx, 0, 0); PG8_BWRITEH(by, 0, 8);
    PG8_BLOADH(bx, cB + (size_t)PG8_KT(1, crot) * bkt, 0); PG8_BLOADH(by, cB + (size_t)PG8_KT(1, crot) * bkt, 4);
    PG8_STAGE(PG8_SA(1, 0), cA + (size_t)PG8_KT(1, crot) * kstep, voffA);
    PG8_WAIT_V(0); PG8_WAIT_L(0);
    if (wr == 1) PG8_BAR;
    PG8_BAR;
    PG8_BAR;
    for (;;) {
        const bool has_next = S.next(ui + 1, nxt);
        const char* nA = has_next ? (const char*)Ag + (size_t)nxt.pm * tstep : cA;
        const int nrot = (has_next && PG8_KROT) ? S.krot(nxt) : crot;
        const float* nB = cB; const PG8_GAS char* nP = cP; if (has_next) { const float *b0, *b1; BM_.ptrs(nxt, b0, b1); nB = (bh ? b1 : b0) + bslab; nP = (const PG8_GAS char*)(bh ? b1 : b0) + (size_t)((nxt.pm & 3) * ldw * 4); }
        for (int t = 0; t < nt; t += 2) {
            const bool last = (t == nt - 2);
            const int k1 = PG8_KT(t + 1, crot), k2 = last ? PG8_KT(0, nrot) : PG8_KT(t + 2, crot), k3 = last ? PG8_KT(1, nrot) : PG8_KT(t + 3, crot);
            const char* a1 = cA + (size_t)k1 * kstep;
            const char* a2 = (last ? nA : cA) + (size_t)k2 * kstep;
            const char* a3 = (last ? nA : cA) + (size_t)k3 * kstep;
            const float* b2 = (last ? nB : cB) + (size_t)k2 * bkt;
            const float* b3 = (last ? nB : cB) + (size_t)k3 * bkt;
            const int i2 = t + 2 + PFD, i3 = i2 + 1;
            const PG8_GAS char* pf2 = i2 < nt ? cP + (size_t)i2 * (bkt * 4) : nP + (size_t)(i2 - nt) * (bkt * 4);
            const PG8_GAS char* pf3 = i3 < nt ? cP + (size_t)i3 * (bkt * 4) : nP + (size_t)(i3 - nt) * (bkt * 4);
            if (last && has_next) S.a_ready(nxt);
            PG8_LDB(B0, 0, 0); PG8_LDB(B1, 0, 1); PG8_SCHED; PG8_LDA(At, 0, 0); PG8_WAIT_VB; PG8_BWRITEH(bx, 1, 0); PG8_BLOADH(bx, b2, 0); PG8_STAGE(PG8_SA(1, 1), a1 + hstep, voffA);
            PG8_WAIT_VA; PG8_WAIT_L(0); PG8_BAR; PG8_MMA(0, 0, At, B0); PG8_MMA(0, 1, At, B1); PG8_BAR; PG8_SCHED;
            PG8_LDA(At, 0, 1); PG8_WAIT_VB; PG8_BWRITEH(by, 1, 8); PG8_BLOADH(by, b2, 4); PG8_STAGE(PG8_SA(0, 0), a2, voffA); PG8_PF(pf2);
            PG8_WAIT_VC; PG8_WAIT_L(0); PG8_BAR; PG8_MMA(1, 0, At, B0); PG8_MMA(1, 1, At, B1); PG8_BAR; PG8_SCHED;
            PG8_LDB(B0, 1, 0); PG8_LDB(B1, 1, 1); PG8_SCHED; PG8_LDA(At, 1, 0); PG8_WAIT_VB; PG8_BWRITEH(bx, 0, 0); PG8_BLOADH(bx, b3, 0); PG8_STAGE(PG8_SA(0, 1), a2 + hstep, voffA);
            PG8_WAIT_VA; PG8_WAIT_L(0); PG8_BAR; PG8_MMA(0, 0, At, B0); PG8_MMA(0, 1, At, B1); PG8_BAR; PG8_SCHED;
            PG8_LDA(At, 1, 1); PG8_WAIT_VB; PG8_BWRITEH(by, 0, 8); PG8_BLOADH(by, b3, 4); PG8_STAGE(PG8_SA(1, 0), a3, voffA); PG8_PF(pf3);
            PG8_WAIT_VC; PG8_WAIT_L(0); PG8_BAR; PG8_MMA(1, 0, At, B0); PG8_MMA(1, 1, At, B1); PG8_BAR; PG8_SCHED;
        }
        if constexpr (ALIGN_EPI) { if (wr == 0) PG8_BAR; }
        E(acc, cur, wr, wc, fr, fq); S.done(cur);
        if (!has_next) break;
#pragma unroll
        for (int a = 0; a < 2; ++a)
#pragma unroll
            for (int b = 0; b < 2; ++b)
#pragma unroll
                for (int m = 0; m < 4; ++m)
#pragma unroll
                    for (int n = 0; n < 2; ++n) acc[a][b][m][n] = (f32x4){0.f, 0.f, 0.f, 0.f};
        cur = nxt; cA = nA; cB = nB; cP = nP; crot = nrot; ++ui;
        if constexpr (ALIGN_EPI) { if (wr == 1) PG8_BAR; }
    }
    PG8_WAIT_V(0);
    asm volatile("" :: "v"(pfd));
    if constexpr (!ALIGN_EPI) { if (wr == 0) PG8_BAR; }
    PG8_BAR;
#undef PG8_PF
#undef PG8_KT
#undef PG8_WAIT_VA
#undef PG8_WAIT_VB
#undef PG8_WAIT_VC
#undef PG8_SA
#undef PG8_SB
#undef PG8_STAGE
#undef PG8_LDA
#undef PG8_LDB
#undef PG8_MMA
#undef PG8_WAIT_V
#undef PG8_WAIT_L
#undef PG8_BAR
#undef PG8_SCHED
#undef PG8_BLOADH
#undef PG8_BWRITEH
#undef PG8_GAS
}
}
namespace att {
using bf16x8 = __attribute__((ext_vector_type(8))) short;
using s16x4  = __attribute__((ext_vector_type(4))) short;
using f32x16 = __attribute__((ext_vector_type(16))) float;
using u32x4  = __attribute__((ext_vector_type(4))) unsigned;
typedef unsigned short bf16;
constexpr int D = 128, NW = 8, QBLK = 32, KVBLK = 64;
constexpr float SCALE = 0.088388347648318440f;
constexpr float THR = 8.f;
constexpr int SHM_V = KVBLK * D * 2, SHM_K = KVBLK * D * 2, SHM_ATTN = 2 * SHM_V + 2 * SHM_K + NW * 64 * 4;
#define KSWZ(row, colB) ((row) * 256 + ((colB) ^ (((row) & 7) << 4)))
#define SBAR() __builtin_amdgcn_sched_barrier(0)
__device__ __forceinline__ int crow(int r, int hi) { return (r & 3) + 8 * (r >> 2) + 4 * hi; }
__device__ __forceinline__ unsigned cvtpk(float lo, float hi) { unsigned r; asm volatile("v_cvt_pk_bf16_f32 %0, %1, %2" : "=v"(r) : "v"(lo), "v"(hi)); return r; }

__device__ __forceinline__ void partialSM(f32x16& p0, f32x16& p1, float& m_reg, float& mn, float& alpha, bool domask, int dm, int hi) {
  constexpr float C = SCALE * 1.4426950408889634f;
  if (domask) {
    const int db = dm + 4 * hi + 128;
#pragma unroll
    for (int r = 0; r < 16; ++r) { const int d0 = db + (r & 3) + 8 * (r >> 2);
      if ((unsigned)d0 > 256u) p0[r] = -1e30f; if ((unsigned)(d0 + 32) > 256u) p1[r] = -1e30f; }
  }
  float pmax = p0[0];
#pragma unroll
  for (int r = 1; r < 16; ++r) pmax = fmaxf(pmax, p0[r]);
#pragma unroll
  for (int r = 0; r < 16; ++r) pmax = fmaxf(pmax, p1[r]);
  { auto rr = __builtin_amdgcn_permlane32_swap(__float_as_uint(pmax), __float_as_uint(pmax), false, false);
    pmax = fmaxf(__uint_as_float(rr[0]), __uint_as_float(rr[1])); }
  if (__builtin_expect(__all(pmax - m_reg <= THR / SCALE), 1)) { mn = m_reg; alpha = 1.f; }
  else { mn = fmaxf(m_reg, pmax); alpha = __builtin_amdgcn_exp2f((m_reg - mn) * C); m_reg = mn; }
  float mnC = -mn * C;
#pragma unroll
  for (int r = 0; r < 16; ++r) p0[r] = fmaf(p0[r], C, mnC);
#pragma unroll
  for (int r = 0; r < 16; ++r) p1[r] = fmaf(p1[r], C, mnC);
#pragma unroll
  for (int r = 0; r < 16; ++r) p0[r] = __builtin_amdgcn_exp2f(p0[r]);
}
__device__ __forceinline__ void finishSM(f32x16& p0, f32x16& p1, float alpha, float& l_reg, bf16x8& pa0, bf16x8& pa1, bf16x8& pa2, bf16x8& pa3) {
#pragma unroll
  for (int r = 0; r < 16; ++r) p1[r] = __builtin_amdgcn_exp2f(p1[r]);
  float ps = 0;
#pragma unroll
  for (int r = 0; r < 16; ++r) ps += p0[r];
#pragma unroll
  for (int r = 0; r < 16; ++r) ps += p1[r];
  { auto rr = __builtin_amdgcn_permlane32_swap(__float_as_uint(ps), __float_as_uint(ps), false, false);
    ps = __uint_as_float(rr[0]) + __uint_as_float(rr[1]); }
  l_reg = l_reg * alpha + ps;
#define PK4(P, BASE, OUT) do { unsigned a0 = cvtpk(P[BASE + 0], P[BASE + 1]), a1 = cvtpk(P[BASE + 2], P[BASE + 3]);   \
    unsigned b0 = cvtpk(P[BASE + 4], P[BASE + 5]), b1 = cvtpk(P[BASE + 6], P[BASE + 7]);                              \
    auto r0 = __builtin_amdgcn_permlane32_swap(a0, b0, false, false); auto r1 = __builtin_amdgcn_permlane32_swap(a1, b1, false, false); \
    u32x4 w = {r0[0], r1[0], r0[1], r1[1]}; OUT = *reinterpret_cast<bf16x8*>(&w); } while (0)
  PK4(p0, 0, pa0); PK4(p0, 8, pa1); PK4(p1, 0, pa2); PK4(p1, 8, pa3);
#undef PK4
}
__device__ __forceinline__ void qkt(f32x16& p0, f32x16& p1, const char* Ks, const bf16x8* qr, int r32, int hi) {
  p0 = f32x16{}; p1 = f32x16{};
#pragma unroll
  for (int d0 = 0; d0 < 8; ++d0) { int cb = (d0 * 16 + hi * 8) * 2;
    bf16x8 b0 = *reinterpret_cast<const bf16x8*>(Ks + KSWZ(r32, cb));
    bf16x8 b1 = *reinterpret_cast<const bf16x8*>(Ks + KSWZ(32 + r32, cb));
    p0 = __builtin_amdgcn_mfma_f32_32x32x16_bf16(b0, qr[d0], p0, 0, 0, 0);
    p1 = __builtin_amdgcn_mfma_f32_32x32x16_bf16(b1, qr[d0], p1, 0, 0, 0); }
}
__device__ __forceinline__ int v_st(int k, int c) { const int kk = (k & ~0xC) | ((k & 4) << 1) | ((k & 8) >> 1); return ((kk >> 3) * 4 + (c >> 5)) * 512 + ((kk & 7) * 32 + (c & 31)) * 2; }
__device__ __forceinline__ int v_rd_base(int lane) { return ((lane & 3) << 3) | (((lane >> 2) & 3) << 6) | (((lane >> 4) & 1) << 5) | (((lane >> 5) & 1) << 8); }
constexpr int v_rd_off(int d0, int ks, int half) { return d0 * 512 + ks * 4096 + half * 2048; }
template <int OFF> __device__ __forceinline__ s16x4 tr_read(int vb) {
  s16x4 r; asm volatile("ds_read_b64_tr_b16 %0, %1 offset:%2" : "=&v"(r) : "v"(vb), "i"(OFF) : "memory"); return r;
}
template <int D0> __device__ __forceinline__ void pv_one(f32x16& od, int vb, bf16x8 pa0, bf16x8 pa1, bf16x8 pa2, bf16x8 pa3) {
  const s16x4 l0 = tr_read<v_rd_off(D0, 0, 0)>(vb), h0 = tr_read<v_rd_off(D0, 0, 1)>(vb), l1 = tr_read<v_rd_off(D0, 1, 0)>(vb), h1 = tr_read<v_rd_off(D0, 1, 1)>(vb);
  const s16x4 l2 = tr_read<v_rd_off(D0, 2, 0)>(vb), h2 = tr_read<v_rd_off(D0, 2, 1)>(vb), l3 = tr_read<v_rd_off(D0, 3, 0)>(vb), h3 = tr_read<v_rd_off(D0, 3, 1)>(vb);
  asm volatile("s_waitcnt lgkmcnt(0)" ::: "memory"); SBAR();
#define PK(L, H) (bf16x8){L[0], L[1], L[2], L[3], H[0], H[1], H[2], H[3]}
  od = __builtin_amdgcn_mfma_f32_32x32x16_bf16(pa0, PK(l0, h0), od, 0, 0, 0);
  od = __builtin_amdgcn_mfma_f32_32x32x16_bf16(pa1, PK(l1, h1), od, 0, 0, 0);
  od = __builtin_amdgcn_mfma_f32_32x32x16_bf16(pa2, PK(l2, h2), od, 0, 0, 0);
  od = __builtin_amdgcn_mfma_f32_32x32x16_bf16(pa3, PK(l3, h3), od, 0, 0, 0);
#undef PK
}
__device__ __forceinline__ void pv_d0(f32x16* o, int vb, bf16x8 pa0, bf16x8 pa1, bf16x8 pa2, bf16x8 pa3) {
  pv_one<0>(o[0], vb, pa0, pa1, pa2, pa3); pv_one<1>(o[1], vb, pa0, pa1, pa2, pa3); pv_one<2>(o[2], vb, pa0, pa1, pa2, pa3); pv_one<3>(o[3], vb, pa0, pa1, pa2, pa3);
}

struct Job {
  const bf16* Q;
  const bf16* K; const bf16* V;
  int NT;
  int kb0;
  int mask;
  int dq;
  int use_sink; float sink_l2;
  void* O; float lam;
};

template <int LD, int OMODE>
__device__ __forceinline__ void attn_unit(const Job& J, char* lds) {
  constexpr int LDO = 2048;
  const int tid = threadIdx.x, wid = tid >> 6, lane = tid & 63, r32 = lane & 31, hi = lane >> 5;
  char* V_lds = lds; char* K_lds = lds + 2 * SHM_V;
  float* ws = (float*)(lds + 2 * SHM_V + 2 * SHM_K) + wid * 64; float* li_l = ws; float* al_l = ws + 32;
  float m_reg = -1e30f, l_reg = 0; f32x16 o[4] = {}; bf16x8 qr[8];
  const bf16* Qw = J.Q + (long)(wid * QBLK + r32) * LD + hi * 8;
#pragma unroll
  for (int d0 = 0; d0 < 8; ++d0) qr[d0] = *reinterpret_cast<const bf16x8*>(Qw + d0 * 16);
  const int sr = tid >> 4, sc = (tid & 15) * 8, vst0 = v_st(sr, sc), vst1 = v_st(32 + sr, sc);
  const int vb0 = (int)(uintptr_t)V_lds + v_rd_base(lane);
  const int toff = sr * LD + sc;
  constexpr int ldk = LD; const int kb0 = J.kb0, NT = J.NT;
  const bf16* Kh = J.K; const bf16* Vh = J.V;
  const bool msk = J.mask != 0;
  const int dml = J.dq - (wid * QBLK + r32);
  struct { bf16x8 vs0, vs1, ks0, ks1; } sr_[2];
#define KROWT(t) ((t) < 4 ? (t) * 64 : kb0 + ((t) - 4) * 64)
#define SLOAD(i, t) do { const int k0_ = KROWT(t); const bf16* vp_ = Vh + (size_t)k0_ * ldk + toff; const bf16* kp_ = Kh + (size_t)k0_ * ldk + toff; sr_[i].vs0 = *(const bf16x8*)vp_; sr_[i].vs1 = *(const bf16x8*)(vp_ + 32 * ldk); \
    sr_[i].ks0 = *(const bf16x8*)kp_; sr_[i].ks1 = *(const bf16x8*)(kp_ + 32 * ldk); } while (0)
#define SWRITE(b, i) do { *(bf16x8*)(V_lds + (b) * SHM_V + vst0) = sr_[i].vs0;          \
    *(bf16x8*)(V_lds + (b) * SHM_V + vst1) = sr_[i].vs1; int kc = sc * 2;               \
    *(bf16x8*)(K_lds + (b) * SHM_K + KSWZ(sr, kc)) = sr_[i].ks0;                       \
    *(bf16x8*)(K_lds + (b) * SHM_K + KSWZ(32 + sr, kc)) = sr_[i].ks1; } while (0)
#define SWAIT() asm volatile("s_waitcnt vmcnt(4)" ::: "memory")
#define RESC(a) do { if (__any((a) < 1.f)) { if (hi == 0) al_l[r32] = (a); asm volatile("s_waitcnt lgkmcnt(0)" ::: "memory"); \
    _Pragma("unroll") for (int d = 0; d < 4; ++d) _Pragma("unroll") for (int r = 0; r < 16; ++r) o[d][r] *= al_l[crow(r, hi)]; } } while (0)
#define MSK(t) (msk && (t) >= 4), (dml + ((t) - 4) * 64)
  f32x16 pA0, pA1, pB0, pB1; float mnA, mnB, alA, alB; bf16x8 pa0, pa1, pa2, pa3;
  constexpr int SE = 0, SO = 1;
  SLOAD(SE, 0); asm volatile("s_waitcnt vmcnt(0)" ::: "memory"); SWRITE(0, SE); __syncthreads();
  qkt(pA0, pA1, K_lds, qr, r32, hi); partialSM(pA0, pA1, m_reg, mnA, alA, false, 0, hi);
  SLOAD(SO, 1); if (2 < NT) SLOAD(SE, 2);
  SWAIT(); SWRITE(1, SO); __syncthreads();
  for (int j = 1; j + 1 < NT; j += 2) {
    SBAR(); qkt(pB0, pB1, K_lds + SHM_K, qr, r32, hi);
    finishSM(pA0, pA1, alA, l_reg, pa0, pa1, pa2, pa3); SBAR();
    SLOAD(SO, j + 2); SBAR();
    pv_d0(o, vb0, pa0, pa1, pa2, pa3); partialSM(pB0, pB1, m_reg, mnB, alB, MSK(j), hi);
    __syncthreads(); SWAIT(); SWRITE(0, SE);
    RESC(alB); __syncthreads();
    SBAR(); qkt(pA0, pA1, K_lds, qr, r32, hi);
    finishSM(pB0, pB1, alB, l_reg, pa0, pa1, pa2, pa3); SBAR();
    if (j + 3 < NT) SLOAD(SE, j + 3); SBAR();
    pv_d0(o, vb0 + SHM_V, pa0, pa1, pa2, pa3); partialSM(pA0, pA1, m_reg, mnA, alA, MSK(j + 1), hi);
    __syncthreads(); SWAIT(); SWRITE(1, SO);
    RESC(alA); __syncthreads();
  }
  SBAR(); qkt(pB0, pB1, K_lds + SHM_K, qr, r32, hi);
  finishSM(pA0, pA1, alA, l_reg, pa0, pa1, pa2, pa3); SBAR();
  pv_d0(o, vb0, pa0, pa1, pa2, pa3); partialSM(pB0, pB1, m_reg, mnB, alB, MSK(NT - 1), hi);
  __syncthreads(); RESC(alB);
  finishSM(pB0, pB1, alB, l_reg, pa0, pa1, pa2, pa3); SBAR();
  pv_d0(o, vb0 + SHM_V, pa0, pa1, pa2, pa3);
  if (J.use_sink) l_reg += __builtin_amdgcn_exp2f(J.sink_l2 - m_reg * (SCALE * 1.4426950408889634f));
  if (hi == 0) li_l[r32] = l_reg; asm volatile("s_waitcnt lgkmcnt(0)" ::: "memory");
  float rli[16];
#pragma unroll
  for (int r = 0; r < 16; ++r) rli[r] = __builtin_amdgcn_rcpf(li_l[crow(r, hi)]);
  if constexpr (OMODE == 0) {
    bf16* Ow = (bf16*)J.O + (long)(wid * QBLK) * LDO + r32;
#pragma unroll
    for (int r = 0; r < 16; ++r) { const int orow = crow(r, hi);
#pragma unroll
      for (int d0 = 0; d0 < 4; ++d0) Ow[orow * LDO + d0 * 32] = (bf16)(cvtpk(o[d0][r] * rli[r], 0.f) & 0xffffu); }
  } else if constexpr (OMODE == 1) {
    float* Ow = (float*)J.O + (long)(wid * QBLK) * LDO + r32;
#pragma unroll
    for (int r = 0; r < 16; ++r) { const int orow = crow(r, hi);
#pragma unroll
      for (int d0 = 0; d0 < 4; ++d0) Ow[orow * LDO + d0 * 32] = o[d0][r] * rli[r]; }
  }
#undef KROWT
#undef SLOAD
#undef SWRITE
#undef SWAIT
#undef RESC
#undef MSK
}
#undef KSWZ
#undef SBAR
}

constexpr int NWAVES = 8;
constexpr int DM = 2048, NBATCH = 2, SEQ = 4096, CTXL = 256, SB = SEQ + CTXL  , NROWS = NBATCH * SB  ;
constexpr int NEXP = 16, CAP_L = 512, CAP_C = 32, EROWS = 1280  ;
constexpr int NQKV0 = 3072, NQKV1 = 6144, NMOD = 6 * DM;
constexpr float EPS = 1e-6f;
constexpr float LAMBDA_INIT = 0.35550906759096926f;

constexpr size_t MiB = 1u << 20;
constexpr size_t WS_CTL = 0, CTL_ZERO_BYTES = 1 * MiB;
constexpr size_t WS_ROPE = 1 * MiB;
constexpr size_t WS_MODS = 2 * MiB;
constexpr size_t WS_AFF  = 3 * MiB;
constexpr size_t WS_RL   = 4 * MiB;
constexpr size_t WS_GATE = 5 * MiB;
constexpr size_t WS_INV  = 6 * MiB;
constexpr size_t WS_WIN0 = 8 * MiB;
constexpr size_t WS_WOUT0 = WS_WIN0 + 12 * MiB;
constexpr size_t WS_WIN1 = WS_WOUT0 + 8 * MiB;
constexpr size_t WS_WOUT1 = WS_WIN1 + 24 * MiB;
constexpr size_t WS_WGU = WS_WOUT1 + 8 * MiB;
constexpr size_t WS_WD  = WS_WGU + 512 * MiB;
constexpr size_t WS_H   = WS_WD + 256 * MiB;
constexpr size_t WS_QKV = WS_H + 34 * MiB;
constexpr size_t WS_Y   = WS_QKV + 102 * MiB;
constexpr size_t WS_YO  = WS_Y + 34 * MiB;
constexpr size_t WS_XL  = WS_YO + 68 * MiB;
constexpr size_t WS_XG  = WS_XL + 68 * MiB;
constexpr size_t WS_HM  = WS_XG + 80 * MiB;
constexpr size_t WS_YE  = WS_HM + 80 * MiB;
constexpr size_t WS_END = WS_YE + 80 * MiB;
constexpr int CW_BAR = 4096;

constexpr int RING_BYTES = 131072;
constexpr int LDSCTL_OFF = RING_BYTES, MISC_OFF = LDSCTL_OFF + 320;
constexpr int LDS_BYTES = 147456;

#define LAS __attribute__((address_space(3)))
typedef unsigned short bf16;
typedef unsigned v4u __attribute__((ext_vector_type(4)));
typedef unsigned v2u __attribute__((ext_vector_type(2)));
typedef int v4i __attribute__((ext_vector_type(4)));
typedef float f32x4 __attribute__((ext_vector_type(4)));
__device__ __forceinline__ unsigned f2bf(float f) { unsigned u = __builtin_bit_cast(unsigned, f); return (u + 0x7fffu + ((u >> 16) & 1u)) >> 16; }
__device__ __forceinline__ unsigned pk2(float lo, float hi) { return f2bf(lo) | (f2bf(hi) << 16); }
__device__ __forceinline__ float bf_lo(unsigned w) { return __builtin_bit_cast(float, w << 16); }
__device__ __forceinline__ float bf_hi(unsigned w) { return __builtin_bit_cast(float, w & 0xffff0000u); }

#define XB_TMO      128
#define XB_XCNT(j)  (256  + 64 * (j))
#define XB_XSUB(j)  (1280 + 64 * (j))
#define XB_XGEN(j)  (2304 + 64 * (j))
#define XB_TOP      3328
#define XB_TOPGEN   3392
#define XCD_BAR_WORDS 3456
#define XB_SPIN_CAP (1u << 18)
__device__ __forceinline__ unsigned xb_ld(unsigned* p)              { return __hip_atomic_load(p, __ATOMIC_RELAXED, __HIP_MEMORY_SCOPE_AGENT); }
__device__ __forceinline__ unsigned xb_add(unsigned* p, unsigned v) { return __hip_atomic_fetch_add(p, v, __ATOMIC_RELAXED, __HIP_MEMORY_SCOPE_AGENT); }
__device__ __forceinline__ unsigned xb_xcc_id() { return (unsigned)__builtin_amdgcn_s_getreg((3 << 11) | 20) & 0xFu; }
#define XB_SPIN(cond, bar) do { unsigned _sp = 0; while (cond) { __builtin_amdgcn_s_sleep(1); \
    if ((++_sp & 255u) == 0u) { if (xb_ld(&(bar)[XB_TMO])) break; if (_sp > XB_SPIN_CAP) { atomicAdd(&(bar)[XB_TMO], 1u); break; } } } } while (0)
struct XcdBarrier { unsigned* bar; unsigned x; volatile LAS unsigned* st; };
__device__ __forceinline__ XcdBarrier xcd_barrier_post(unsigned* bar, volatile LAS unsigned* st) {
    XcdBarrier b; b.bar = bar; b.x = xb_xcc_id(); b.st = st;
    if (threadIdx.x == 0) (void)xb_add(&bar[XB_XCNT(b.x)], 1u);
    return b;
}
__device__ __forceinline__ void xcd_barrier_complete(unsigned* bar, unsigned x, unsigned& nloc, unsigned& nx) {
    const unsigned G = gridDim.x * gridDim.y * gridDim.z;
    unsigned sum, cnt, mine, sp = 0u;
    for (;;) {
        sum = 0u; cnt = 0u; mine = 0u;
#pragma unroll
        for (unsigned j = 0; j < 16; ++j) { const unsigned c = xb_ld(&bar[XB_XCNT(j)]); sum += c; cnt += (c > 0u) ? 1u : 0u; mine = (j == x) ? c : mine; }
        if (sum == G) break;
        __builtin_amdgcn_s_sleep(1);
        if ((++sp & 255u) == 0u) { if (xb_ld(&bar[XB_TMO])) break; if (sp > XB_SPIN_CAP) { atomicAdd(&bar[XB_TMO], 1u); break; } }
    }
    nloc = mine > 0u ? mine : 1u; nx = cnt > 0u ? cnt : 1u;
}
__device__ __forceinline__ void xcd_barrier(const XcdBarrier& b) {
    asm volatile("s_waitcnt vmcnt(0)" ::: "memory");
    __syncthreads();
    if (threadIdx.x == 0) {
        unsigned* bar = b.bar;
        __builtin_amdgcn_s_waitcnt(0);
        unsigned nloc = b.st[0], nx = b.st[1];
        if (nloc == 0u) { xcd_barrier_complete(bar, b.x, nloc, nx); b.st[0] = nloc; b.st[1] = nx; }
        const unsigned old = xb_add(&bar[XB_XSUB(b.x)], 1u);
        const unsigned gen = old / nloc;
        if (old + 1u == (gen + 1u) * nloc) {
            __builtin_amdgcn_fence(__ATOMIC_RELEASE, "agent");
            asm volatile("s_waitcnt vmcnt(0)" ::: "memory");
            const unsigned og = xb_add(&bar[XB_TOP], 1u);
            const unsigned tg = og / nx;
            if (og + 1u == (tg + 1u) * nx) xb_add(&bar[XB_TOPGEN], 1u);
            else XB_SPIN(xb_ld(&bar[XB_TOPGEN]) == tg, bar);
            __builtin_amdgcn_fence(__ATOMIC_ACQUIRE, "agent");
            xb_add(&bar[XB_XGEN(b.x)], 1u);
            asm volatile("s_waitcnt vmcnt(0)" ::: "memory");
        } else {
            XB_SPIN(xb_ld(&bar[XB_XGEN(b.x)]) == gen, bar);
            __builtin_amdgcn_fence(__ATOMIC_ACQUIRE, "agent");
            asm volatile("s_waitcnt vmcnt(0)" ::: "memory");
        }
    }
    __syncthreads();
}

struct Args { const float* in[20]; float* out; unsigned char* ws; int ph_lo, ph_hi; };
struct Frame {
    LAS unsigned char* lds;
    int tid, lane, wave, G, gw, NGW;
    __attribute__((address_space(1))) unsigned char* ws;
};
template <class T> __device__ __forceinline__ T* fresh(T* p) { __attribute__((address_space(1))) T* q = (__attribute__((address_space(1))) T*)p; asm volatile("" : "+s"(q)); return (T*)q; }
__device__ __forceinline__ float wave_sum(float v) {
#pragma unroll
    for (int o = 1; o < 64; o <<= 1) v += __shfl_xor(v, o);
    return v;
}
__device__ __forceinline__ int wave_incl_scan(int v, int lane) {
#pragma unroll
    for (int o = 1; o < 64; o <<= 1) { const int t = __shfl_up(v, o); if (lane >= o) v += t; }
    return v;
}
__device__ __forceinline__ void transpose_item(const float* W, int K, int N, bf16* WT, int k0, int n0, int drow0, LAS float* scr, int lane) {
#pragma unroll 8
    for (int i = 0; i < 32; ++i) { const int kk = 2 * i + (lane >> 5); scr[kk * 33 + (lane & 31)] = W[(size_t)(k0 + kk) * N + n0 + (lane & 31)]; }
    asm volatile("s_waitcnt lgkmcnt(0)" ::: "memory");
    const int c = lane & 7;
#pragma unroll
    for (int j = 0; j < 4; ++j) { const int n = (lane >> 3) + 8 * j; const LAS float* s = scr + (8 * c) * 33 + n;
        v4u o; o.x = pk2(s[0 * 33], s[1 * 33]); o.y = pk2(s[2 * 33], s[3 * 33]); o.z = pk2(s[4 * 33], s[5 * 33]); o.w = pk2(s[6 * 33], s[7 * 33]);
        *(v4u*)(WT + (size_t)(drow0 + n) * K + k0 + 8 * c) = o; }
    asm volatile("s_waitcnt lgkmcnt(0)" ::: "memory");
}
__device__ __forceinline__ void ld_row(const float* p, int lane, f32x4 (&v)[8]) {
#pragma unroll
    for (int j = 0; j < 8; ++j) v[j] = *(const f32x4*)(p + 4 * lane + 256 * j);
}
__device__ __forceinline__ float row_rstd(const f32x4 (&v)[8]) {
    float s = 0.f;
#pragma unroll
    for (int j = 0; j < 8; ++j) s += (v[j].x * v[j].x + v[j].y * v[j].y) + (v[j].z * v[j].z + v[j].w * v[j].w);
    return 1.0f / sqrtf(wave_sum(s) * (1.0f / DM) + EPS);
}
__device__ __forceinline__ void st_row_bf16(bf16* p, int lane, const f32x4 (&v)[8]) {
#pragma unroll
    for (int j = 0; j < 8; ++j) { v2u w; w.x = pk2(v[j].x, v[j].y); w.y = pk2(v[j].z, v[j].w); *(v2u*)(p + 4 * lane + 256 * j) = w; }
}
__device__ __forceinline__ void norm_mod(f32x4 (&h)[8], const f32x4 (&x)[8], float r, const float* g, const float* sc, const float* sh, int lane) {
#pragma unroll
    for (int j = 0; j < 8; ++j) { const int c = 4 * lane + 256 * j; const f32x4 gg = *(const f32x4*)(g + c), s1 = *(const f32x4*)(sc + c), s0 = *(const f32x4*)(sh + c);
        h[j] = x[j] * r * gg * (s1 + 1.0f) + s0; }
}
__device__ __forceinline__ const float* in_row_ptr(const float* x_in, const float* ctx_in, int row) {
    const int b = row / SB, s = row - b * SB;
    return s < CTXL ? ctx_in + ((size_t)(b * CTXL + s)) * DM : x_in + ((size_t)(b * SEQ + s - CTXL)) * DM;
}
__device__ __forceinline__ const float* mods_ptr(const Frame& F, int layer, int row, int chunk) {
    const int b = row / SB, s = row - b * SB; const int vec = s < CTXL ? 2 : b;
    return (const float*)(F.ws + WS_MODS) + ((size_t)(layer * 3 + vec)) * NMOD + chunk * DM;
}

__device__ __forceinline__ void p0_prologue(Frame& F, const float* c_in, const float* c_ctx, const float* mod_w, const float* mod_b, const float* ab_w_in, const float* ab_w_out, const float* dif_w_in, const float* dif_w_out) {
    LAS float* sc = (LAS float*)F.lds;
    LAS float* red = (LAS float*)(F.lds + 24576);
    for (int i = F.tid; i < 3 * DM; i += 512) { const int v = i / DM, k = i - v * DM; const float cv = v < 2 ? c_in[v * DM + k] : c_ctx[k]; sc[i] = cv / (1.0f + __expf(-cv)); }
    __syncthreads();
    const int tx = F.tid & 7, ty = F.tid >> 3;
    for (int it = blockIdx.x; it < 2 * 384; it += F.G) {
        const int l = it / 384, sl = it - l * 384;
        const float* wp = mod_w + (size_t)l * DM * NMOD + sl * 32 + tx * 4;
        f32x4 a0 = {0.f, 0.f, 0.f, 0.f}, a1 = a0, a2 = a0;
#pragma unroll 8
        for (int i = 0; i < 32; ++i) { const int k = ty + 64 * i; const f32x4 w = *(const f32x4*)(wp + (size_t)k * NMOD);
            a0 += w * sc[k]; a1 += w * sc[DM + k]; a2 += w * sc[2 * DM + k]; }
        LAS float* rp = red + F.tid * 12;
        rp[0] = a0.x; rp[1] = a0.y; rp[2] = a0.z; rp[3] = a0.w; rp[4] = a1.x; rp[5] = a1.y; rp[6] = a1.z; rp[7] = a1.w; rp[8] = a2.x; rp[9] = a2.y; rp[10] = a2.z; rp[11] = a2.w;
        __syncthreads();
        if (F.tid < 96) { const int v = F.tid >> 5, col = F.tid & 31, txx = col >> 2, jj = col & 3; float s = 0.f;
            for (int t = 0; t < 64; ++t) s += red[(t * 8 + txx) * 12 + v * 4 + jj];
            ((float*)(F.ws + WS_MODS))[((size_t)(l * 3 + v)) * NMOD + sl * 32 + col] = s + mod_b[l * NMOD + sl * 32 + col]; }
        __syncthreads();
    }
    { const int gi = blockIdx.x * 512 + F.tid;
      if (gi < 2048) { const int pos = gi >> 5, f = gi & 31; const float inv = __builtin_amdgcn_exp2f(-(float)f * (13.287712379549449f / 32.0f)); const float ang = (float)pos * inv;
          float* rt = (float*)(F.ws + WS_ROPE); rt[gi] = __cosf(ang); rt[2048 + gi] = __sinf(ang); } }
    __syncthreads();
    __syncthreads();
    LAS float* scr = (LAS float*)(F.lds + F.wave * 16384);
    constexpr int I_IN0 = 32 * 96, I_OUT = 32 * 64, I_IN1 = 32 * 192;
    constexpr int NITEMS = I_IN0 + I_OUT + I_IN1 + I_OUT;
    for (int it = F.gw; it < NITEMS; it += F.NGW) {
        int r = it;
        if (r < I_IN0) { const int kb = r / 96, nb = r % 96; transpose_item(ab_w_in, DM, NQKV0, (bf16*)(F.ws + WS_WIN0), 64 * kb, 32 * nb, 32 * nb, scr, F.lane); continue; } r -= I_IN0;
        if (r < I_OUT) { const int kb = r / 64, nb = r % 64; transpose_item(ab_w_out, DM, DM, (bf16*)(F.ws + WS_WOUT0), 64 * kb, 32 * nb, 32 * nb, scr, F.lane); continue; } r -= I_OUT;
        if (r < I_IN1) { const int kb = r / 192, nb = r % 192; transpose_item(dif_w_in, DM, NQKV1, (bf16*)(F.ws + WS_WIN1), 64 * kb, 32 * nb, 32 * nb, scr, F.lane); continue; } r -= I_IN1;
        { const int kb = r / 64, nb = r % 64; transpose_item(dif_w_out, DM, DM, (bf16*)(F.ws + WS_WOUT1), 64 * kb, 32 * nb, 32 * nb, scr, F.lane); }
    }
}

__device__ __forceinline__ void t_norm0(Frame& F, const float* x_in, const float* ctx_in, const float* norm_g) {
    for (int row = F.gw; row < NROWS; row += F.NGW) {
        f32x4 x[8], h[8]; ld_row(in_row_ptr(x_in, ctx_in, row), F.lane, x);
        const float r = row_rstd(x);
        norm_mod(h, x, r, fresh(norm_g), mods_ptr(F, 0, row, 1), mods_ptr(F, 0, row, 0), F.lane);
        st_row_bf16((bf16*)(F.ws + WS_H) + (size_t)row * DM, F.lane, h);
    }
}
__device__ __forceinline__ void t_prep(Frame& F, int layer, const float* q_norm, const float* k_norm) {
    const int ld = layer == 0 ? NQKV0 : NQKV1;
    const float* rt = (const float*)(F.ws + WS_ROPE);
    const int f = F.lane & 31, d0 = (F.lane >> 5) * 64 + f;
    for (int row = F.gw; row < NROWS; row += F.NGW) {
        const int b = row / SB, s = row - b * SB; const bool lat = s >= CTXL;
        if (layer == 1 && !lat) continue;
        float cs = 1.f, sn = 0.f;
        if (lat) { const int t = s - CTXL; const int pos = (F.lane >> 5) ? (t & 63) : (t >> 6); cs = rt[pos * 32 + f]; sn = rt[2048 + pos * 32 + f]; }
        bf16* rp = (bf16*)(F.ws + WS_QKV) + (size_t)row * ld;
        const int nheads = layer == 0 ? 20 : 32;
        for (int hh = 0; hh < nheads; ++hh) {
            int col; const float* g = nullptr;
            if (layer == 0) {
                if (hh < 10) col = hh * 128; else if (hh < 18) { col = 1536 + (hh - 10) * 128; g = q_norm; } else { col = 2560 + (hh - 18) * 128; g = k_norm; }
                if (!lat && g == nullptr) continue;
            } else col = hh * 128;
            float a = bf_lo((unsigned)rp[col + d0]), c2 = bf_lo((unsigned)rp[col + d0 + 32]);
            if (g) { const float ss = wave_sum(a * a + c2 * c2); const float r = 1.0f / sqrtf(ss * (1.0f / 128.0f) + EPS); a = a * r * g[d0]; c2 = c2 * r * g[d0 + 32]; }
            const float o1 = a * cs - c2 * sn, o2 = c2 * cs + a * sn;
            rp[col + d0] = (bf16)f2bf(o1); rp[col + d0 + 32] = (bf16)f2bf(o2);
        }
    }
}
__device__ __forceinline__ void t_subln(Frame& F, const float* dif_lambda, const float* dif_subln) {
    const float* lp = dif_lambda;
    const float s01 = wave_sum(lp[F.lane] * lp[128 + F.lane] + lp[64 + F.lane] * lp[192 + F.lane]);
    const float s23 = wave_sum(lp[256 + F.lane] * lp[384 + F.lane] + lp[320 + F.lane] * lp[448 + F.lane]);
    const float lam = __expf(s01) - __expf(s23) + LAMBDA_INIT;
    for (int i = F.gw; i < NBATCH * SEQ; i += F.NGW) {
        const int b = i / SEQ, row = b * SB + CTXL + (i - b * SEQ);
        f32x4 v[8], w[8]; ld_row((const float*)(F.ws + WS_YO) + (size_t)row * DM, F.lane, v); ld_row((const float*)(F.ws + WS_XG) + (size_t)row * DM, F.lane, w);
        const f32x4 g = *(const f32x4*)(fresh(dif_subln) + 4 * F.lane);
#pragma unroll
        for (int j = 0; j < 8; ++j) { v[j] = v[j] - w[j] * lam;
            const float ss = wave_sum((v[j].x * v[j].x + v[j].y * v[j].y) + (v[j].z * v[j].z + v[j].w * v[j].w));
            const float r = (1.0f - LAMBDA_INIT) / sqrtf(ss * (1.0f / 256.0f) + EPS); v[j] = v[j] * r * g; }
        st_row_bf16((bf16*)(F.ws + WS_Y) + (size_t)row * DM, F.lane, v);
    }
}
__device__ __forceinline__ void t_post_attn(Frame& F, int layer, const float* x_in, const float* ctx_in, const float* norm_g, const float* router_w) {
    const float* ng0 = norm_g + (size_t)layer * 4 * DM;
    const float* wr0 = router_w + (size_t)layer * DM * NEXP;
    for (int q = F.tid; q < DM * 4; q += NWAVES * 64) { const int c = q >> 2, eq = q & 3; const int pc = (c & ~15) | ((c >> 2) & 3) | ((c & 3) << 2);
        *(LAS f32x4*)(F.lds + pc * 64 + ((eq ^ ((c >> 4) & 3)) << 4)) = *(const f32x4*)(wr0 + c * 16 + eq * 4); }
    __syncthreads();
    const int rsw = (F.lane >> 2) & 3;
    const LAS unsigned char* wl0 = F.lds + (16 * (F.lane >> 2) + (F.lane & 3)) * 64 + ((0 ^ rsw) << 4);
    const LAS unsigned char* wl1 = F.lds + (16 * (F.lane >> 2) + (F.lane & 3)) * 64 + ((1 ^ rsw) << 4);
    const LAS unsigned char* wl2 = F.lds + (16 * (F.lane >> 2) + (F.lane & 3)) * 64 + ((2 ^ rsw) << 4);
    const LAS unsigned char* wl3 = F.lds + (16 * (F.lane >> 2) + (F.lane & 3)) * 64 + ((3 ^ rsw) << 4);
    for (int row = F.gw; row < NROWS; row += F.NGW) {
        const int b = row / SB, s = row - b * SB;
        if (layer == 1 && s < CTXL) continue;
        const float* ng = fresh(ng0);
        f32x4 y[8], x[8], h[8];
        ld_row((const float*)(F.ws + WS_YO) + (size_t)row * DM, F.lane, y);
        ld_row(layer == 0 ? in_row_ptr(x_in, ctx_in, row) : (const float*)(F.ws + WS_XL) + (size_t)row * DM, F.lane, x);
        const float ry = row_rstd(y);
        const float* ga = mods_ptr(F, layer, row, 2);
#pragma unroll
        for (int j = 0; j < 8; ++j) { const int c = 4 * F.lane + 256 * j; x[j] = x[j] + *(const f32x4*)(ga + c) * (y[j] * ry * *(const f32x4*)(ng + DM + c)); }
        float* xl = (float*)(F.ws + WS_XL) + (size_t)row * DM;
#pragma unroll
        for (int j = 0; j < 8; ++j) *(f32x4*)(xl + 4 * F.lane + 256 * j) = x[j];
        const float rx = row_rstd(x);
        norm_mod(h, x, rx, ng + 2 * DM, mods_ptr(F, layer, row, 4), mods_ptr(F, layer, row, 3), F.lane);
        st_row_bf16((bf16*)(F.ws + WS_H) + (size_t)row * DM, F.lane, h);
        float lg[16];
#pragma unroll
        for (int e = 0; e < 16; ++e) lg[e] = 0.f;
#pragma unroll
        for (int j = 0; j < 8; ++j) {
            asm volatile("" ::: "memory");
#pragma unroll
            for (int i = 0; i < 4; ++i) { const float hv = h[j][i]; const int co = j * 16384 + i * 256;
                const f32x4 w0 = *(const LAS f32x4*)(wl0 + co), w1 = *(const LAS f32x4*)(wl1 + co), w2 = *(const LAS f32x4*)(wl2 + co), w3 = *(const LAS f32x4*)(wl3 + co);
                lg[0] += hv * w0.x; lg[1] += hv * w0.y; lg[2] += hv * w0.z; lg[3] += hv * w0.w; lg[4] += hv * w1.x; lg[5] += hv * w1.y; lg[6] += hv * w1.z; lg[7] += hv * w1.w;
                lg[8] += hv * w2.x; lg[9] += hv * w2.y; lg[10] += hv * w2.z; lg[11] += hv * w2.w; lg[12] += hv * w3.x; lg[13] += hv * w3.y; lg[14] += hv * w3.z; lg[15] += hv * w3.w; } }
        float mx = -1e30f;
#pragma unroll
        for (int e = 0; e < 16; ++e) { lg[e] = wave_sum(lg[e]); mx = fmaxf(mx, lg[e]); }
        float sum = 0.f;
#pragma unroll
        for (int e = 0; e < 16; ++e) { lg[e] = __expf(lg[e] - mx); sum += lg[e]; }
        const float rs = 1.0f / sum;
        float* aff = (float*)(F.ws + WS_AFF) + (size_t)b * NEXP * SB + s;
#pragma unroll
        for (int e = 0; e < 16; ++e) if (F.lane == e) aff[(size_t)e * SB] = lg[e] * rs;
    }
}
template <int VPT>
__device__ __forceinline__ void topk_problem(Frame& F, const float* vals, int N, int cap, int e, int rowbase, int slotbase, bool write_inv) {
    LAS int* hist = (LAS int*)F.lds;
    LAS int* wt = (LAS int*)(F.lds + 1024);
    LAS int* selw = (LAS int*)(F.lds + 1280);
    float v[VPT]; unsigned key[VPT];
#pragma unroll
    for (int k = 0; k < VPT; ++k) { const int i = F.tid * VPT + k; const bool ok = i < N; v[k] = ok ? vals[i] : 0.f; const unsigned u = __builtin_bit_cast(unsigned, v[k]);
        key[k] = ok ? ((u & 0x80000000u) ? ~u : (u | 0x80000000u)) : 0u; }
    unsigned prefix = 0u, maskb = 0u; int need = cap;
    for (int pass = 0; pass < 4; ++pass) {
        const int shift = 24 - 8 * pass;
        if (F.tid < 256) hist[F.tid] = 0;
        __syncthreads();
#pragma unroll
        for (int k = 0; k < VPT; ++k) { const int i = F.tid * VPT + k; if (i < N && (key[k] & maskb) == prefix) __hip_atomic_fetch_add(&hist[(key[k] >> shift) & 255u], 1, __ATOMIC_RELAXED, __HIP_MEMORY_SCOPE_WORKGROUP); }
        __syncthreads();
        if (F.wave == 0) {
            const int l = F.lane; const int h0 = hist[255 - 4 * l], h1 = hist[254 - 4 * l], h2 = hist[253 - 4 * l], h3 = hist[252 - 4 * l];
            const int sm = h0 + h1 + h2 + h3; const int incl = wave_incl_scan(sm, l); const int excl = incl - sm;
            const unsigned long long m = __ballot(incl >= need); const int fl = m ? (__ffsll((long long)m) - 1) : 63;
            if (l == fl) { int c = excl, bin;
                if (c + h0 >= need) bin = 255 - 4 * l; else { c += h0; if (c + h1 >= need) bin = 254 - 4 * l; else { c += h1; if (c + h2 >= need) bin = 253 - 4 * l; else { c += h2; bin = 252 - 4 * l; } } }
                selw[0] = bin; selw[1] = need - c; }
        }
        __syncthreads();
        prefix |= ((unsigned)selw[0]) << shift; maskb |= 0xFFu << shift; need = selw[1];
        __syncthreads();
    }
    int ceq = 0;
#pragma unroll
    for (int k = 0; k < VPT; ++k) { const int i = F.tid * VPT + k; if (i < N && key[k] == prefix) ++ceq; }
    int incl = wave_incl_scan(ceq, F.lane);
    if (F.lane == 63) wt[F.wave] = incl;
    __syncthreads();
    int eqbase = incl - ceq;
    for (int w = 0; w < F.wave; ++w) eqbase += wt[w];
    int csel = 0; bool sel[VPT];
#pragma unroll
    for (int k = 0; k < VPT; ++k) { const int i = F.tid * VPT + k; const bool ok = i < N; const bool eq = ok && key[k] == prefix;
        sel[k] = ok && (key[k] > prefix || (eq && eqbase < need)); if (eq) ++eqbase; if (sel[k]) ++csel; }
    incl = wave_incl_scan(csel, F.lane);
    if (F.lane == 63) wt[8 + F.wave] = incl;
    __syncthreads();
    int sbase = incl - csel;
    for (int w = 0; w < F.wave; ++w) sbase += wt[8 + w];
    int* RL = (int*)(F.ws + WS_RL) + e * EROWS; float* GT = (float*)(F.ws + WS_GATE) + e * EROWS; int* INV = (int*)(F.ws + WS_INV);
#pragma unroll
    for (int k = 0; k < VPT; ++k) { const int i = F.tid * VPT + k;
        if (i < N) { const int grow = rowbase + i;
            if (sel[k]) { const int slot = slotbase + sbase; ++sbase; RL[slot] = grow; GT[slot] = v[k]; if (write_inv) INV[grow * 16 + e] = slot; }
            else if (write_inv) INV[grow * 16 + e] = -1; } }
    __syncthreads();
}
__device__ __forceinline__ void t_topk(Frame& F, int layer) {
    const int nprob = layer == 0 ? 64 : 32;
    for (int p = blockIdx.x; p < nprob; p += F.G) {
        const int kind = p >> 5, q = p & 31, b = q >> 4, e = q & 15;
        const float* aff = (const float*)(F.ws + WS_AFF) + ((size_t)(b * NEXP + e)) * SB;
        if (kind == 0) topk_problem<8>(F, aff + CTXL, SEQ, CAP_L, e, b * SB + CTXL, b * CAP_L, true);
        else           topk_problem<1>(F, aff, CTXL, CAP_C, e, b * SB, 2 * CAP_L + b * CAP_C, true);
    }
}
__device__ __forceinline__ void t_gather(Frame& F, int layer) {
    const int np = layer == 0 ? 1280 : 1024, nvalid = layer == 0 ? 1088 : 1024;
    const int* RL = (const int*)(F.ws + WS_RL);
    for (int i = F.gw; i < NEXP * np; i += F.NGW) {
        const int e = i / np, slot = i - e * np;
        v4u* dst = (v4u*)((bf16*)(F.ws + WS_XG) + ((size_t)(e * EROWS + slot)) * DM) + F.lane;
        if (slot < nvalid) { const int src = RL[e * EROWS + slot]; const v4u* sp = (const v4u*)((const bf16*)(F.ws + WS_H) + (size_t)src * DM) + F.lane;
#pragma unroll
            for (int j = 0; j < 4; ++j) dst[64 * j] = sp[64 * j];
        } else {
#pragma unroll
            for (int j = 0; j < 4; ++j) dst[64 * j] = (v4u){0u, 0u, 0u, 0u};
        }
    }
}
__device__ __forceinline__ void t_post_moe(Frame& F, int layer, const float* norm_g, float* out) {
    const float* ng0 = norm_g + (size_t)layer * 4 * DM;
    const int* INV = (const int*)(F.ws + WS_INV); const float* GT = (const float*)(F.ws + WS_GATE);
    for (int row = F.gw; row < NROWS; row += F.NGW) {
        const int b = row / SB, s = row - b * SB;
        if (layer == 1 && s < CTXL) continue;
        const float* ng = fresh(ng0); const float* ng1 = fresh(norm_g + 4 * DM);
        f32x4 mo[8], x[8];
#pragma unroll
        for (int j = 0; j < 8; ++j) mo[j] = (f32x4){0.f, 0.f, 0.f, 0.f};
        const v4i* ip = (const v4i*)(INV + (size_t)row * 16);
        const v4i i0 = ip[0], i1 = ip[1], i2 = ip[2], i3 = ip[3];
        const int sl[16] = {i0.x, i0.y, i0.z, i0.w, i1.x, i1.y, i1.z, i1.w, i2.x, i2.y, i2.z, i2.w, i3.x, i3.y, i3.z, i3.w};
#pragma unroll
        for (int e = 0; e < 16; ++e) { const int slot = sl[e];
            if (slot >= 0) { const float g = GT[e * EROWS + slot]; const bf16* yp = (const bf16*)(F.ws + WS_YE) + ((size_t)(e * EROWS + slot)) * DM + 4 * F.lane;
#pragma unroll
                for (int j = 0; j < 8; ++j) { const v2u w = *(const v2u*)(yp + 256 * j); mo[j].x += g * bf_lo(w.x); mo[j].y += g * bf_hi(w.x); mo[j].z += g * bf_lo(w.y); mo[j].w += g * bf_hi(w.y); } } }
        ld_row((const float*)(F.ws + WS_XL) + (size_t)row * DM, F.lane, x);
        const float rm = row_rstd(mo);
        const float* gf = mods_ptr(F, layer, row, 5);
#pragma unroll
        for (int j = 0; j < 8; ++j) { const int c = 4 * F.lane + 256 * j; x[j] = x[j] + *(const f32x4*)(gf + c) * (mo[j] * rm * *(const f32x4*)(ng + 3 * DM + c)); }
        if (layer == 0) {
            float* xl = (float*)(F.ws + WS_XL) + (size_t)row * DM;
#pragma unroll
            for (int j = 0; j < 8; ++j) *(f32x4*)(xl + 4 * F.lane + 256 * j) = x[j];
            f32x4 h[8]; const float rx = row_rstd(x);
            norm_mod(h, x, rx, ng1, mods_ptr(F, 1, row, 1), mods_ptr(F, 1, row, 0), F.lane);
            st_row_bf16((bf16*)(F.ws + WS_H) + (size_t)row * DM, F.lane, h);
        } else {
            float* op = out + ((size_t)(b * SEQ + s - CTXL)) * DM;
#pragma unroll
            for (int j = 0; j < 8; ++j) *(f32x4*)(op + 4 * F.lane + 256 * j) = x[j];
        }
    }
}

__device__ __forceinline__ void p_attn0(Frame& F, const float* ab_sink) {
    char* lds = (char*)F.lds;
    const bf16* QKV = (const bf16*)(F.ws + WS_QKV); bf16* Y = (bf16*)(F.ws + WS_Y);
    const int c = blockIdx.x;
    for (int u = c; u < 544; u += F.G) {
        att::Job J; J.kb0 = CTXL; J.mask = 0; J.dq = 0; J.use_sink = 0; J.sink_l2 = 0.f; J.lam = 0.f;
        int b, h, grpB; size_t qrow;
        if (u < 512) {
            const int uu = u & 255, x = uu & 7, i = uu >> 3, grp = x >> 1, idx = (x & 1) * 32 + i;
            b = grp >> 1; const int kv = grp & 1; h = kv * 4 + (idx >> 4); const int qb = idx & 15; grpB = u < 256;
            qrow = (size_t)b * SB + CTXL + qb * 256;
            if (grpB) J.NT = 68;
            else { const int q0 = qb * 256, lo = q0 - 128 < 0 ? 0 : q0 - 128, hiK = q0 + 384 > SEQ ? SEQ : q0 + 384;
                   J.NT = 4 + (hiK - lo) / 64; J.kb0 = CTXL + lo; J.mask = 1; J.dq = lo - q0; }
        } else { const int uu = u - 512; grpB = uu >> 4; b = (uu >> 3) & 1; h = uu & 7; qrow = (size_t)b * SB; J.NT = 4; }
        const int kv = h >> 2;
        if (!grpB) { J.use_sink = 1; J.sink_l2 = ab_sink[h] * 1.4426950408889634f; }
        const int qcol = grpB ? 1536 + h * 128 : h * 128, kcol = grpB ? 2560 + kv * 128 : 1024 + kv * 128, vcol = grpB ? 2816 + kv * 128 : 1280 + kv * 128;
        J.Q = QKV + qrow * NQKV0 + qcol; J.K = QKV + (size_t)b * SB * NQKV0 + kcol; J.V = QKV + (size_t)b * SB * NQKV0 + vcol;
        J.O = (void*)(Y + qrow * DM + (grpB ? 1024 : 0) + h * 128);
        __syncthreads();
        att::attn_unit<NQKV0, 0>(J, lds);
    }
}
__device__ __forceinline__ void p_attn1(Frame& F) {
    char* lds = (char*)F.lds;
    const bf16* QKV = (const bf16*)(F.ws + WS_QKV);
    for (int u = blockIdx.x; u < 1024; u += F.G) {
        const int x = u & 7, i = u >> 3;
        const int b = x >> 2, hp = x & 3, h = hp * 2 + ((i >> 6) & 1), m = (i >> 5) & 1, half = (i >> 4) & 1, qb = i & 15;
        const size_t qrow = (size_t)b * SB + CTXL + qb * 256;
        float* O = (float*)(F.ws + (m ? WS_XG : WS_YO));
        att::Job J; J.kb0 = CTXL; J.mask = 0; J.dq = 0; J.use_sink = 0; J.sink_l2 = 0.f; J.lam = 0.f; J.NT = 68;
        J.V = QKV + (size_t)b * SB * NQKV1 + 4096 + h * 256 + half * 128;
        J.O = (void*)(O + qrow * DM + h * 256 + half * 128);
        J.Q = QKV + qrow * NQKV1 + (2 * h + m) * 128; J.K = QKV + (size_t)b * SB * NQKV1 + 2048 + (2 * h + m) * 128;
        __syncthreads();
        att::attn_unit<NQKV1, 1>(J, lds);
    }
}

#define IN(k) (lo <= (k) && (k) < hi)
#define SEAM(k) do { if (IN((k) + 1)) xcd_barrier(bar); } while (0)
#define INP(k) ({ int k_ = (k); asm volatile("" : "+s"(k_)); (const float*)(const __attribute__((address_space(1))) float*)args.in[k_]; })
#ifndef PROBE_MASK
#define PROBE_MASK 0
#endif
#define PROBED(k) ((k) >= 0 && ((PROBE_MASK >> ((k) < 0 ? 0 : (k))) & 1))
#define REP2(k, ...) do { __VA_ARGS__; if constexpr (PROBED(k)) { __syncthreads(); __VA_ARGS__; } } while (0)
#define REP(k) for (int rep_ = 0; rep_ < (((k) >= 0 && ((PROBE_MASK >> ((k) < 0 ? 0 : (k))) & 1)) ? 2 : 1); ++rep_, __syncthreads())
#define FRESH() do { asm volatile("" : "+s"(F.ws)); int t_ = threadIdx.x; asm volatile("" : "+v"(t_)); F.tid = t_; F.lane = t_ & 63; F.wave = __builtin_amdgcn_readfirstlane(t_ >> 6); \
    F.gw = blockIdx.x * NWAVES + F.wave; } while (0)
template <int layer>
__device__ __forceinline__ void layer_phases(Frame& F, const Args& args, const int lo, const int hi, const XcdBarrier& bar) {

        const int pb = 2 + 11 * layer;
        if (IN(pb + 0)) {
            FRESH();
            pg8::Gemm g{(const pg8::bf16_t*)(F.ws + WS_H), (const pg8::bf16_t*)(F.ws + (layer == 0 ? WS_WIN0 : WS_WIN1)), NROWS, layer == 0 ? NQKV0 : NQKV1, DM};
            pg8::DenseOrder S; S.init(NROWS / 256, (layer == 0 ? NQKV0 : NQKV1) / 256, F.G, (int)blockIdx.x, 0);
            pg8::EpiStoreBf16 E{(pg8::bf16_t*)(F.ws + WS_QKV), layer == 0 ? NQKV0 : NQKV1, 1 << 20};
            pg8::gemm_phase<pg8::EpiStoreBf16, pg8::DenseOrder, true, true>(F.lds, g, S, E);
            SEAM(pb + 0);
        }
        if (IN(pb + 1)) { FRESH(); t_prep(F, layer, INP(10), INP(11)); SEAM(pb + 1); }
        if (IN(pb + 2)) { FRESH(); REP(pb + 2) { if (layer == 0) p_attn0(F, INP(9)); else p_attn1(F); } SEAM(pb + 2); }
        if (IN(pb + 3)) { if (layer == 1) { FRESH(); REP(pb + 3) t_subln(F, INP(14), INP(15)); SEAM(pb + 3); } }
        if (IN(pb + 4)) {
            FRESH();
            pg8::Gemm g{(const pg8::bf16_t*)(F.ws + WS_Y), (const pg8::bf16_t*)(F.ws + (layer == 0 ? WS_WOUT0 : WS_WOUT1)), NROWS, DM, DM};
            pg8::DenseOrder S; S.init(layer == 0 ? 34 : 32, DM / 256, F.G, (int)blockIdx.x, layer);
            pg8::EpiStoreF32 E{(float*)(F.ws + WS_YO), DM};
            pg8::gemm_phase<pg8::EpiStoreF32, pg8::DenseOrder, true, true>(F.lds, g, S, E);
            SEAM(pb + 4);
        }
        if (IN(pb + 5)) { FRESH(); REP(layer == 0 ? pb + 5 : -2) t_post_attn(F, layer, INP(0), INP(2), INP(6), INP(16)); SEAM(pb + 5); }
        if (IN(pb + 6)) { FRESH(); REP(pb + 6) t_topk(F, layer); SEAM(pb + 6); }
        if (IN(pb + 7)) { FRESH(); REP(pb + 7) t_gather(F, layer); SEAM(pb + 7); }
        if (IN(pb + 8)) {
            FRESH();
            pg8::BMoeGU Bm{INP(17) + (size_t)layer * 16 * DM * DM, INP(18) + (size_t)layer * 16 * DM * DM};
            pg8::MoeOrder S; S.init(layer == 0 ? 5 : 4, 16, F.G, (int)blockIdx.x);
            pg8::EpiSwiGLU E{(pg8::bf16_t*)(F.ws + WS_HM), DM};
            REP2(pb + 8, pg8::gemm_phase_w<pg8::EpiSwiGLU, pg8::MoeOrder, pg8::BMoeGU>(F.lds, (const pg8::bf16_t*)(F.ws + WS_XG), DM, Bm, S, E));
            SEAM(pb + 8);
        }
        if (IN(pb + 9)) {
            FRESH();
            pg8::BMoeDn Bm{INP(19) + (size_t)layer * 16 * DM * DM};
            pg8::MoeOrder S; S.init(layer == 0 ? 5 : 4, 8, F.G, (int)blockIdx.x);
            pg8::EpiStoreBf16 E{(pg8::bf16_t*)(F.ws + WS_YE), DM, 8};
            REP2(pb + 9, pg8::gemm_phase_w<pg8::EpiStoreBf16, pg8::MoeOrder, pg8::BMoeDn>(F.lds, (const pg8::bf16_t*)(F.ws + WS_HM), DM, Bm, S, E));
            SEAM(pb + 9);
        }
        if (IN(pb + 10)) { FRESH(); REP(layer == 1 ? pb + 10 : -2) t_post_moe(F, layer, INP(6), args.out); SEAM(pb + 10); }
}
constexpr int NPHASE = 24;
__global__ void __launch_bounds__(NWAVES * 64, 2) fwd(Args args) {
    extern __shared__ __attribute__((aligned(16))) unsigned char lds[];
    Frame F;
    F.lds = (LAS unsigned char*)lds;
    F.tid = threadIdx.x; F.lane = F.tid & 63; F.wave = __builtin_amdgcn_readfirstlane(F.tid >> 6);
    F.G = gridDim.x; F.gw = blockIdx.x * NWAVES + F.wave; F.NGW = F.G * NWAVES;
    F.ws = (__attribute__((address_space(1))) unsigned char*)args.ws;
    volatile LAS unsigned* MISC = (volatile LAS unsigned*)(F.lds + MISC_OFF);
    for (int u = F.tid; u < (LDS_BYTES - LDSCTL_OFF) / 4; u += NWAVES * 64) ((LAS unsigned*)(F.lds + LDSCTL_OFF))[u] = 0u;
    __syncthreads();
    const int lo = args.ph_lo, hi = args.ph_hi;
    const bool multi = (hi - lo) > 1;
    XcdBarrier bar; bar.bar = (unsigned*)(F.ws + WS_CTL) + CW_BAR; bar.x = 0; bar.st = nullptr;
    if (multi) bar = xcd_barrier_post((unsigned*)(F.ws + WS_CTL) + CW_BAR, MISC + 8);

    if (IN(0)) { FRESH(); REP(0) p0_prologue(F, INP(1), INP(3), INP(4), INP(5), INP(7), INP(8), INP(12), INP(13)); SEAM(0); }
    if (IN(1)) { FRESH(); REP(1) t_norm0(F, INP(0), INP(2), INP(6)); SEAM(1); }
    layer_phases<0>(F, args, lo, hi, bar);
    layer_phases<1>(F, args, lo, hi, bar);
}

extern "C" void kernel_launch(void* const* d_in, const int* in_sizes, int n_in, void* d_out, int out_size, void* d_ws, size_t ws_size, hipStream_t stream) {
    static int grid = 0;
    if (grid == 0) {
        if (n_in != 20 || out_size != NBATCH * SEQ * DM || ws_size < WS_END) { fprintf(stderr, "kernel_launch: shape mismatch (n_in %d out %d ws %zu need %zu)\n", n_in, out_size, ws_size, (size_t)WS_END); grid = -1; return; }
        int dev = 0, cus = 0, per_cu = 0;
        if (hipGetDevice(&dev) != hipSuccess || hipDeviceGetAttribute(&cus, hipDeviceAttributeMultiprocessorCount, dev) != hipSuccess) { grid = -1; return; }
        if (hipFuncSetAttribute((const void*)fwd, hipFuncAttributeMaxDynamicSharedMemorySize, LDS_BYTES) != hipSuccess) { fprintf(stderr, "kernel_launch: hipFuncSetAttribute failed\n"); grid = -1; return; }
        if (hipOccupancyMaxActiveBlocksPerMultiprocessor(&per_cu, (const void*)fwd, NWAVES * 64, LDS_BYTES) != hipSuccess || per_cu < 1)
            fprintf(stderr, "kernel_launch: note: occupancy query reports %d workgroups per CU\n", per_cu);
        (void)hipGetLastError();
        grid = cus;
    }
    if (grid < 0) return;
    if (hipMemsetAsync((char*)d_ws + WS_CTL, 0, CTL_ZERO_BYTES, stream) != hipSuccess) return;
    Args a{};
    for (int i = 0; i < 20; ++i) a.in[i] = (const float*)d_in[i];
    a.out = (float*)d_out; a.ws = (unsigned char*)d_ws;
#if MK_ONE_LAUNCH
    a.ph_lo = 0; a.ph_hi = NPHASE;
    hipLaunchKernelGGL(fwd, dim3(grid), dim3(NWAVES * 64), LDS_BYTES, stream, a);
#if defined(PROBE_EXTRA)
    { const int extra[] = {PROBE_EXTRA}; for (int ph : extra) { a.ph_lo = ph; a.ph_hi = ph + 1; hipLaunchKernelGGL(fwd, dim3(grid), dim3(NWAVES * 64), LDS_BYTES, stream, a); } }
#endif
#else
    for (int ph = 0; ph < NPHASE; ++ph) {
        if (ph == 5) continue;
        a.ph_lo = ph; a.ph_hi = ph + 1;
        hipLaunchKernelGGL(fwd, dim3(grid), dim3(NWAVES * 64), LDS_BYTES, stream, a);
    }
#endif
    const hipError_t le = hipPeekAtLastError();
    if (le != hipSuccess) fprintf(stderr, "kernel_launch: launch failed: %s\n", hipGetErrorName(le));
}
```

```cpp
#include <hip/hip_runtime.h>
#include <cstdio>
#include <cstdint>

#ifndef MK_ONE_LAUNCH
#define MK_ONE_LAUNCH 1
#endif

namespace pg8 {
#define PG8_LAS __attribute__((address_space(3)))
typedef unsigned short bf16_t;
typedef short bf16x8 __attribute__((ext_vector_type(8)));
typedef float f32x4 __attribute__((ext_vector_type(4)));
typedef unsigned u32x4 __attribute__((ext_vector_type(4)));
constexpr int BM = 256, BK = 64, HALF = 128, HTB = HALF * BK * 2  , STAGE_BYTES = 8 * HTB, NXCD = 8, WGM = 8;

__host__ __device__ __forceinline__ int lds_byte(int r, int c) { const int st = (r >> 4) * 2 + (c >> 5), rr = r & 15, cc = c & 31, ob = rr * 64 + cc * 2; return st * 1024 + (ob ^ (((ob >> 9) & 1) << 5)); }
__host__ __device__ __forceinline__ void stage_rc(int b, int& R, int& C) { const int st = b / 1024, sb = b % 1024, swz = sb ^ (((sb >> 9) & 1) << 5); R = (st >> 1) * 16 + swz / 64; C = (st & 1) * 32 + (swz % 64) / 2; }
__host__ __device__ __forceinline__ int perm32(int rho) { const int n = rho >> 4, i = rho & 15; return 8 * (i >> 2) + 4 * n + (i & 3); }

struct Unit { int pm, pn, kc; };
struct Gemm { const bf16_t* A; const bf16_t* Bt; int ld, N, K; };

struct StaticOrder {
    int nM, nN, nwg, G, c;
    __host__ __device__ void init(int M, int N, int G_, int c_) { nM = M / BM; nN = N / BM; nwg = nM * nN; G = G_; c = c_; }
    __host__ __device__ bool next(int i, Unit& u) const {
        const long L = (long)i * G + c; if (L >= nwg) return false;
        int wgid = (int)L; { const int q = nwg / NXCD, r = nwg % NXCD, xcd = wgid % NXCD, off = wgid / NXCD; wgid = (xcd < r ? xcd * (q + 1) : r * (q + 1) + (xcd - r) * q) + off; }
        const int nig = WGM * nN, gid = wgid / nig, fm = gid * WGM, gsz = (nM - fm) < WGM ? (nM - fm) : WGM;
        u.pm = fm + ((wgid % nig) % gsz); u.pn = (wgid % nig) / gsz; return true;
    }
    __device__ __forceinline__ void a_ready(const Unit&) const {}
    __device__ __forceinline__ void done(const Unit&) const {}
};

__device__ __forceinline__ unsigned cvt_pk_bf16(float lo, float hi) { unsigned r; asm volatile("v_cvt_pk_bf16_f32 %0, %1, %2" : "=v"(r) : "v"(lo), "v"(hi)); return r; }
struct DenseOrder {
    StaticOrder so; int kind;
    __device__ void init(int nM, int nN, int G_, int c_, int kind_) { so.init(nM * BM, nN * BM, G_, c_); kind = kind_; }
    __device__ bool next(int i, Unit& u) const {
        if (!so.next(i, u)) return false;
        u.kc = 0;
        if (kind == 1) { const int b = u.pm >> 4, j = u.pm & 15; u.pm = 17 * b + 1 + j; }
        return true;
    }
    __device__ __forceinline__ int krot(const Unit& u) const { return (u.pm & 3) * 8; }
    __device__ __forceinline__ void a_ready(const Unit&) const {}
    __device__ __forceinline__ void done(const Unit&) const {}
};
struct CtxSplitOrder {
    int c;
    __device__ bool next(int i, Unit& u) const { if (i != 0 || c >= 64) return false; u.pm = 17 * (c >> 5); u.pn = (c >> 2) & 7; u.kc = c & 3; return true; }
    __device__ __forceinline__ void a_ready(const Unit&) const {}
    __device__ __forceinline__ void done(const Unit&) const {}
};
struct MoeOrder {
    int NP, NJ, nU, G, c;
    __device__ void init(int NP_, int NJ_, int G_, int c_) { NP = NP_; NJ = NJ_; nU = 16 * NP_ * NJ_; G = G_; c = c_; }
    __device__ bool next(int i, Unit& u) const {
        const int L = i * G + c; if (L >= nU) return false;
        const int xcd = L & 7, off = L >> 3, id = xcd * (nU >> 3) + off;
        const int per = NJ * NP, e = id / per, rem = id - e * per, j = rem / NP, p = rem - j * NP;
        u.pm = 5 * e + p; u.pn = NJ * e + j; u.kc = 0; return true;
    }
    __device__ __forceinline__ int krot(const Unit& u) const { const int p = u.pm % 5; return NP == 4 ? p * 8 : p * 6; }
    __device__ __forceinline__ void a_ready(const Unit&) const {}
    __device__ __forceinline__ void done(const Unit&) const {}
};

typedef __amdgpu_buffer_rsrc_t rsrc_t;
__device__ __forceinline__ rsrc_t wt_rsrc(void* base) { return __builtin_amdgcn_make_buffer_rsrc(base, 0, 0x7fffffff, 0x00020000); }
__device__ __forceinline__ void st16_wt(rsrc_t r, unsigned byteoff, u32x4 v) { __builtin_amdgcn_raw_buffer_store_b128(v, r, (int)byteoff, 0, 0); }
struct EpiStoreBf16 {
    static constexpr bool PERM = true, AFTER_DRAIN = false;
    bf16_t* O; int ldc; int nmod;
    __device__ __forceinline__ void operator()(const f32x4 (&acc)[2][2][4][2], const Unit& u, int wr, int wc, int fr, int fq) const {
        const int row0 = u.pm * BM + wr * 64 + fr, col0 = (u.pn % nmod) * BM + wc * 32 + 8 * fq;
        const rsrc_t rs = wt_rsrc(O);
#pragma unroll
        for (int ai = 0; ai < 2; ++ai)
#pragma unroll
            for (int m = 0; m < 4; ++m) { const unsigned ro = (unsigned)(((size_t)(row0 + ai * HALF + m * 16) * ldc + col0) * 2);
#pragma unroll
                for (int bj = 0; bj < 2; ++bj) { const f32x4 v0 = acc[ai][bj][m][0], v1 = acc[ai][bj][m][1];
                    u32x4 w; w.x = cvt_pk_bf16(v0[0], v0[1]); w.y = cvt_pk_bf16(v0[2], v0[3]); w.z = cvt_pk_bf16(v1[0], v1[1]); w.w = cvt_pk_bf16(v1[2], v1[3]);
                    st16_wt(rs, ro + bj * HALF * 2, w); } }
    }
};
struct EpiStoreF32 {
    static constexpr bool PERM = true, AFTER_DRAIN = false;
    float* O; int ldc;
    __device__ __forceinline__ void operator()(const f32x4 (&acc)[2][2][4][2], const Unit& u, int wr, int wc, int fr, int fq) const {
        const int row0 = u.pm * BM + wr * 64 + fr, col0 = u.pn * BM + wc * 32 + 8 * fq;
#pragma unroll
        for (int ai = 0; ai < 2; ++ai)
#pragma unroll
            for (int m = 0; m < 4; ++m) { float* rowp = O + (size_t)(row0 + ai * HALF + m * 16) * ldc + col0;
#pragma unroll
                for (int bj = 0; bj < 2; ++bj) { *(f32x4*)(rowp + bj * HALF) = acc[ai][bj][m][0]; *(f32x4*)(rowp + bj * HALF + 4) = acc[ai][bj][m][1]; } }
    }
};
struct EpiPartF32 {
    static constexpr bool PERM = true, AFTER_DRAIN = false;
    float* O; int ldc;
    __device__ __forceinline__ void operator()(const f32x4 (&acc)[2][2][4][2], const Unit& u, int wr, int wc, int fr, int fq) const {
        const int row0 = (u.pm / 17) * BM + wr * 64 + fr, col0 = u.pn * BM + wc * 32 + 8 * fq; float* Ob = O + (size_t)u.kc * 512 * ldc;
#pragma unroll
        for (int ai = 0; ai < 2; ++ai)
#pragma unroll
            for (int m = 0; m < 4; ++m) { float* rowp = Ob + (size_t)(row0 + ai * HALF + m * 16) * ldc + col0;
#pragma unroll
                for (int bj = 0; bj < 2; ++bj) { *(f32x4*)(rowp + bj * HALF) = acc[ai][bj][m][0]; *(f32x4*)(rowp + bj * HALF + 4) = acc[ai][bj][m][1]; } }
    }
};
__device__ __forceinline__ float silu_f(float g) { return g * __builtin_amdgcn_rcpf(1.0f + __builtin_amdgcn_exp2f(-1.4426950408889634f * g)); }
struct EpiSwiGLU {
    static constexpr bool PERM = true, AFTER_DRAIN = false;
    bf16_t* O; int ldc;
    __device__ __forceinline__ void operator()(const f32x4 (&acc)[2][2][4][2], const Unit& u, int wr, int wc, int fr, int fq) const {
        const int row0 = u.pm * BM + wr * 64 + fr, col0 = (u.pn & 15) * HALF + wc * 32 + 8 * fq;
        const rsrc_t rs = wt_rsrc(O);
#pragma unroll
        for (int ai = 0; ai < 2; ++ai)
#pragma unroll
            for (int m = 0; m < 4; ++m) { const unsigned ro = (unsigned)(((size_t)(row0 + ai * HALF + m * 16) * ldc + col0) * 2);
                const f32x4 g0 = acc[ai][0][m][0], g1 = acc[ai][0][m][1], u0 = acc[ai][1][m][0], u1 = acc[ai][1][m][1];
                u32x4 w;
                w.x = cvt_pk_bf16(silu_f(g0[0]) * u0[0], silu_f(g0[1]) * u0[1]); w.y = cvt_pk_bf16(silu_f(g0[2]) * u0[2], silu_f(g0[3]) * u0[3]);
                w.z = cvt_pk_bf16(silu_f(g1[0]) * u1[0], silu_f(g1[1]) * u1[1]); w.w = cvt_pk_bf16(silu_f(g1[2]) * u1[2], silu_f(g1[3]) * u1[3]);
                st16_wt(rs, ro, w); }
    }
};

template <class Epi, class Sched, bool ALIGN_EPI = false, bool SP2 = false>
__device__ __forceinline__ void gemm_phase(PG8_LAS unsigned char* lds, const Gemm g, const Sched& S, const Epi& E) {
    const int tid = threadIdx.x, wid = __builtin_amdgcn_readfirstlane(tid >> 6), lane = tid & 63, wr = wid >> 2, wc = wid & 3, fr = lane & 15, fq = lane >> 4;
    const int K = g.K, nt = K / BK;
    unsigned voffA[2], voffB[2];
#pragma unroll
    for (int i = 0; i < 2; ++i) { int R, C; stage_rc(tid * 16 + i * 8192, R, C); const int Rb = Epi::PERM ? ((R & ~31) + perm32(R & 31)) : R;
        voffA[i] = (unsigned)(R * g.ld + C) * 2u; voffB[i] = (unsigned)(Rb * g.ld + C) * 2u; }
    const size_t kstep = (size_t)(BK * 2);
    const size_t hstep = (size_t)HALF * g.ld * 2;
    const size_t tstep = 2 * hstep;
    const unsigned ldsw = (unsigned)wid * 1024u;
    const int aoff = lds_byte(wr * 64 + fr, fq * 8), boff = lds_byte(wc * 32 + fr, fq * 8);
#define PG8_SA(b, h) (((b) * 2 + (h)) * HTB)
#define PG8_SB(b, h) ((4 + (b) * 2 + (h)) * HTB)
#define PG8_STAGE(bufoff, gbase, voff) do { _Pragma("unroll") for (int _i = 0; _i < 2; ++_i) \
        __builtin_amdgcn_global_load_lds((const unsigned*)((const char*)(gbase) + (voff)[_i]), (PG8_LAS unsigned*)(lds + (bufoff) + ldsw + _i * 8192), 16, 0, 0); } while (0)
#define PG8_LDA(dst, b, h) do { _Pragma("unroll") for (int m = 0; m < 4; ++m) _Pragma("unroll") for (int k = 0; k < 2; ++k) dst[m][k] = *(const PG8_LAS bf16x8*)(lds + PG8_SA(b, h) + aoff + m * 2048 + k * 1024); } while (0)
#define PG8_LDB(dst, b, h) do { _Pragma("unroll") for (int n = 0; n < 2; ++n) _Pragma("unroll") for (int k = 0; k < 2; ++k) dst[n][k] = *(const PG8_LAS bf16x8*)(lds + PG8_SB(b, h) + boff + n * 2048 + k * 1024); } while (0)
#define PG8_MMA(ai, bj, At, Bt) do { __builtin_amdgcn_s_setprio(1); _Pragma("unroll") for (int m = 0; m < 4; ++m) _Pragma("unroll") for (int n = 0; n < 2; ++n) _Pragma("unroll") for (int k = 0; k < 2; ++k) \
        acc[ai][bj][m][n] = __builtin_amdgcn_mfma_f32_16x16x32_bf16(Bt[n][k], At[m][k], acc[ai][bj][m][n], 0, 0, 0); __builtin_amdgcn_s_setprio(0); } while (0)
#define PG8_WAIT_V(n) asm volatile("s_waitcnt vmcnt(" #n ")" ::: "memory")
#define PG8_WAIT_L(n) asm volatile("s_waitcnt lgkmcnt(" #n ")" ::: "memory")
#define PG8_BAR __builtin_amdgcn_s_barrier()
#define PG8_SCHED __builtin_amdgcn_sched_barrier(0)
    Unit cur, nxt; int ui = 0;
    if (!S.next(0, cur)) return;
    f32x4 acc[2][2][4][2];
#pragma unroll
    for (int a = 0; a < 2; ++a)
#pragma unroll
        for (int b = 0; b < 2; ++b)
#pragma unroll
            for (int m = 0; m < 4; ++m)
#pragma unroll
                for (int n = 0; n < 2; ++n) acc[a][b][m][n] = (f32x4){0.f, 0.f, 0.f, 0.f};
    bf16x8 At[4][2], B0[2][2], B1[2][2];
    const char* cA = (const char*)g.A + (size_t)cur.pm * tstep + (size_t)cur.kc * K * 2; const char* cB = (const char*)g.Bt + (size_t)cur.pn * tstep + (size_t)cur.kc * K * 2;
    S.a_ready(cur);
    if constexpr (SP2) {
        PG8_STAGE(PG8_SB(0, 0), cB, voffB); PG8_STAGE(PG8_SB(0, 1), cB + hstep, voffB); PG8_STAGE(PG8_SA(0, 0), cA, voffA); PG8_STAGE(PG8_SA(0, 1), cA + hstep, voffA);
        if (wr == 1) PG8_BAR;
        PG8_WAIT_V(2); PG8_BAR;
        PG8_STAGE(PG8_SB(1, 0), cB + kstep, voffB); PG8_STAGE(PG8_SA(1, 0), cA + kstep, voffA); PG8_STAGE(PG8_SB(1, 1), cB + hstep + kstep, voffB);
        PG8_WAIT_V(6); PG8_BAR;
    } else {
        PG8_STAGE(PG8_SB(0, 0), cB, voffB); PG8_STAGE(PG8_SA(0, 0), cA, voffA); PG8_STAGE(PG8_SB(0, 1), cB + hstep, voffB); PG8_STAGE(PG8_SA(0, 1), cA + hstep, voffA);
        if (wr == 1) PG8_BAR;
        PG8_WAIT_V(4); PG8_BAR;
        PG8_STAGE(PG8_SB(1, 0), cB + kstep, voffB); PG8_STAGE(PG8_SA(1, 0), cA + kstep, voffA); PG8_STAGE(PG8_SB(1, 1), cB + hstep + kstep, voffB);
        PG8_WAIT_V(6); PG8_BAR;
    }
    for (;;) {
        const bool has_next = S.next(ui + 1, nxt);
        const char* nA = has_next ? (const char*)g.A + (size_t)nxt.pm * tstep + (size_t)nxt.kc * K * 2 : cA; const char* nB = has_next ? (const char*)g.Bt + (size_t)nxt.pn * tstep + (size_t)nxt.kc * K * 2 : cB;
        for (int t = 0; t < nt; t += 2) {
            const bool last = (t == nt - 2);
            const char* a1 = cA + (size_t)(t + 1) * kstep;
            const char* a2 = last ? nA : cA + (size_t)(t + 2) * kstep; const char* b2 = last ? nB : cB + (size_t)(t + 2) * kstep;
            const char* a3 = a2 + kstep; const char* b3 = b2 + kstep;
            if (last && has_next) S.a_ready(nxt);
            if constexpr (SP2) {
            PG8_LDB(B0, 0, 0); PG8_LDB(B1, 0, 1); PG8_SCHED; PG8_LDA(At, 0, 0); PG8_STAGE(PG8_SA(1, 1), a1 + hstep, voffA);
            PG8_WAIT_V(8); PG8_WAIT_L(0); PG8_BAR; PG8_MMA(0, 0, At, B0); PG8_MMA(0, 1, At, B1); PG8_BAR; PG8_SCHED;
            PG8_LDA(At, 0, 1); PG8_STAGE(PG8_SB(0, 0), b2, voffB); PG8_STAGE(PG8_SB(0, 1), b2 + hstep, voffB); PG8_STAGE(PG8_SA(0, 0), a2, voffA);
            PG8_WAIT_V(8); PG8_WAIT_L(0); PG8_BAR; PG8_MMA(1, 0, At, B0); PG8_MMA(1, 1, At, B1); PG8_BAR; PG8_SCHED;
            PG8_LDB(B0, 1, 0); PG8_LDB(B1, 1, 1); PG8_SCHED; PG8_LDA(At, 1, 0); PG8_STAGE(PG8_SA(0, 1), a2 + hstep, voffA);
            PG8_WAIT_V(8); PG8_WAIT_L(0); PG8_BAR; PG8_MMA(0, 0, At, B0); PG8_MMA(0, 1, At, B1); PG8_BAR; PG8_SCHED;
            PG8_LDA(At, 1, 1); PG8_STAGE(PG8_SB(1, 0), b3, voffB); PG8_STAGE(PG8_SB(1, 1), b3 + hstep, voffB); PG8_STAGE(PG8_SA(1, 0), a3, voffA);
            PG8_WAIT_V(8); PG8_WAIT_L(0); PG8_BAR; PG8_MMA(1, 0, At, B0); PG8_MMA(1, 1, At, B1); PG8_BAR; PG8_SCHED;
            } else {
            PG8_LDB(B0, 0, 0); PG8_SCHED; PG8_LDA(At, 0, 0); PG8_STAGE(PG8_SA(1, 1), a1 + hstep, voffA);
            PG8_WAIT_L(8); PG8_BAR; PG8_WAIT_L(0); PG8_MMA(0, 0, At, B0); PG8_BAR; PG8_SCHED;
            PG8_LDB(B1, 0, 1); PG8_STAGE(PG8_SB(0, 0), b2, voffB);
            PG8_BAR; PG8_WAIT_L(0); PG8_MMA(0, 1, At, B1); PG8_BAR;
            PG8_LDA(At, 0, 1); PG8_STAGE(PG8_SA(0, 0), a2, voffA);
            PG8_BAR; PG8_WAIT_L(0); PG8_MMA(1, 0, At, B0); PG8_BAR; PG8_SCHED;
            PG8_STAGE(PG8_SB(0, 1), b2 + hstep, voffB);
            PG8_WAIT_V(6); PG8_BAR; PG8_MMA(1, 1, At, B1); PG8_BAR;
            PG8_LDB(B0, 1, 0); PG8_SCHED; PG8_LDA(At, 1, 0); PG8_STAGE(PG8_SA(0, 1), a2 + hstep, voffA);
            PG8_WAIT_L(8); PG8_BAR; PG8_WAIT_L(0); PG8_MMA(0, 0, At, B0); PG8_BAR; PG8_SCHED;
            PG8_LDB(B1, 1, 1); PG8_STAGE(PG8_SB(1, 0), b3, voffB);
            PG8_BAR; PG8_WAIT_L(0); PG8_MMA(0, 1, At, B1); PG8_BAR;
            PG8_LDA(At, 1, 1); PG8_STAGE(PG8_SA(1, 0), a3, voffA);
            PG8_BAR; PG8_WAIT_L(0); PG8_MMA(1, 0, At, B0); PG8_BAR; PG8_SCHED;
            PG8_STAGE(PG8_SB(1, 1), b3 + hstep, voffB);
            PG8_WAIT_V(6); PG8_BAR; PG8_MMA(1, 1, At, B1); PG8_BAR;
            }
        }
        if constexpr (ALIGN_EPI) { if (wr == 0) PG8_BAR; }
        if constexpr (!Epi::AFTER_DRAIN) { E(acc, cur, wr, wc, fr, fq); S.done(cur); }
        if (!has_next) break;
#pragma unroll
        for (int a = 0; a < 2; ++a)
#pragma unroll
            for (int b = 0; b < 2; ++b)
#pragma unroll
                for (int m = 0; m < 4; ++m)
#pragma unroll
                    for (int n = 0; n < 2; ++n) acc[a][b][m][n] = (f32x4){0.f, 0.f, 0.f, 0.f};
        cur = nxt; cA = nA; cB = nB; ++ui;
        if constexpr (ALIGN_EPI) { if (wr == 1) PG8_BAR; }
    }
    PG8_WAIT_V(0);
    if constexpr (!ALIGN_EPI) { if (wr == 0) PG8_BAR; }
    PG8_BAR;
    if constexpr (Epi::AFTER_DRAIN) { E.fused(acc, cur, wr, wc, fr, fq, lds, wid, lane); S.done(cur); }
#undef PG8_SA
#undef PG8_SB
#undef PG8_STAGE
#undef PG8_LDA
#undef PG8_LDB
#undef PG8_MMA
#undef PG8_WAIT_V
#undef PG8_WAIT_L
#undef PG8_BAR
#undef PG8_SCHED
}
#ifndef PG8_KROT
#define PG8_KROT 0
#endif
#ifndef PG8_PF_DIST
#define PG8_PF_DIST 0
#endif
template <int LDW_> struct BDense { static constexpr int LDW = LDW_; const float* W; __device__ __forceinline__ void ptrs(const Unit& u, const float*& b0, const float*& b1) const { b0 = W + (size_t)u.pn * 256; b1 = b0 + 128; } };
struct BMoeGU { static constexpr int LDW = 2048; const float* G; const float* U; __device__ __forceinline__ void ptrs(const Unit& u, const float*& b0, const float*& b1) const {
    const size_t o = (size_t)(u.pn >> 4) * 2048 * 2048 + (size_t)(u.pn & 15) * 128; b0 = G + o; b1 = U + o; } };
struct BMoeDn { static constexpr int LDW = 2048; const float* W; __device__ __forceinline__ void ptrs(const Unit& u, const float*& b0, const float*& b1) const {
    b0 = W + (size_t)(u.pn >> 3) * 2048 * 2048 + (size_t)(u.pn & 7) * 256; b1 = b0 + 128; } };
typedef float f32x2 __attribute__((ext_vector_type(2)));
typedef unsigned u32x2 __attribute__((ext_vector_type(2)));
typedef __bf16 bf16x2_t __attribute__((ext_vector_type(2)));
__device__ __forceinline__ unsigned cvt_pk_c(float lo, float hi) { f32x2 v = {lo, hi}; bf16x2_t b = __builtin_convertvector(v, bf16x2_t); return __builtin_bit_cast(unsigned, b); }

template <class Epi, class Sched, class BMap, bool GATHER = false, bool ALIGN_EPI = true>
__device__ __forceinline__ void gemm_phase_w(PG8_LAS unsigned char* lds, const bf16_t* Ag, const int K, const BMap BM_, const Sched& S, const Epi& E, const int* RLg = nullptr, const int nvalid = 0) {
    static_assert(Epi::PERM && !Epi::AFTER_DRAIN, "gemm_phase_w: PERM epilogues only");
    const int tid = threadIdx.x, wid = __builtin_amdgcn_readfirstlane(tid >> 6), lane = tid & 63, wr = wid >> 2, wc = wid & 3, fr = lane & 15, fq = lane >> 4;
    const int nt = K / BK;
    unsigned voffA[2][2];
    const size_t kstep = (size_t)(BK * 2);
    const size_t hstep = GATHER ? (size_t)0 : (size_t)HALF * K * 2;
    const size_t tstep = GATHER ? (size_t)0 : (size_t)HALF * K * 4;
    int gR0, gC0; stage_rc(tid * 16, gR0, gC0);
    if constexpr (GATHER) {
        PG8_LAS unsigned* tab = (PG8_LAS unsigned*)(lds + 8 * HTB);
        const __attribute__((address_space(1))) int* rl = (const __attribute__((address_space(1))) int*)RLg;
        Unit u_;
        for (int i = 0; S.next(i, u_); ++i)
            if (tid < 256) { const int e_ = u_.pm / 5, slot_ = (u_.pm - 5 * e_) * 256 + tid; tab[i * 256 + tid] = (slot_ < nvalid ? (unsigned)rl[e_ * 1280 + slot_] : 0u) * (unsigned)(K * 2); }
        __syncthreads();
#pragma unroll
        for (int h = 0; h < 2; ++h)
#pragma unroll
            for (int i = 0; i < 2; ++i) voffA[h][i] = tab[gR0 + 64 * i + 128 * h] + (unsigned)(gC0 * 2);
    } else {
#pragma unroll
        for (int i = 0; i < 2; ++i) { voffA[0][i] = (unsigned)((gR0 + 64 * i) * K + gC0) * 2u; voffA[1][i] = voffA[0][i]; }
    }
    const unsigned ldsw = (unsigned)wid * 1024u;
    const int aoff = lds_byte(wr * 64 + fr, fq * 8), boff = lds_byte(wc * 32 + fr, fq * 8);
    constexpr int ldw = BMap::LDW;
    const int bh = wid >> 2, cb = (wid >> 1) & 1, kh = wid & 1, bq = lane & 15, bch = lane >> 4;
    const unsigned blane = (unsigned)(bch * 8 * ldw + 4 * bq) * 4u;
    const size_t bkt = (size_t)BK * ldw;
    const int bslab = 64 * cb + 32 * kh * ldw;
    const int rho0 = 32 * (2 * cb + (bq >> 3)) + 16 * (bq & 1) + 4 * ((bq & 7) >> 1), bs = (bq & 1);
    const bool rot1 = (bs & 1) != 0;
    constexpr int PFD = PG8_PF_DIST;
    const unsigned pfv = (unsigned)((16 * (wid & 3) + 4 * (lane >> 4)) * ldw * 4 + ((lane >> 2) & 3) * 128);
    unsigned pfd = 0u;
    unsigned wadr[4];
#pragma unroll
    for (int j = 0; j < 4; ++j) wadr[j] = (unsigned)(uintptr_t)lds + (unsigned)(4 * HTB + bh * HTB + lds_byte(rho0 + ((j + bs) & 3), 32 * kh + 8 * bch));
#define PG8_SA(b, h) (((b) * 2 + (h)) * HTB)
#define PG8_SB(b, h) ((4 + (b) * 2 + (h)) * HTB)
#define PG8_STAGE(bufoff, gbase, voff) do { _Pragma("unroll") for (int _i = 0; _i < 2; ++_i) \
        __builtin_amdgcn_global_load_lds((const unsigned*)((const char*)(gbase) + (voff)[_i]), (PG8_LAS unsigned*)(lds + (bufoff) + ldsw + _i * 8192), 16, 0, 0); } while (0)
#define PG8_LDA(dst, b, h) do { _Pragma("unroll") for (int m = 0; m < 4; ++m) _Pragma("unroll") for (int k = 0; k < 2; ++k) dst[m][k] = *(const PG8_LAS bf16x8*)(lds + PG8_SA(b, h) + aoff + m * 2048 + k * 1024); } while (0)
#define PG8_LDB(dst, b, h) do { _Pragma("unroll") for (int n = 0; n < 2; ++n) _Pragma("unroll") for (int k = 0; k < 2; ++k) dst[n][k] = *(const PG8_LAS bf16x8*)(lds + PG8_SB(b, h) + boff + n * 2048 + k * 1024); } while (0)
#define PG8_MMA(ai, bj, At, Bt) do { __builtin_amdgcn_s_setprio(1); _Pragma("unroll") for (int m = 0; m < 4; ++m) _Pragma("unroll") for (int n = 0; n < 2; ++n) _Pragma("unroll") for (int k = 0; k < 2; ++k) \
        acc[ai][bj][m][n] = __builtin_amdgcn_mfma_f32_16x16x32_bf16(Bt[n][k], At[m][k], acc[ai][bj][m][n], 0, 0, 0); __builtin_amdgcn_s_setprio(0); } while (0)
#define PG8_WAIT_V(n) asm volatile("s_waitcnt vmcnt(" #n ")" ::: "memory")
#if PG8_PF_DIST > 0
#define PG8_WAIT_VA PG8_WAIT_V(13)
#define PG8_WAIT_VB PG8_WAIT_V(5)
#define PG8_WAIT_VC PG8_WAIT_V(14)
#else
#define PG8_WAIT_VA PG8_WAIT_V(12)
#define PG8_WAIT_VB PG8_WAIT_V(8)
#define PG8_WAIT_VC PG8_WAIT_V(12)
#endif
#define PG8_WAIT_L(n) asm volatile("s_waitcnt lgkmcnt(" #n ")" ::: "memory")
#define PG8_BAR __builtin_amdgcn_s_barrier()
#define PG8_SCHED __builtin_amdgcn_sched_barrier(0)
#define PG8_GAS __attribute__((address_space(1)))
#define PG8_BLOADH(R, sb, K0) do { const PG8_GAS char* sb_ = (const PG8_GAS char*)(sb); _Pragma("unroll") for (int kk = 0; kk < 4; ++kk) { \
        const PG8_GAS char* p_ = sb_ + (size_t)(((K0) + kk) * ldw * 4); asm volatile("global_load_dwordx4 %0, %1, %2" : "=v"(R[kk]) : "v"(blane), "s"(p_) : "memory"); } } while (0)
#define PG8_BWRITEH(R, b, HOFF) do { u32x2 d_[4]; _Pragma("unroll") for (int i = 0; i < 4; ++i) { d_[i].x = cvt_pk_bf16(R[0][i], R[1][i]); d_[i].y = cvt_pk_bf16(R[2][i], R[3][i]); } \
        _Pragma("unroll") for (int j = 0; j < 4; ++j) { const u32x2 a_ = d_[j], b_ = d_[(j + 1) & 3]; u32x2 t_; t_.x = rot1 ? b_.x : a_.x; t_.y = rot1 ? b_.y : a_.y; \
            asm volatile("ds_write_b64 %0, %1 offset:%2" :: "v"(wadr[j]), "v"(t_), "i"((b) * 2 * HTB + (HOFF)) : "memory"); } } while (0)
#define PG8_PF(p) do { if constexpr (PFD > 0) { const PG8_GAS char* q_ = (p); asm volatile("global_load_dword %0, %1, %2" : "+v"(pfd) : "v"(pfv), "s"(q_) : "memory"); } } while (0)
    Unit cur, nxt; int ui = 0;
    if (!S.next(0, cur)) return;
    for (int d_ = 0; d_ < (int)((blockIdx.x >> 5) & 7); ++d_) __builtin_amdgcn_s_sleep(8);
    f32x4 acc[2][2][4][2];
#pragma unroll
    for (int a = 0; a < 2; ++a)
#pragma unroll
        for (int b = 0; b < 2; ++b)
#pragma unroll
            for (int m = 0; m < 4; ++m)
#pragma unroll
                for (int n = 0; n < 2; ++n) acc[a][b][m][n] = (f32x4){0.f, 0.f, 0.f, 0.f};
    bf16x8 At[4][2], B0[2][2], B1[2][2];
    f32x4 bx[4], by[4];
    const char* cA = (const char*)Ag + (size_t)cur.pm * tstep;
    const float* cB; const PG8_GAS char* cP; { const float *b0, *b1; BM_.ptrs(cur, b0, b1); cB = (bh ? b1 : b0) + bslab; cP = (const PG8_GAS char*)(bh ? b1 : b0) + (size_t)((cur.pm & 3) * ldw * 4); }
    int crot = PG8_KROT ? S.krot(cur) : 0;
#define PG8_KT(i, rot) (((i) + (rot)) & (nt - 1))
    S.a_ready(cur);
    PG8_STAGE(PG8_SA(0, 0), cA + (size_t)PG8_KT(0, crot) * kstep, voffA[0]); PG8_STAGE(PG8_SA(0, 1), cA + (size_t)PG8_KT(0, crot) * kstep + hstep, voffA[GATHER ? 1 : 0]);
    PG8_BLOADH(bx, cB + (size_t)PG8_KT(0, crot) * bkt, 0); PG8_BLOADH(by, cB + (size_t)PG8_KT(0, crot) * bkt, 4);
    PG8_WAIT_V(0); PG8_BWRITEH(bx, 0, 0); PG8_BWRITEH(by, 0, 8);
    PG8_BLOADH(bx, cB + (size_t)PG8_KT(1, crot) * bkt, 0); PG8_BLOADH(by, cB + (size_t)PG8_KT(1, crot) * bkt, 4);
    PG8_STAGE(PG8_SA(1, 0), cA + (size_t)PG8_KT(1, crot) * kstep, voffA[0]);
    PG8_WAIT_V(0); PG8_WAIT_L(0);
    if (wr == 1) PG8_BAR;
    PG8_BAR;
    PG8_BAR;
    for (;;) {
        const bool has_next = S.next(ui + 1, nxt);
        const char* nA = has_next ? (const char*)Ag + (size_t)nxt.pm * tstep : cA;
        const int nrot = (has_next && PG8_KROT) ? S.krot(nxt) : crot;
        const float* nB = cB; const PG8_GAS char* nP = cP; if (has_next) { const float *b0, *b1; BM_.ptrs(nxt, b0, b1); nB = (bh ? b1 : b0) + bslab; nP = (const PG8_GAS char*)(bh ? b1 : b0) + (size_t)((nxt.pm & 3) * ldw * 4); }
        for (int t = 0; t < nt; t += 2) {
            const bool last = (t == nt - 2);
            const int k1 = PG8_KT(t + 1, crot), k2 = last ? PG8_KT(0, nrot) : PG8_KT(t + 2, crot), k3 = last ? PG8_KT(1, nrot) : PG8_KT(t + 3, crot);
            const char* a1 = cA + (size_t)k1 * kstep;
            const char* a2 = (last ? nA : cA) + (size_t)k2 * kstep;
            const char* a3 = (last ? nA : cA) + (size_t)k3 * kstep;
            const float* b2 = (last ? nB : cB) + (size_t)k2 * bkt;
            const float* b3 = (last ? nB : cB) + (size_t)k3 * bkt;
            const int i2 = t + 2 + PFD, i3 = i2 + 1;
            const PG8_GAS char* pf2 = i2 < nt ? cP + (size_t)i2 * (bkt * 4) : nP + (size_t)(i2 - nt) * (bkt * 4);
            const PG8_GAS char* pf3 = i3 < nt ? cP + (size_t)i3 * (bkt * 4) : nP + (size_t)(i3 - nt) * (bkt * 4);
            if (last && has_next) S.a_ready(nxt);
            PG8_LDB(B0, 0, 0); PG8_LDB(B1, 0, 1); PG8_SCHED; PG8_LDA(At, 0, 0); PG8_WAIT_VB; PG8_BWRITEH(bx, 1, 0); PG8_BLOADH(bx, b2, 0); PG8_STAGE(PG8_SA(1, 1), a1 + hstep, voffA[GATHER ? 1 : 0]);
            PG8_WAIT_VA; PG8_WAIT_L(0); PG8_BAR; PG8_MMA(0, 0, At, B0); PG8_MMA(0, 1, At, B1); PG8_BAR; PG8_SCHED;
            if constexpr (GATHER) { if (last && has_next) {
                const unsigned ta_ = (unsigned)(uintptr_t)lds + (unsigned)(8 * HTB + (ui + 1) * 1024 + gR0 * 4);
                asm volatile("ds_read_b32 %0, %1" : "=v"(voffA[0][0]) : "v"(ta_) : "memory");
                asm volatile("ds_read_b32 %0, %1 offset:256" : "=v"(voffA[0][1]) : "v"(ta_) : "memory");
                asm volatile("ds_read_b32 %0, %1 offset:512" : "=v"(voffA[1][0]) : "v"(ta_) : "memory");
                asm volatile("ds_read_b32 %0, %1 offset:768" : "=v"(voffA[1][1]) : "v"(ta_) : "memory");
                asm volatile("s_waitcnt lgkmcnt(0)" : "+v"(voffA[0][0]), "+v"(voffA[0][1]), "+v"(voffA[1][0]), "+v"(voffA[1][1]) :: "memory");
#pragma unroll
                for (int h = 0; h < 2; ++h)
#pragma unroll
                    for (int i = 0; i < 2; ++i) voffA[h][i] += (unsigned)(gC0 * 2);
            } }
            PG8_LDA(At, 0, 1); PG8_WAIT_VB; PG8_BWRITEH(by, 1, 8); PG8_BLOADH(by, b2, 4); PG8_STAGE(PG8_SA(0, 0), a2, voffA[0]); PG8_PF(pf2);
            PG8_WAIT_VC; PG8_WAIT_L(0); PG8_BAR; PG8_MMA(1, 0, At, B0); PG8_MMA(1, 1, At, B1); PG8_BAR; PG8_SCHED;
            PG8_LDB(B0, 1, 0); PG8_LDB(B1, 1, 1); PG8_SCHED; PG8_LDA(At, 1, 0); PG8_WAIT_VB; PG8_BWRITEH(bx, 0, 0); PG8_BLOADH(bx, b3, 0); PG8_STAGE(PG8_SA(0, 1), a2 + hstep, voffA[GATHER ? 1 : 0]);
            PG8_WAIT_VA; PG8_WAIT_L(0); PG8_BAR; PG8_MMA(0, 0, At, B0); PG8_MMA(0, 1, At, B1); PG8_BAR; PG8_SCHED;
            PG8_LDA(At, 1, 1); PG8_WAIT_VB; PG8_BWRITEH(by, 0, 8); PG8_BLOADH(by, b3, 4); PG8_STAGE(PG8_SA(1, 0), a3, voffA[0]); PG8_PF(pf3);
            PG8_WAIT_VC; PG8_WAIT_L(0); PG8_BAR; PG8_MMA(1, 0, At, B0); PG8_MMA(1, 1, At, B1); PG8_BAR; PG8_SCHED;
        }
        if constexpr (ALIGN_EPI) { if (wr == 0) PG8_BAR; }
        E(acc, cur, wr, wc, fr, fq); S.done(cur);
        if (!has_next) break;
#pragma unroll
        for (int a = 0; a < 2; ++a)
#pragma unroll
            for (int b = 0; b < 2; ++b)
#pragma unroll
                for (int m = 0; m < 4; ++m)
#pragma unroll
                    for (int n = 0; n < 2; ++n) acc[a][b][m][n] = (f32x4){0.f, 0.f, 0.f, 0.f};
        cur = nxt; cA = nA; cB = nB; cP = nP; crot = nrot; ++ui;
        if constexpr (ALIGN_EPI) { if (wr == 1) PG8_BAR; }
    }
    PG8_WAIT_V(0);
    asm volatile("" :: "v"(pfd));
    if constexpr (!ALIGN_EPI) { if (wr == 0) PG8_BAR; }
    PG8_BAR;
#undef PG8_PF
#undef PG8_KT
#undef PG8_WAIT_VA
#undef PG8_WAIT_VB
#undef PG8_WAIT_VC
#undef PG8_SA
#undef PG8_SB
#undef PG8_STAGE
#undef PG8_LDA
#undef PG8_LDB
#undef PG8_MMA
#undef PG8_WAIT_V
#undef PG8_WAIT_L
#undef PG8_BAR
#undef PG8_SCHED
#undef PG8_BLOADH
#undef PG8_BWRITEH
#undef PG8_GAS
}
}
namespace att {
using bf16x8 = __attribute__((ext_vector_type(8))) short;
using s16x4  = __attribute__((ext_vector_type(4))) short;
using f32x16 = __attribute__((ext_vector_type(16))) float;
using u32x4  = __attribute__((ext_vector_type(4))) unsigned;
typedef unsigned short bf16;
constexpr int D = 128, NW = 8, QBLK = 32, KVBLK = 64;
constexpr float SCALE = 0.088388347648318440f;
constexpr float THR = 8.f;
constexpr int SHM_V = KVBLK * D * 2, SHM_K = KVBLK * D * 2, SHM_ATTN = 2 * SHM_V + 2 * SHM_K + NW * 64 * 4;
#define KSWZ(row, colB) ((row) * 256 + ((colB) ^ (((row) & 7) << 4)))
#define SBAR() __builtin_amdgcn_sched_barrier(0)
__device__ __forceinline__ int crow(int r, int hi) { return (r & 3) + 8 * (r >> 2) + 4 * hi; }
__device__ __forceinline__ unsigned cvtpk(float lo, float hi) { unsigned r; asm volatile("v_cvt_pk_bf16_f32 %0, %1, %2" : "=v"(r) : "v"(lo), "v"(hi)); return r; }

__device__ __forceinline__ void partialSM(f32x16& p0, f32x16& p1, float& m_reg, float& mn, float& alpha, bool domask, int dm, int hi) {
  constexpr float C = SCALE * 1.4426950408889634f;
  if (domask) {
    const int db = dm + 4 * hi + 128;
#pragma unroll
    for (int r = 0; r < 16; ++r) { const int d0 = db + (r & 3) + 8 * (r >> 2);
      if ((unsigned)d0 > 256u) p0[r] = -1e30f; if ((unsigned)(d0 + 32) > 256u) p1[r] = -1e30f; }
  }
  float pmax = p0[0];
#pragma unroll
  for (int r = 1; r < 16; ++r) pmax = fmaxf(pmax, p0[r]);
#pragma unroll
  for (int r = 0; r < 16; ++r) pmax = fmaxf(pmax, p1[r]);
  { auto rr = __builtin_amdgcn_permlane32_swap(__float_as_uint(pmax), __float_as_uint(pmax), false, false);
    pmax = fmaxf(__uint_as_float(rr[0]), __uint_as_float(rr[1])); }
  if (__builtin_expect(__all(pmax - m_reg <= THR / SCALE), 1)) { mn = m_reg; alpha = 1.f; }
  else { mn = fmaxf(m_reg, pmax); alpha = __builtin_amdgcn_exp2f((m_reg - mn) * C); m_reg = mn; }
  float mnC = -mn * C;
#pragma unroll
  for (int r = 0; r < 16; ++r) p0[r] = fmaf(p0[r], C, mnC);
#pragma unroll
  for (int r = 0; r < 16; ++r) p1[r] = fmaf(p1[r], C, mnC);
#pragma unroll
  for (int r = 0; r < 16; ++r) p0[r] = __builtin_amdgcn_exp2f(p0[r]);
}
__device__ __forceinline__ void finishSM(f32x16& p0, f32x16& p1, float alpha, float& l_reg, bf16x8& pa0, bf16x8& pa1, bf16x8& pa2, bf16x8& pa3) {
#pragma unroll
  for (int r = 0; r < 16; ++r) p1[r] = __builtin_amdgcn_exp2f(p1[r]);
  float ps = 0;
#pragma unroll
  for (int r = 0; r < 16; ++r) ps += p0[r];
#pragma unroll
  for (int r = 0; r < 16; ++r) ps += p1[r];
  { auto rr = __builtin_amdgcn_permlane32_swap(__float_as_uint(ps), __float_as_uint(ps), false, false);
    ps = __uint_as_float(rr[0]) + __uint_as_float(rr[1]); }
  l_reg = l_reg * alpha + ps;
#define PK4(P, BASE, OUT) do { unsigned a0 = cvtpk(P[BASE + 0], P[BASE + 1]), a1 = cvtpk(P[BASE + 2], P[BASE + 3]);   \
    unsigned b0 = cvtpk(P[BASE + 4], P[BASE + 5]), b1 = cvtpk(P[BASE + 6], P[BASE + 7]);                              \
    auto r0 = __builtin_amdgcn_permlane32_swap(a0, b0, false, false); auto r1 = __builtin_amdgcn_permlane32_swap(a1, b1, false, false); \
    u32x4 w = {r0[0], r1[0], r0[1], r1[1]}; OUT = *reinterpret_cast<bf16x8*>(&w); } while (0)
  PK4(p0, 0, pa0); PK4(p0, 8, pa1); PK4(p1, 0, pa2); PK4(p1, 8, pa3);
#undef PK4
}
__device__ __forceinline__ int v_rd_base(int lane) { return ((lane & 3) << 3) | (((lane >> 2) & 3) << 6) | (((lane >> 4) & 1) << 5) | (((lane >> 5) & 1) << 8); }
constexpr int v_rd_off(int d0, int ks, int half) { return d0 * 512 + ks * 4096 + half * 2048; }
template <int OFF> __device__ __forceinline__ s16x4 tr_read(int vb) {
  s16x4 r; asm volatile("ds_read_b64_tr_b16 %0, %1 offset:%2" : "=&v"(r) : "v"(vb), "i"(OFF) : "memory"); return r;
}

typedef float f32x4v __attribute__((ext_vector_type(4)));
__device__ __forceinline__ void q_prep(bf16x8* qr, bool do_norm, bool do_rope, int t, const float* g, const float* rt, int hi) {
  float q[8][8];
#pragma unroll
  for (int d0 = 0; d0 < 8; ++d0)
#pragma unroll
    for (int i = 0; i < 8; ++i) q[d0][i] = __uint_as_float(((unsigned)(unsigned short)qr[d0][i]) << 16);
  if (do_norm) {
    float ss = 0.f;
#pragma unroll
    for (int d0 = 0; d0 < 8; ++d0)
#pragma unroll
      for (int i = 0; i < 8; ++i) ss += q[d0][i] * q[d0][i];
    ss += __shfl_xor(ss, 32);
    const float r = 1.0f / sqrtf(ss * (1.0f / 128.0f) + 1e-6f);
#pragma unroll
    for (int d0 = 0; d0 < 8; ++d0) { const f32x4v g0 = *(const f32x4v*)(g + d0 * 16 + hi * 8), g1 = *(const f32x4v*)(g + d0 * 16 + hi * 8 + 4);
#pragma unroll
      for (int i = 0; i < 4; ++i) { q[d0][i] = q[d0][i] * r * g0[i]; q[d0][4 + i] = q[d0][4 + i] * r * g1[i]; } }
  }
  if (do_rope) {
#pragma unroll
    for (int pr = 0; pr < 4; ++pr) { const int a = (pr & 1) + (pr >> 1) * 4, c = a + 2; const int pos = (pr >> 1) ? (t & 63) : (t >> 6);
      const float* cp = rt + pos * 32 + (a & 1) * 16 + hi * 8;
      const f32x4v c0 = *(const f32x4v*)cp, c1 = *(const f32x4v*)(cp + 4), s0 = *(const f32x4v*)(cp + 2048), s1 = *(const f32x4v*)(cp + 2052);
#pragma unroll
      for (int i = 0; i < 8; ++i) { const float cs = i < 4 ? c0[i & 3] : c1[i & 3], sn = i < 4 ? s0[i & 3] : s1[i & 3];
        const float o1 = q[a][i] * cs - q[c][i] * sn, o2 = q[c][i] * cs + q[a][i] * sn; q[a][i] = o1; q[c][i] = o2; } }
  }
#pragma unroll
  for (int d0 = 0; d0 < 8; ++d0) { u32x4 w = {cvtpk(q[d0][0], q[d0][1]), cvtpk(q[d0][2], q[d0][3]), cvtpk(q[d0][4], q[d0][5]), cvtpk(q[d0][6], q[d0][7])}; qr[d0] = *reinterpret_cast<bf16x8*>(&w); }
}

struct Job {
  const bf16* Q;
  const bf16* K; const bf16* V;
  int NT;
  int kb0;
  int mask;
  int dq;
  int use_sink; float sink_l2;
  void* O; float lam;
  int qmode; int t0; const float* qg; const float* rt;
};
template <int OFF> __device__ __forceinline__ bf16x8 rd128(int a) { bf16x8 r; asm volatile("ds_read_b128 %0, %1 offset:%2" : "=&v"(r) : "v"(a), "i"(OFF) : "memory"); return r; }
struct Job256 { const bf16* Q; const bf16* K; const bf16* V; bf16* O; int NT; int t0; const float* rt;
  const bf16* O0; float lam, sc; const float* g; };
constexpr int V256 = KVBLK * 256 * 2, SHM_ATTN256 = 2 * V256 + 2 * SHM_K + NW * 64 * 4;
constexpr int v_rd_off256(int d0, int ks, int half) { return d0 * 512 + ks * 8192 + half * 4096; }
#define PKV(L, H) (bf16x8){L[0], L[1], L[2], L[3], H[0], H[1], H[2], H[3]}
#define WAITL(n) asm volatile("s_waitcnt lgkmcnt(" #n ")" ::: "memory")
#define RKM(M, U) do { U = rd128<((M) & 1) * 8192 + ((M) >> 3) * 128>(ka[((M) >> 1) & 3] + kbo); } while (0)
#define MQM(M, U) do { if constexpr (((M) & 1) == 0) p0 = __builtin_amdgcn_mfma_f32_32x32x16_bf16(U, qr[(M) >> 1], p0, 0, 0, 0); else p1 = __builtin_amdgcn_mfma_f32_32x32x16_bf16(U, qr[(M) >> 1], p1, 0, 0, 0); } while (0)
template <bool HAS_PV, bool HAS_QK>
__device__ __forceinline__ void mseg256(f32x16* o, f32x16& p0, f32x16& p1, int vb, const int (&ka)[4], int kbo, const bf16x8* qr, bf16x8 pa0, bf16x8 pa1, bf16x8 pa2, bf16x8 pa3) {
  bf16x8 U0, U1, U2, U3, U4;
  if constexpr (HAS_PV) {
    s16x4 H0[4], H1[4], H2[4], H3[4];
#define RH(HS, H) do { H[0] = tr_read<v_rd_off256(2 * ((HS) >> 2), (HS) & 3, 0)>(vb); H[1] = tr_read<v_rd_off256(2 * ((HS) >> 2), (HS) & 3, 1)>(vb); \
    H[2] = tr_read<v_rd_off256(2 * ((HS) >> 2) + 1, (HS) & 3, 0)>(vb); H[3] = tr_read<v_rd_off256(2 * ((HS) >> 2) + 1, (HS) & 3, 1)>(vb); } while (0)
#define MH(HS, H) do { const bf16x8 pk_ = ((HS) & 3) == 0 ? pa0 : ((HS) & 3) == 1 ? pa1 : ((HS) & 3) == 2 ? pa2 : pa3; \
    o[2 * ((HS) >> 2)] = __builtin_amdgcn_mfma_f32_32x32x16_bf16(pk_, PKV(H[0], H[1]), o[2 * ((HS) >> 2)], 0, 0, 0); \
    o[2 * ((HS) >> 2) + 1] = __builtin_amdgcn_mfma_f32_32x32x16_bf16(pk_, PKV(H[2], H[3]), o[2 * ((HS) >> 2) + 1], 0, 0, 0); } while (0)
#define PVH(HS, H, HN) do { WAITL(8); SBAR(); RH((HS) + 3, HN); SBAR(); MH(HS, H); SBAR(); } while (0)
    RH(0, H0); RH(1, H1); RH(2, H2);
    PVH(0, H0, H3); PVH(1, H1, H0); PVH(2, H2, H1); PVH(3, H3, H2); PVH(4, H0, H3); PVH(5, H1, H0); PVH(6, H2, H1); PVH(7, H3, H2);
    PVH(8, H0, H3); PVH(9, H1, H0); PVH(10, H2, H1); PVH(11, H3, H2); PVH(12, H0, H3);
    if constexpr (HAS_QK) {
      WAITL(8); SBAR(); RKM(0, U0); RKM(1, U1); SBAR(); MH(13, H1); SBAR();
      WAITL(6); SBAR(); RKM(2, U2); RKM(3, U3); SBAR(); MH(14, H2); SBAR();
      WAITL(4); SBAR(); RKM(4, U4); SBAR(); MH(15, H3); SBAR();
    } else {
      WAITL(8); SBAR(); MH(13, H1); SBAR();
      WAITL(4); SBAR(); MH(14, H2); SBAR();
      WAITL(0); SBAR(); MH(15, H3); SBAR();
    }
#undef RH
#undef MH
#undef PVH
  } else if constexpr (HAS_QK) { RKM(0, U0); RKM(1, U1); RKM(2, U2); RKM(3, U3); RKM(4, U4); }
  if constexpr (HAS_QK) {
    p0 = f32x16{}; p1 = f32x16{};
#define QM(M, U) do { WAITL(4); SBAR(); MQM(M, U); SBAR(); RKM((M) + 5, U); } while (0)
    QM(0, U0); QM(1, U1); QM(2, U2); QM(3, U3); QM(4, U4); QM(5, U0); QM(6, U1); QM(7, U2); QM(8, U3); QM(9, U4); QM(10, U0);
#undef QM
    WAITL(4); SBAR(); MQM(11, U1); SBAR();
    WAITL(3); SBAR(); MQM(12, U2); SBAR();
    WAITL(2); SBAR(); MQM(13, U3); SBAR();
    WAITL(1); SBAR(); MQM(14, U4); SBAR();
    WAITL(0); SBAR(); MQM(15, U0); SBAR();
  }
}
template <int LD, int EPI>
__device__ __forceinline__ void attn_unit256s(const Job256& J, char* lds) {
  typedef __attribute__((address_space(3))) unsigned las_u32;
  constexpr int LDO = 2048;
  int tid_ = threadIdx.x; asm volatile("" : "+v"(tid_));
  const int tid = tid_, wid = __builtin_amdgcn_readfirstlane(tid >> 6), lane = tid & 63, r32 = lane & 31, hi = lane >> 5;
  int hb;
  { int simd_; asm volatile("s_getreg_b32 %0, hwreg(HW_REG_HW_ID, 4, 2)" : "=s"(simd_));
    int* sid_ = (int*)(lds + 3 * V256 + 3 * SHM_K + NW * 64 * 4);
    if (lane == 0) sid_[wid] = simd_;
    __syncthreads();
    int rank_ = 0;
#pragma unroll
    for (int w = 0; w < NW; ++w) rank_ += (w < wid && sid_[w] == simd_) ? 1 : 0;
    hb = __builtin_amdgcn_readfirstlane(rank_) & 1;
    __syncthreads(); }
  char* V_lds = lds; char* K_lds = lds + 3 * V256;
  float* ws = (float*)(lds + 3 * V256 + 3 * SHM_K) + wid * 64; float* li_l = ws; float* al_l = ws + 32;
  float m_reg = -1e30f, l_reg = 0; f32x16 o[8] = {}; bf16x8 qr[8];
  const bf16* Qw = J.Q + (long)(wid * QBLK + r32) * LD + hi * 8;
#pragma unroll
  for (int d0 = 0; d0 < 8; ++d0) qr[d0] = *reinterpret_cast<const bf16x8*>(Qw + d0 * 16);
  q_prep(qr, false, true, J.t0 + wid * QBLK + r32, nullptr, J.rt, hi);
  unsigned kso[2], vso0;
#pragma unroll
  for (int i = 0; i < 2; ++i) { const int U = (2 * wid + i) * 64 + lane, row = U >> 4, ch = (U & 15) ^ (row & 7); kso[i] = (unsigned)(row * LD + ch * 8); }
  { const int U = (4 * wid) * 64 + lane, st = U >> 5, kk = (st >> 3) * 8 + ((U & 31) >> 2), k = (kk & ~0xC) | ((kk & 4) << 1) | ((kk & 8) >> 1);
    vso0 = (unsigned)(k * LD + (st & 7) * 32 + (U & 3) * 8); }
  const int vb0 = (int)(uintptr_t)V_lds + v_rd_base(lane);
  int ka[4];
#pragma unroll
  for (int d0 = 0; d0 < 4; ++d0) ka[d0] = (int)(uintptr_t)K_lds + r32 * 256 + ((32 * d0 + 16 * hi) ^ ((r32 & 7) << 4));
  const bf16* Kh = J.K; const bf16* Vh = J.V; const int NT = J.NT;
#define DMA_K(t, buf) do { const bf16* kp_ = Kh + (size_t)(t) * 64 * LD; \
    _Pragma("unroll") for (int i = 0; i < 2; ++i) __builtin_amdgcn_global_load_lds((const unsigned*)(kp_ + kso[i]), (las_u32*)(K_lds + (buf) * SHM_K + (2 * wid + i) * 1024), 16, 0, 0); } while (0)
#define DMA_V(t, buf) do { const bf16* vp_ = Vh + (size_t)(t) * 64 * LD; \
    _Pragma("unroll") for (int i = 0; i < 4; ++i) __builtin_amdgcn_global_load_lds((const unsigned*)((vp_ + 64 * i) + vso0), (las_u32*)(V_lds + (buf) * V256 + (4 * wid + i) * 1024), 16, 0, 0); } while (0)
#define MOD3(x) ((x) >= 3 ? (x) - 3 : (x))
#define DMA_STAGE(s, kslot, vslot) do { const int s_ = (s); if (s_ < NT) DMA_K(s_, kslot); if (s_ >= 1 && s_ <= NT) DMA_V(s_ - 1, vslot); } while (0)
#define WG_BAR() do { SBAR(); __builtin_amdgcn_s_barrier(); asm volatile("" ::: "memory"); SBAR(); } while (0)
  f32x16 p0 = {}, p1 = {}; float mn, al; bf16x8 pa0 = {}, pa1 = {}, pa2 = {}, pa3 = {};
#pragma unroll
  for (int d0 = 0; d0 < 8; ++d0) asm volatile("" :: "v"(qr[d0]));
  DMA_STAGE(0, 0, 0); DMA_STAGE(1, 1, 0);
  asm volatile("s_waitcnt vmcnt(6)" ::: "memory"); WG_BAR();
  if (hb == 1) { DMA_STAGE(2, 2, 1); WG_BAR(); }
  int c3 = 0;
#define WAIT_STAGE(j_) do { if ((j_) + 2 < NT) asm volatile("s_waitcnt vmcnt(6)" ::: "memory"); else asm volatile("s_waitcnt vmcnt(0)" ::: "memory"); } while (0)
#define ITER(J, HAS_PV, HAS_QK) do { const int j_ = (J); \
    if (hb == 0 && j_ + 2 <= NT) DMA_STAGE(j_ + 2, MOD3(c3 + 2), MOD3(c3 + 1)); \
    __builtin_amdgcn_s_setprio(1); SBAR(); \
    mseg256<HAS_PV, HAS_QK>(o, p0, p1, vb0 + MOD3(c3 + 2) * V256, ka, c3 * SHM_K, qr, pa0, pa1, pa2, pa3); \
    __builtin_amdgcn_s_setprio(0); \
    if (hb == 1) WAIT_STAGE(j_); \
    WG_BAR(); \
    if (hb == 1 && j_ + 3 <= NT) DMA_STAGE(j_ + 3, c3, MOD3(c3 + 2)); \
    if constexpr (HAS_QK) { SOFTMAX(); } \
    if (hb == 0) WAIT_STAGE(j_); \
    WG_BAR(); c3 = MOD3(c3 + 1); } while (0)
#define SOFTMAX() do { \
      partialSM(p0, p1, m_reg, mn, al, false, 0, hi); \
      if (__any(al < 1.f)) { if (hi == 0) al_l[r32] = al; asm volatile("s_waitcnt lgkmcnt(0)" ::: "memory"); \
        _Pragma("unroll") for (int d = 0; d < 8; ++d) _Pragma("unroll") for (int r = 0; r < 16; ++r) o[d][r] *= al_l[crow(r, hi)]; } \
      finishSM(p0, p1, al, l_reg, pa0, pa1, pa2, pa3); } while (0)
  ITER(0, false, true);
  for (int j = 1; j < NT; ++j) ITER(j, true, true);
  ITER(NT, true, false);
#undef ITER
#undef SOFTMAX
  if (hb == 0) WG_BAR();
  if (hi == 0) li_l[r32] = l_reg; asm volatile("s_waitcnt lgkmcnt(0)" ::: "memory");
  float rli[16];
#pragma unroll
  for (int r = 0; r < 16; ++r) rli[r] = __builtin_amdgcn_rcpf(li_l[crow(r, hi)]);
  bf16* Ow = J.O + (long)(wid * QBLK) * LDO + r32;
  asm volatile("" : "+v"(Ow));
  if constexpr (EPI == 0) {
#pragma unroll
    for (int r = 0; r < 16; ++r) { const int orow = crow(r, hi);
#pragma unroll
      for (int d0 = 0; d0 < 8; ++d0) Ow[orow * LDO + d0 * 32] = (bf16)(cvtpk(o[d0][r] * rli[r], 0.f) & 0xffffu); }
  } else {
    const bf16* O0w = J.O0 + (long)(wid * QBLK) * LDO + r32;
    asm volatile("" : "+v"(O0w));
    const float lam = J.lam, sc = J.sc;
    float gv[8]; const float* gl_ = J.g + r32; asm volatile("" : "+v"(gl_));
#pragma unroll
    for (int d0 = 0; d0 < 8; ++d0) gv[d0] = gl_[d0 * 32];
#pragma unroll
    for (int r = 0; r < 16; ++r) { const int orow = crow(r, hi); float ss = 0.f, v[8];
      asm volatile("" ::: "memory");
#pragma unroll
      for (int d0 = 0; d0 < 8; ++d0) v[d0] = __uint_as_float(((unsigned)O0w[orow * LDO + d0 * 32]) << 16);
#pragma unroll
      for (int d0 = 0; d0 < 8; ++d0) { v[d0] = v[d0] - (o[d0][r] * rli[r]) * lam; ss += v[d0] * v[d0]; }
      ss += __shfl_xor(ss, 1); ss += __shfl_xor(ss, 2); ss += __shfl_xor(ss, 4); ss += __shfl_xor(ss, 8); ss += __shfl_xor(ss, 16);
      const float rr = sc / sqrtf(ss * (1.0f / 256.0f) + 1e-6f);
#pragma unroll
      for (int d0 = 0; d0 < 8; ++d0) Ow[orow * LDO + d0 * 32] = (bf16)(cvtpk(v[d0] * rr * gv[d0], 0.f) & 0xffffu); }
  }
#undef DMA_K
#undef DMA_V
#undef DMA_STAGE
#undef MOD3
#undef WAIT_STAGE
#undef WG_BAR
}

template <bool HAS_PV, bool HAS_QK>
__device__ __forceinline__ void mseg128(f32x16* o, f32x16& p0, f32x16& p1, int vb, const int (&ka)[4], int kbo, const bf16x8* qr, bf16x8 pa0, bf16x8 pa1, bf16x8 pa2, bf16x8 pa3) {
  bf16x8 U0 = {}, U1 = {}, U2 = {}, U3 = {}, U4 = {};
  if constexpr (HAS_PV) {
    s16x4 H0[4], H1[4], H2[4], H3[4];
#define RH(HS, H) do { H[0] = tr_read<v_rd_off(2 * ((HS) >> 2), (HS) & 3, 0)>(vb); H[1] = tr_read<v_rd_off(2 * ((HS) >> 2), (HS) & 3, 1)>(vb); \
    H[2] = tr_read<v_rd_off(2 * ((HS) >> 2) + 1, (HS) & 3, 0)>(vb); H[3] = tr_read<v_rd_off(2 * ((HS) >> 2) + 1, (HS) & 3, 1)>(vb); } while (0)
#define MH(HS, H) do { const bf16x8 pk_ = ((HS) & 3) == 0 ? pa0 : ((HS) & 3) == 1 ? pa1 : ((HS) & 3) == 2 ? pa2 : pa3; \
    o[2 * ((HS) >> 2)] = __builtin_amdgcn_mfma_f32_32x32x16_bf16(pk_, PKV(H[0], H[1]), o[2 * ((HS) >> 2)], 0, 0, 0); \
    o[2 * ((HS) >> 2) + 1] = __builtin_amdgcn_mfma_f32_32x32x16_bf16(pk_, PKV(H[2], H[3]), o[2 * ((HS) >> 2) + 1], 0, 0, 0); } while (0)
#define PVH(HS, H, HN) do { WAITL(8); SBAR(); RH((HS) + 3, HN); SBAR(); MH(HS, H); SBAR(); } while (0)
    RH(0, H0); RH(1, H1); RH(2, H2);
    PVH(0, H0, H3); PVH(1, H1, H0); PVH(2, H2, H1); PVH(3, H3, H2); PVH(4, H0, H3);
    if constexpr (HAS_QK) {
      WAITL(8); SBAR(); RKM(0, U0); RKM(1, U1); SBAR(); MH(5, H1); SBAR();
      WAITL(6); SBAR(); RKM(2, U2); RKM(3, U3); SBAR(); MH(6, H2); SBAR();
      WAITL(4); SBAR(); RKM(4, U4); SBAR(); MH(7, H3); SBAR();
    } else {
      WAITL(8); SBAR(); MH(5, H1); SBAR();
      WAITL(4); SBAR(); MH(6, H2); SBAR();
      WAITL(0); SBAR(); MH(7, H3); SBAR();
    }
#undef RH
#undef MH
#undef PVH
  } else if constexpr (HAS_QK) { RKM(0, U0); RKM(1, U1); RKM(2, U2); RKM(3, U3); RKM(4, U4); }
  if constexpr (HAS_QK) {
    p0 = f32x16{}; p1 = f32x16{};
#define QM(M, U) do { WAITL(4); SBAR(); MQM(M, U); SBAR(); RKM((M) + 5, U); } while (0)
    QM(0, U0); QM(1, U1); QM(2, U2); QM(3, U3); QM(4, U4); QM(5, U0); QM(6, U1); QM(7, U2); QM(8, U3); QM(9, U4); QM(10, U0);
#undef QM
    WAITL(4); SBAR(); MQM(11, U1); SBAR();
    WAITL(3); SBAR(); MQM(12, U2); SBAR();
    WAITL(2); SBAR(); MQM(13, U3); SBAR();
    WAITL(1); SBAR(); MQM(14, U4); SBAR();
    WAITL(0); SBAR(); MQM(15, U0); SBAR();
  }
}
template <int LD, bool MASKED>
__device__ __forceinline__ void attn_unit128s(const Job& J, char* lds) {
  typedef __attribute__((address_space(3))) unsigned las_u32;
  constexpr int LDO = 2048;
  const int tid = threadIdx.x, wid = __builtin_amdgcn_readfirstlane(tid >> 6), lane = tid & 63, r32 = lane & 31, hi = lane >> 5;
  char* V_lds = lds; char* K_lds = lds + 3 * SHM_V;
  float* ws = (float*)(lds + 3 * SHM_V + 3 * SHM_K) + wid * 64; float* li_l = ws; float* al_l = ws + 32;
  int hb;
  { int simd_; asm volatile("s_getreg_b32 %0, hwreg(HW_REG_HW_ID, 4, 2)" : "=s"(simd_));
    int* sid_ = (int*)(lds + 3 * SHM_V + 3 * SHM_K + NW * 64 * 4);
    if (lane == 0) sid_[wid] = simd_;
    __syncthreads();
    int rank_ = 0;
#pragma unroll
    for (int w = 0; w < NW; ++w) rank_ += (w < wid && sid_[w] == simd_) ? 1 : 0;
    hb = __builtin_amdgcn_readfirstlane(rank_) & 1;
    __syncthreads(); }
  float m_reg = -1e30f, l_reg = 0; f32x16 o[4] = {}; bf16x8 qr[8];
  const bf16* Qw = J.Q + (long)(wid * QBLK + r32) * LD + hi * 8;
#pragma unroll
  for (int d0 = 0; d0 < 8; ++d0) qr[d0] = *reinterpret_cast<const bf16x8*>(Qw + d0 * 16);
  q_prep(qr, (J.qmode & 1) != 0, (J.qmode & 2) != 0, J.t0 + wid * QBLK + r32, J.qg, J.rt, hi);
  unsigned kso[2], vso0;
#pragma unroll
  for (int i = 0; i < 2; ++i) { const int U = (2 * wid + i) * 64 + lane, row = U >> 4, ch = (U & 15) ^ (row & 7); kso[i] = (unsigned)(row * LD + ch * 8); }
  { const int U = (2 * wid) * 64 + lane, st = U >> 5, kk = (st >> 2) * 8 + ((U & 31) >> 2), k = (kk & ~0xC) | ((kk & 4) << 1) | ((kk & 8) >> 1);
    vso0 = (unsigned)(k * LD + (st & 3) * 32 + (U & 3) * 8); }
  const int vb0 = (int)(uintptr_t)V_lds + v_rd_base(lane);
  int ka[4];
#pragma unroll
  for (int d0 = 0; d0 < 4; ++d0) ka[d0] = (int)(uintptr_t)K_lds + r32 * 256 + ((32 * d0 + 16 * hi) ^ ((r32 & 7) << 4));
  const bf16* Kh = J.K; const bf16* Vh = J.V; const int NT = J.NT, kb0 = J.kb0;
  const bool msk = MASKED && J.mask != 0;
  const int dml = J.dq - (wid * QBLK + r32);
#define KROWT(t) ((t) < 4 ? (t) * 64 : kb0 + ((t) - 4) * 64)
#define DMA_K(t, buf) do { const bf16* kp_ = Kh + (size_t)KROWT(t) * LD; \
    _Pragma("unroll") for (int i = 0; i < 2; ++i) __builtin_amdgcn_global_load_lds((const unsigned*)(kp_ + kso[i]), (las_u32*)(K_lds + (buf) * SHM_K + (2 * wid + i) * 1024), 16, 0, 0); } while (0)
#define DMA_V(t, buf) do { const bf16* vp_ = Vh + (size_t)KROWT(t) * LD; \
    _Pragma("unroll") for (int i = 0; i < 2; ++i) __builtin_amdgcn_global_load_lds((const unsigned*)((vp_ + 64 * i) + vso0), (las_u32*)(V_lds + (buf) * SHM_V + (2 * wid + i) * 1024), 16, 0, 0); } while (0)
#define MOD3(x) ((x) >= 3 ? (x) - 3 : (x))
#define DMA_STAGE(s, kslot, vslot) do { const int s_ = (s); if (s_ < NT) DMA_K(s_, kslot); if (s_ >= 1 && s_ <= NT) DMA_V(s_ - 1, vslot); } while (0)
#define WG_BAR() do { SBAR(); __builtin_amdgcn_s_barrier(); asm volatile("" ::: "memory"); SBAR(); } while (0)
#define WAIT_STAGE(j_) do { if ((j_) + 2 < NT) asm volatile("s_waitcnt vmcnt(4)" ::: "memory"); else asm volatile("s_waitcnt vmcnt(0)" ::: "memory"); } while (0)
  f32x16 p0 = {}, p1 = {}; float mn, al; bf16x8 pa0 = {}, pa1 = {}, pa2 = {}, pa3 = {};
#pragma unroll
  for (int d0 = 0; d0 < 8; ++d0) asm volatile("" :: "v"(qr[d0]));
  DMA_STAGE(0, 0, 0); DMA_STAGE(1, 1, 0);
  asm volatile("s_waitcnt vmcnt(4)" ::: "memory"); WG_BAR();
  if (hb == 1) { DMA_STAGE(2, 2, 1); WG_BAR(); }
  int c3 = 0;
#define ITER(J_, HAS_PV, HAS_QK) do { const int j_ = (J_); \
    if (hb == 0 && j_ + 2 <= NT) DMA_STAGE(j_ + 2, MOD3(c3 + 2), MOD3(c3 + 1)); \
    __builtin_amdgcn_s_setprio(1); SBAR(); \
    mseg128<HAS_PV, HAS_QK>(o, p0, p1, vb0 + MOD3(c3 + 2) * SHM_V, ka, c3 * SHM_K, qr, pa0, pa1, pa2, pa3); \
    __builtin_amdgcn_s_setprio(0); \
    if (hb == 1) WAIT_STAGE(j_); \
    WG_BAR(); \
    if (hb == 1 && j_ + 3 <= NT) DMA_STAGE(j_ + 3, c3, MOD3(c3 + 2)); \
    if constexpr (HAS_QK) { \
      partialSM(p0, p1, m_reg, mn, al, msk && j_ >= 4, dml + (j_ - 4) * 64, hi); \
      if (__any(al < 1.f)) { if (hi == 0) al_l[r32] = al; asm volatile("s_waitcnt lgkmcnt(0)" ::: "memory"); \
        _Pragma("unroll") for (int d = 0; d < 4; ++d) _Pragma("unroll") for (int r = 0; r < 16; ++r) o[d][r] *= al_l[crow(r, hi)]; } \
      finishSM(p0, p1, al, l_reg, pa0, pa1, pa2, pa3); } \
    if (hb == 0) WAIT_STAGE(j_); \
    WG_BAR(); c3 = MOD3(c3 + 1); } while (0)
  ITER(0, false, true);
  for (int j = 1; j < NT; ++j) ITER(j, true, true);
  ITER(NT, true, false);
#undef ITER
  if (hb == 0) WG_BAR();
  if (J.use_sink) l_reg += __builtin_amdgcn_exp2f(J.sink_l2 - m_reg * (SCALE * 1.4426950408889634f));
  if (hi == 0) li_l[r32] = l_reg; asm volatile("s_waitcnt lgkmcnt(0)" ::: "memory");
  float rli[16];
#pragma unroll
  for (int r = 0; r < 16; ++r) rli[r] = __builtin_amdgcn_rcpf(li_l[crow(r, hi)]);
  bf16* Ow = (bf16*)J.O + (long)(wid * QBLK) * LDO + r32;
#pragma unroll
  for (int r = 0; r < 16; ++r) { const int orow = crow(r, hi);
#pragma unroll
    for (int d0 = 0; d0 < 4; ++d0) Ow[orow * LDO + d0 * 32] = (bf16)(cvtpk(o[d0][r] * rli[r], 0.f) & 0xffffu); }
#undef KROWT
#undef DMA_K
#undef DMA_V
#undef DMA_STAGE
#undef MOD3
#undef WAIT_STAGE
#undef WG_BAR
}

#undef KSWZ
#undef SBAR
}

constexpr int NWAVES = 8;
constexpr int DM = 2048, NBATCH = 2, SEQ = 4096, CTXL = 256, SB = SEQ + CTXL  , NROWS = NBATCH * SB  ;
constexpr int NEXP = 16, CAP_L = 512, CAP_C = 32, EROWS = 1280  ;
constexpr int NQKV0 = 3072, NQKV1 = 6144, NMOD = 6 * DM;
constexpr float EPS = 1e-6f;
constexpr float LAMBDA_INIT = 0.35550906759096926f;

constexpr size_t MiB = 1u << 20;
constexpr size_t WS_CTL = 0, CTL_ZERO_BYTES = 1 * MiB;
constexpr size_t WS_ROPE = 1 * MiB;
constexpr size_t WS_MODS = 2 * MiB;
constexpr size_t WS_AFF  = 3 * MiB;
constexpr size_t WS_RL   = 4 * MiB;
constexpr size_t WS_GATE = 5 * MiB;
constexpr size_t WS_INV  = 6 * MiB;
constexpr size_t WS_WIN0 = 8 * MiB;
constexpr size_t WS_WOUT0 = WS_WIN0 + 12 * MiB;
constexpr size_t WS_WIN1 = WS_WOUT0 + 8 * MiB;
constexpr size_t WS_WOUT1 = WS_WIN1 + 24 * MiB;
constexpr size_t WS_WGU = WS_WOUT1 + 8 * MiB;
constexpr size_t WS_WD  = WS_WGU + 512 * MiB;
constexpr size_t WS_H   = WS_WD + 256 * MiB;
constexpr size_t WS_QKV = WS_H + 34 * MiB;
constexpr size_t WS_Y   = WS_QKV + 102 * MiB;
constexpr size_t WS_YO  = WS_Y + 34 * MiB;
constexpr size_t WS_XL  = WS_YO + 68 * MiB;
constexpr size_t WS_XG  = WS_XL + 68 * MiB;
constexpr size_t WS_HM  = WS_XG + 80 * MiB;
constexpr size_t WS_YE  = WS_HM + 80 * MiB;
constexpr size_t WS_END = WS_YE + 80 * MiB;
constexpr int CW_BAR = 4096;

constexpr int RING_BYTES = 131072;
constexpr int LDS_BYTES = 163840;
constexpr int CW_BST = 8192;

#define LAS __attribute__((address_space(3)))
typedef unsigned short bf16;
typedef unsigned v4u __attribute__((ext_vector_type(4)));
typedef unsigned v2u __attribute__((ext_vector_type(2)));
typedef int v4i __attribute__((ext_vector_type(4)));
typedef float f32x4 __attribute__((ext_vector_type(4)));
__device__ __forceinline__ unsigned f2bf(float f) { unsigned u = __builtin_bit_cast(unsigned, f); return (u + 0x7fffu + ((u >> 16) & 1u)) >> 16; }
__device__ __forceinline__ unsigned pk2(float lo, float hi) { return f2bf(lo) | (f2bf(hi) << 16); }
__device__ __forceinline__ float bf_lo(unsigned w) { return __builtin_bit_cast(float, w << 16); }
__device__ __forceinline__ float bf_hi(unsigned w) { return __builtin_bit_cast(float, w & 0xffff0000u); }

#define XB_TMO      128
#define XB_XCNT(j)  (256  + 64 * (j))
#define XB_XSUB(j)  (1280 + 64 * (j))
#define XB_XGEN(j)  (2304 + 64 * (j))
#define XB_TOP      3328
#define XB_TOPGEN   3392
#define XCD_BAR_WORDS 3456
#define XB_SPIN_CAP (1u << 18)
__device__ __forceinline__ unsigned xb_ld(unsigned* p)              { return __hip_atomic_load(p, __ATOMIC_RELAXED, __HIP_MEMORY_SCOPE_AGENT); }
__device__ __forceinline__ unsigned xb_add(unsigned* p, unsigned v) { return __hip_atomic_fetch_add(p, v, __ATOMIC_RELAXED, __HIP_MEMORY_SCOPE_AGENT); }
__device__ __forceinline__ unsigned xb_xcc_id() { return (unsigned)__builtin_amdgcn_s_getreg((3 << 11) | 20) & 0xFu; }
#define XB_SPIN(cond, bar) do { unsigned _sp = 0; while (cond) { __builtin_amdgcn_s_sleep(1); \
    if ((++_sp & 255u) == 0u) { if (xb_ld(&(bar)[XB_TMO])) break; if (_sp > XB_SPIN_CAP) { atomicAdd(&(bar)[XB_TMO], 1u); break; } } } } while (0)
struct XcdBarrier { unsigned* bar; unsigned x; unsigned* st; };
__device__ __forceinline__ XcdBarrier xcd_barrier_post(unsigned* bar, unsigned* st) {
    XcdBarrier b; b.bar = bar; b.x = xb_xcc_id(); b.st = st;
    if (threadIdx.x == 0) (void)xb_add(&bar[XB_XCNT(b.x)], 1u);
    return b;
}
__device__ __forceinline__ void xcd_barrier_complete(unsigned* bar, unsigned x, unsigned& nloc, unsigned& nx) {
    const unsigned G = gridDim.x * gridDim.y * gridDim.z;
    unsigned sum, cnt, mine, sp = 0u;
    for (;;) {
        sum = 0u; cnt = 0u; mine = 0u;
#pragma unroll
        for (unsigned j = 0; j < 16; ++j) { const unsigned c = xb_ld(&bar[XB_XCNT(j)]); sum += c; cnt += (c > 0u) ? 1u : 0u; mine = (j == x) ? c : mine; }
        if (sum == G) break;
        __builtin_amdgcn_s_sleep(1);
        if ((++sp & 255u) == 0u) { if (xb_ld(&bar[XB_TMO])) break; if (sp > XB_SPIN_CAP) { atomicAdd(&bar[XB_TMO], 1u); break; } }
    }
    nloc = mine > 0u ? mine : 1u; nx = cnt > 0u ? cnt : 1u;
}
__device__ __forceinline__ void xcd_barrier(const XcdBarrier& b) {
    asm volatile("s_waitcnt vmcnt(0)" ::: "memory");
    __syncthreads();
    if (threadIdx.x == 0) {
        unsigned* bar = b.bar;
        __builtin_amdgcn_s_waitcnt(0);
        unsigned nloc = xb_ld(&b.st[0]), nx = xb_ld(&b.st[1]);
        if (nloc == 0u) { xcd_barrier_complete(bar, b.x, nloc, nx); __hip_atomic_store(&b.st[0], nloc, __ATOMIC_RELAXED, __HIP_MEMORY_SCOPE_AGENT); __hip_atomic_store(&b.st[1], nx, __ATOMIC_RELAXED, __HIP_MEMORY_SCOPE_AGENT); }
        const unsigned old = xb_add(&bar[XB_XSUB(b.x)], 1u);
        const unsigned gen = old / nloc;
        if (old + 1u == (gen + 1u) * nloc) {
            __builtin_amdgcn_fence(__ATOMIC_RELEASE, "agent");
            asm volatile("s_waitcnt vmcnt(0)" ::: "memory");
            const unsigned og = xb_add(&bar[XB_TOP], 1u);
            const unsigned tg = og / nx;
            if (og + 1u == (tg + 1u) * nx) xb_add(&bar[XB_TOPGEN], 1u);
            else XB_SPIN(xb_ld(&bar[XB_TOPGEN]) == tg, bar);
            __builtin_amdgcn_fence(__ATOMIC_ACQUIRE, "agent");
            xb_add(&bar[XB_XGEN(b.x)], 1u);
            asm volatile("s_waitcnt vmcnt(0)" ::: "memory");
        } else {
            XB_SPIN(xb_ld(&bar[XB_XGEN(b.x)]) == gen, bar);
            __builtin_amdgcn_fence(__ATOMIC_ACQUIRE, "agent");
            asm volatile("s_waitcnt vmcnt(0)" ::: "memory");
        }
    }
    __syncthreads();
}

struct Args { const float* in[20]; float* out; unsigned char* ws; int ph_lo, ph_hi; };
struct Frame {
    LAS unsigned char* lds;
    int tid, lane, wave, G, gw, NGW;
    __attribute__((address_space(1))) unsigned char* ws;
};
template <class T> __device__ __forceinline__ T* fresh(T* p) { __attribute__((address_space(1))) T* q = (__attribute__((address_space(1))) T*)p; asm volatile("" : "+s"(q)); return (T*)q; }
__device__ __forceinline__ float wave_sum(float v) {
#pragma unroll
    for (int o = 1; o < 64; o <<= 1) v += __shfl_xor(v, o);
    return v;
}
__device__ __forceinline__ int wave_incl_scan(int v, int lane) {
#pragma unroll
    for (int o = 1; o < 64; o <<= 1) { const int t = __shfl_up(v, o); if (lane >= o) v += t; }
    return v;
}
__device__ __forceinline__ void transpose_item(const float* W, int K, int N, bf16* WT, int k0, int n0, int drow0, LAS float* scr, int lane) {
#pragma unroll 8
    for (int i = 0; i < 32; ++i) { const int kk = 2 * i + (lane >> 5); scr[kk * 33 + (lane & 31)] = W[(size_t)(k0 + kk) * N + n0 + (lane & 31)]; }
    asm volatile("s_waitcnt lgkmcnt(0)" ::: "memory");
    const int c = lane & 7;
#pragma unroll
    for (int j = 0; j < 4; ++j) { const int n = (lane >> 3) + 8 * j; const LAS float* s = scr + (8 * c) * 33 + n;
        v4u o; o.x = pk2(s[0 * 33], s[1 * 33]); o.y = pk2(s[2 * 33], s[3 * 33]); o.z = pk2(s[4 * 33], s[5 * 33]); o.w = pk2(s[6 * 33], s[7 * 33]);
        *(v4u*)(WT + (size_t)(drow0 + n) * K + k0 + 8 * c) = o; }
    asm volatile("s_waitcnt lgkmcnt(0)" ::: "memory");
}
__device__ __forceinline__ void ld_row(const float* p, int lane, f32x4 (&v)[8]) {
#pragma unroll
    for (int j = 0; j < 8; ++j) v[j] = *(const f32x4*)(p + 4 * lane + 256 * j);
}
__device__ __forceinline__ void ld_row_bf16(const bf16* p, int lane, f32x4 (&v)[8]) {
#pragma unroll
    for (int j = 0; j < 8; ++j) { const v2u w = *(const v2u*)(p + 4 * lane + 256 * j); v[j] = (f32x4){bf_lo(w.x), bf_hi(w.x), bf_lo(w.y), bf_hi(w.y)}; }
}
__device__ __forceinline__ float row_rstd(const f32x4 (&v)[8]) {
    float s = 0.f;
#pragma unroll
    for (int j = 0; j < 8; ++j) s += (v[j].x * v[j].x + v[j].y * v[j].y) + (v[j].z * v[j].z + v[j].w * v[j].w);
    return 1.0f / sqrtf(wave_sum(s) * (1.0f / DM) + EPS);
}
__device__ __forceinline__ void st_row_bf16(bf16* p, int lane, const f32x4 (&v)[8]) {
#pragma unroll
    for (int j = 0; j < 8; ++j) { v2u w; w.x = pk2(v[j].x, v[j].y); w.y = pk2(v[j].z, v[j].w); *(v2u*)(p + 4 * lane + 256 * j) = w; }
}
__device__ __forceinline__ void norm_mod(f32x4 (&h)[8], const f32x4 (&x)[8], float r, const float* g, const float* sc, const float* sh, int lane) {
#pragma unroll
    for (int j = 0; j < 8; ++j) { const int c = 4 * lane + 256 * j; const f32x4 gg = *(const f32x4*)(g + c), s1 = *(const f32x4*)(sc + c), s0 = *(const f32x4*)(sh + c);
        h[j] = x[j] * r * gg * (s1 + 1.0f) + s0; }
}
__device__ __forceinline__ const float* in_row_ptr(const float* x_in, const float* ctx_in, int row) {
    const int b = row / SB, s = row - b * SB;
    return s < CTXL ? ctx_in + ((size_t)(b * CTXL + s)) * DM : x_in + ((size_t)(b * SEQ + s - CTXL)) * DM;
}
__device__ __forceinline__ const float* mods_ptr(const Frame& F, int layer, int row, int chunk) {
    const int b = row / SB, s = row - b * SB; const int vec = s < CTXL ? 2 : b;
    return (const float*)(F.ws + WS_MODS) + ((size_t)(layer * 3 + vec)) * NMOD + chunk * DM;
}

__device__ __forceinline__ void setup_part(Frame& F, int l, int vc, int NV, int what  , const float* c_in, const float* c_ctx, const float* mod_w, const float* mod_b, const float* w_in, const float* w_out) {
    LAS float* sc = (LAS float*)F.lds;
    LAS float* red = (LAS float*)(F.lds + 24576);
    if (what & 1) {
    for (int i = F.tid; i < 3 * DM; i += 512) { const int v = i / DM, k = i - v * DM; const float cv = v < 2 ? c_in[v * DM + k] : c_ctx[k]; sc[i] = cv / (1.0f + __expf(-cv)); }
    __syncthreads();
    const int tx = F.tid & 7, ty = F.tid >> 3;
    for (int sl = vc; sl < 384; sl += NV) {
        const float* wp = mod_w + (size_t)l * DM * NMOD + sl * 32 + tx * 4;
        f32x4 a0 = {0.f, 0.f, 0.f, 0.f}, a1 = a0, a2 = a0;
#pragma unroll 8
        for (int i = 0; i < 32; ++i) { const int k = ty + 64 * i; const f32x4 w = *(const f32x4*)(wp + (size_t)k * NMOD);
            a0 += w * sc[k]; a1 += w * sc[DM + k]; a2 += w * sc[2 * DM + k]; }
        LAS float* rp = red + F.tid * 12;
        rp[0] = a0.x; rp[1] = a0.y; rp[2] = a0.z; rp[3] = a0.w; rp[4] = a1.x; rp[5] = a1.y; rp[6] = a1.z; rp[7] = a1.w; rp[8] = a2.x; rp[9] = a2.y; rp[10] = a2.z; rp[11] = a2.w;
        __syncthreads();
        if (F.tid < 96) { const int v = F.tid >> 5, col = F.tid & 31, txx = col >> 2, jj = col & 3; float s = 0.f;
            for (int t = 0; t < 64; ++t) s += red[(t * 8 + txx) * 12 + v * 4 + jj];
            ((float*)(F.ws + WS_MODS))[((size_t)(l * 3 + v)) * NMOD + sl * 32 + col] = s + mod_b[l * NMOD + sl * 32 + col]; }
        __syncthreads();
    }
    }
    if (!(what & 2)) return;
    LAS float* scr = (LAS float*)(F.lds + F.wave * 16384);
    const int nin = l == 0 ? NQKV0 : NQKV1, nbi = nin / 32, I_IN = 32 * nbi, I_OUT = 32 * 64;
    bf16* win = (bf16*)(F.ws + (l == 0 ? WS_WIN0 : WS_WIN1)); bf16* wout = (bf16*)(F.ws + (l == 0 ? WS_WOUT0 : WS_WOUT1));
    for (int it = vc * NWAVES + F.wave; it < I_IN + I_OUT; it += NV * NWAVES) {
        if (it < I_IN) { const int kb = it / nbi, nb = it - kb * nbi; transpose_item(w_in, DM, nin, win, 64 * kb, 32 * nb, 32 * nb, scr, F.lane); }
        else { const int r = it - I_IN, kb = r / 64, nb = r % 64; transpose_item(w_out, DM, DM, wout, 64 * kb, 32 * nb, 32 * nb, scr, F.lane); }
    }
}
__device__ __forceinline__ void p0_prologue(Frame& F, const float* c_in, const float* c_ctx, const float* mod_w, const float* mod_b, const float* ab_w_in, const float* ab_w_out) {
    { const int gi = blockIdx.x * 512 + F.tid;
      if (gi < 2048) { const int pos = gi >> 5, f = gi & 31; const float inv = __builtin_amdgcn_exp2f(-(float)f * (13.287712379549449f / 32.0f)); const float ang = (float)pos * inv;
          float* rt = (float*)(F.ws + WS_ROPE); rt[gi] = __cosf(ang); rt[2048 + gi] = __sinf(ang); } }
    setup_part(F, 0, (int)blockIdx.x, F.G, 3, c_in, c_ctx, mod_w, mod_b, ab_w_in, ab_w_out);
}

__device__ __forceinline__ void t_norm0(Frame& F, const float* x_in, const float* ctx_in, const float* norm_g) {
    for (int row = F.gw; row < NROWS; row += 2 * F.NGW) {
        const int row2 = row + F.NGW; const bool has2 = row2 < NROWS;
        f32x4 x1[8], x2[8], h[8];
        ld_row(in_row_ptr(x_in, ctx_in, row), F.lane, x1);
        if (has2) ld_row(in_row_ptr(x_in, ctx_in, row2), F.lane, x2);
        asm volatile("" ::: "memory");
        { const float r = row_rstd(x1);
          norm_mod(h, x1, r, fresh(norm_g), mods_ptr(F, 0, row, 1), mods_ptr(F, 0, row, 0), F.lane);
          st_row_bf16((bf16*)(F.ws + WS_H) + (size_t)row * DM, F.lane, h); }
        if (has2) { const float r = row_rstd(x2);
          norm_mod(h, x2, r, fresh(norm_g), mods_ptr(F, 0, row2, 1), mods_ptr(F, 0, row2, 0), F.lane);
          st_row_bf16((bf16*)(F.ws + WS_H) + (size_t)row2 * DM, F.lane, h); }
    }
}
__device__ __forceinline__ void t_prep(Frame& F, int layer, const float* q_norm, const float* k_norm) {
    const int ld = layer == 0 ? NQKV0 : NQKV1;
    const float* rt = (const float*)(F.ws + WS_ROPE);
    const int hs = F.lane >> 3, part = F.lane & 7, isc = part >> 2, fq = (part & 3) * 8, d0 = isc * 64 + fq;
    for (int row = F.gw; row < NROWS; row += F.NGW) {
        const int b = row / SB, s = row - b * SB; const bool lat = s >= CTXL;
        if (layer == 1 && !lat) continue;
        float cs[8], sn[8];
        if (lat) { const int t = s - CTXL; const int pos = isc ? (t & 63) : (t >> 6); const float* cp = fresh(rt) + pos * 32 + fq;
            const f32x4 c0 = *(const f32x4*)cp, c1 = *(const f32x4*)(cp + 4), s0 = *(const f32x4*)(cp + 2048), s1 = *(const f32x4*)(cp + 2052);
            cs[0] = c0.x; cs[1] = c0.y; cs[2] = c0.z; cs[3] = c0.w; cs[4] = c1.x; cs[5] = c1.y; cs[6] = c1.z; cs[7] = c1.w;
            sn[0] = s0.x; sn[1] = s0.y; sn[2] = s0.z; sn[3] = s0.w; sn[4] = s1.x; sn[5] = s1.y; sn[6] = s1.z; sn[7] = s1.w;
        } else {
#pragma unroll
            for (int i = 0; i < 8; ++i) { cs[i] = 1.f; sn[i] = 0.f; } }
        bf16* rp = (bf16*)(F.ws + WS_QKV) + (size_t)row * ld;
#pragma unroll
        for (int st = (layer == 0 ? 0 : 2); st < (layer == 0 ? 1 : 4); ++st) {
            const int hh = st * 8 + hs;
            int col; bool act = true, donorm = false; const float* g = k_norm;
            if (layer == 0) {
                if (hs < 2) col = 1024 + hs * 128; else { col = 2560 + ((hs - 2) & 1) * 128; donorm = true; }
                act = hs < 4 && (lat || donorm);
                if (!act) col = 0;
            } else col = hh * 128;
            v4u A = *(const v4u*)(rp + col + d0), C = *(const v4u*)(rp + col + d0 + 32);
            float a[8], c[8];
            a[0] = bf_lo(A.x); a[1] = bf_hi(A.x); a[2] = bf_lo(A.y); a[3] = bf_hi(A.y); a[4] = bf_lo(A.z); a[5] = bf_hi(A.z); a[6] = bf_lo(A.w); a[7] = bf_hi(A.w);
            c[0] = bf_lo(C.x); c[1] = bf_hi(C.x); c[2] = bf_lo(C.y); c[3] = bf_hi(C.y); c[4] = bf_lo(C.z); c[5] = bf_hi(C.z); c[6] = bf_lo(C.w); c[7] = bf_hi(C.w);
            if (layer == 0) {
                float ss = 0.f;
#pragma unroll
                for (int i = 0; i < 8; ++i) ss += a[i] * a[i] + c[i] * c[i];
                ss += __shfl_xor(ss, 1); ss += __shfl_xor(ss, 2); ss += __shfl_xor(ss, 4);
                const float r = 1.0f / sqrtf(ss * (1.0f / 128.0f) + EPS);
                const f32x4 g0 = *(const f32x4*)(g + d0), g1 = *(const f32x4*)(g + d0 + 4), g2 = *(const f32x4*)(g + d0 + 32), g3 = *(const f32x4*)(g + d0 + 36);
                const float ga[8] = {g0.x, g0.y, g0.z, g0.w, g1.x, g1.y, g1.z, g1.w}, gc[8] = {g2.x, g2.y, g2.z, g2.w, g3.x, g3.y, g3.z, g3.w};
#pragma unroll
                for (int i = 0; i < 8; ++i) { a[i] = donorm ? a[i] * r * ga[i] : a[i]; c[i] = donorm ? c[i] * r * gc[i] : c[i]; }
            }
            v4u oa, oc;
            { float o1[8], o2[8];
#pragma unroll
              for (int i = 0; i < 8; ++i) { o1[i] = a[i] * cs[i] - c[i] * sn[i]; o2[i] = c[i] * cs[i] + a[i] * sn[i]; }
              oa.x = pk2(o1[0], o1[1]); oa.y = pk2(o1[2], o1[3]); oa.z = pk2(o1[4], o1[5]); oa.w = pk2(o1[6], o1[7]);
              oc.x = pk2(o2[0], o2[1]); oc.y = pk2(o2[2], o2[3]); oc.z = pk2(o2[4], o2[5]); oc.w = pk2(o2[6], o2[7]); }
            if (act) { *(v4u*)(rp + col + d0) = oa; *(v4u*)(rp + col + d0 + 32) = oc; }
        }
    }
}
__device__ __forceinline__ void t_post_attn(Frame& F, int layer, const float* x_in, const float* ctx_in, const float* norm_g, const float* router_w) {
    const float* ng0 = norm_g + (size_t)layer * 4 * DM;
    const float* wr0 = router_w + (size_t)layer * DM * NEXP;
    for (int q = F.tid; q < DM * 4; q += NWAVES * 64) { const int c = q >> 2, eq = q & 3; const int pc = (c & ~15) | ((c >> 2) & 3) | ((c & 3) << 2);
        *(LAS f32x4*)(F.lds + pc * 64 + ((eq ^ ((c >> 4) & 3)) << 4)) = *(const f32x4*)(wr0 + c * 16 + eq * 4); }
    __syncthreads();
    const int rsw = (F.lane >> 2) & 3;
    const LAS unsigned char* wl0 = F.lds + (16 * (F.lane >> 2) + (F.lane & 3)) * 64 + ((0 ^ rsw) << 4);
    const LAS unsigned char* wl1 = F.lds + (16 * (F.lane >> 2) + (F.lane & 3)) * 64 + ((1 ^ rsw) << 4);
    const LAS unsigned char* wl2 = F.lds + (16 * (F.lane >> 2) + (F.lane & 3)) * 64 + ((2 ^ rsw) << 4);
    const LAS unsigned char* wl3 = F.lds + (16 * (F.lane >> 2) + (F.lane & 3)) * 64 + ((3 ^ rsw) << 4);
    for (int row = F.gw; row < NROWS; row += F.NGW) {
        const int b = row / SB, s = row - b * SB;
        if (layer == 1 && s < CTXL) continue;
        const float* ng = fresh(ng0);
        f32x4 y[8], x[8], h[8];
        ld_row_bf16((const bf16*)(F.ws + WS_YO) + (size_t)row * DM, F.lane, y);
        if (layer == 0) ld_row(in_row_ptr(x_in, ctx_in, row), F.lane, x); else ld_row_bf16((const bf16*)(F.ws + WS_XL) + (size_t)row * DM, F.lane, x);
        const float ry = row_rstd(y);
        const float* ga = mods_ptr(F, layer, row, 2);
#pragma unroll
        for (int j = 0; j < 8; ++j) { const int c = 4 * F.lane + 256 * j; x[j] = x[j] + *(const f32x4*)(ga + c) * (y[j] * ry * *(const f32x4*)(ng + DM + c)); }
        st_row_bf16((bf16*)(F.ws + WS_XL) + (size_t)row * DM, F.lane, x);
        const float rx = row_rstd(x);
        norm_mod(h, x, rx, ng + 2 * DM, mods_ptr(F, layer, row, 4), mods_ptr(F, layer, row, 3), F.lane);
        st_row_bf16((bf16*)(F.ws + WS_H) + (size_t)row * DM, F.lane, h);
        float lg[16];
#pragma unroll
        for (int e = 0; e < 16; ++e) lg[e] = 0.f;
#pragma unroll
        for (int j = 0; j < 8; ++j) {
            asm volatile("" ::: "memory");
#pragma unroll
            for (int i = 0; i < 4; ++i) { const float hv = h[j][i]; const int co = j * 16384 + i * 256;
                const f32x4 w0 = *(const LAS f32x4*)(wl0 + co), w1 = *(const LAS f32x4*)(wl1 + co), w2 = *(const LAS f32x4*)(wl2 + co), w3 = *(const LAS f32x4*)(wl3 + co);
                lg[0] += hv * w0.x; lg[1] += hv * w0.y; lg[2] += hv * w0.z; lg[3] += hv * w0.w; lg[4] += hv * w1.x; lg[5] += hv * w1.y; lg[6] += hv * w1.z; lg[7] += hv * w1.w;
                lg[8] += hv * w2.x; lg[9] += hv * w2.y; lg[10] += hv * w2.z; lg[11] += hv * w2.w; lg[12] += hv * w3.x; lg[13] += hv * w3.y; lg[14] += hv * w3.z; lg[15] += hv * w3.w; } }
        float mx = -1e30f;
#pragma unroll
        for (int e = 0; e < 16; ++e) { lg[e] = wave_sum(lg[e]); mx = fmaxf(mx, lg[e]); }
        float sum = 0.f;
#pragma unroll
        for (int e = 0; e < 16; ++e) { lg[e] = __expf(lg[e] - mx); sum += lg[e]; }
        const float rs = 1.0f / sum;
        float* aff = (float*)(F.ws + WS_AFF) + (size_t)b * NEXP * SB + s;
#pragma unroll
        for (int e = 0; e < 16; ++e) if (F.lane == e) aff[(size_t)e * SB] = lg[e] * rs;
    }
}
template <int VPT>
__device__ __forceinline__ void topk_problem(Frame& F, const float* vals, int N, int cap, int e, int rowbase, int slotbase, bool write_inv) {
    LAS int* hist = (LAS int*)F.lds;
    LAS int* wt = (LAS int*)(F.lds + 1024);
    LAS int* selw = (LAS int*)(F.lds + 1280);
    float v[VPT]; unsigned key[VPT];
#pragma unroll
    for (int k = 0; k < VPT; ++k) { const int i = F.tid * VPT + k; const bool ok = i < N; v[k] = ok ? vals[i] : 0.f; const unsigned u = __builtin_bit_cast(unsigned, v[k]);
        key[k] = ok ? ((u & 0x80000000u) ? ~u : (u | 0x80000000u)) : 0u; }
    unsigned prefix = 0u, maskb = 0u; int need = cap;
    for (int pass = 0; pass < 4; ++pass) {
        const int shift = 24 - 8 * pass;
        if (F.tid < 256) hist[F.tid] = 0;
        __syncthreads();
#pragma unroll
        for (int k = 0; k < VPT; ++k) { const int i = F.tid * VPT + k; if (i < N && (key[k] & maskb) == prefix) __hip_atomic_fetch_add(&hist[(key[k] >> shift) & 255u], 1, __ATOMIC_RELAXED, __HIP_MEMORY_SCOPE_WORKGROUP); }
        __syncthreads();
        if (F.wave == 0) {
            const int l = F.lane; const int h0 = hist[255 - 4 * l], h1 = hist[254 - 4 * l], h2 = hist[253 - 4 * l], h3 = hist[252 - 4 * l];
            const int sm = h0 + h1 + h2 + h3; const int incl = wave_incl_scan(sm, l); const int excl = incl - sm;
            const unsigned long long m = __ballot(incl >= need); const int fl = m ? (__ffsll((long long)m) - 1) : 63;
            if (l == fl) { int c = excl, bin;
                if (c + h0 >= need) bin = 255 - 4 * l; else { c += h0; if (c + h1 >= need) bin = 254 - 4 * l; else { c += h1; if (c + h2 >= need) bin = 253 - 4 * l; else { c += h2; bin = 252 - 4 * l; } } }
                selw[0] = bin; selw[1] = need - c; }
        }
        __syncthreads();
        prefix |= ((unsigned)selw[0]) << shift; maskb |= 0xFFu << shift; need = selw[1];
        __syncthreads();
    }
    int ceq = 0;
#pragma unroll
    for (int k = 0; k < VPT; ++k) { const int i = F.tid * VPT + k; if (i < N && key[k] == prefix) ++ceq; }
    int incl = wave_incl_scan(ceq, F.lane);
    if (F.lane == 63) wt[F.wave] = incl;
    __syncthreads();
    int eqbase = incl - ceq;
    for (int w = 0; w < F.wave; ++w) eqbase += wt[w];
    int csel = 0; bool sel[VPT];
#pragma unroll
    for (int k = 0; k < VPT; ++k) { const int i = F.tid * VPT + k; const bool ok = i < N; const bool eq = ok && key[k] == prefix;
        sel[k] = ok && (key[k] > prefix || (eq && eqbase < need)); if (eq) ++eqbase; if (sel[k]) ++csel; }
    incl = wave_incl_scan(csel, F.lane);
    if (F.lane == 63) wt[8 + F.wave] = incl;
    __syncthreads();
    int sbase = incl - csel;
    for (int w = 0; w < F.wave; ++w) sbase += wt[8 + w];
    int* RL = (int*)(F.ws + WS_RL) + e * EROWS; float* GT = (float*)(F.ws + WS_GATE) + e * EROWS; int* INV = (int*)(F.ws + WS_INV);
#pragma unroll
    for (int k = 0; k < VPT; ++k) { const int i = F.tid * VPT + k;
        if (i < N) { const int grow = rowbase + i;
            if (sel[k]) { const int slot = slotbase + sbase; ++sbase; RL[slot] = grow; GT[slot] = v[k]; if (write_inv) INV[grow * 16 + e] = slot; }
            else if (write_inv) INV[grow * 16 + e] = -1; } }
    __syncthreads();
}
__device__ __forceinline__ void t_topk(Frame& F, int layer) {
    const int nprob = layer == 0 ? 64 : 32;
    for (int p = blockIdx.x; p < nprob; p += F.G) {
        const int kind = p >> 5, q = p & 31, b = q >> 4, e = q & 15;
        const float* aff = (const float*)(F.ws + WS_AFF) + ((size_t)(b * NEXP + e)) * SB;
        if (kind == 0) topk_problem<8>(F, aff + CTXL, SEQ, CAP_L, e, b * SB + CTXL, b * CAP_L, true);
        else           topk_problem<1>(F, aff, CTXL, CAP_C, e, b * SB, 2 * CAP_L + b * CAP_C, true);
    }
}
__device__ __forceinline__ void t_post_moe(Frame& F, int layer, const float* norm_g, float* out) {
    const float* ng0 = norm_g + (size_t)layer * 4 * DM;
    const int* INV = (const int*)(F.ws + WS_INV); const float* GT = (const float*)(F.ws + WS_GATE);
    for (int row = F.gw; row < NROWS; row += F.NGW) {
        const int b = row / SB, s = row - b * SB;
        if (layer == 1 && s < CTXL) continue;
        const float* ng = fresh(ng0); const float* ng1 = fresh(norm_g + 4 * DM);
        f32x4 mo[8], x[8];
#pragma unroll
        for (int j = 0; j < 8; ++j) mo[j] = (f32x4){0.f, 0.f, 0.f, 0.f};
        const int invv = (F.lane < 16) ? INV[(size_t)row * 16 + F.lane] : -1;
        ld_row_bf16((const bf16*)(F.ws + WS_XL) + (size_t)row * DM, F.lane, x);
        unsigned long long em = __ballot(invv >= 0);
        while (em) {
            const int e0 = __builtin_ctzll(em); em &= em - 1;
            const bool two = em != 0; const int e1 = two ? __builtin_ctzll(em) : e0; if (two) em &= em - 1;
            const int s0 = __builtin_amdgcn_readlane(invv, e0), s1 = __builtin_amdgcn_readlane(invv, e1);
            const float g0 = GT[e0 * EROWS + s0], g1 = two ? GT[e1 * EROWS + s1] : 0.f;
            const bf16* y0 = (const bf16*)(F.ws + WS_YE) + ((size_t)(e0 * EROWS + s0)) * DM + 4 * F.lane;
            const bf16* y1 = (const bf16*)(F.ws + WS_YE) + ((size_t)(e1 * EROWS + s1)) * DM + 4 * F.lane;
            v2u w0[8], w1[8];
#pragma unroll
            for (int j = 0; j < 8; ++j) { w0[j] = *(const v2u*)(y0 + 256 * j); w1[j] = *(const v2u*)(y1 + 256 * j); }
#pragma unroll
            for (int j = 0; j < 8; ++j) { mo[j].x += g0 * bf_lo(w0[j].x); mo[j].y += g0 * bf_hi(w0[j].x); mo[j].z += g0 * bf_lo(w0[j].y); mo[j].w += g0 * bf_hi(w0[j].y); }
#pragma unroll
            for (int j = 0; j < 8; ++j) { mo[j].x += g1 * bf_lo(w1[j].x); mo[j].y += g1 * bf_hi(w1[j].x); mo[j].z += g1 * bf_lo(w1[j].y); mo[j].w += g1 * bf_hi(w1[j].y); }
        }
        const float rm = row_rstd(mo);
        const float* gf = mods_ptr(F, layer, row, 5);
#pragma unroll
        for (int j = 0; j < 8; ++j) { const int c = 4 * F.lane + 256 * j; x[j] = x[j] + *(const f32x4*)(gf + c) * (mo[j] * rm * *(const f32x4*)(ng + 3 * DM + c)); }
        if (layer == 0) {
            st_row_bf16((bf16*)(F.ws + WS_XL) + (size_t)row * DM, F.lane, x);
            f32x4 h[8]; const float rx = row_rstd(x);
            norm_mod(h, x, rx, ng1, mods_ptr(F, 1, row, 1), mods_ptr(F, 1, row, 0), F.lane);
            st_row_bf16((bf16*)(F.ws + WS_H) + (size_t)row * DM, F.lane, h);
        } else {
            float* op = out + ((size_t)(b * SEQ + s - CTXL)) * DM;
#pragma unroll
            for (int j = 0; j < 8; ++j) *(f32x4*)(op + 4 * F.lane + 256 * j) = x[j];
        }
    }
}

__device__ __forceinline__ void p_attn0(Frame& F, const float* ab_sink, const float* q_norm) {
    char* lds = (char*)F.lds;
    const bf16* QKV = (const bf16*)(F.ws + WS_QKV); bf16* Y = (bf16*)(F.ws + WS_Y);
    const int c = blockIdx.x;
    for (int u = c; u < 544; u += F.G) {
        att::Job J; J.kb0 = CTXL; J.mask = 0; J.dq = 0; J.use_sink = 0; J.sink_l2 = 0.f; J.lam = 0.f;
        int b, h, grpB; size_t qrow;
        if (u < 512) {
            const int uu = u & 255, x = uu & 7, i = uu >> 3, grp = x >> 1, idx = (x & 1) * 32 + i;
            b = grp >> 1; const int kv = grp & 1; h = kv * 4 + (idx >> 4); const int qb = idx & 15; grpB = u < 256;
            qrow = (size_t)b * SB + CTXL + qb * 256;
            if (grpB) J.NT = 68;
            else { const int q0 = qb * 256, lo = q0 - 128 < 0 ? 0 : q0 - 128, hiK = q0 + 384 > SEQ ? SEQ : q0 + 384;
                   J.NT = 4 + (hiK - lo) / 64; J.kb0 = CTXL + lo; J.mask = 1; J.dq = lo - q0; }
        } else { const int uu = u - 512; grpB = uu >> 4; b = (uu >> 3) & 1; h = uu & 7; qrow = (size_t)b * SB; J.NT = 4; }
        const int kv = h >> 2;
        if (!grpB) { J.use_sink = 1; J.sink_l2 = ab_sink[h] * 1.4426950408889634f; }
        const int qcol = grpB ? 1536 + h * 128 : h * 128, kcol = grpB ? 2560 + kv * 128 : 1024 + kv * 128, vcol = grpB ? 2816 + kv * 128 : 1280 + kv * 128;
        J.Q = QKV + qrow * NQKV0 + qcol; J.K = QKV + (size_t)b * SB * NQKV0 + kcol; J.V = QKV + (size_t)b * SB * NQKV0 + vcol;
        J.O = (void*)(Y + qrow * DM + (grpB ? 1024 : 0) + h * 128);
        J.qmode = (grpB ? 1 : 0) | (u < 512 ? 2 : 0); J.t0 = u < 512 ? (int)(qrow - (size_t)b * SB - CTXL) : 0; J.qg = q_norm; J.rt = (const float*)(F.ws + WS_ROPE);
        __syncthreads();
        if (u < 256) att::attn_unit128s<NQKV0, false>(J, lds);
        else att::attn_unit128s<NQKV0, true>(J, lds);
    }
}
__device__ __forceinline__ void p_attn1(Frame& F, const float* dif_lambda, const float* dif_subln) {
    char* lds = (char*)F.lds;
    const bf16* QKV = (const bf16*)(F.ws + WS_QKV);
    const float* lp = dif_lambda;
    const float s01 = wave_sum(lp[F.lane] * lp[128 + F.lane] + lp[64 + F.lane] * lp[192 + F.lane]);
    const float s23 = wave_sum(lp[256 + F.lane] * lp[384 + F.lane] + lp[320 + F.lane] * lp[448 + F.lane]);
    const float lam = __uint_as_float(__builtin_amdgcn_readfirstlane(__float_as_uint(__expf(s01) - __expf(s23) + LAMBDA_INIT)));
    for (int pidx = blockIdx.x; pidx < 256; pidx += F.G) {
        const int x = pidx & 7, i = pidx >> 3;
        const int b = x >> 2, hp = x & 3, h = hp * 2 + (i >> 4), qb = i & 15;
        const size_t qrow = (size_t)b * SB + CTXL + qb * 256;
        att::Job256 J; J.NT = 68; J.t0 = qb * 256; J.rt = (const float*)(F.ws + WS_ROPE);
        J.V = QKV + (size_t)b * SB * NQKV1 + 4096 + h * 256;
        J.O0 = (const bf16*)(F.ws + WS_YO) + qrow * DM + h * 256; J.lam = lam; J.sc = 1.0f - LAMBDA_INIT; J.g = dif_subln;
        J.Q = QKV + qrow * NQKV1 + (2 * h) * 128; J.K = QKV + (size_t)b * SB * NQKV1 + 2048 + (2 * h) * 128;
        J.O = (bf16*)(F.ws + WS_YO) + qrow * DM + h * 256;
        __syncthreads();
        att::attn_unit256s<NQKV1, 0>(J, lds);
        J.Q += 128; J.K += 128;
        J.O = (bf16*)(F.ws + WS_Y) + qrow * DM + h * 256;
        __syncthreads();
        att::attn_unit256s<NQKV1, 1>(J, lds);
    }
}

#define IN(k) (lo <= (k) && (k) < hi)
#define SEAM(k) do { if (IN((k) + 1)) xcd_barrier(bar); } while (0)
#define INP(k) ({ int k_ = (k); asm volatile("" : "+s"(k_)); (const float*)(const __attribute__((address_space(1))) float*)args.in[k_]; })
#ifndef PROBE_MASK
#define PROBE_MASK 0
#endif
#if defined(PROBE_WAIT)
#define STAMP(k) do { if (blockIdx.x == 0 && F.tid == 0) { volatile unsigned long long* tm_ = (volatile unsigned long long*)(F.ws + WS_CTL + 2048); const unsigned long long now_ = __builtin_amdgcn_s_memrealtime(); \
    if (tm_[2]) tm_[1] += now_ - tm_[0]; tm_[0] = now_; tm_[2] = (((unsigned long long)(PROBE_WAIT) >> (k)) & 1ull); } } while (0)
#else
#define STAMP(k) do { } while (0)
#endif
#define PROBED(k) ((k) >= 0 && ((PROBE_MASK >> ((k) < 0 ? 0 : (k))) & 1))
#define REP2(k, ...) do { __VA_ARGS__; if constexpr (PROBED(k)) { __syncthreads(); __VA_ARGS__; } } while (0)
#define REP(k) for (int rep_ = 0; rep_ < (((k) >= 0 && ((PROBE_MASK >> ((k) < 0 ? 0 : (k))) & 1)) ? 2 : 1); ++rep_, __syncthreads())
#define FRESH() do { asm volatile("" : "+s"(F.ws)); int t_ = threadIdx.x; asm volatile("" : "+v"(t_)); F.tid = t_; F.lane = t_ & 63; F.wave = __builtin_amdgcn_readfirstlane(t_ >> 6); \
    F.gw = blockIdx.x * NWAVES + F.wave; } while (0)
template <int layer>
__device__ __forceinline__ void layer_phases(Frame& F, const Args& args, const int lo, const int hi, const XcdBarrier& bar) {

        const int pb = 2 + 11 * layer;
        if (IN(pb + 0)) {
            FRESH(); STAMP(pb + 0);
            pg8::Gemm g{(const pg8::bf16_t*)(F.ws + WS_H), (const pg8::bf16_t*)(F.ws + (layer == 0 ? WS_WIN0 : WS_WIN1)), DM, layer == 0 ? NQKV0 : NQKV1, DM};
            pg8::DenseOrder S; S.init(NROWS / 256, (layer == 0 ? NQKV0 : NQKV1) / 256, F.G, (int)blockIdx.x, 0);
            pg8::EpiStoreBf16 E{(pg8::bf16_t*)(F.ws + WS_QKV), layer == 0 ? NQKV0 : NQKV1, 1 << 20};
            pg8::gemm_phase<pg8::EpiStoreBf16, pg8::DenseOrder, true, true>(F.lds, g, S, E);
            if (layer == 0) {
                const int nU = (NROWS / 256) * (NQKV0 / 256), first_idle = nU - F.G;
                int vc = (int)blockIdx.x, NV = F.G;
                if (first_idle > 0 && first_idle < F.G) { vc -= first_idle; NV -= first_idle; }
                if (vc >= 0) { __syncthreads(); setup_part(F, 1, vc, NV, 1, INP(1), INP(3), INP(4), INP(5), INP(12), INP(13)); }
            }
            SEAM(pb + 0);
        }
        if (IN(pb + 1)) { FRESH(); STAMP(pb + 1); t_prep(F, layer, INP(10), INP(11)); SEAM(pb + 1); }
        if (IN(pb + 2)) { FRESH(); STAMP(pb + 2); REP(pb + 2) { if (layer == 0) p_attn0(F, INP(9), INP(10)); else p_attn1(F, INP(14), INP(15)); } SEAM(pb + 2); }
        if (IN(pb + 4)) {
            FRESH(); STAMP(pb + 4);
            pg8::Gemm g{(const pg8::bf16_t*)(F.ws + WS_Y), (const pg8::bf16_t*)(F.ws + (layer == 0 ? WS_WOUT0 : WS_WOUT1)), DM, DM, DM};
            pg8::DenseOrder S; S.init(layer == 0 ? 34 : 32, DM / 256, F.G, (int)blockIdx.x, layer);
            pg8::EpiStoreBf16 E{(pg8::bf16_t*)(F.ws + WS_YO), DM, 1 << 20};
            pg8::gemm_phase<pg8::EpiStoreBf16, pg8::DenseOrder, true, true>(F.lds, g, S, E);
            if (layer == 0) {
                const int first_idle = 34 * (DM / 256) - F.G;
                int vc = (int)blockIdx.x, NV = F.G;
                if (first_idle > 0 && first_idle < F.G) { vc -= first_idle; NV -= first_idle; }
                if (vc >= 0) { __syncthreads(); setup_part(F, 1, vc, NV, 2, INP(1), INP(3), INP(4), INP(5), INP(12), INP(13)); }
            }
            SEAM(pb + 4);
        }
        if (IN(pb + 5)) { FRESH(); STAMP(pb + 5); REP(layer == 0 ? pb + 5 : -2) t_post_attn(F, layer, INP(0), INP(2), INP(6), INP(16)); SEAM(pb + 5); }
        if (IN(pb + 6)) { FRESH(); STAMP(pb + 6); REP(pb + 6) t_topk(F, layer); SEAM(pb + 6); }
        if (IN(pb + 8)) {
            FRESH(); STAMP(pb + 8);
            pg8::BMoeGU Bm{INP(17) + (size_t)layer * 16 * DM * DM, INP(18) + (size_t)layer * 16 * DM * DM};
            pg8::MoeOrder S; S.init(layer == 0 ? 5 : 4, 16, F.G, (int)blockIdx.x);
            pg8::EpiSwiGLU E{(pg8::bf16_t*)(F.ws + WS_HM), DM};
            REP2(pb + 8, pg8::gemm_phase_w<pg8::EpiSwiGLU, pg8::MoeOrder, pg8::BMoeGU, true>(F.lds, (const pg8::bf16_t*)(F.ws + WS_H), DM, Bm, S, E, (const int*)(F.ws + WS_RL), layer == 0 ? 1088 : 1024));
            SEAM(pb + 8);
        }
        if (IN(pb + 9)) {
            FRESH(); STAMP(pb + 9);
            pg8::BMoeDn Bm{INP(19) + (size_t)layer * 16 * DM * DM};
            pg8::MoeOrder S; S.init(layer == 0 ? 5 : 4, 8, F.G, (int)blockIdx.x);
            pg8::EpiStoreBf16 E{(pg8::bf16_t*)(F.ws + WS_YE), DM, 8};
            REP2(pb + 9, pg8::gemm_phase_w<pg8::EpiStoreBf16, pg8::MoeOrder, pg8::BMoeDn>(F.lds, (const pg8::bf16_t*)(F.ws + WS_HM), DM, Bm, S, E));
            SEAM(pb + 9);
        }
        if (IN(pb + 10)) { FRESH(); STAMP(pb + 10); REP(layer == 1 ? pb + 10 : -2) t_post_moe(F, layer, INP(6), args.out); SEAM(pb + 10); }
}
constexpr int NPHASE = 24;
__global__ void __launch_bounds__(NWAVES * 64, 2) fwd(Args args) {
    extern __shared__ __attribute__((aligned(16))) unsigned char lds[];
    Frame F;
    F.lds = (LAS unsigned char*)lds;
    F.tid = threadIdx.x; F.lane = F.tid & 63; F.wave = __builtin_amdgcn_readfirstlane(F.tid >> 6);
    F.G = gridDim.x; F.gw = blockIdx.x * NWAVES + F.wave; F.NGW = F.G * NWAVES;
    F.ws = (__attribute__((address_space(1))) unsigned char*)args.ws;
    const int lo = args.ph_lo, hi = args.ph_hi;
    const bool multi = (hi - lo) > 1;
    XcdBarrier bar; bar.bar = (unsigned*)(F.ws + WS_CTL) + CW_BAR; bar.x = 0; bar.st = nullptr;
    if (multi) bar = xcd_barrier_post((unsigned*)(F.ws + WS_CTL) + CW_BAR, (unsigned*)(F.ws + WS_CTL) + CW_BST + 16 * blockIdx.x);

    if (IN(0)) { FRESH(); STAMP(0); REP(0) p0_prologue(F, INP(1), INP(3), INP(4), INP(5), INP(7), INP(8)); SEAM(0); }
    if (IN(1)) { FRESH(); STAMP(1); REP(1) t_norm0(F, INP(0), INP(2), INP(6)); SEAM(1); }
    layer_phases<0>(F, args, lo, hi, bar);
    layer_phases<1>(F, args, lo, hi, bar);
#if defined(PROBE_WAIT)
    if (multi) { STAMP(63);
        if (blockIdx.x == 0 && F.tid == 0) { volatile unsigned long long* tm_ = (volatile unsigned long long*)(F.ws + WS_CTL + 2048); const unsigned long long t0_ = __builtin_amdgcn_s_memrealtime(), w_ = tm_[1];
            while (__builtin_amdgcn_s_memrealtime() - t0_ < w_) __builtin_amdgcn_s_sleep(4); }
        xcd_barrier(bar); }
#endif
}

extern "C" void kernel_launch(void* const* d_in, const int* in_sizes, int n_in, void* d_out, int out_size, void* d_ws, size_t ws_size, hipStream_t stream) {
    static int grid = 0;
    if (grid == 0) {
        if (n_in != 20 || out_size != NBATCH * SEQ * DM || ws_size < WS_END) { fprintf(stderr, "kernel_launch: shape mismatch (n_in %d out %d ws %zu need %zu)\n", n_in, out_size, ws_size, (size_t)WS_END); grid = -1; return; }
        int dev = 0, cus = 0, per_cu = 0;
        if (hipGetDevice(&dev) != hipSuccess || hipDeviceGetAttribute(&cus, hipDeviceAttributeMultiprocessorCount, dev) != hipSuccess) { grid = -1; return; }
        if (hipFuncSetAttribute((const void*)fwd, hipFuncAttributeMaxDynamicSharedMemorySize, LDS_BYTES) != hipSuccess) { fprintf(stderr, "kernel_launch: hipFuncSetAttribute failed\n"); grid = -1; return; }
        if (hipOccupancyMaxActiveBlocksPerMultiprocessor(&per_cu, (const void*)fwd, NWAVES * 64, LDS_BYTES) != hipSuccess || per_cu < 1)
            fprintf(stderr, "kernel_launch: note: occupancy query reports %d workgroups per CU\n", per_cu);
        (void)hipGetLastError();
        grid = cus;
    }
    if (grid < 0) return;
    if (hipMemsetAsync((char*)d_ws + WS_CTL, 0, CTL_ZERO_BYTES, stream) != hipSuccess) return;
    Args a{};
    for (int i = 0; i < 20; ++i) a.in[i] = (const float*)d_in[i];
    a.out = (float*)d_out; a.ws = (unsigned char*)d_ws;
#if MK_ONE_LAUNCH
    a.ph_lo = 0; a.ph_hi = NPHASE;
    hipLaunchKernelGGL(fwd, dim3(grid), dim3(NWAVES * 64), LDS_BYTES, stream, a);
#if defined(PROBE_EXTRA)
    { const int extra[] = {PROBE_EXTRA}; for (int ph : extra) { a.ph_lo = ph; a.ph_hi = ph + 1; hipLaunchKernelGGL(fwd, dim3(grid), dim3(NWAVES * 64), LDS_BYTES, stream, a); } }
#endif
#else
    for (int ph = 0; ph < NPHASE; ++ph) {
        if (ph == 5) continue;
        a.ph_lo = ph; a.ph_hi = ph + 1;
        hipLaunchKernelGGL(fwd, dim3(grid), dim3(NWAVES * 64), LDS_BYTES, stream, a);
    }
#endif
    const hipError_t le = hipPeekAtLastError();
    if (le != hipSuccess) fprintf(stderr, "kernel_launch: launch failed: %s\n", hipGetErrorName(le));
}
```

```cpp
#include <hip/hip_runtime.h>
#include <cstdio>
#include <cstdint>

#ifndef MK_ONE_LAUNCH
#define MK_ONE_LAUNCH 1
#endif

namespace pg8 {
#define PG8_LAS __attribute__((address_space(3)))
typedef unsigned short bf16_t;
typedef short bf16x8 __attribute__((ext_vector_type(8)));
typedef float f32x4 __attribute__((ext_vector_type(4)));
typedef unsigned u32x4 __attribute__((ext_vector_type(4)));
constexpr int BM = 256, BK = 64, HALF = 128, HTB = HALF * BK * 2  , STAGE_BYTES = 8 * HTB, NXCD = 8, WGM = 8;

__host__ __device__ __forceinline__ int lds_byte(int r, int c) { const int st = (r >> 4) * 2 + (c >> 5), rr = r & 15, cc = c & 31, ob = rr * 64 + cc * 2; return st * 1024 + (ob ^ (((ob >> 9) & 1) << 5)); }
__host__ __device__ __forceinline__ void stage_rc(int b, int& R, int& C) { const int st = b / 1024, sb = b % 1024, swz = sb ^ (((sb >> 9) & 1) << 5); R = (st >> 1) * 16 + swz / 64; C = (st & 1) * 32 + (swz % 64) / 2; }
__host__ __device__ __forceinline__ int perm32(int rho) { const int n = rho >> 4, i = rho & 15; return 8 * (i >> 2) + 4 * n + (i & 3); }

struct Unit { int pm, pn, kc; };
struct Gemm { const bf16_t* A; const bf16_t* Bt; int ld, N, K; };

struct StaticOrder {
    int nM, nN, nwg, G, c;
    __host__ __device__ void init(int M, int N, int G_, int c_) { nM = M / BM; nN = N / BM; nwg = nM * nN; G = G_; c = c_; }
    __host__ __device__ bool next(int i, Unit& u) const {
        const long L = (long)i * G + c; if (L >= nwg) return false;
        int wgid = (int)L; { const int q = nwg / NXCD, r = nwg % NXCD, xcd = wgid % NXCD, off = wgid / NXCD; wgid = (xcd < r ? xcd * (q + 1) : r * (q + 1) + (xcd - r) * q) + off; }
        const int nig = WGM * nN, gid = wgid / nig, fm = gid * WGM, gsz = (nM - fm) < WGM ? (nM - fm) : WGM;
        u.pm = fm + ((wgid % nig) % gsz); u.pn = (wgid % nig) / gsz; return true;
    }
    __device__ __forceinline__ void a_ready(const Unit&) const {}
    __device__ __forceinline__ void done(const Unit&) const {}
};

__device__ __forceinline__ unsigned cvt_pk_bf16(float lo, float hi) { unsigned r; asm volatile("v_cvt_pk_bf16_f32 %0, %1, %2" : "=v"(r) : "v"(lo), "v"(hi)); return r; }
struct DenseOrder {
    StaticOrder so; int kind;
    __device__ void init(int nM, int nN, int G_, int c_, int kind_) { so.init(nM * BM, nN * BM, G_, c_); kind = kind_; }
    __device__ bool next(int i, Unit& u) const {
        if (!so.next(i, u)) return false;
        u.kc = 0;
        if (kind == 1) { const int b = u.pm >> 4, j = u.pm & 15; u.pm = 17 * b + 1 + j; }
        return true;
    }
    __device__ __forceinline__ int krot(const Unit& u) const { return (u.pm & 3) * 8; }
    __device__ __forceinline__ void a_ready(const Unit&) const {}
    __device__ __forceinline__ void done(const Unit&) const {}
};
struct CtxSplitOrder {
    int c;
    __device__ bool next(int i, Unit& u) const { if (i != 0 || c >= 64) return false; u.pm = 17 * (c >> 5); u.pn = (c >> 2) & 7; u.kc = c & 3; return true; }
    __device__ __forceinline__ void a_ready(const Unit&) const {}
    __device__ __forceinline__ void done(const Unit&) const {}
};
struct MoeOrder {
    int NP, NJ, nU, G, c, lim;
    __device__ void init(int NP_, int NJ_, int G_, int c_) { NP = NP_; NJ = NJ_; nU = 16 * NP_ * NJ_; G = G_; c = c_; lim = nU; }
    __device__ bool next(int i, Unit& u) const {
        const int L = i * G + c; if (L >= lim) return false;
        const int xcd = L & 7, off = L >> 3, id = xcd * (nU >> 3) + off;
        const int per = NJ * NP, e = id / per, rem = id - e * per, j = rem / NP, p = rem - j * NP;
        u.pm = 5 * e + p; u.pn = NJ * e + j; u.kc = 0; return true;
    }
    __device__ __forceinline__ int krot(const Unit& u) const { const int p = u.pm % 5; return NP == 4 ? p * 8 : p * 6; }
    __device__ __forceinline__ void a_ready(const Unit&) const {}
    __device__ __forceinline__ void done(const Unit&) const {}
};

struct MoeOrderTail {
    int c;
    __device__ bool next(int i, Unit& u) const {
        if (i != 0) return false;
        const int xcd = c & 7, k = c >> 3, id = xcd * 80 + 64 + (k >> 1), e = id / 40, rem = id - 40 * e, j = rem / 5, p = rem - 5 * j;
        u.pm = 5 * e + p; u.pn = 8 * e + j; u.kc = k & 1; return true;
    }
    __device__ __forceinline__ int krot(const Unit&) const { return 0; }
    __device__ __forceinline__ void a_ready(const Unit&) const {}
    __device__ __forceinline__ void done(const Unit&) const {}
};
typedef __amdgpu_buffer_rsrc_t rsrc_t;
__device__ __forceinline__ rsrc_t wt_rsrc(void* base) { return __builtin_amdgcn_make_buffer_rsrc(base, 0, 0x7fffffff, 0x00020000); }
__device__ __forceinline__ void st16_wt(rsrc_t r, unsigned byteoff, u32x4 v) { __builtin_amdgcn_raw_buffer_store_b128(v, r, (int)byteoff, 0, 0); }
struct EpiStoreBf16 {
    static constexpr bool PERM = true, AFTER_DRAIN = false;
    bf16_t* O; int ldc; int nmod;
    __device__ __forceinline__ void operator()(const f32x4 (&acc)[2][2][4][2], const Unit& u, int wr, int wc, int fr, int fq) const {
        const int row0 = u.pm * BM + wr * 64 + fr, col0 = (u.pn % nmod) * BM + wc * 32 + 8 * fq;
        const rsrc_t rs = wt_rsrc(O);
#pragma unroll
        for (int ai = 0; ai < 2; ++ai)
#pragma unroll
            for (int m = 0; m < 4; ++m) { const unsigned ro = (unsigned)(((size_t)(row0 + ai * HALF + m * 16) * ldc + col0) * 2);
#pragma unroll
                for (int bj = 0; bj < 2; ++bj) { const f32x4 v0 = acc[ai][bj][m][0], v1 = acc[ai][bj][m][1];
                    u32x4 w; w.x = cvt_pk_bf16(v0[0], v0[1]); w.y = cvt_pk_bf16(v0[2], v0[3]); w.z = cvt_pk_bf16(v1[0], v1[1]); w.w = cvt_pk_bf16(v1[2], v1[3]);
                    st16_wt(rs, ro + bj * HALF * 2, w); } }
    }
};
struct EpiStoreBf16K {
    static constexpr bool PERM = true, AFTER_DRAIN = false;
    bf16_t* O; long d1; int ldc; int nmod;
    __device__ __forceinline__ void operator()(const f32x4 (&acc)[2][2][4][2], const Unit& u, int wr, int wc, int fr, int fq) const {
        const int row0 = u.pm * BM + wr * 64 + fr, col0 = (u.pn % nmod) * BM + wc * 32 + 8 * fq;
        const rsrc_t rs = wt_rsrc(O + (long)u.kc * d1);
#pragma unroll
        for (int ai = 0; ai < 2; ++ai)
#pragma unroll
            for (int m = 0; m < 4; ++m) { const unsigned ro = (unsigned)(((size_t)(row0 + ai * HALF + m * 16) * ldc + col0) * 2);
#pragma unroll
                for (int bj = 0; bj < 2; ++bj) { const f32x4 v0 = acc[ai][bj][m][0], v1 = acc[ai][bj][m][1];
                    u32x4 w; w.x = cvt_pk_bf16(v0[0], v0[1]); w.y = cvt_pk_bf16(v0[2], v0[3]); w.z = cvt_pk_bf16(v1[0], v1[1]); w.w = cvt_pk_bf16(v1[2], v1[3]);
                    st16_wt(rs, ro + bj * HALF * 2, w); } }
    }
};
struct EpiStoreF32 {
    static constexpr bool PERM = true, AFTER_DRAIN = false;
    float* O; int ldc;
    __device__ __forceinline__ void operator()(const f32x4 (&acc)[2][2][4][2], const Unit& u, int wr, int wc, int fr, int fq) const {
        const int row0 = u.pm * BM + wr * 64 + fr, col0 = u.pn * BM + wc * 32 + 8 * fq;
#pragma unroll
        for (int ai = 0; ai < 2; ++ai)
#pragma unroll
            for (int m = 0; m < 4; ++m) { float* rowp = O + (size_t)(row0 + ai * HALF + m * 16) * ldc + col0;
#pragma unroll
                for (int bj = 0; bj < 2; ++bj) { *(f32x4*)(rowp + bj * HALF) = acc[ai][bj][m][0]; *(f32x4*)(rowp + bj * HALF + 4) = acc[ai][bj][m][1]; } }
    }
};
struct EpiPartF32 {
    static constexpr bool PERM = true, AFTER_DRAIN = false;
    float* O; int ldc;
    __device__ __forceinline__ void operator()(const f32x4 (&acc)[2][2][4][2], const Unit& u, int wr, int wc, int fr, int fq) const {
        const int row0 = (u.pm / 17) * BM + wr * 64 + fr, col0 = u.pn * BM + wc * 32 + 8 * fq; float* Ob = O + (size_t)u.kc * 512 * ldc;
#pragma unroll
        for (int ai = 0; ai < 2; ++ai)
#pragma unroll
            for (int m = 0; m < 4; ++m) { float* rowp = Ob + (size_t)(row0 + ai * HALF + m * 16) * ldc + col0;
#pragma unroll
                for (int bj = 0; bj < 2; ++bj) { *(f32x4*)(rowp + bj * HALF) = acc[ai][bj][m][0]; *(f32x4*)(rowp + bj * HALF + 4) = acc[ai][bj][m][1]; } }
    }
};
__device__ __forceinline__ float silu_f(float g) { return g * __builtin_amdgcn_rcpf(1.0f + __builtin_amdgcn_exp2f(-1.4426950408889634f * g)); }
struct EpiSwiGLU {
    static constexpr bool PERM = true, AFTER_DRAIN = false;
    bf16_t* O; int ldc;
    __device__ __forceinline__ void operator()(const f32x4 (&acc)[2][2][4][2], const Unit& u, int wr, int wc, int fr, int fq) const {
        const int row0 = u.pm * BM + wr * 64 + fr, col0 = (u.pn & 15) * HALF + wc * 32 + 8 * fq;
        const rsrc_t rs = wt_rsrc(O);
#pragma unroll
        for (int ai = 0; ai < 2; ++ai)
#pragma unroll
            for (int m = 0; m < 4; ++m) { const unsigned ro = (unsigned)(((size_t)(row0 + ai * HALF + m * 16) * ldc + col0) * 2);
                const f32x4 g0 = acc[ai][0][m][0], g1 = acc[ai][0][m][1], u0 = acc[ai][1][m][0], u1 = acc[ai][1][m][1];
                u32x4 w;
                w.x = cvt_pk_bf16(silu_f(g0[0]) * u0[0], silu_f(g0[1]) * u0[1]); w.y = cvt_pk_bf16(silu_f(g0[2]) * u0[2], silu_f(g0[3]) * u0[3]);
                w.z = cvt_pk_bf16(silu_f(g1[0]) * u1[0], silu_f(g1[1]) * u1[1]); w.w = cvt_pk_bf16(silu_f(g1[2]) * u1[2], silu_f(g1[3]) * u1[3]);
                st16_wt(rs, ro, w); }
    }
};

template <class Epi, class Sched, bool ALIGN_EPI = false, bool SP2 = false>
__device__ __forceinline__ void gemm_phase(PG8_LAS unsigned char* lds, const Gemm g, const Sched& S, const Epi& E) {
    const int tid = threadIdx.x, wid = __builtin_amdgcn_readfirstlane(tid >> 6), lane = tid & 63, wr = wid >> 2, wc = wid & 3, fr = lane & 15, fq = lane >> 4;
    const int K = g.K, nt = K / BK;
    unsigned voffA[2], voffB[2];
#pragma unroll
    for (int i = 0; i < 2; ++i) { int R, C; stage_rc(tid * 16 + i * 8192, R, C); const int Rb = Epi::PERM ? ((R & ~31) + perm32(R & 31)) : R;
        voffA[i] = (unsigned)(R * g.ld + C) * 2u; voffB[i] = (unsigned)(Rb * g.ld + C) * 2u; }
    const size_t kstep = (size_t)(BK * 2);
    const size_t hstep = (size_t)HALF * g.ld * 2;
    const size_t tstep = 2 * hstep;
    const unsigned ldsw = (unsigned)wid * 1024u;
    const int aoff = lds_byte(wr * 64 + fr, fq * 8), boff = lds_byte(wc * 32 + fr, fq * 8);
#define PG8_SA(b, h) (((b) * 2 + (h)) * HTB)
#define PG8_SB(b, h) ((4 + (b) * 2 + (h)) * HTB)
#define PG8_STAGE(bufoff, gbase, voff) do { _Pragma("unroll") for (int _i = 0; _i < 2; ++_i) \
        __builtin_amdgcn_global_load_lds((const unsigned*)((const char*)(gbase) + (voff)[_i]), (PG8_LAS unsigned*)(lds + (bufoff) + ldsw + _i * 8192), 16, 0, 0); } while (0)
#define PG8_LDA(dst, b, h) do { _Pragma("unroll") for (int m = 0; m < 4; ++m) _Pragma("unroll") for (int k = 0; k < 2; ++k) dst[m][k] = *(const PG8_LAS bf16x8*)(lds + PG8_SA(b, h) + aoff + m * 2048 + k * 1024); } while (0)
#define PG8_LDB(dst, b, h) do { _Pragma("unroll") for (int n = 0; n < 2; ++n) _Pragma("unroll") for (int k = 0; k < 2; ++k) dst[n][k] = *(const PG8_LAS bf16x8*)(lds + PG8_SB(b, h) + boff + n * 2048 + k * 1024); } while (0)
#define PG8_MMA(ai, bj, At, Bt) do { __builtin_amdgcn_s_setprio(1); _Pragma("unroll") for (int m = 0; m < 4; ++m) _Pragma("unroll") for (int n = 0; n < 2; ++n) _Pragma("unroll") for (int k = 0; k < 2; ++k) \
        acc[ai][bj][m][n] = __builtin_amdgcn_mfma_f32_16x16x32_bf16(Bt[n][k], At[m][k], acc[ai][bj][m][n], 0, 0, 0); __builtin_amdgcn_s_setprio(0); } while (0)
#define PG8_WAIT_V(n) asm volatile("s_waitcnt vmcnt(" #n ")" ::: "memory")
#define PG8_WAIT_L(n) asm volatile("s_waitcnt lgkmcnt(" #n ")" ::: "memory")
#define PG8_BAR __builtin_amdgcn_s_barrier()
#define PG8_SCHED __builtin_amdgcn_sched_barrier(0)
    Unit cur, nxt; int ui = 0;
    if (!S.next(0, cur)) return;
    f32x4 acc[2][2][4][2];
#pragma unroll
    for (int a = 0; a < 2; ++a)
#pragma unroll
        for (int b = 0; b < 2; ++b)
#pragma unroll
            for (int m = 0; m < 4; ++m)
#pragma unroll
                for (int n = 0; n < 2; ++n) acc[a][b][m][n] = (f32x4){0.f, 0.f, 0.f, 0.f};
    bf16x8 At[4][2], B0[2][2], B1[2][2];
    const char* cA = (const char*)g.A + (size_t)cur.pm * tstep + (size_t)cur.kc * K * 2; const char* cB = (const char*)g.Bt + (size_t)cur.pn * tstep + (size_t)cur.kc * K * 2;
    S.a_ready(cur);
    if constexpr (SP2) {
        PG8_STAGE(PG8_SB(0, 0), cB, voffB); PG8_STAGE(PG8_SB(0, 1), cB + hstep, voffB); PG8_STAGE(PG8_SA(0, 0), cA, voffA); PG8_STAGE(PG8_SA(0, 1), cA + hstep, voffA);
        if (wr == 1) PG8_BAR;
        PG8_WAIT_V(2); PG8_BAR;
        PG8_STAGE(PG8_SB(1, 0), cB + kstep, voffB); PG8_STAGE(PG8_SA(1, 0), cA + kstep, voffA); PG8_STAGE(PG8_SB(1, 1), cB + hstep + kstep, voffB);
        PG8_WAIT_V(6); PG8_BAR;
    } else {
        PG8_STAGE(PG8_SB(0, 0), cB, voffB); PG8_STAGE(PG8_SA(0, 0), cA, voffA); PG8_STAGE(PG8_SB(0, 1), cB + hstep, voffB); PG8_STAGE(PG8_SA(0, 1), cA + hstep, voffA);
        if (wr == 1) PG8_BAR;
        PG8_WAIT_V(4); PG8_BAR;
        PG8_STAGE(PG8_SB(1, 0), cB + kstep, voffB); PG8_STAGE(PG8_SA(1, 0), cA + kstep, voffA); PG8_STAGE(PG8_SB(1, 1), cB + hstep + kstep, voffB);
        PG8_WAIT_V(6); PG8_BAR;
    }
    for (;;) {
        const bool has_next = S.next(ui + 1, nxt);
        const char* nA = has_next ? (const char*)g.A + (size_t)nxt.pm * tstep + (size_t)nxt.kc * K * 2 : cA; const char* nB = has_next ? (const char*)g.Bt + (size_t)nxt.pn * tstep + (size_t)nxt.kc * K * 2 : cB;
        for (int t = 0; t < nt; t += 2) {
            const bool last = (t == nt - 2);
            const char* a1 = cA + (size_t)(t + 1) * kstep;
            const char* a2 = last ? nA : cA + (size_t)(t + 2) * kstep; const char* b2 = last ? nB : cB + (size_t)(t + 2) * kstep;
            const char* a3 = a2 + kstep; const char* b3 = b2 + kstep;
            if (last && has_next) S.a_ready(nxt);
            if constexpr (SP2) {
            PG8_LDB(B0, 0, 0); PG8_LDB(B1, 0, 1); PG8_SCHED; PG8_LDA(At, 0, 0); PG8_STAGE(PG8_SA(1, 1), a1 + hstep, voffA);
            PG8_WAIT_V(8); PG8_WAIT_L(0); PG8_BAR; PG8_MMA(0, 0, At, B0); PG8_MMA(0, 1, At, B1); PG8_BAR; PG8_SCHED;
            PG8_LDA(At, 0, 1); PG8_STAGE(PG8_SB(0, 0), b2, voffB); PG8_STAGE(PG8_SB(0, 1), b2 + hstep, voffB); PG8_STAGE(PG8_SA(0, 0), a2, voffA);
            PG8_WAIT_V(8); PG8_WAIT_L(0); PG8_BAR; PG8_MMA(1, 0, At, B0); PG8_MMA(1, 1, At, B1); PG8_BAR; PG8_SCHED;
            PG8_LDB(B0, 1, 0); PG8_LDB(B1, 1, 1); PG8_SCHED; PG8_LDA(At, 1, 0); PG8_STAGE(PG8_SA(0, 1), a2 + hstep, voffA);
            PG8_WAIT_V(8); PG8_WAIT_L(0); PG8_BAR; PG8_MMA(0, 0, At, B0); PG8_MMA(0, 1, At, B1); PG8_BAR; PG8_SCHED;
            PG8_LDA(At, 1, 1); PG8_STAGE(PG8_SB(1, 0), b3, voffB); PG8_STAGE(PG8_SB(1, 1), b3 + hstep, voffB); PG8_STAGE(PG8_SA(1, 0), a3, voffA);
            PG8_WAIT_V(8); PG8_WAIT_L(0); PG8_BAR; PG8_MMA(1, 0, At, B0); PG8_MMA(1, 1, At, B1); PG8_BAR; PG8_SCHED;
            } else {
            PG8_LDB(B0, 0, 0); PG8_SCHED; PG8_LDA(At, 0, 0); PG8_STAGE(PG8_SA(1, 1), a1 + hstep, voffA);
            PG8_WAIT_L(8); PG8_BAR; PG8_WAIT_L(0); PG8_MMA(0, 0, At, B0); PG8_BAR; PG8_SCHED;
            PG8_LDB(B1, 0, 1); PG8_STAGE(PG8_SB(0, 0), b2, voffB);
            PG8_BAR; PG8_WAIT_L(0); PG8_MMA(0, 1, At, B1); PG8_BAR;
            PG8_LDA(At, 0, 1); PG8_STAGE(PG8_SA(0, 0), a2, voffA);
            PG8_BAR; PG8_WAIT_L(0); PG8_MMA(1, 0, At, B0); PG8_BAR; PG8_SCHED;
            PG8_STAGE(PG8_SB(0, 1), b2 + hstep, voffB);
            PG8_WAIT_V(6); PG8_BAR; PG8_MMA(1, 1, At, B1); PG8_BAR;
            PG8_LDB(B0, 1, 0); PG8_SCHED; PG8_LDA(At, 1, 0); PG8_STAGE(PG8_SA(0, 1), a2 + hstep, voffA);
            PG8_WAIT_L(8); PG8_BAR; PG8_WAIT_L(0); PG8_MMA(0, 0, At, B0); PG8_BAR; PG8_SCHED;
            PG8_LDB(B1, 1, 1); PG8_STAGE(PG8_SB(1, 0), b3, voffB);
            PG8_BAR; PG8_WAIT_L(0); PG8_MMA(0, 1, At, B1); PG8_BAR;
            PG8_LDA(At, 1, 1); PG8_STAGE(PG8_SA(1, 0), a3, voffA);
            PG8_BAR; PG8_WAIT_L(0); PG8_MMA(1, 0, At, B0); PG8_BAR; PG8_SCHED;
            PG8_STAGE(PG8_SB(1, 1), b3 + hstep, voffB);
            PG8_WAIT_V(6); PG8_BAR; PG8_MMA(1, 1, At, B1); PG8_BAR;
            }
        }
        if constexpr (ALIGN_EPI) { if (wr == 0) PG8_BAR; }
        if constexpr (!Epi::AFTER_DRAIN) { E(acc, cur, wr, wc, fr, fq); S.done(cur); }
        if (!has_next) break;
#pragma unroll
        for (int a = 0; a < 2; ++a)
#pragma unroll
            for (int b = 0; b < 2; ++b)
#pragma unroll
                for (int m = 0; m < 4; ++m)
#pragma unroll
                    for (int n = 0; n < 2; ++n) acc[a][b][m][n] = (f32x4){0.f, 0.f, 0.f, 0.f};
        cur = nxt; cA = nA; cB = nB; ++ui;
        if constexpr (ALIGN_EPI) { if (wr == 1) PG8_BAR; }
    }
    PG8_WAIT_V(0);
    if constexpr (!ALIGN_EPI) { if (wr == 0) PG8_BAR; }
    PG8_BAR;
    if constexpr (Epi::AFTER_DRAIN) { E.fused(acc, cur, wr, wc, fr, fq, lds, wid, lane); S.done(cur); }
#undef PG8_SA
#undef PG8_SB
#undef PG8_STAGE
#undef PG8_LDA
#undef PG8_LDB
#undef PG8_MMA
#undef PG8_WAIT_V
#undef PG8_WAIT_L
#undef PG8_BAR
#undef PG8_SCHED
}
#ifndef PG8_KROT
#define PG8_KROT 0
#endif
#ifndef PG8_PF_DIST
#define PG8_PF_DIST 0
#endif
template <int LDW_> struct BDense { static constexpr int LDW = LDW_; const float* W; __device__ __forceinline__ void ptrs(const Unit& u, const float*& b0, const float*& b1) const { b0 = W + (size_t)u.pn * 256; b1 = b0 + 128; } };
struct BMoeGU { static constexpr int LDW = 2048; const float* G; const float* U; __device__ __forceinline__ void ptrs(const Unit& u, const float*& b0, const float*& b1) const {
    const size_t o = (size_t)(u.pn >> 4) * 2048 * 2048 + (size_t)(u.pn & 15) * 128; b0 = G + o; b1 = U + o; } };
struct BMoeDn { static constexpr int LDW = 2048; const float* W; __device__ __forceinline__ void ptrs(const Unit& u, const float*& b0, const float*& b1) const {
    b0 = W + (size_t)(u.pn >> 3) * 2048 * 2048 + (size_t)(u.pn & 7) * 256; b1 = b0 + 128; } };
typedef float f32x2 __attribute__((ext_vector_type(2)));
typedef unsigned u32x2 __attribute__((ext_vector_type(2)));
typedef __bf16 bf16x2_t __attribute__((ext_vector_type(2)));
__device__ __forceinline__ unsigned cvt_pk_c(float lo, float hi) { f32x2 v = {lo, hi}; bf16x2_t b = __builtin_convertvector(v, bf16x2_t); return __builtin_bit_cast(unsigned, b); }

template <class Epi, class Sched, class BMap, bool GATHER = false, bool ALIGN_EPI = true, bool KSPLIT = false>
__device__ __forceinline__ void gemm_phase_w(PG8_LAS unsigned char* lds, const bf16_t* Ag, const int K, const BMap BM_, const Sched& S, const Epi& E, const int* RLg = nullptr, const int nvalid = 0, const int ldA = 0) {
    static_assert(Epi::PERM && !Epi::AFTER_DRAIN, "gemm_phase_w: PERM epilogues only");
    int tid_ = threadIdx.x; asm volatile("" : "+v"(tid_));
    const int tid = tid_, wid = __builtin_amdgcn_readfirstlane(tid >> 6), lane = tid & 63, wr = wid >> 2, wc = wid & 3, fr = lane & 15, fq = lane >> 4;
    const int nt = K / BK, ld = KSPLIT ? ldA : K;
    unsigned voffA[2][2];
    const size_t kstep = (size_t)(BK * 2);
    const size_t hstep = GATHER ? (size_t)0 : (size_t)HALF * ld * 2;
    const size_t tstep = GATHER ? (size_t)0 : (size_t)HALF * ld * 4;
    int gR0, gC0; stage_rc(tid * 16, gR0, gC0);
    if constexpr (GATHER) {
        PG8_LAS unsigned* tab = (PG8_LAS unsigned*)(lds + 8 * HTB);
        const __attribute__((address_space(1))) int* rl = (const __attribute__((address_space(1))) int*)RLg;
        Unit u_;
        for (int i = 0; S.next(i, u_); ++i)
            if (tid < 256) { const int e_ = u_.pm / 5, slot_ = (u_.pm - 5 * e_) * 256 + tid; tab[i * 256 + tid] = (slot_ < nvalid ? (unsigned)rl[e_ * 1280 + slot_] : 0u) * (unsigned)(K * 2); }
        __syncthreads();
#pragma unroll
        for (int h = 0; h < 2; ++h)
#pragma unroll
            for (int i = 0; i < 2; ++i) voffA[h][i] = tab[gR0 + 64 * i + 128 * h] + (unsigned)(gC0 * 2);
    } else {
#pragma unroll
        for (int i = 0; i < 2; ++i) { voffA[0][i] = (unsigned)((gR0 + 64 * i) * ld + gC0) * 2u; voffA[1][i] = voffA[0][i]; }
    }
    const unsigned ldsw = (unsigned)wid * 1024u;
    const int aoff = lds_byte(wr * 64 + fr, fq * 8), boff = lds_byte(wc * 32 + fr, fq * 8);
    constexpr int ldw = BMap::LDW;
    const int bh = wid >> 2, cb = (wid >> 1) & 1, kh = wid & 1, bq = lane & 15, bch = lane >> 4;
    const unsigned blane = (unsigned)(bch * 8 * ldw + 4 * bq) * 4u;
    const size_t bkt = (size_t)BK * ldw;
    const int bslab = 64 * cb + 32 * kh * ldw;
    const int rho0 = 32 * (2 * cb + (bq >> 3)) + 16 * (bq & 1) + 4 * ((bq & 7) >> 1), bs = (bq & 1);
    const bool rot1 = (bs & 1) != 0;
    constexpr int PFD = PG8_PF_DIST;
    const unsigned pfv = (unsigned)((16 * (wid & 3) + 4 * (lane >> 4)) * ldw * 4 + ((lane >> 2) & 3) * 128);
    unsigned pfd = 0u;
    unsigned wadr[4];
#pragma unroll
    for (int j = 0; j < 4; ++j) wadr[j] = (unsigned)(uintptr_t)lds + (unsigned)(4 * HTB + bh * HTB + lds_byte(rho0 + ((j + bs) & 3), 32 * kh + 8 * bch));
#define PG8_SA(b, h) (((b) * 2 + (h)) * HTB)
#define PG8_SB(b, h) ((4 + (b) * 2 + (h)) * HTB)
#define PG8_STAGE(bufoff, gbase, voff) do { _Pragma("unroll") for (int _i = 0; _i < 2; ++_i) \
        __builtin_amdgcn_global_load_lds((const unsigned*)((const char*)(gbase) + (voff)[_i]), (PG8_LAS unsigned*)(lds + (bufoff) + ldsw + _i * 8192), 16, 0, 0); } while (0)
#define PG8_LDA(dst, b, h) do { _Pragma("unroll") for (int m = 0; m < 4; ++m) _Pragma("unroll") for (int k = 0; k < 2; ++k) dst[m][k] = *(const PG8_LAS bf16x8*)(lds + PG8_SA(b, h) + aoff + m * 2048 + k * 1024); } while (0)
#define PG8_LDB(dst, b, h) do { _Pragma("unroll") for (int n = 0; n < 2; ++n) _Pragma("unroll") for (int k = 0; k < 2; ++k) dst[n][k] = *(const PG8_LAS bf16x8*)(lds + PG8_SB(b, h) + boff + n * 2048 + k * 1024); } while (0)
#define PG8_MMA(ai, bj, At, Bt) do { __builtin_amdgcn_s_setprio(1); _Pragma("unroll") for (int m = 0; m < 4; ++m) _Pragma("unroll") for (int n = 0; n < 2; ++n) _Pragma("unroll") for (int k = 0; k < 2; ++k) \
        acc[ai][bj][m][n] = __builtin_amdgcn_mfma_f32_16x16x32_bf16(Bt[n][k], At[m][k], acc[ai][bj][m][n], 0, 0, 0); __builtin_amdgcn_s_setprio(0); } while (0)
#define PG8_WAIT_V(n) asm volatile("s_waitcnt vmcnt(" #n ")" ::: "memory")
#if PG8_PF_DIST > 0
#define PG8_WAIT_VA PG8_WAIT_V(13)
#define PG8_WAIT_VB PG8_WAIT_V(5)
#define PG8_WAIT_VC PG8_WAIT_V(14)
#else
#define PG8_WAIT_VA PG8_WAIT_V(12)
#define PG8_WAIT_VB PG8_WAIT_V(8)
#define PG8_WAIT_VC PG8_WAIT_V(12)
#endif
#define PG8_WAIT_L(n) asm volatile("s_waitcnt lgkmcnt(" #n ")" ::: "memory")
#define PG8_BAR __builtin_amdgcn_s_barrier()
#define PG8_SCHED __builtin_amdgcn_sched_barrier(0)
#define PG8_GAS __attribute__((address_space(1)))
#define PG8_BLOADH(R, sb, K0) do { const PG8_GAS char* sb_ = (const PG8_GAS char*)(sb); _Pragma("unroll") for (int kk = 0; kk < 4; ++kk) { \
        const PG8_GAS char* p_ = sb_ + (size_t)(((K0) + kk) * ldw * 4); asm volatile("global_load_dwordx4 %0, %1, %2" : "=v"(R[kk]) : "v"(blane), "s"(p_) : "memory"); } } while (0)
#define PG8_BWRITEH(R, b, HOFF) do { u32x2 d_[4]; _Pragma("unroll") for (int i = 0; i < 4; ++i) { d_[i].x = cvt_pk_bf16(R[0][i], R[1][i]); d_[i].y = cvt_pk_bf16(R[2][i], R[3][i]); } \
        _Pragma("unroll") for (int j = 0; j < 4; ++j) { const u32x2 a_ = d_[j], b_ = d_[(j + 1) & 3]; u32x2 t_; t_.x = rot1 ? b_.x : a_.x; t_.y = rot1 ? b_.y : a_.y; \
            asm volatile("ds_write_b64 %0, %1 offset:%2" :: "v"(wadr[j]), "v"(t_), "i"((b) * 2 * HTB + (HOFF)) : "memory"); } } while (0)
#define PG8_PF(p) do { if constexpr (PFD > 0) { const PG8_GAS char* q_ = (p); asm volatile("global_load_dword %0, %1, %2" : "+v"(pfd) : "v"(pfv), "s"(q_) : "memory"); } } while (0)
    Unit cur, nxt; int ui = 0;
    if (!S.next(0, cur)) return;
    for (int d_ = 0; d_ < (int)((blockIdx.x >> 5) & 7); ++d_) __builtin_amdgcn_s_sleep(8);
    f32x4 acc[2][2][4][2];
#pragma unroll
    for (int a = 0; a < 2; ++a)
#pragma unroll
        for (int b = 0; b < 2; ++b)
#pragma unroll
            for (int m = 0; m < 4; ++m)
#pragma unroll
                for (int n = 0; n < 2; ++n) acc[a][b][m][n] = (f32x4){0.f, 0.f, 0.f, 0.f};
    bf16x8 At[4][2], B0[2][2], B1[2][2];
    f32x4 bx[4], by[4];
    const char* cA = (const char*)Ag + (size_t)cur.pm * tstep + (KSPLIT ? (size_t)cur.kc * K * 2 : (size_t)0);
    const float* cB; const PG8_GAS char* cP; { const float *b0, *b1; BM_.ptrs(cur, b0, b1); cB = (bh ? b1 : b0) + bslab + (KSPLIT ? (size_t)cur.kc * K * ldw : (size_t)0); cP = (const PG8_GAS char*)(bh ? b1 : b0) + (size_t)((cur.pm & 3) * ldw * 4); }
    int crot = PG8_KROT ? S.krot(cur) : 0;
#define PG8_KT(i, rot) (((i) + (rot)) & (nt - 1))
    S.a_ready(cur);
    PG8_STAGE(PG8_SA(0, 0), cA + (size_t)PG8_KT(0, crot) * kstep, voffA[0]); PG8_STAGE(PG8_SA(0, 1), cA + (size_t)PG8_KT(0, crot) * kstep + hstep, voffA[GATHER ? 1 : 0]);
    PG8_BLOADH(bx, cB + (size_t)PG8_KT(0, crot) * bkt, 0); PG8_BLOADH(by, cB + (size_t)PG8_KT(0, crot) * bkt, 4);
    PG8_WAIT_V(0); PG8_BWRITEH(bx, 0, 0); PG8_BWRITEH(by, 0, 8);
    PG8_BLOADH(bx, cB + (size_t)PG8_KT(1, crot) * bkt, 0); PG8_BLOADH(by, cB + (size_t)PG8_KT(1, crot) * bkt, 4);
    PG8_STAGE(PG8_SA(1, 0), cA + (size_t)PG8_KT(1, crot) * kstep, voffA[0]);
    PG8_WAIT_V(0); PG8_WAIT_L(0);
    if (wr == 1) PG8_BAR;
    PG8_BAR;
    PG8_BAR;
    for (;;) {
        const bool has_next = S.next(ui + 1, nxt);
        const char* nA = has_next ? (const char*)Ag + (size_t)nxt.pm * tstep + (KSPLIT ? (size_t)nxt.kc * K * 2 : (size_t)0) : cA;
        const int nrot = (has_next && PG8_KROT) ? S.krot(nxt) : crot;
        const float* nB = cB; const PG8_GAS char* nP = cP; if (has_next) { const float *b0, *b1; BM_.ptrs(nxt, b0, b1); nB = (bh ? b1 : b0) + bslab + (KSPLIT ? (size_t)nxt.kc * K * ldw : (size_t)0); nP = (const PG8_GAS char*)(bh ? b1 : b0) + (size_t)((nxt.pm & 3) * ldw * 4); }
        for (int t = 0; t < nt; t += 2) {
            const bool last = (t == nt - 2);
            const int k1 = PG8_KT(t + 1, crot), k2 = last ? PG8_KT(0, nrot) : PG8_KT(t + 2, crot), k3 = last ? PG8_KT(1, nrot) : PG8_KT(t + 3, crot);
            const char* a1 = cA + (size_t)k1 * kstep;
            const char* a2 = (last ? nA : cA) + (size_t)k2 * kstep;
            const char* a3 = (last ? nA : cA) + (size_t)k3 * kstep;
            const float* b2 = (last ? nB : cB) + (size_t)k2 * bkt;
            const float* b3 = (last ? nB : cB) + (size_t)k3 * bkt;
            const int i2 = t + 2 + PFD, i3 = i2 + 1;
            const PG8_GAS char* pf2 = i2 < nt ? cP + (size_t)i2 * (bkt * 4) : nP + (size_t)(i2 - nt) * (bkt * 4);
            const PG8_GAS char* pf3 = i3 < nt ? cP + (size_t)i3 * (bkt * 4) : nP + (size_t)(i3 - nt) * (bkt * 4);
            if (last && has_next) S.a_ready(nxt);
            PG8_LDB(B0, 0, 0); PG8_LDB(B1, 0, 1); PG8_SCHED; PG8_LDA(At, 0, 0); PG8_WAIT_VB; PG8_BWRITEH(bx, 1, 0); PG8_BLOADH(bx, b2, 0); PG8_STAGE(PG8_SA(1, 1), a1 + hstep, voffA[GATHER ? 1 : 0]);
            PG8_WAIT_VA; PG8_WAIT_L(0); PG8_BAR; PG8_MMA(0, 0, At, B0); PG8_MMA(0, 1, At, B1); PG8_BAR; PG8_SCHED;
            if constexpr (GATHER) { if (last && has_next) {
                const unsigned ta_ = (unsigned)(uintptr_t)lds + (unsigned)(8 * HTB + (ui + 1) * 1024 + gR0 * 4);
                asm volatile("ds_read_b32 %0, %1" : "=v"(voffA[0][0]) : "v"(ta_) : "memory");
                asm volatile("ds_read_b32 %0, %1 offset:256" : "=v"(voffA[0][1]) : "v"(ta_) : "memory");
                asm volatile("ds_read_b32 %0, %1 offset:512" : "=v"(voffA[1][0]) : "v"(ta_) : "memory");
                asm volatile("ds_read_b32 %0, %1 offset:768" : "=v"(voffA[1][1]) : "v"(ta_) : "memory");
                asm volatile("s_waitcnt lgkmcnt(0)" : "+v"(voffA[0][0]), "+v"(voffA[0][1]), "+v"(voffA[1][0]), "+v"(voffA[1][1]) :: "memory");
#pragma unroll
                for (int h = 0; h < 2; ++h)
#pragma unroll
                    for (int i = 0; i < 2; ++i) voffA[h][i] += (unsigned)(gC0 * 2);
            } }
            PG8_LDA(At, 0, 1); PG8_WAIT_VB; PG8_BWRITEH(by, 1, 8); PG8_BLOADH(by, b2, 4); PG8_STAGE(PG8_SA(0, 0), a2, voffA[0]); PG8_PF(pf2);
            PG8_WAIT_VC; PG8_WAIT_L(0); PG8_BAR; PG8_MMA(1, 0, At, B0); PG8_MMA(1, 1, At, B1); PG8_BAR; PG8_SCHED;
            PG8_LDB(B0, 1, 0); PG8_LDB(B1, 1, 1); PG8_SCHED; PG8_LDA(At, 1, 0); PG8_WAIT_VB; PG8_BWRITEH(bx, 0, 0); PG8_BLOADH(bx, b3, 0); PG8_STAGE(PG8_SA(0, 1), a2 + hstep, voffA[GATHER ? 1 : 0]);
            PG8_WAIT_VA; PG8_WAIT_L(0); PG8_BAR; PG8_MMA(0, 0, At, B0); PG8_MMA(0, 1, At, B1); PG8_BAR; PG8_SCHED;
            PG8_LDA(At, 1, 1); PG8_WAIT_VB; PG8_BWRITEH(by, 0, 8); PG8_BLOADH(by, b3, 4); PG8_STAGE(PG8_SA(1, 0), a3, voffA[0]); PG8_PF(pf3);
            PG8_WAIT_VC; PG8_WAIT_L(0); PG8_BAR; PG8_MMA(1, 0, At, B0); PG8_MMA(1, 1, At, B1); PG8_BAR; PG8_SCHED;
        }
        if constexpr (ALIGN_EPI) { if (wr == 0) PG8_BAR; }
        E(acc, cur, wr, wc, fr, fq); S.done(cur);
        if (!has_next) break;
#pragma unroll
        for (int a = 0; a < 2; ++a)
#pragma unroll
            for (int b = 0; b < 2; ++b)
#pragma unroll
                for (int m = 0; m < 4; ++m)
#pragma unroll
                    for (int n = 0; n < 2; ++n) acc[a][b][m][n] = (f32x4){0.f, 0.f, 0.f, 0.f};
        cur = nxt; cA = nA; cB = nB; cP = nP; crot = nrot; ++ui;
        if constexpr (ALIGN_EPI) { if (wr == 1) PG8_BAR; }
    }
    PG8_WAIT_V(0);
    asm volatile("" :: "v"(pfd));
    if constexpr (!ALIGN_EPI) { if (wr == 0) PG8_BAR; }
    PG8_BAR;
#undef PG8_PF
#undef PG8_KT
#undef PG8_WAIT_VA
#undef PG8_WAIT_VB
#undef PG8_WAIT_VC
#undef PG8_SA
#undef PG8_SB
#undef PG8_STAGE
#undef PG8_LDA
#undef PG8_LDB
#undef PG8_MMA
#undef PG8_WAIT_V
#undef PG8_WAIT_L
#undef PG8_BAR
#undef PG8_SCHED
#undef PG8_BLOADH
#undef PG8_BWRITEH
#undef PG8_GAS
}
}
namespace att {
using bf16x8 = __attribute__((ext_vector_type(8))) short;
using s16x4  = __attribute__((ext_vector_type(4))) short;
using f32x16 = __attribute__((ext_vector_type(16))) float;
using u32x4  = __attribute__((ext_vector_type(4))) unsigned;
typedef unsigned short bf16;
constexpr int D = 128, NW = 8, QBLK = 32, KVBLK = 64;
constexpr float SCALE = 0.088388347648318440f;
constexpr float THR = 8.f;
constexpr int SHM_V = KVBLK * D * 2, SHM_K = KVBLK * D * 2, SHM_ATTN = 2 * SHM_V + 2 * SHM_K + NW * 64 * 4;
#define KSWZ(row, colB) ((row) * 256 + ((colB) ^ (((row) & 7) << 4)))
#define SBAR() __builtin_amdgcn_sched_barrier(0)
__device__ __forceinline__ int crow(int r, int hi) { return (r & 3) + 8 * (r >> 2) + 4 * hi; }
__device__ __forceinline__ unsigned cvtpk(float lo, float hi) { unsigned r; asm volatile("v_cvt_pk_bf16_f32 %0, %1, %2" : "=v"(r) : "v"(lo), "v"(hi)); return r; }

__device__ __forceinline__ void partialSM(f32x16& p0, f32x16& p1, float& m_reg, float& mn, float& alpha, bool domask, int dm, int hi) {
  constexpr float C = SCALE * 1.4426950408889634f;
  if (domask) {
    const int db = dm + 4 * hi + 128;
#pragma unroll
    for (int r = 0; r < 16; ++r) { const int d0 = db + (r & 3) + 8 * (r >> 2);
      if ((unsigned)d0 > 256u) p0[r] = -1e30f; if ((unsigned)(d0 + 32) > 256u) p1[r] = -1e30f; }
  }
  float pmax = p0[0];
#pragma unroll
  for (int r = 1; r < 16; ++r) pmax = fmaxf(pmax, p0[r]);
#pragma unroll
  for (int r = 0; r < 16; ++r) pmax = fmaxf(pmax, p1[r]);
  { auto rr = __builtin_amdgcn_permlane32_swap(__float_as_uint(pmax), __float_as_uint(pmax), false, false);
    pmax = fmaxf(__uint_as_float(rr[0]), __uint_as_float(rr[1])); }
  if (__builtin_expect(__all(pmax - m_reg <= THR / SCALE), 1)) { mn = m_reg; alpha = 1.f; }
  else { mn = fmaxf(m_reg, pmax); alpha = __builtin_amdgcn_exp2f((m_reg - mn) * C); m_reg = mn; }
  float mnC = -mn * C;
#pragma unroll
  for (int r = 0; r < 16; ++r) p0[r] = fmaf(p0[r], C, mnC);
#pragma unroll
  for (int r = 0; r < 16; ++r) p1[r] = fmaf(p1[r], C, mnC);
#pragma unroll
  for (int r = 0; r < 16; ++r) p0[r] = __builtin_amdgcn_exp2f(p0[r]);
}
__device__ __forceinline__ void finishSM_np(f32x16& p0, f32x16& p1, float alpha, float& l_reg, bf16x8& pa0, bf16x8& pa1, bf16x8& pa2, bf16x8& pa3) {
#pragma unroll
  for (int r = 0; r < 16; ++r) p1[r] = __builtin_amdgcn_exp2f(p1[r]);
  float ps = 0;
#pragma unroll
  for (int r = 0; r < 16; ++r) ps += p0[r];
#pragma unroll
  for (int r = 0; r < 16; ++r) ps += p1[r];
  { auto rr = __builtin_amdgcn_permlane32_swap(__float_as_uint(ps), __float_as_uint(ps), false, false);
    ps = __uint_as_float(rr[0]) + __uint_as_float(rr[1]); }
  l_reg = l_reg * alpha + ps;
#define PK8(P, BASE, OUT) do { u32x4 w = {cvtpk(P[BASE + 0], P[BASE + 1]), cvtpk(P[BASE + 2], P[BASE + 3]), cvtpk(P[BASE + 4], P[BASE + 5]), cvtpk(P[BASE + 6], P[BASE + 7])}; OUT = *reinterpret_cast<bf16x8*>(&w); } while (0)
  PK8(p0, 0, pa0); PK8(p0, 8, pa1); PK8(p1, 0, pa2); PK8(p1, 8, pa3);
#undef PK8
}
__device__ __forceinline__ int v_rd_base(int lane) { return ((lane & 3) << 3) | (((lane >> 2) & 3) << 6) | (((lane >> 4) & 1) << 5) | (((lane >> 5) & 1) << 8); }
constexpr int v_rd_off(int d0, int ks, int half) { return d0 * 512 + ks * 4096 + half * 2048; }
template <int OFF> __device__ __forceinline__ s16x4 tr_read(int vb) {
  s16x4 r; asm volatile("ds_read_b64_tr_b16 %0, %1 offset:%2" : "=&v"(r) : "v"(vb), "i"(OFF) : "memory"); return r;
}

typedef float f32x4v __attribute__((ext_vector_type(4)));
__device__ __forceinline__ void q_prep(bf16x8* qr, bool do_norm, bool do_rope, int t, const float* g, const float* rt, int hi) {
  float q[8][8];
#pragma unroll
  for (int d0 = 0; d0 < 8; ++d0)
#pragma unroll
    for (int i = 0; i < 8; ++i) q[d0][i] = __uint_as_float(((unsigned)(unsigned short)qr[d0][i]) << 16);
  if (do_norm) {
    float ss = 0.f;
#pragma unroll
    for (int d0 = 0; d0 < 8; ++d0)
#pragma unroll
      for (int i = 0; i < 8; ++i) ss += q[d0][i] * q[d0][i];
    ss += __shfl_xor(ss, 32);
    const float r = 1.0f / sqrtf(ss * (1.0f / 128.0f) + 1e-6f);
#pragma unroll
    for (int d0 = 0; d0 < 8; ++d0) { const f32x4v g0 = *(const f32x4v*)(g + d0 * 16 + hi * 8), g1 = *(const f32x4v*)(g + d0 * 16 + hi * 8 + 4);
#pragma unroll
      for (int i = 0; i < 4; ++i) { q[d0][i] = q[d0][i] * r * g0[i]; q[d0][4 + i] = q[d0][4 + i] * r * g1[i]; } }
  }
  if (do_rope) {
#pragma unroll
    for (int pr = 0; pr < 4; ++pr) { const int a = (pr & 1) + (pr >> 1) * 4, c = a + 2; const int pos = (pr >> 1) ? (t & 63) : (t >> 6);
      const float* cp = rt + pos * 32 + (a & 1) * 16 + hi * 8;
      const f32x4v c0 = *(const f32x4v*)cp, c1 = *(const f32x4v*)(cp + 4), s0 = *(const f32x4v*)(cp + 2048), s1 = *(const f32x4v*)(cp + 2052);
#pragma unroll
      for (int i = 0; i < 8; ++i) { const float cs = i < 4 ? c0[i & 3] : c1[i & 3], sn = i < 4 ? s0[i & 3] : s1[i & 3];
        const float o1 = q[a][i] * cs - q[c][i] * sn, o2 = q[c][i] * cs + q[a][i] * sn; q[a][i] = o1; q[c][i] = o2; } }
  }
#pragma unroll
  for (int d0 = 0; d0 < 8; ++d0) { u32x4 w = {cvtpk(q[d0][0], q[d0][1]), cvtpk(q[d0][2], q[d0][3]), cvtpk(q[d0][4], q[d0][5]), cvtpk(q[d0][6], q[d0][7])}; qr[d0] = *reinterpret_cast<bf16x8*>(&w); }
}

struct Job {
  const bf16* Q;
  const bf16* K; const bf16* V;
  int NT;
  int kb0;
  int mask;
  int dq;
  int use_sink; float sink_l2;
  void* O; float lam;
  int qmode; int t0; const float* qg; const float* rt;
};
template <int OFF> __device__ __forceinline__ bf16x8 rd128(int a) { bf16x8 r; asm volatile("ds_read_b128 %0, %1 offset:%2" : "=&v"(r) : "v"(a), "i"(OFF) : "memory"); return r; }
struct Job256 { const bf16* Q; const bf16* K; const bf16* V; bf16* O; int NT; int t0; const float* rt;
  const bf16* O0; float lam, sc; const float* g; };
constexpr int V256 = KVBLK * 256 * 2, SHM_ATTN256 = 2 * V256 + 2 * SHM_K + NW * 64 * 4;
constexpr int v_rd_off256(int d0, int ks, int half) { return d0 * 512 + ks * 8192 + half * 4096; }
#define PKV(L, H) (bf16x8){L[0], L[1], L[2], L[3], H[0], H[1], H[2], H[3]}
#define WAITL(n) asm volatile("s_waitcnt lgkmcnt(" #n ")" ::: "memory")
#define RKM(M, U) do { U = rd128<((M) & 1) * 8192 + ((M) >> 3) * 128>(ka[((M) >> 1) & 3] + kbo); } while (0)
#define MQM(M, U) do { if constexpr (((M) & 1) == 0) p0 = __builtin_amdgcn_mfma_f32_32x32x16_bf16(U, qr[(M) >> 1], p0, 0, 0, 0); else p1 = __builtin_amdgcn_mfma_f32_32x32x16_bf16(U, qr[(M) >> 1], p1, 0, 0, 0); } while (0)
template <bool HAS_PV, bool HAS_QK>
__device__ __forceinline__ void mseg256(f32x16* o, f32x16& p0, f32x16& p1, int vb, const int (&ka)[4], int kbo, const bf16x8* qr, bf16x8 pa0, bf16x8 pa1, bf16x8 pa2, bf16x8 pa3) {
  bf16x8 U0, U1, U2, U3, U4;
  if constexpr (HAS_PV) {
    s16x4 H0[4], H1[4], H2[4], H3[4];
#define RH(HS, H) do { H[0] = tr_read<v_rd_off256(2 * ((HS) >> 2), (HS) & 3, 0)>(vb); H[1] = tr_read<v_rd_off256(2 * ((HS) >> 2), (HS) & 3, 1)>(vb); \
    H[2] = tr_read<v_rd_off256(2 * ((HS) >> 2) + 1, (HS) & 3, 0)>(vb); H[3] = tr_read<v_rd_off256(2 * ((HS) >> 2) + 1, (HS) & 3, 1)>(vb); } while (0)
#define MH(HS, H) do { const bf16x8 pk_ = ((HS) & 3) == 0 ? pa0 : ((HS) & 3) == 1 ? pa1 : ((HS) & 3) == 2 ? pa2 : pa3; \
    o[2 * ((HS) >> 2)] = __builtin_amdgcn_mfma_f32_32x32x16_bf16(pk_, PKV(H[0], H[1]), o[2 * ((HS) >> 2)], 0, 0, 0); \
    o[2 * ((HS) >> 2) + 1] = __builtin_amdgcn_mfma_f32_32x32x16_bf16(pk_, PKV(H[2], H[3]), o[2 * ((HS) >> 2) + 1], 0, 0, 0); } while (0)
#define PVH(HS, H, HN) do { WAITL(8); SBAR(); RH((HS) + 3, HN); SBAR(); MH(HS, H); SBAR(); } while (0)
    RH(0, H0); RH(1, H1); RH(2, H2);
    PVH(0, H0, H3); PVH(1, H1, H0); PVH(2, H2, H1); PVH(3, H3, H2); PVH(4, H0, H3); PVH(5, H1, H0); PVH(6, H2, H1); PVH(7, H3, H2);
    PVH(8, H0, H3); PVH(9, H1, H0); PVH(10, H2, H1); PVH(11, H3, H2); PVH(12, H0, H3);
    if constexpr (HAS_QK) {
      WAITL(8); SBAR(); RKM(0, U0); RKM(1, U1); SBAR(); MH(13, H1); SBAR();
      WAITL(6); SBAR(); RKM(2, U2); RKM(3, U3); SBAR(); MH(14, H2); SBAR();
      WAITL(4); SBAR(); RKM(4, U4); SBAR(); MH(15, H3); SBAR();
    } else {
      WAITL(8); SBAR(); MH(13, H1); SBAR();
      WAITL(4); SBAR(); MH(14, H2); SBAR();
      WAITL(0); SBAR(); MH(15, H3); SBAR();
    }
#undef RH
#undef MH
#undef PVH
  } else if constexpr (HAS_QK) { RKM(0, U0); RKM(1, U1); RKM(2, U2); RKM(3, U3); RKM(4, U4); }
  if constexpr (HAS_QK) {
    p0 = f32x16{}; p1 = f32x16{};
#define QM(M, U) do { WAITL(4); SBAR(); MQM(M, U); SBAR(); RKM((M) + 5, U); } while (0)
    QM(0, U0); QM(1, U1); QM(2, U2); QM(3, U3); QM(4, U4); QM(5, U0); QM(6, U1); QM(7, U2); QM(8, U3); QM(9, U4); QM(10, U0);
#undef QM
    WAITL(4); SBAR(); MQM(11, U1); SBAR();
    WAITL(3); SBAR(); MQM(12, U2); SBAR();
    WAITL(2); SBAR(); MQM(13, U3); SBAR();
    WAITL(1); SBAR(); MQM(14, U4); SBAR();
    WAITL(0); SBAR(); MQM(15, U0); SBAR();
  }
}
template <int LD, int EPI>
__device__ __forceinline__ void attn_unit256s(const Job256& J, char* lds) {
  typedef __attribute__((address_space(3))) unsigned las_u32;
  constexpr int LDO = 2048;
  int tid_ = threadIdx.x; asm volatile("" : "+v"(tid_));
  const int tid = tid_, wid = __builtin_amdgcn_readfirstlane(tid >> 6), lane = tid & 63, r32 = lane & 31, hi = lane >> 5;
  int hb;
  { int simd_; asm volatile("s_getreg_b32 %0, hwreg(HW_REG_HW_ID, 4, 2)" : "=s"(simd_));
    int* sid_ = (int*)(lds + 3 * V256 + 3 * SHM_K + NW * 64 * 4);
    if (lane == 0) sid_[wid] = simd_;
    __syncthreads();
    int rank_ = 0;
#pragma unroll
    for (int w = 0; w < NW; ++w) rank_ += (w < wid && sid_[w] == simd_) ? 1 : 0;
    hb = __builtin_amdgcn_readfirstlane(rank_) & 1;
    __syncthreads(); }
  char* V_lds = lds; char* K_lds = lds + 3 * V256;
  float* ws = (float*)(lds + 3 * V256 + 3 * SHM_K) + wid * 64; float* li_l = ws; float* al_l = ws + 32;
  float m_reg = -1e30f, l_reg = 0; f32x16 o[8] = {}; bf16x8 qr[8];
  const bf16* Qw = J.Q + (long)(wid * QBLK + r32) * LD + hi * 8;
#pragma unroll
  for (int d0 = 0; d0 < 8; ++d0) qr[d0] = *reinterpret_cast<const bf16x8*>(Qw + d0 * 16);
  q_prep(qr, false, true, J.t0 + wid * QBLK + r32, nullptr, J.rt, hi);
  unsigned kso[2], vso0;
#pragma unroll
  for (int i = 0; i < 2; ++i) { const int U = (2 * wid + i) * 64 + lane, row = U >> 4, ch = (U & 15) ^ (row & 7); kso[i] = (unsigned)(row * LD + ch * 8); }
  { const int U = (4 * wid) * 64 + lane, st = U >> 5, kk = (st >> 3) * 8 + ((U & 31) >> 2), k = kk;
    vso0 = (unsigned)(k * LD + (st & 7) * 32 + (U & 3) * 8); }
  const int vb0 = (int)(uintptr_t)V_lds + v_rd_base(lane);
  int ka[4];
#pragma unroll
  for (int d0 = 0; d0 < 4; ++d0) ka[d0] = (int)(uintptr_t)K_lds + r32 * 256 + ((32 * d0 + 16 * hi) ^ ((r32 & 7) << 4));
  const bf16* Kh = J.K; const bf16* Vh = J.V; const int NT = J.NT;
#define DMA_K(t, buf) do { const bf16* kp_ = Kh + (size_t)(t) * 64 * LD; \
    _Pragma("unroll") for (int i = 0; i < 2; ++i) __builtin_amdgcn_global_load_lds((const unsigned*)(kp_ + kso[i]), (las_u32*)(K_lds + (buf) * SHM_K + (2 * wid + i) * 1024), 16, 0, 0); } while (0)
#define DMA_V(t, buf) do { const bf16* vp_ = Vh + (size_t)(t) * 64 * LD; \
    _Pragma("unroll") for (int i = 0; i < 4; ++i) __builtin_amdgcn_global_load_lds((const unsigned*)((vp_ + 64 * i) + vso0), (las_u32*)(V_lds + (buf) * V256 + (4 * wid + i) * 1024), 16, 0, 0); } while (0)
#define MOD3(x) ((x) >= 3 ? (x) - 3 : (x))
#define DMA_STAGE(s, kslot, vslot) do { const int s_ = (s); if (s_ < NT) DMA_K(s_, kslot); if (s_ >= 1 && s_ <= NT) DMA_V(s_ - 1, vslot); } while (0)
#define WG_BAR() do { SBAR(); __builtin_amdgcn_s_barrier(); asm volatile("" ::: "memory"); SBAR(); } while (0)
  f32x16 p0 = {}, p1 = {}; float mn, al; bf16x8 pa0 = {}, pa1 = {}, pa2 = {}, pa3 = {};
#pragma unroll
  for (int d0 = 0; d0 < 8; ++d0) asm volatile("" :: "v"(qr[d0]));
  DMA_STAGE(0, 0, 0); DMA_STAGE(1, 1, 0);
  asm volatile("s_waitcnt vmcnt(6)" ::: "memory"); WG_BAR();
  if (hb == 1) { DMA_STAGE(2, 2, 1); WG_BAR(); }
  int c3 = 0;
#define WAIT_STAGE(j_) do { if ((j_) + 2 < NT) asm volatile("s_waitcnt vmcnt(6)" ::: "memory"); else asm volatile("s_waitcnt vmcnt(0)" ::: "memory"); } while (0)
#define ITER(J, HAS_PV, HAS_QK) do { const int j_ = (J); \
    if (hb == 0 && j_ + 2 <= NT) DMA_STAGE(j_ + 2, MOD3(c3 + 2), MOD3(c3 + 1)); \
    __builtin_amdgcn_s_setprio(1); SBAR(); \
    mseg256<HAS_PV, HAS_QK>(o, p0, p1, vb0 + MOD3(c3 + 2) * V256, ka, c3 * SHM_K, qr, pa0, pa1, pa2, pa3); \
    __builtin_amdgcn_s_setprio(0); \
    if (hb == 1) WAIT_STAGE(j_); \
    WG_BAR(); \
    if (hb == 1 && j_ + 3 <= NT) DMA_STAGE(j_ + 3, c3, MOD3(c3 + 2)); \
    if constexpr (HAS_QK) { SOFTMAX(); } \
    if (hb == 0) WAIT_STAGE(j_); \
    WG_BAR(); c3 = MOD3(c3 + 1); } while (0)
#define SOFTMAX() do { \
      partialSM(p0, p1, m_reg, mn, al, false, 0, hi); \
      if (__any(al < 1.f)) { if (hi == 0) al_l[r32] = al; asm volatile("s_waitcnt lgkmcnt(0)" ::: "memory"); \
        _Pragma("unroll") for (int d = 0; d < 8; ++d) _Pragma("unroll") for (int r = 0; r < 16; ++r) o[d][r] *= al_l[crow(r, hi)]; } \
      finishSM_np(p0, p1, al, l_reg, pa0, pa1, pa2, pa3); } while (0)
  ITER(0, false, true);
  for (int j = 1; j < NT; ++j) ITER(j, true, true);
  ITER(NT, true, false);
#undef ITER
#undef SOFTMAX
  if (hb == 0) WG_BAR();
  if (hi == 0) li_l[r32] = l_reg; asm volatile("s_waitcnt lgkmcnt(0)" ::: "memory");
  float rli[16];
#pragma unroll
  for (int r = 0; r < 16; ++r) rli[r] = __builtin_amdgcn_rcpf(li_l[crow(r, hi)]);
  bf16* Ow = J.O + (long)(wid * QBLK) * LDO + r32;
  asm volatile("" : "+v"(Ow));
  if constexpr (EPI == 0) {
#pragma unroll
    for (int r = 0; r < 16; ++r) { const int orow = crow(r, hi);
#pragma unroll
      for (int d0 = 0; d0 < 8; ++d0) Ow[orow * LDO + d0 * 32] = (bf16)(cvtpk(o[d0][r] * rli[r], 0.f) & 0xffffu); }
  } else {
    const bf16* O0w = J.O0 + (long)(wid * QBLK) * LDO + r32;
    asm volatile("" : "+v"(O0w));
    const float lam = J.lam, sc = J.sc;
    float gv[8]; const float* gl_ = J.g + r32; asm volatile("" : "+v"(gl_));
#pragma unroll
    for (int d0 = 0; d0 < 8; ++d0) gv[d0] = gl_[d0 * 32];
#pragma unroll
    for (int r = 0; r < 16; ++r) { const int orow = crow(r, hi); float ss = 0.f, v[8];
      asm volatile("" ::: "memory");
#pragma unroll
      for (int d0 = 0; d0 < 8; ++d0) v[d0] = __uint_as_float(((unsigned)O0w[orow * LDO + d0 * 32]) << 16);
#pragma unroll
      for (int d0 = 0; d0 < 8; ++d0) { v[d0] = v[d0] - (o[d0][r] * rli[r]) * lam; ss += v[d0] * v[d0]; }
      ss += __shfl_xor(ss, 1); ss += __shfl_xor(ss, 2); ss += __shfl_xor(ss, 4); ss += __shfl_xor(ss, 8); ss += __shfl_xor(ss, 16);
      const float rr = sc / sqrtf(ss * (1.0f / 256.0f) + 1e-6f);
#pragma unroll
      for (int d0 = 0; d0 < 8; ++d0) Ow[orow * LDO + d0 * 32] = (bf16)(cvtpk(v[d0] * rr * gv[d0], 0.f) & 0xffffu); }
  }
#undef DMA_K
#undef DMA_V
#undef DMA_STAGE
#undef MOD3
#undef WAIT_STAGE
#undef WG_BAR
}

struct SMst { float pmax, mn, al, mnC, ps, r0, r1, pm, mnew, dk, t, psa, psb, psc; };
#define PE(e) ((e) < 16 ? p0[(e) & 15] : p1[(e) & 15])
template <int N>
__device__ __forceinline__ void sm_chunk(f32x16& p0, f32x16& p1, SMst& st, float& m_reg, float& l_reg, bf16x8& pa0, bf16x8& pa1, bf16x8& pa2, bf16x8& pa3) {
  constexpr float C = SCALE * 1.4426950408889634f;
#define PK8S(P, BASE, OUT) do { u32x4 w = {cvtpk(P[BASE + 0], P[BASE + 1]), cvtpk(P[BASE + 2], P[BASE + 3]), cvtpk(P[BASE + 4], P[BASE + 5]), cvtpk(P[BASE + 6], P[BASE + 7])}; OUT = *reinterpret_cast<bf16x8*>(&w); } while (0)
  if constexpr (N < 4) {
    constexpr int e = 8 * N;
    const float t0 = fmaxf(fmaxf(PE(e), PE(e + 1)), PE(e + 2)), t1 = fmaxf(fmaxf(PE(e + 3), PE(e + 4)), PE(e + 5));
    const float t2 = N == 0 ? fmaxf(PE(e + 6), PE(e + 7)) : fmaxf(fmaxf(PE(e + 6), PE(e + 7)), st.pmax);
    st.pmax = fmaxf(fmaxf(t0, t1), t2);
  } else if constexpr (N == 4) {
    auto rr = __builtin_amdgcn_permlane32_swap(__float_as_uint(st.pmax), __float_as_uint(st.pmax), false, false);
    st.r0 = __uint_as_float(rr[0]); st.r1 = __uint_as_float(rr[1]);
  } else if constexpr (N == 5) {
    st.pm = fmaxf(st.r0, st.r1);
  } else if constexpr (N == 6) {
    st.mnew = fmaxf(m_reg, st.pm); st.dk = st.pm - m_reg;
  } else if constexpr (N == 7) {
    st.t = (m_reg - st.mnew) * C; st.mn = st.dk <= THR / SCALE ? m_reg : st.mnew;
  } else if constexpr (N == 8) {
    const float anew = __builtin_amdgcn_exp2f(st.t);
    st.al = st.dk <= THR / SCALE ? 1.f : anew; m_reg = st.mn; st.mnC = -st.mn * C;
  } else if constexpr (N < 25) {
    constexpr int e = 2 * (N - 9);
    if constexpr (e < 16) { p0[e] = __builtin_amdgcn_exp2f(fmaf(p0[e], C, st.mnC)); p0[e + 1] = __builtin_amdgcn_exp2f(fmaf(p0[e + 1], C, st.mnC)); }
    else { p1[e - 16] = __builtin_amdgcn_exp2f(fmaf(p1[e - 16], C, st.mnC)); p1[e - 15] = __builtin_amdgcn_exp2f(fmaf(p1[e - 15], C, st.mnC)); }
  } else if constexpr (N == 25) {
    st.psa = ((PE(0) + PE(1)) + (PE(2) + PE(3))) + ((PE(4) + PE(5)) + (PE(6) + PE(7))) + ((PE(8) + PE(9)) + PE(10));
  } else if constexpr (N == 26) {
    st.psb = ((PE(11) + PE(12)) + (PE(13) + PE(14))) + ((PE(15) + PE(16)) + (PE(17) + PE(18))) + ((PE(19) + PE(20)) + PE(21));
  } else if constexpr (N == 27) {
    st.psc = ((PE(22) + PE(23)) + (PE(24) + PE(25))) + ((PE(26) + PE(27)) + (PE(28) + PE(29))) + (PE(30) + PE(31));
  } else if constexpr (N == 28) {
    PK8S(p0, 0, pa0); st.ps = (st.psa + st.psb) + st.psc;
  } else if constexpr (N == 29) {
    PK8S(p0, 8, pa1);
    auto rr = __builtin_amdgcn_permlane32_swap(__float_as_uint(st.ps), __float_as_uint(st.ps), false, false);
    st.r0 = __uint_as_float(rr[0]); st.r1 = __uint_as_float(rr[1]);
  } else if constexpr (N == 30) {
    PK8S(p1, 0, pa2); st.ps = st.r0 + st.r1;
  } else if constexpr (N == 31) {
    PK8S(p1, 8, pa3); l_reg = l_reg * st.al + st.ps;
  }
#undef PK8S
}
#define VC(N) do { sm_chunk<N>(s0, s1, st, m_reg, l_reg, w0, w1, w2, w3); SBAR(); } while (0)
template <bool HAS_PV, bool HAS_QK>
__device__ __forceinline__ void pblock128(f32x16* o, f32x16& s0, f32x16& s1, f32x16& q0, f32x16& q1, SMst& st, float& m_reg, float& l_reg,
                                          bf16x8 r0, bf16x8 r1, bf16x8 r2, bf16x8 r3, bf16x8& w0, bf16x8& w1, bf16x8& w2, bf16x8& w3, int vb, const int (&ka)[4], int kbo, const bf16x8* qr) {
  bf16x8 U0, U1, U2, U3, U4;
#define RKP(M, U) do { U = rd128<((M) & 1) * 8192 + ((M) >> 3) * 128>(ka[((M) >> 1) & 3] + kbo); } while (0)
#define MQP(M, U) do { if constexpr (((M) & 1) == 0) q0 = __builtin_amdgcn_mfma_f32_32x32x16_bf16(U, qr[(M) >> 1], q0, 0, 0, 0); else q1 = __builtin_amdgcn_mfma_f32_32x32x16_bf16(U, qr[(M) >> 1], q1, 0, 0, 0); } while (0)
  if constexpr (HAS_PV) {
    s16x4 H0[4], H1[4], H2[4], H3[4];
#define RHP(HS, H) do { H[0] = tr_read<v_rd_off(2 * ((HS) >> 2), (HS) & 3, 0)>(vb); H[1] = tr_read<v_rd_off(2 * ((HS) >> 2), (HS) & 3, 1)>(vb); \
    H[2] = tr_read<v_rd_off(2 * ((HS) >> 2) + 1, (HS) & 3, 0)>(vb); H[3] = tr_read<v_rd_off(2 * ((HS) >> 2) + 1, (HS) & 3, 1)>(vb); } while (0)
#define PKR(HS) (((HS) & 3) == 0 ? r0 : ((HS) & 3) == 1 ? r1 : ((HS) & 3) == 2 ? r2 : r3)
#define MHA(HS, H) do { o[2 * ((HS) >> 2)] = __builtin_amdgcn_mfma_f32_32x32x16_bf16(PKR(HS), PKV(H[0], H[1]), o[2 * ((HS) >> 2)], 0, 0, 0); } while (0)
#define MHB(HS, H) do { o[2 * ((HS) >> 2) + 1] = __builtin_amdgcn_mfma_f32_32x32x16_bf16(PKR(HS), PKV(H[2], H[3]), o[2 * ((HS) >> 2) + 1], 0, 0, 0); } while (0)
#define VPV(HS) do { if constexpr (HAS_QK) VC(2 * (HS)); else { VC(4 * (HS)); VC(4 * (HS) + 1); } } while (0)
#define VPV2(HS) do { if constexpr (HAS_QK) VC(2 * (HS) + 1); else { VC(4 * (HS) + 2); VC(4 * (HS) + 3); } } while (0)
#define PVP(HS, H, HN) do { WAITL(8); SBAR(); RHP((HS) + 3, HN); SBAR(); MHA(HS, H); VPV(HS); MHB(HS, H); VPV2(HS); } while (0)
    RHP(0, H0); RHP(1, H1); RHP(2, H2);
    PVP(0, H0, H3); PVP(1, H1, H0); PVP(2, H2, H1); PVP(3, H3, H2); PVP(4, H0, H3);
    if constexpr (HAS_QK) {
      WAITL(8); SBAR(); RKP(0, U0); RKP(1, U1); SBAR(); MHA(5, H1); VPV(5); MHB(5, H1); VPV2(5);
      WAITL(6); SBAR(); RKP(2, U2); RKP(3, U3); SBAR(); MHA(6, H2); VPV(6); MHB(6, H2); VPV2(6);
      WAITL(4); SBAR(); RKP(4, U4); SBAR(); MHA(7, H3); VPV(7); MHB(7, H3); VPV2(7);
    } else {
      WAITL(8); SBAR(); MHA(5, H1); VPV(5); MHB(5, H1); VPV2(5);
      WAITL(4); SBAR(); MHA(6, H2); VPV(6); MHB(6, H2); VPV2(6);
      WAITL(0); SBAR(); MHA(7, H3); VPV(7); MHB(7, H3); VPV2(7);
    }
#undef RHP
#undef PKR
#undef MHA
#undef MHB
#undef VPV
#undef VPV2
#undef PVP
  } else if constexpr (HAS_QK) { RKP(0, U0); RKP(1, U1); RKP(2, U2); RKP(3, U3); RKP(4, U4); }
  if constexpr (HAS_QK) {
    q0 = f32x16{}; q1 = f32x16{};
#define VQK(M) do { if constexpr (HAS_PV) VC(16 + (M)); else { VC(2 * (M)); VC(2 * (M) + 1); } } while (0)
#define QMP(M, U) do { WAITL(4); SBAR(); MQP(M, U); SBAR(); RKP((M) + 5, U); VQK(M); } while (0)
    QMP(0, U0); QMP(1, U1); QMP(2, U2); QMP(3, U3); QMP(4, U4); QMP(5, U0); QMP(6, U1); QMP(7, U2); QMP(8, U3); QMP(9, U4); QMP(10, U0);
#undef QMP
    WAITL(4); SBAR(); MQP(11, U1); SBAR(); VQK(11);
    WAITL(3); SBAR(); MQP(12, U2); SBAR(); VQK(12);
    WAITL(2); SBAR(); MQP(13, U3); SBAR(); VQK(13);
    WAITL(1); SBAR(); MQP(14, U4); SBAR(); VQK(14);
    WAITL(0); SBAR(); MQP(15, U0); SBAR(); VQK(15);
#undef VQK
  }
  VC(32);
#undef RKP
#undef MQP
}
__device__ __forceinline__ void pv_only128(f32x16* o, bf16x8 r0, bf16x8 r1, bf16x8 r2, bf16x8 r3, int vb) {
  s16x4 H0[4], H1[4], H2[4], H3[4];
#define RHP(HS, H) do { H[0] = tr_read<v_rd_off(2 * ((HS) >> 2), (HS) & 3, 0)>(vb); H[1] = tr_read<v_rd_off(2 * ((HS) >> 2), (HS) & 3, 1)>(vb); \
    H[2] = tr_read<v_rd_off(2 * ((HS) >> 2) + 1, (HS) & 3, 0)>(vb); H[3] = tr_read<v_rd_off(2 * ((HS) >> 2) + 1, (HS) & 3, 1)>(vb); } while (0)
#define PKR(HS) (((HS) & 3) == 0 ? r0 : ((HS) & 3) == 1 ? r1 : ((HS) & 3) == 2 ? r2 : r3)
#define MHAB(HS, H) do { o[2 * ((HS) >> 2)] = __builtin_amdgcn_mfma_f32_32x32x16_bf16(PKR(HS), PKV(H[0], H[1]), o[2 * ((HS) >> 2)], 0, 0, 0); \
    o[2 * ((HS) >> 2) + 1] = __builtin_amdgcn_mfma_f32_32x32x16_bf16(PKR(HS), PKV(H[2], H[3]), o[2 * ((HS) >> 2) + 1], 0, 0, 0); } while (0)
#define PVP(HS, H, HN) do { WAITL(8); SBAR(); RHP((HS) + 3, HN); SBAR(); MHAB(HS, H); SBAR(); } while (0)
  RHP(0, H0); RHP(1, H1); RHP(2, H2);
  PVP(0, H0, H3); PVP(1, H1, H0); PVP(2, H2, H1); PVP(3, H3, H2); PVP(4, H0, H3);
  WAITL(8); SBAR(); MHAB(5, H1); SBAR();
  WAITL(4); SBAR(); MHAB(6, H2); SBAR();
  WAITL(0); SBAR(); MHAB(7, H3); SBAR();
#undef RHP
#undef PKR
#undef MHAB
#undef PVP
}
template <int LD, bool MASKED>
__device__ __forceinline__ void attn_unit128p(const Job& J, char* lds) {
  typedef __attribute__((address_space(3))) unsigned las_u32;
  constexpr int LDO = 2048;
  int tid_ = threadIdx.x; asm volatile("" : "+v"(tid_));
  const int tid = tid_, wid = __builtin_amdgcn_readfirstlane(tid >> 6), lane = tid & 63, r32 = lane & 31, hi = lane >> 5;
  char* V_lds = lds; char* K_lds = lds + 3 * SHM_V;
  float* ws = (float*)(lds + 3 * SHM_V + 3 * SHM_K) + wid * 64; float* li_l = ws; float* al_l = ws + 32;
  float m_reg = -1e30f, l_reg = 0; f32x16 o[4] = {}; bf16x8 qr[8];
  const bf16* Qw = J.Q + (long)(wid * QBLK + r32) * LD + hi * 8;
#pragma unroll
  for (int d0 = 0; d0 < 8; ++d0) qr[d0] = *reinterpret_cast<const bf16x8*>(Qw + d0 * 16);
  q_prep(qr, (J.qmode & 1) != 0, (J.qmode & 2) != 0, J.t0 + wid * QBLK + r32, J.qg, J.rt, hi);
  unsigned kso[2], vso0;
#pragma unroll
  for (int i = 0; i < 2; ++i) { const int U = (2 * wid + i) * 64 + lane, row = U >> 4, ch = (U & 15) ^ (row & 7); kso[i] = (unsigned)(row * LD + ch * 8); }
  { const int U = (2 * wid) * 64 + lane, st_ = U >> 5, kk = (st_ >> 2) * 8 + ((U & 31) >> 2), k = kk;
    vso0 = (unsigned)(k * LD + (st_ & 3) * 32 + (U & 3) * 8); }
  const int vb0 = (int)(uintptr_t)V_lds + v_rd_base(lane);
  int ka[4];
#pragma unroll
  for (int d0 = 0; d0 < 4; ++d0) ka[d0] = (int)(uintptr_t)K_lds + r32 * 256 + ((32 * d0 + 16 * hi) ^ ((r32 & 7) << 4));
  const bf16* Kh = J.K; const bf16* Vh = J.V; const int NT = J.NT, kb0 = J.kb0;
  const bool msk = MASKED && J.mask != 0;
  const int dml = J.dq - (wid * QBLK + r32);
#define KROWT(t) ((t) < 4 ? (t) * 64 : kb0 + ((t) - 4) * 64)
#define DMA_K(t, buf) do { const bf16* kp_ = Kh + (size_t)KROWT(t) * LD; \
    _Pragma("unroll") for (int i = 0; i < 2; ++i) __builtin_amdgcn_global_load_lds((const unsigned*)(kp_ + kso[i]), (las_u32*)(K_lds + (buf) * SHM_K + (2 * wid + i) * 1024), 16, 0, 0); } while (0)
#define DMA_V(t, buf) do { const bf16* vp_ = Vh + (size_t)KROWT(t) * LD; \
    _Pragma("unroll") for (int i = 0; i < 2; ++i) __builtin_amdgcn_global_load_lds((const unsigned*)((vp_ + 64 * i) + vso0), (las_u32*)(V_lds + (buf) * SHM_V + (2 * wid + i) * 1024), 16, 0, 0); } while (0)
#define MOD3(x) ((x) >= 3 ? (x) - 3 : (x))
#define DMA_STAGE(s, ks) do { const int s_ = (s); if (s_ < NT) DMA_K(s_, ks); if (s_ >= 2 && s_ <= NT + 1) DMA_V(s_ - 2, MOD3((ks) + 1)); } while (0)
#define WG_BAR() do { SBAR(); __builtin_amdgcn_s_barrier(); asm volatile("" ::: "memory"); SBAR(); } while (0)
#define WAIT_STAGE(j_) do { if ((j_) + 3 < NT) asm volatile("s_waitcnt vmcnt(4)" ::: "memory"); else asm volatile("s_waitcnt vmcnt(0)" ::: "memory"); } while (0)
#define MASKP(P0, P1, j_) do { if (msk && (j_) >= 4) { const int db = dml + ((j_) - 4) * 64 + 4 * hi + 128; \
    _Pragma("unroll") for (int r = 0; r < 16; ++r) { const int d0 = db + (r & 3) + 8 * (r >> 2); if ((unsigned)d0 > 256u) P0[r] = -1e30f; if ((unsigned)(d0 + 32) > 256u) P1[r] = -1e30f; } } } while (0)
#define RESCALE() do { if (__any(st.al < 1.f)) { if (hi == 0) al_l[r32] = st.al; asm volatile("s_waitcnt lgkmcnt(0)" ::: "memory"); \
    _Pragma("unroll") for (int d = 0; d < 4; ++d) _Pragma("unroll") for (int r = 0; r < 16; ++r) o[d][r] *= al_l[crow(r, hi)]; } } while (0)
  f32x16 pA0 = {}, pA1 = {}, pB0 = {}, pB1 = {}; SMst st; st.pmax = 0.f; st.mn = 0.f; st.al = 1.f; st.mnC = 0.f; st.ps = 0.f;
  bf16x8 x0 = {}, x1 = {}, x2 = {}, x3 = {}, y0 = {}, y1 = {}, y2 = {}, y3 = {};
#pragma unroll
  for (int d0 = 0; d0 < 8; ++d0) asm volatile("" :: "v"(qr[d0]));
  DMA_STAGE(0, 0); DMA_STAGE(1, 1); DMA_STAGE(2, 2);
  asm volatile("s_waitcnt vmcnt(6)" ::: "memory"); WG_BAR();
  { bf16x8 d0_ = {}, d1_ = {}, d2_ = {}, d3_ = {};
    f32x16 t0 = {}, t1 = {}; SMst ts = st; float tm = m_reg, tl = l_reg;
    (void)t0; (void)t1; (void)ts; (void)tm; (void)tl; (void)d0_; (void)d1_; (void)d2_; (void)d3_;
    bf16x8 U0, U1, U2, U3, U4; const int kbo = 0;
#define RKP(M, U) do { U = rd128<((M) & 1) * 8192 + ((M) >> 3) * 128>(ka[((M) >> 1) & 3] + kbo); } while (0)
#define MQP(M, U) do { if constexpr (((M) & 1) == 0) pA0 = __builtin_amdgcn_mfma_f32_32x32x16_bf16(U, qr[(M) >> 1], pA0, 0, 0, 0); else pA1 = __builtin_amdgcn_mfma_f32_32x32x16_bf16(U, qr[(M) >> 1], pA1, 0, 0, 0); } while (0)
    RKP(0, U0); RKP(1, U1); RKP(2, U2); RKP(3, U3); RKP(4, U4);
#define QMP(M, U) do { WAITL(4); SBAR(); MQP(M, U); SBAR(); RKP((M) + 5, U); } while (0)
    QMP(0, U0); QMP(1, U1); QMP(2, U2); QMP(3, U3); QMP(4, U4); QMP(5, U0); QMP(6, U1); QMP(7, U2); QMP(8, U3); QMP(9, U4); QMP(10, U0);
#undef QMP
    WAITL(4); SBAR(); MQP(11, U1); SBAR(); WAITL(3); SBAR(); MQP(12, U2); SBAR(); WAITL(2); SBAR(); MQP(13, U3); SBAR(); WAITL(1); SBAR(); MQP(14, U4); SBAR(); WAITL(0); SBAR(); MQP(15, U0); SBAR();
#undef RKP
#undef MQP
  }
  asm volatile("s_waitcnt vmcnt(4)" ::: "memory"); WG_BAR();
  int c3 = 0;
#define ITERP(J_, HAS_PV, HAS_QK, S0, S1, Q0, Q1, R0, R1, R2, R3, W0, W1, W2, W3) do { const int j_ = (J_); \
    if (j_ + 3 <= NT + 1) DMA_STAGE(j_ + 3, c3); \
    MASKP(S0, S1, j_); SBAR(); \
    pblock128<HAS_PV, HAS_QK>(o, S0, S1, Q0, Q1, st, m_reg, l_reg, R0, R1, R2, R3, W0, W1, W2, W3, vb0 + MOD3(c3 + 2) * SHM_V, ka, MOD3(c3 + 1) * SHM_K, qr); \
    RESCALE(); \
    WAIT_STAGE(j_); WG_BAR(); c3 = MOD3(c3 + 1); } while (0)
  ITERP(0, false, true, pA0, pA1, pB0, pB1, y0, y1, y2, y3, x0, x1, x2, x3);
  for (int j = 1; j + 1 < NT; j += 2) {
    ITERP(j, true, true, pB0, pB1, pA0, pA1, x0, x1, x2, x3, y0, y1, y2, y3);
    ITERP(j + 1, true, true, pA0, pA1, pB0, pB1, y0, y1, y2, y3, x0, x1, x2, x3);
  }
  ITERP(NT - 1, true, false, pB0, pB1, pA0, pA1, x0, x1, x2, x3, y0, y1, y2, y3);
  pv_only128(o, y0, y1, y2, y3, vb0 + MOD3(c3 + 2) * SHM_V);
#undef ITERP
  if (J.use_sink) l_reg += __builtin_amdgcn_exp2f(J.sink_l2 - m_reg * (SCALE * 1.4426950408889634f));
  if (hi == 0) li_l[r32] = l_reg; asm volatile("s_waitcnt lgkmcnt(0)" ::: "memory");
  float rli[16];
#pragma unroll
  for (int r = 0; r < 16; ++r) rli[r] = __builtin_amdgcn_rcpf(li_l[crow(r, hi)]);
  bf16* Ow = (bf16*)J.O + (long)(wid * QBLK) * LDO + r32;
  asm volatile("" : "+v"(Ow));
#pragma unroll
  for (int r = 0; r < 16; ++r) { const int orow = crow(r, hi);
#pragma unroll
    for (int d0 = 0; d0 < 4; ++d0) Ow[orow * LDO + d0 * 32] = (bf16)(cvtpk(o[d0][r] * rli[r], 0.f) & 0xffffu); }
#undef KROWT
#undef DMA_K
#undef DMA_V
#undef DMA_STAGE
#undef MOD3
#undef WAIT_STAGE
#undef WG_BAR
#undef MASKP
#undef RESCALE
}
#undef VC
#undef PE
#undef KSWZ
#undef SBAR
}

constexpr int NWAVES = 8;
constexpr int DM = 2048, NBATCH = 2, SEQ = 4096, CTXL = 256, SB = SEQ + CTXL  , NROWS = NBATCH * SB  ;
constexpr int NEXP = 16, CAP_L = 512, CAP_C = 32, EROWS = 1280  ;
constexpr int NQKV0 = 3072, NQKV1 = 6144, NMOD = 6 * DM;
constexpr float EPS = 1e-6f;
constexpr float LAMBDA_INIT = 0.35550906759096926f;

constexpr size_t MiB = 1u << 20;
constexpr size_t WS_CTL = 0, CTL_ZERO_BYTES = 64 * 1024;
constexpr size_t WS_ROPE = 1 * MiB;
constexpr size_t WS_MODS = 2 * MiB;
constexpr size_t WS_AFF  = 3 * MiB;
constexpr size_t WS_RL   = 4 * MiB;
constexpr size_t WS_GATE = 5 * MiB;
constexpr size_t WS_INV  = 6 * MiB;
constexpr size_t WS_WIN0 = 8 * MiB;
constexpr size_t WS_WOUT0 = WS_WIN0 + 12 * MiB;
constexpr size_t WS_WIN1 = WS_WOUT0 + 8 * MiB;
constexpr size_t WS_WOUT1 = WS_WIN1 + 24 * MiB;
constexpr size_t WS_WGU = WS_WOUT1 + 8 * MiB;
constexpr size_t WS_WD  = WS_WGU + 512 * MiB;
constexpr size_t WS_H   = WS_WD + 256 * MiB;
constexpr size_t WS_QKV = WS_H + 34 * MiB;
constexpr size_t WS_Y   = WS_QKV + 102 * MiB;
constexpr size_t WS_YO  = WS_Y + 34 * MiB;
constexpr size_t WS_XL  = WS_YO + 68 * MiB;
constexpr size_t WS_XG  = WS_XL + 68 * MiB;
constexpr size_t WS_HM  = WS_XG + 80 * MiB;
constexpr size_t WS_YE  = WS_HM + 80 * MiB;
constexpr size_t WS_END = WS_YE + 80 * MiB;
constexpr int CW_BAR = 4096;

constexpr int RING_BYTES = 131072;
constexpr int LDS_BYTES = 163840;
constexpr int CW_BST = 8192;

#define LAS __attribute__((address_space(3)))
typedef unsigned short bf16;
typedef unsigned v4u __attribute__((ext_vector_type(4)));
typedef unsigned v2u __attribute__((ext_vector_type(2)));
typedef int v4i __attribute__((ext_vector_type(4)));
typedef float f32x4 __attribute__((ext_vector_type(4)));
__device__ __forceinline__ unsigned f2bf(float f) { unsigned u = __builtin_bit_cast(unsigned, f); return (u + 0x7fffu + ((u >> 16) & 1u)) >> 16; }
__device__ __forceinline__ unsigned pk2(float lo, float hi) { return f2bf(lo) | (f2bf(hi) << 16); }
__device__ __forceinline__ float bf_lo(unsigned w) { return __builtin_bit_cast(float, w << 16); }
__device__ __forceinline__ float bf_hi(unsigned w) { return __builtin_bit_cast(float, w & 0xffff0000u); }

#define XB_TMO      128
#define XB_XCNT(j)  (256  + 64 * (j))
#define XB_XSUB(j)  (1280 + 64 * (j))
#define XB_XGEN(j)  (2304 + 64 * (j))
#define XB_TOP      3328
#define XB_TOPGEN   3392
#define XCD_BAR_WORDS 3456
#define XB_SPIN_CAP (1u << 18)
__device__ __forceinline__ unsigned xb_ld(unsigned* p)              { return __hip_atomic_load(p, __ATOMIC_RELAXED, __HIP_MEMORY_SCOPE_AGENT); }
__device__ __forceinline__ unsigned xb_add(unsigned* p, unsigned v) { return __hip_atomic_fetch_add(p, v, __ATOMIC_RELAXED, __HIP_MEMORY_SCOPE_AGENT); }
__device__ __forceinline__ unsigned xb_xcc_id() { return (unsigned)__builtin_amdgcn_s_getreg((3 << 11) | 20) & 0xFu; }
#define XB_SPIN(cond, bar) do { unsigned _sp = 0; while (cond) { __builtin_amdgcn_s_sleep(1); \
    if ((++_sp & 255u) == 0u) { if (xb_ld(&(bar)[XB_TMO])) break; if (_sp > XB_SPIN_CAP) { atomicAdd(&(bar)[XB_TMO], 1u); break; } } } } while (0)
struct XcdBarrier { unsigned* bar; unsigned x; unsigned* st; };
__device__ __forceinline__ XcdBarrier xcd_barrier_post(unsigned* bar, unsigned* st) {
    XcdBarrier b; b.bar = bar; b.x = xb_xcc_id(); b.st = st;
    if (threadIdx.x == 0) (void)xb_add(&bar[XB_XCNT(b.x)], 1u);
    return b;
}
__device__ __forceinline__ void xcd_barrier_complete(unsigned* bar, unsigned x, unsigned& nloc, unsigned& nx) {
    const unsigned G = gridDim.x * gridDim.y * gridDim.z;
    unsigned sum, cnt, mine, sp = 0u;
    for (;;) {
        sum = 0u; cnt = 0u; mine = 0u;
#pragma unroll
        for (unsigned j = 0; j < 16; ++j) { const unsigned c = xb_ld(&bar[XB_XCNT(j)]); sum += c; cnt += (c > 0u) ? 1u : 0u; mine = (j == x) ? c : mine; }
        if (sum == G) break;
        __builtin_amdgcn_s_sleep(1);
        if ((++sp & 255u) == 0u) { if (xb_ld(&bar[XB_TMO])) break; if (sp > XB_SPIN_CAP) { atomicAdd(&bar[XB_TMO], 1u); break; } }
    }
    nloc = mine > 0u ? mine : 1u; nx = cnt > 0u ? cnt : 1u;
}
__device__ __forceinline__ void xcd_barrier(const XcdBarrier& b) {
    unsigned nloc = 0u, nx = 0u;
    if (threadIdx.x == 0) { nloc = xb_ld(&b.st[0]); nx = xb_ld(&b.st[1]); }
    asm volatile("s_waitcnt vmcnt(0)" ::: "memory");
    __syncthreads();
    if (threadIdx.x == 0) {
        unsigned* bar = b.bar;
        __builtin_amdgcn_s_waitcnt(0);
        if (nloc == 0u) { xcd_barrier_complete(bar, b.x, nloc, nx); __hip_atomic_store(&b.st[0], nloc, __ATOMIC_RELAXED, __HIP_MEMORY_SCOPE_AGENT); __hip_atomic_store(&b.st[1], nx, __ATOMIC_RELAXED, __HIP_MEMORY_SCOPE_AGENT); }
        const unsigned old = xb_add(&bar[XB_XSUB(b.x)], 1u);
        const unsigned gen = old / nloc;
        if (old + 1u == (gen + 1u) * nloc) {
            __builtin_amdgcn_fence(__ATOMIC_RELEASE, "agent");
            asm volatile("s_waitcnt vmcnt(0)" ::: "memory");
            const unsigned og = xb_add(&bar[XB_TOP], 1u);
            const unsigned target = (og / nx + 1u) * nx;
            if (og + 1u != target) XB_SPIN(xb_ld(&bar[XB_TOP]) < target, bar);
            xb_add(&bar[XB_XGEN(b.x)], 1u);
            __builtin_amdgcn_fence(__ATOMIC_ACQUIRE, "agent");
            asm volatile("s_waitcnt vmcnt(0)" ::: "memory");
        } else {
            XB_SPIN(xb_ld(&bar[XB_XGEN(b.x)]) == gen, bar);
            __builtin_amdgcn_fence(__ATOMIC_ACQUIRE, "agent");
            asm volatile("s_waitcnt vmcnt(0)" ::: "memory");
        }
    }
    __syncthreads();
}

struct Args { const float* in[20]; float* out; unsigned char* ws; int ph_lo, ph_hi; };
struct Frame {
    LAS unsigned char* lds;
    int tid, lane, wave, G, gw, NGW;
    __attribute__((address_space(1))) unsigned char* ws;
};
template <class T> __device__ __forceinline__ T* fresh(T* p) { __attribute__((address_space(1))) T* q = (__attribute__((address_space(1))) T*)p; asm volatile("" : "+s"(q)); return (T*)q; }
template <int CTRL, int ROW_MASK> __device__ __forceinline__ float dpp_add(float v) {
    return v + __int_as_float(__builtin_amdgcn_update_dpp(0, __float_as_int(v), CTRL, ROW_MASK, 0xf, true)); }
__device__ __forceinline__ float wave_sum(float v) {
    v = dpp_add<0x111, 0xf>(v); v = dpp_add<0x112, 0xf>(v); v = dpp_add<0x114, 0xf>(v); v = dpp_add<0x118, 0xf>(v);
    v = dpp_add<0x142, 0xa>(v); v = dpp_add<0x143, 0xc>(v);
    return __int_as_float(__builtin_amdgcn_readlane(__float_as_int(v), 63));
}
__device__ __forceinline__ int wave_incl_scan(int v, int lane) {
#pragma unroll
    for (int o = 1; o < 64; o <<= 1) { const int t = __shfl_up(v, o); if (lane >= o) v += t; }
    return v;
}
__device__ __forceinline__ void transpose_item(const float* W, int K, int N, bf16* WT, int k0, int n0, int drow0, LAS float* scr, int lane) {
#pragma unroll 8
    for (int i = 0; i < 32; ++i) { const int kk = 2 * i + (lane >> 5); scr[kk * 33 + (lane & 31)] = W[(size_t)(k0 + kk) * N + n0 + (lane & 31)]; }
    asm volatile("s_waitcnt lgkmcnt(0)" ::: "memory");
    const int c = lane & 7;
#pragma unroll
    for (int j = 0; j < 4; ++j) { const int n = (lane >> 3) + 8 * j; const LAS float* s = scr + (8 * c) * 33 + n;
        v4u o; o.x = pk2(s[0 * 33], s[1 * 33]); o.y = pk2(s[2 * 33], s[3 * 33]); o.z = pk2(s[4 * 33], s[5 * 33]); o.w = pk2(s[6 * 33], s[7 * 33]);
        *(v4u*)(WT + (size_t)(drow0 + n) * K + k0 + 8 * c) = o; }
    asm volatile("s_waitcnt lgkmcnt(0)" ::: "memory");
}
__device__ __forceinline__ void ld_row(const float* p, int lane, f32x4 (&v)[8]) {
#pragma unroll
    for (int j = 0; j < 8; ++j) v[j] = *(const f32x4*)(p + 4 * lane + 256 * j);
}
__device__ __forceinline__ void ld_row_bf16(const bf16* p, int lane, f32x4 (&v)[8]) {
#pragma unroll
    for (int j = 0; j < 8; ++j) { const v2u w = *(const v2u*)(p + 4 * lane + 256 * j); v[j] = (f32x4){bf_lo(w.x), bf_hi(w.x), bf_lo(w.y), bf_hi(w.y)}; }
}
__device__ __forceinline__ float row_rstd(const f32x4 (&v)[8]) {
    float s = 0.f;
#pragma unroll
    for (int j = 0; j < 8; ++j) s += (v[j].x * v[j].x + v[j].y * v[j].y) + (v[j].z * v[j].z + v[j].w * v[j].w);
    return 1.0f / sqrtf(wave_sum(s) * (1.0f / DM) + EPS);
}
__device__ __forceinline__ void st_row_bf16(bf16* p, int lane, const f32x4 (&v)[8]) {
#pragma unroll
    for (int j = 0; j < 8; ++j) { v2u w; w.x = pk2(v[j].x, v[j].y); w.y = pk2(v[j].z, v[j].w); *(v2u*)(p + 4 * lane + 256 * j) = w; }
}
__device__ __forceinline__ void norm_mod(f32x4 (&h)[8], const f32x4 (&x)[8], float r, const float* g, const float* sc, const float* sh, int lane) {
#pragma unroll
    for (int j = 0; j < 8; ++j) { const int c = 4 * lane + 256 * j; const f32x4 gg = *(const f32x4*)(g + c), s1 = *(const f32x4*)(sc + c), s0 = *(const f32x4*)(sh + c);
        h[j] = x[j] * r * gg * (s1 + 1.0f) + s0; }
}
__device__ __forceinline__ const float* in_row_ptr(const float* x_in, const float* ctx_in, int row) {
    const int b = row / SB, s = row - b * SB;
    return s < CTXL ? ctx_in + ((size_t)(b * CTXL + s)) * DM : x_in + ((size_t)(b * SEQ + s - CTXL)) * DM;
}
__device__ __forceinline__ const float* mods_ptr(const Frame& F, int layer, int row, int chunk) {
    const int b = row / SB, s = row - b * SB; const int vec = s < CTXL ? 2 : b;
    return (const float*)(F.ws + WS_MODS) + ((size_t)(layer * 3 + vec)) * NMOD + chunk * DM;
}

__device__ __forceinline__ void setup_part(Frame& F, int l, int vc, int NV, int what  , const float* c_in, const float* c_ctx, const float* mod_w, const float* mod_b, const float* w_in, const float* w_out, const int sl_lo = 0, const int sl_hi = 384) {
    LAS float* sc = (LAS float*)F.lds;
    LAS float* red = (LAS float*)(F.lds + 24576);
    if (what & 1) {
    for (int i = F.tid; i < 3 * DM; i += 512) { const int v = i / DM, k = i - v * DM; const float cv = v < 2 ? c_in[v * DM + k] : c_ctx[k]; sc[i] = cv / (1.0f + __expf(-cv)); }
    __syncthreads();
    const int tx = F.tid & 7, ty = F.tid >> 3;
    for (int sl = sl_lo + vc; sl < sl_hi; sl += NV) {
        const float* wp = mod_w + (size_t)l * DM * NMOD + sl * 32 + tx * 4;
        f32x4 a0 = {0.f, 0.f, 0.f, 0.f}, a1 = a0, a2 = a0;
#pragma unroll 8
        for (int i = 0; i < 32; ++i) { const int k = ty + 64 * i; const f32x4 w = *(const f32x4*)(wp + (size_t)k * NMOD);
            a0 += w * sc[k]; a1 += w * sc[DM + k]; a2 += w * sc[2 * DM + k]; }
        LAS float* rp = red + F.tid * 12;
        rp[0] = a0.x; rp[1] = a0.y; rp[2] = a0.z; rp[3] = a0.w; rp[4] = a1.x; rp[5] = a1.y; rp[6] = a1.z; rp[7] = a1.w; rp[8] = a2.x; rp[9] = a2.y; rp[10] = a2.z; rp[11] = a2.w;
        __syncthreads();
        if (F.tid < 96) { const int v = F.tid >> 5, col = F.tid & 31, txx = col >> 2, jj = col & 3; float s = 0.f;
            for (int t = 0; t < 64; ++t) s += red[(t * 8 + txx) * 12 + v * 4 + jj];
            ((float*)(F.ws + WS_MODS))[((size_t)(l * 3 + v)) * NMOD + sl * 32 + col] = s + mod_b[l * NMOD + sl * 32 + col]; }
        __syncthreads();
    }
    }
    if (!(what & 2)) return;
    LAS float* scr = (LAS float*)(F.lds + F.wave * 16384);
    const int nin = l == 0 ? NQKV0 : NQKV1, nbi = nin / 32, I_IN = 32 * nbi, I_OUT = 32 * 64;
    bf16* win = (bf16*)(F.ws + (l == 0 ? WS_WIN0 : WS_WIN1)); bf16* wout = (bf16*)(F.ws + (l == 0 ? WS_WOUT0 : WS_WOUT1));
    const int it_lo = (what & 8) ? I_IN : 0, it_hi = (what & 4) ? I_IN : I_IN + I_OUT;
    for (int it = it_lo + vc * NWAVES + F.wave; it < it_hi; it += NV * NWAVES) {
        if (it < I_IN) { const int kb = it / nbi, nb = it - kb * nbi; transpose_item(w_in, DM, nin, win, 64 * kb, 32 * nb, 32 * nb, scr, F.lane); }
        else { const int r = it - I_IN, kb = r / 64, nb = r % 64; transpose_item(w_out, DM, DM, wout, 64 * kb, 32 * nb, 32 * nb, scr, F.lane); }
    }
}
__device__ __forceinline__ void p0_prologue(Frame& F, const float* c_in, const float* c_ctx, const float* mod_w, const float* mod_b, const float* ab_w_in, const float* ab_w_out) {
    { const int gi = blockIdx.x * 512 + F.tid;
      if (gi < 2048) { const int pos = gi >> 5, f = gi & 31; const float inv = __builtin_amdgcn_exp2f(-(float)f * (13.287712379549449f / 32.0f)); const float ang = (float)pos * inv;
          float* rt = (float*)(F.ws + WS_ROPE); rt[gi] = __cosf(ang); rt[2048 + gi] = __sinf(ang); } }
    setup_part(F, 0, (int)blockIdx.x, F.G, 1, c_in, c_ctx, mod_w, mod_b, ab_w_in, ab_w_out, 0, 128);
    __syncthreads();
    setup_part(F, 0, ((int)blockIdx.x + F.G / 2) % F.G, F.G, 2 | 4, c_in, c_ctx, mod_w, mod_b, ab_w_in, ab_w_out);
}

__device__ __forceinline__ void t_norm0(Frame& F, const float* x_in, const float* ctx_in, const float* norm_g) {
    for (int row = F.gw; row < NROWS; row += 2 * F.NGW) {
        const int row2 = row + F.NGW; const bool has2 = row2 < NROWS;
        f32x4 x1[8], x2[8], h[8];
        ld_row(in_row_ptr(x_in, ctx_in, row), F.lane, x1);
        if (has2) ld_row(in_row_ptr(x_in, ctx_in, row2), F.lane, x2);
        asm volatile("" ::: "memory");
        { const float r = row_rstd(x1);
          norm_mod(h, x1, r, fresh(norm_g), mods_ptr(F, 0, row, 1), mods_ptr(F, 0, row, 0), F.lane);
          st_row_bf16((bf16*)(F.ws + WS_H) + (size_t)row * DM, F.lane, h); }
        if (has2) { const float r = row_rstd(x2);
          norm_mod(h, x2, r, fresh(norm_g), mods_ptr(F, 0, row2, 1), mods_ptr(F, 0, row2, 0), F.lane);
          st_row_bf16((bf16*)(F.ws + WS_H) + (size_t)row2 * DM, F.lane, h); }
    }
}
__device__ __forceinline__ void t_prep(Frame& F, int layer, const float* q_norm, const float* k_norm) {
    const int ld = layer == 0 ? NQKV0 : NQKV1;
    const float* rt = (const float*)(F.ws + WS_ROPE);
    const int hs = F.lane >> 3, part = F.lane & 7, isc = part >> 2, fq = (part & 3) * 8, d0 = isc * 64 + fq;
    for (int row = F.gw; row < NROWS; row += F.NGW) {
        const int b = row / SB, s = row - b * SB; const bool lat = s >= CTXL;
        if (layer == 1 && !lat) continue;
        float cs[8], sn[8];
        if (lat) { const int t = s - CTXL; const int pos = isc ? (t & 63) : (t >> 6); const float* cp = fresh(rt) + pos * 32 + fq;
            const f32x4 c0 = *(const f32x4*)cp, c1 = *(const f32x4*)(cp + 4), s0 = *(const f32x4*)(cp + 2048), s1 = *(const f32x4*)(cp + 2052);
            cs[0] = c0.x; cs[1] = c0.y; cs[2] = c0.z; cs[3] = c0.w; cs[4] = c1.x; cs[5] = c1.y; cs[6] = c1.z; cs[7] = c1.w;
            sn[0] = s0.x; sn[1] = s0.y; sn[2] = s0.z; sn[3] = s0.w; sn[4] = s1.x; sn[5] = s1.y; sn[6] = s1.z; sn[7] = s1.w;
        } else {
#pragma unroll
            for (int i = 0; i < 8; ++i) { cs[i] = 1.f; sn[i] = 0.f; } }
        bf16* rp = (bf16*)(F.ws + WS_QKV) + (size_t)row * ld;
#pragma unroll
        for (int st = (layer == 0 ? 0 : 2); st < (layer == 0 ? 1 : 4); ++st) {
            const int hh = st * 8 + hs;
            int col; bool act = true, donorm = false; const float* g = k_norm;
            if (layer == 0) {
                if (hs < 2) col = 1024 + hs * 128; else { col = 2560 + ((hs - 2) & 1) * 128; donorm = true; }
                act = hs < 4 && (lat || donorm);
                if (!act) col = 0;
            } else col = hh * 128;
            v4u A = *(const v4u*)(rp + col + d0), C = *(const v4u*)(rp + col + d0 + 32);
            float a[8], c[8];
            a[0] = bf_lo(A.x); a[1] = bf_hi(A.x); a[2] = bf_lo(A.y); a[3] = bf_hi(A.y); a[4] = bf_lo(A.z); a[5] = bf_hi(A.z); a[6] = bf_lo(A.w); a[7] = bf_hi(A.w);
            c[0] = bf_lo(C.x); c[1] = bf_hi(C.x); c[2] = bf_lo(C.y); c[3] = bf_hi(C.y); c[4] = bf_lo(C.z); c[5] = bf_hi(C.z); c[6] = bf_lo(C.w); c[7] = bf_hi(C.w);
            if (layer == 0) {
                float ss = 0.f;
#pragma unroll
                for (int i = 0; i < 8; ++i) ss += a[i] * a[i] + c[i] * c[i];
                ss += __shfl_xor(ss, 1); ss += __shfl_xor(ss, 2); ss += __shfl_xor(ss, 4);
                const float r = 1.0f / sqrtf(ss * (1.0f / 128.0f) + EPS);
                const f32x4 g0 = *(const f32x4*)(g + d0), g1 = *(const f32x4*)(g + d0 + 4), g2 = *(const f32x4*)(g + d0 + 32), g3 = *(const f32x4*)(g + d0 + 36);
                const float ga[8] = {g0.x, g0.y, g0.z, g0.w, g1.x, g1.y, g1.z, g1.w}, gc[8] = {g2.x, g2.y, g2.z, g2.w, g3.x, g3.y, g3.z, g3.w};
#pragma unroll
                for (int i = 0; i < 8; ++i) { a[i] = donorm ? a[i] * r * ga[i] : a[i]; c[i] = donorm ? c[i] * r * gc[i] : c[i]; }
            }
            v4u oa, oc;
            { float o1[8], o2[8];
#pragma unroll
              for (int i = 0; i < 8; ++i) { o1[i] = a[i] * cs[i] - c[i] * sn[i]; o2[i] = c[i] * cs[i] + a[i] * sn[i]; }
              oa.x = pk2(o1[0], o1[1]); oa.y = pk2(o1[2], o1[3]); oa.z = pk2(o1[4], o1[5]); oa.w = pk2(o1[6], o1[7]);
              oc.x = pk2(o2[0], o2[1]); oc.y = pk2(o2[2], o2[3]); oc.z = pk2(o2[4], o2[5]); oc.w = pk2(o2[6], o2[7]); }
            if (act) { *(v4u*)(rp + col + d0) = oa; *(v4u*)(rp + col + d0 + 32) = oc; }
        }
    }
}
__device__ __forceinline__ void t_post_attn(Frame& F, int layer, const float* x_in, const float* ctx_in, const float* norm_g, const float* router_w) {
    const float* ng0 = norm_g + (size_t)layer * 4 * DM;
    const float* wr0 = router_w + (size_t)layer * DM * NEXP;
    for (int q = F.tid; q < DM * 4; q += NWAVES * 64) { const int c = q >> 2, eq = q & 3; const int pc = (c & ~15) | ((c >> 2) & 3) | ((c & 3) << 2);
        *(LAS f32x4*)(F.lds + pc * 64 + ((eq ^ ((c >> 4) & 3)) << 4)) = *(const f32x4*)(wr0 + c * 16 + eq * 4); }
    __syncthreads();
    const int rsw = (F.lane >> 2) & 3;
    const LAS unsigned char* wl0 = F.lds + (16 * (F.lane >> 2) + (F.lane & 3)) * 64 + ((0 ^ rsw) << 4);
    const LAS unsigned char* wl1 = F.lds + (16 * (F.lane >> 2) + (F.lane & 3)) * 64 + ((1 ^ rsw) << 4);
    const LAS unsigned char* wl2 = F.lds + (16 * (F.lane >> 2) + (F.lane & 3)) * 64 + ((2 ^ rsw) << 4);
    const LAS unsigned char* wl3 = F.lds + (16 * (F.lane >> 2) + (F.lane & 3)) * 64 + ((3 ^ rsw) << 4);
    for (int row = F.gw; row < NROWS; row += F.NGW) {
        const int b = row / SB, s = row - b * SB;
        if (layer == 1 && s < CTXL) continue;
        const float* ng = fresh(ng0);
        f32x4 y[8], x[8], h[8];
        ld_row_bf16((const bf16*)(F.ws + WS_YO) + (size_t)row * DM, F.lane, y);
        if (layer == 0) ld_row(in_row_ptr(x_in, ctx_in, row), F.lane, x); else ld_row_bf16((const bf16*)(F.ws + WS_XL) + (size_t)row * DM, F.lane, x);
        const float ry = row_rstd(y);
        const float* ga = mods_ptr(F, layer, row, 2);
#pragma unroll
        for (int j = 0; j < 8; ++j) { const int c = 4 * F.lane + 256 * j; x[j] = x[j] + *(const f32x4*)(ga + c) * (y[j] * ry * *(const f32x4*)(ng + DM + c)); }
        st_row_bf16((bf16*)(F.ws + WS_XL) + (size_t)row * DM, F.lane, x);
        const float rx = row_rstd(x);
        norm_mod(h, x, rx, ng + 2 * DM, mods_ptr(F, layer, row, 4), mods_ptr(F, layer, row, 3), F.lane);
        st_row_bf16((bf16*)(F.ws + WS_H) + (size_t)row * DM, F.lane, h);
        float lg[16];
#pragma unroll
        for (int e = 0; e < 16; ++e) lg[e] = 0.f;
#pragma unroll
        for (int j = 0; j < 8; ++j) {
            asm volatile("" ::: "memory");
#pragma unroll
            for (int i = 0; i < 4; ++i) { const float hv = h[j][i]; const int co = j * 16384 + i * 256;
                const f32x4 w0 = *(const LAS f32x4*)(wl0 + co), w1 = *(const LAS f32x4*)(wl1 + co), w2 = *(const LAS f32x4*)(wl2 + co), w3 = *(const LAS f32x4*)(wl3 + co);
                lg[0] += hv * w0.x; lg[1] += hv * w0.y; lg[2] += hv * w0.z; lg[3] += hv * w0.w; lg[4] += hv * w1.x; lg[5] += hv * w1.y; lg[6] += hv * w1.z; lg[7] += hv * w1.w;
                lg[8] += hv * w2.x; lg[9] += hv * w2.y; lg[10] += hv * w2.z; lg[11] += hv * w2.w; lg[12] += hv * w3.x; lg[13] += hv * w3.y; lg[14] += hv * w3.z; lg[15] += hv * w3.w; } }
        float r8[8], r4[4], r2[2], lgt;
        { const bool up = (F.lane & 32) != 0;
#pragma unroll
          for (int k = 0; k < 8; ++k) { const float keep = up ? lg[8 + k] : lg[k], give = up ? lg[k] : lg[8 + k]; r8[k] = keep + __shfl_xor(give, 32); } }
        { const bool up = (F.lane & 16) != 0;
#pragma unroll
          for (int k = 0; k < 4; ++k) { const float keep = up ? r8[4 + k] : r8[k], give = up ? r8[k] : r8[4 + k]; r4[k] = keep + __shfl_xor(give, 16); } }
        { const bool up = (F.lane & 8) != 0;
#pragma unroll
          for (int k = 0; k < 2; ++k) { const float keep = up ? r4[2 + k] : r4[k], give = up ? r4[k] : r4[2 + k]; r2[k] = keep + __shfl_xor(give, 8); } }
        { const bool up = (F.lane & 4) != 0; const float keep = up ? r2[1] : r2[0], give = up ? r2[0] : r2[1]; lgt = keep + __shfl_xor(give, 4); }
        lgt += __shfl_xor(lgt, 2); lgt += __shfl_xor(lgt, 1);
        float mx = lgt;
        mx = fmaxf(mx, __shfl_xor(mx, 4)); mx = fmaxf(mx, __shfl_xor(mx, 8)); mx = fmaxf(mx, __shfl_xor(mx, 16)); mx = fmaxf(mx, __shfl_xor(mx, 32));
        const float ex = __expf(lgt - mx);
        const float rs = 4.0f / wave_sum(ex);
        float* aff = (float*)(F.ws + WS_AFF) + (size_t)b * NEXP * SB + s;
        if ((F.lane & 3) == 0) aff[(size_t)(F.lane >> 2) * SB] = ex * rs;
    }
}
template <int VPT>
__device__ __forceinline__ void topk_problem(Frame& F, const float* vals, int N, int cap, int e, int rowbase, int slotbase, bool write_inv) {
    LAS int* hist = (LAS int*)F.lds;
    LAS int* wt = (LAS int*)(F.lds + 1024);
    LAS int* selw = (LAS int*)(F.lds + 1280);
    float v[VPT]; unsigned key[VPT];
#pragma unroll
    for (int k = 0; k < VPT; ++k) { const int i = F.tid * VPT + k; const bool ok = i < N; v[k] = ok ? vals[i] : 0.f; const unsigned u = __builtin_bit_cast(unsigned, v[k]);
        key[k] = ok ? ((u & 0x80000000u) ? ~u : (u | 0x80000000u)) : 0u; }
    unsigned prefix = 0u, maskb = 0u; int need = cap;
    for (int pass = 0; pass < 4; ++pass) {
        const int shift = 24 - 8 * pass;
        if (F.tid < 256) hist[F.tid] = 0;
        __syncthreads();
#pragma unroll
        for (int k = 0; k < VPT; ++k) { const int i = F.tid * VPT + k; if (i < N && (key[k] & maskb) == prefix) __hip_atomic_fetch_add(&hist[(key[k] >> shift) & 255u], 1, __ATOMIC_RELAXED, __HIP_MEMORY_SCOPE_WORKGROUP); }
        __syncthreads();
        if (F.wave == 0) {
            const int l = F.lane; const int h0 = hist[255 - 4 * l], h1 = hist[254 - 4 * l], h2 = hist[253 - 4 * l], h3 = hist[252 - 4 * l];
            const int sm = h0 + h1 + h2 + h3; const int incl = wave_incl_scan(sm, l); const int excl = incl - sm;
            const unsigned long long m = __ballot(incl >= need); const int fl = m ? (__ffsll((long long)m) - 1) : 63;
            if (l == fl) { int c = excl, bin;
                if (c + h0 >= need) bin = 255 - 4 * l; else { c += h0; if (c + h1 >= need) bin = 254 - 4 * l; else { c += h1; if (c + h2 >= need) bin = 253 - 4 * l; else { c += h2; bin = 252 - 4 * l; } } }
                selw[0] = bin; selw[1] = need - c; }
        }
        __syncthreads();
        prefix |= ((unsigned)selw[0]) << shift; maskb |= 0xFFu << shift; need = selw[1];
        __syncthreads();
    }
    int ceq = 0;
#pragma unroll
    for (int k = 0; k < VPT; ++k) { const int i = F.tid * VPT + k; if (i < N && key[k] == prefix) ++ceq; }
    int incl = wave_incl_scan(ceq, F.lane);
    if (F.lane == 63) wt[F.wave] = incl;
    __syncthreads();
    int eqbase = incl - ceq;
    for (int w = 0; w < F.wave; ++w) eqbase += wt[w];
    int csel = 0; bool sel[VPT];
#pragma unroll
    for (int k = 0; k < VPT; ++k) { const int i = F.tid * VPT + k; const bool ok = i < N; const bool eq = ok && key[k] == prefix;
        sel[k] = ok && (key[k] > prefix || (eq && eqbase < need)); if (eq) ++eqbase; if (sel[k]) ++csel; }
    incl = wave_incl_scan(csel, F.lane);
    if (F.lane == 63) wt[8 + F.wave] = incl;
    __syncthreads();
    int sbase = incl - csel;
    for (int w = 0; w < F.wave; ++w) sbase += wt[8 + w];
    int* RL = (int*)(F.ws + WS_RL) + e * EROWS; float* GT = (float*)(F.ws + WS_GATE) + e * EROWS; int* INV = (int*)(F.ws + WS_INV);
#pragma unroll
    for (int k = 0; k < VPT; ++k) { const int i = F.tid * VPT + k;
        if (i < N) { const int grow = rowbase + i;
            if (sel[k]) { const int slot = slotbase + sbase; ++sbase; RL[slot] = grow; GT[slot] = v[k]; if (write_inv) INV[grow * 16 + e] = slot; }
            else if (write_inv) INV[grow * 16 + e] = -1; } }
    __syncthreads();
}
__device__ __forceinline__ void t_topk(Frame& F, int layer) {
    const int nprob = layer == 0 ? 64 : 32;
    for (int p = blockIdx.x; p < nprob; p += F.G) {
        const int kind = p >> 5, q = p & 31, b = q >> 4, e = q & 15;
        const float* aff = (const float*)(F.ws + WS_AFF) + ((size_t)(b * NEXP + e)) * SB;
        if (kind == 0) topk_problem<8>(F, aff + CTXL, SEQ, CAP_L, e, b * SB + CTXL, b * CAP_L, true);
        else           topk_problem<1>(F, aff, CTXL, CAP_C, e, b * SB, 2 * CAP_L + b * CAP_C, true);
    }
}
__device__ __forceinline__ void t_post_moe(Frame& F, int layer, const float* norm_g, float* out) {
    const float* ng0 = norm_g + (size_t)layer * 4 * DM;
    const int* INV = (const int*)(F.ws + WS_INV); const float* GT = (const float*)(F.ws + WS_GATE);
    for (int row = F.gw; row < NROWS; row += F.NGW) {
        const int b = row / SB, s = row - b * SB;
        if (layer == 1 && s < CTXL) continue;
        const float* ng = fresh(ng0); const float* ng1 = fresh(norm_g + 4 * DM);
        f32x4 mo[8], x[8];
#pragma unroll
        for (int j = 0; j < 8; ++j) mo[j] = (f32x4){0.f, 0.f, 0.f, 0.f};
        const int invv = (F.lane < 16) ? INV[(size_t)row * 16 + F.lane] : -1;
        ld_row_bf16((const bf16*)(F.ws + WS_XL) + (size_t)row * DM, F.lane, x);
        unsigned long long em = __ballot(invv >= 0);
        while (em) {
            const int e0 = __builtin_ctzll(em); em &= em - 1;
            const bool two = em != 0; const int e1 = two ? __builtin_ctzll(em) : e0; if (two) em &= em - 1;
            const int s0 = __builtin_amdgcn_readlane(invv, e0), s1 = __builtin_amdgcn_readlane(invv, e1);
            const float g0 = GT[e0 * EROWS + s0], g1 = two ? GT[e1 * EROWS + s1] : 0.f;
            const bf16* y0 = (const bf16*)(F.ws + WS_YE) + ((size_t)(e0 * EROWS + s0)) * DM + 4 * F.lane;
            const bf16* y1 = (const bf16*)(F.ws + WS_YE) + ((size_t)(e1 * EROWS + s1)) * DM + 4 * F.lane;
            v2u w0[8], w1[8];
#pragma unroll
            for (int j = 0; j < 8; ++j) { w0[j] = *(const v2u*)(y0 + 256 * j); w1[j] = *(const v2u*)(y1 + 256 * j); }
#pragma unroll
            for (int j = 0; j < 8; ++j) { mo[j].x += g0 * bf_lo(w0[j].x); mo[j].y += g0 * bf_hi(w0[j].x); mo[j].z += g0 * bf_lo(w0[j].y); mo[j].w += g0 * bf_hi(w0[j].y); }
#pragma unroll
            for (int j = 0; j < 8; ++j) { mo[j].x += g1 * bf_lo(w1[j].x); mo[j].y += g1 * bf_hi(w1[j].x); mo[j].z += g1 * bf_lo(w1[j].y); mo[j].w += g1 * bf_hi(w1[j].y); }
            if (layer == 0 && F.G == 256) {
                const size_t d2 = WS_XG - WS_YE;
                if (e0 & 1) {
#pragma unroll
                    for (int j = 4; j < 8; ++j) if (j >= 5 || s0 >= 1024) { const v2u t = *(const v2u*)((const unsigned char*)(y0 + 256 * j) + d2);
                        mo[j].x += g0 * bf_lo(t.x); mo[j].y += g0 * bf_hi(t.x); mo[j].z += g0 * bf_lo(t.y); mo[j].w += g0 * bf_hi(t.y); } }
                if (two && (e1 & 1)) {
#pragma unroll
                    for (int j = 4; j < 8; ++j) if (j >= 5 || s1 >= 1024) { const v2u t = *(const v2u*)((const unsigned char*)(y1 + 256 * j) + d2);
                        mo[j].x += g1 * bf_lo(t.x); mo[j].y += g1 * bf_hi(t.x); mo[j].z += g1 * bf_lo(t.y); mo[j].w += g1 * bf_hi(t.y); } }
            }
        }
        const float rm = row_rstd(mo);
        const float* gf = mods_ptr(F, layer, row, 5);
#pragma unroll
        for (int j = 0; j < 8; ++j) { const int c = 4 * F.lane + 256 * j; x[j] = x[j] + *(const f32x4*)(gf + c) * (mo[j] * rm * *(const f32x4*)(ng + 3 * DM + c)); }
        if (layer == 0) {
            st_row_bf16((bf16*)(F.ws + WS_XL) + (size_t)row * DM, F.lane, x);
            f32x4 h[8]; const float rx = row_rstd(x);
            norm_mod(h, x, rx, ng1, mods_ptr(F, 1, row, 1), mods_ptr(F, 1, row, 0), F.lane);
            st_row_bf16((bf16*)(F.ws + WS_H) + (size_t)row * DM, F.lane, h);
        } else {
            float* op = out + ((size_t)(b * SEQ + s - CTXL)) * DM;
#pragma unroll
            for (int j = 0; j < 8; ++j) *(f32x4*)(op + 4 * F.lane + 256 * j) = x[j];
        }
    }
}

__device__ __forceinline__ void p_attn0(Frame& F, const float* ab_sink, const float* q_norm) {
    char* lds = (char*)F.lds;
    const bf16* QKV = (const bf16*)(F.ws + WS_QKV); bf16* Y = (bf16*)(F.ws + WS_Y);
    const int c = blockIdx.x;
    for (int r = 0; r < (544 + F.G - 1) / F.G; ++r) {
        int u = c + r * F.G;
        if (F.G == 256 && r == 2) { const int i5 = c >> 3, m = i5 & 15; if (m != 0 && m != 15) break; u = 512 + (c & 7) + 8 * ((i5 >> 4) * 2 + (m == 15 ? 1 : 0)); }
        else if (u >= 544) break;
        att::Job J; J.kb0 = CTXL; J.mask = 0; J.dq = 0; J.use_sink = 0; J.sink_l2 = 0.f; J.lam = 0.f;
        int b, h, grpB; size_t qrow;
        if (u < 512) {
            const int uu = u & 255, x = uu & 7, i = uu >> 3, grp = x >> 1, idx = (x & 1) * 32 + i;
            b = grp >> 1; const int kv = grp & 1; h = kv * 4 + (idx >> 4); const int qb = idx & 15; grpB = u < 256;
            qrow = (size_t)b * SB + CTXL + qb * 256;
            if (grpB) J.NT = 68;
            else { const int q0 = qb * 256, lo = q0 - 128 < 0 ? 0 : q0 - 128, hiK = q0 + 384 > SEQ ? SEQ : q0 + 384;
                   J.NT = 4 + (hiK - lo) / 64; J.kb0 = CTXL + lo; J.mask = 1; J.dq = lo - q0; }
        } else { const int uu = u - 512; grpB = uu >> 4; b = (uu >> 3) & 1; h = uu & 7; qrow = (size_t)b * SB; J.NT = 4; }
        const int kv = h >> 2;
        if (!grpB) { J.use_sink = 1; J.sink_l2 = ab_sink[h] * 1.4426950408889634f; }
        const int qcol = grpB ? 1536 + h * 128 : h * 128, kcol = grpB ? 2560 + kv * 128 : 1024 + kv * 128, vcol = grpB ? 2816 + kv * 128 : 1280 + kv * 128;
        J.Q = QKV + qrow * NQKV0 + qcol; J.K = QKV + (size_t)b * SB * NQKV0 + kcol; J.V = QKV + (size_t)b * SB * NQKV0 + vcol;
        J.O = (void*)(Y + qrow * DM + (grpB ? 1024 : 0) + h * 128);
        J.qmode = (grpB ? 1 : 0) | (u < 512 ? 2 : 0); J.t0 = u < 512 ? (int)(qrow - (size_t)b * SB - CTXL) : 0; J.qg = q_norm; J.rt = (const float*)(F.ws + WS_ROPE);
        __syncthreads();
        if (u < 256) att::attn_unit128p<NQKV0, false>(J, lds);
        else att::attn_unit128p<NQKV0, true>(J, lds);
    }
}
__device__ __forceinline__ void p_attn1(Frame& F, const float* dif_lambda, const float* dif_subln) {
    char* lds = (char*)F.lds;
    const bf16* QKV = (const bf16*)(F.ws + WS_QKV);
    const float* lp = dif_lambda;
    const float s01 = wave_sum(lp[F.lane] * lp[128 + F.lane] + lp[64 + F.lane] * lp[192 + F.lane]);
    const float s23 = wave_sum(lp[256 + F.lane] * lp[384 + F.lane] + lp[320 + F.lane] * lp[448 + F.lane]);
    const float lam = __uint_as_float(__builtin_amdgcn_readfirstlane(__float_as_uint(__expf(s01) - __expf(s23) + LAMBDA_INIT)));
    for (int pidx = blockIdx.x; pidx < 256; pidx += F.G) {
        const int x = pidx & 7, i = pidx >> 3;
        const int b = x >> 2, hp = x & 3, h = hp * 2 + (i >> 4), qb = i & 15;
        const size_t qrow = (size_t)b * SB + CTXL + qb * 256;
        att::Job256 J; J.NT = 68; J.t0 = qb * 256; J.rt = (const float*)(F.ws + WS_ROPE);
        J.V = QKV + (size_t)b * SB * NQKV1 + 4096 + h * 256;
        J.O0 = (const bf16*)(F.ws + WS_YO) + qrow * DM + h * 256; J.lam = lam; J.sc = 1.0f - LAMBDA_INIT; J.g = dif_subln;
        J.Q = QKV + qrow * NQKV1 + (2 * h) * 128; J.K = QKV + (size_t)b * SB * NQKV1 + 2048 + (2 * h) * 128;
        J.O = (bf16*)(F.ws + WS_YO) + qrow * DM + h * 256;
        __syncthreads();
        att::attn_unit256s<NQKV1, 0>(J, lds);
        J.Q += 128; J.K += 128;
        J.O = (bf16*)(F.ws + WS_Y) + qrow * DM + h * 256;
        __syncthreads();
        att::attn_unit256s<NQKV1, 1>(J, lds);
    }
}

#define IN(k) (lo <= (k) && (k) < hi)
#define SEAM(k) do { if (IN((k) + 1)) xcd_barrier(bar); } while (0)
#define INP(k) ({ int k_ = (k); asm volatile("" : "+s"(k_)); (const float*)(const __attribute__((address_space(1))) float*)args.in[k_]; })
#ifndef PROBE_MASK
#define PROBE_MASK 0
#endif
#if defined(PROBE_WAIT)
#define STAMP(k) do { if (blockIdx.x == 0 && F.tid == 0) { volatile unsigned long long* tm_ = (volatile unsigned long long*)(F.ws + WS_CTL + 2048); const unsigned long long now_ = __builtin_amdgcn_s_memrealtime(); \
    if (tm_[2]) tm_[1] += now_ - tm_[0]; tm_[0] = now_; tm_[2] = (((unsigned long long)(PROBE_WAIT) >> (k)) & 1ull); } } while (0)
#else
#define STAMP(k) do { } while (0)
#endif
#define PROBED(k) ((k) >= 0 && ((PROBE_MASK >> ((k) < 0 ? 0 : (k))) & 1))
#define REP2(k, ...) do { __VA_ARGS__; if constexpr (PROBED(k)) { __syncthreads(); __VA_ARGS__; } } while (0)
#define REP(k) for (int rep_ = 0; rep_ < (((k) >= 0 && ((PROBE_MASK >> ((k) < 0 ? 0 : (k))) & 1)) ? 2 : 1); ++rep_, __syncthreads())
#define FRESH() do { asm volatile("" : "+s"(F.ws)); int t_ = threadIdx.x; asm volatile("" : "+v"(t_)); F.tid = t_; F.lane = t_ & 63; F.wave = __builtin_amdgcn_readfirstlane(t_ >> 6); \
    F.gw = blockIdx.x * NWAVES + F.wave; } while (0)
template <int layer>
__device__ __forceinline__ void layer_phases(Frame& F, const Args& args, const int lo, const int hi, const XcdBarrier& bar) {

        const int pb = 2 + 11 * layer;
        if (IN(pb + 0)) {
            FRESH(); STAMP(pb + 0);
            pg8::Gemm g{(const pg8::bf16_t*)(F.ws + WS_H), (const pg8::bf16_t*)(F.ws + (layer == 0 ? WS_WIN0 : WS_WIN1)), DM, layer == 0 ? NQKV0 : NQKV1, DM};
            pg8::DenseOrder S; S.init(NROWS / 256, (layer == 0 ? NQKV0 : NQKV1) / 256, F.G, (int)blockIdx.x, 0);
            pg8::EpiStoreBf16 E{(pg8::bf16_t*)(F.ws + WS_QKV), layer == 0 ? NQKV0 : NQKV1, 1 << 20};
            pg8::gemm_phase<pg8::EpiStoreBf16, pg8::DenseOrder, true, true>(F.lds, g, S, E);
            if (layer == 0) {
                const int nU = (NROWS / 256) * (NQKV0 / 256), first_idle = nU - F.G;
                int vc = (int)blockIdx.x, NV = F.G;
                if (first_idle > 0 && first_idle < F.G) { vc -= first_idle; NV -= first_idle; }
                if (vc >= 0) { __syncthreads(); setup_part(F, 1, vc, NV, 1, INP(1), INP(3), INP(4), INP(5), INP(12), INP(13), 0, 128);
                               __syncthreads(); setup_part(F, 0, vc, NV, 2 | 8, INP(1), INP(3), INP(4), INP(5), INP(7), INP(8)); }
            } else {
                const int nU = (NROWS / 256) * (NQKV1 / 256), rem = nU % F.G;
                const int vc = (int)blockIdx.x - rem, NV = F.G - rem;
                if (rem > 0 && vc >= 0) { __syncthreads(); setup_part(F, 1, vc, NV, 1, INP(1), INP(3), INP(4), INP(5), INP(12), INP(13), 128, 384);
                                          __syncthreads(); setup_part(F, 1, vc, NV, 2 | 8, INP(1), INP(3), INP(4), INP(5), INP(12), INP(13)); }
            }
            SEAM(pb + 0);
        }
        if (IN(pb + 1)) { FRESH(); STAMP(pb + 1); t_prep(F, layer, INP(10), INP(11)); SEAM(pb + 1); }
        if (IN(pb + 2)) { FRESH(); STAMP(pb + 2); REP(pb + 2) { if (layer == 0) p_attn0(F, INP(9), INP(10)); else p_attn1(F, INP(14), INP(15)); } SEAM(pb + 2); }
        if (IN(pb + 4)) {
            FRESH(); STAMP(pb + 4);
            pg8::Gemm g{(const pg8::bf16_t*)(F.ws + WS_Y), (const pg8::bf16_t*)(F.ws + (layer == 0 ? WS_WOUT0 : WS_WOUT1)), DM, DM, DM};
            pg8::DenseOrder S; S.init(layer == 0 ? 34 : 32, DM / 256, F.G, (int)blockIdx.x, layer);
            pg8::EpiStoreBf16 E{(pg8::bf16_t*)(F.ws + WS_YO), DM, 1 << 20};
            pg8::gemm_phase<pg8::EpiStoreBf16, pg8::DenseOrder, true, true>(F.lds, g, S, E);
            if (layer == 0) {
                const int first_idle = 34 * (DM / 256) - F.G;
                int vc = (int)blockIdx.x, NV = F.G;
                if (first_idle > 0 && first_idle < F.G) { vc -= first_idle; NV -= first_idle; }
                if (vc >= 0) { __syncthreads(); setup_part(F, 0, vc, NV, 1, INP(1), INP(3), INP(4), INP(5), INP(7), INP(8), 128, 384);
                               __syncthreads(); setup_part(F, 1, vc, NV, 2 | 4, INP(1), INP(3), INP(4), INP(5), INP(12), INP(13)); }
            }
            SEAM(pb + 4);
        }
        if (IN(pb + 5)) { FRESH(); STAMP(pb + 5); REP(layer == 0 ? pb + 5 : -2) t_post_attn(F, layer, INP(0), INP(2), INP(6), INP(16)); SEAM(pb + 5); }
        if (IN(pb + 6)) { FRESH(); STAMP(pb + 6); REP(pb + 6) t_topk(F, layer); SEAM(pb + 6); }
        if (IN(pb + 8)) {
            FRESH(); STAMP(pb + 8);
            pg8::BMoeGU Bm{INP(17) + (size_t)layer * 16 * DM * DM, INP(18) + (size_t)layer * 16 * DM * DM};
            pg8::MoeOrder S; S.init(layer == 0 ? 5 : 4, 16, F.G, (int)blockIdx.x);
            pg8::EpiSwiGLU E{(pg8::bf16_t*)(F.ws + WS_HM), DM};
            REP2(pb + 8, pg8::gemm_phase_w<pg8::EpiSwiGLU, pg8::MoeOrder, pg8::BMoeGU, true>(F.lds, (const pg8::bf16_t*)(F.ws + WS_H), DM, Bm, S, E, (const int*)(F.ws + WS_RL), layer == 0 ? 1088 : 1024));
            SEAM(pb + 8);
        }
        if (IN(pb + 9)) {
            FRESH(); STAMP(pb + 9);
            pg8::BMoeDn Bm{INP(19) + (size_t)layer * 16 * DM * DM};
            pg8::MoeOrder S; S.init(layer == 0 ? 5 : 4, 8, F.G, (int)blockIdx.x);
            pg8::EpiStoreBf16 E{(pg8::bf16_t*)(F.ws + WS_YE), DM, 8};
            if (layer == 0 && F.G == 256) S.lim = 512;
            pg8::gemm_phase_w<pg8::EpiStoreBf16, pg8::MoeOrder, pg8::BMoeDn>(F.lds, (const pg8::bf16_t*)(F.ws + WS_HM), DM, Bm, S, E);
            if (layer == 0) { if (F.G == 256) {
                __syncthreads(); FRESH();
                int bx_ = (int)blockIdx.x; asm volatile("" : "+s"(bx_));
                pg8::MoeOrderTail T{bx_};
                pg8::EpiStoreBf16K E2{(pg8::bf16_t*)(F.ws + WS_YE), ((long)WS_XG - (long)WS_YE) / 2, DM, 8};
                pg8::gemm_phase_w<pg8::EpiStoreBf16K, pg8::MoeOrderTail, pg8::BMoeDn, false, true, true>(F.lds, (const pg8::bf16_t*)(F.ws + WS_HM), DM / 2, Bm, T, E2, nullptr, 0, DM); } }
            SEAM(pb + 9);
        }
        if (IN(pb + 10)) { FRESH(); STAMP(pb + 10); REP(layer == 1 ? pb + 10 : -2) t_post_moe(F, layer, INP(6), args.out); SEAM(pb + 10); }
}
constexpr int NPHASE = 24;
__global__ void __launch_bounds__(NWAVES * 64, 2) fwd(Args args) {
    extern __shared__ __attribute__((aligned(16))) unsigned char lds[];
    Frame F;
    F.lds = (LAS unsigned char*)lds;
    F.tid = threadIdx.x; F.lane = F.tid & 63; F.wave = __builtin_amdgcn_readfirstlane(F.tid >> 6);
    F.G = gridDim.x; F.gw = blockIdx.x * NWAVES + F.wave; F.NGW = F.G * NWAVES;
    F.ws = (__attribute__((address_space(1))) unsigned char*)args.ws;
    const int lo = args.ph_lo, hi = args.ph_hi;
    const bool multi = (hi - lo) > 1;
    XcdBarrier bar; bar.bar = (unsigned*)(F.ws + WS_CTL) + CW_BAR; bar.x = 0; bar.st = nullptr;
    if (multi) bar = xcd_barrier_post((unsigned*)(F.ws + WS_CTL) + CW_BAR, (unsigned*)(F.ws + WS_CTL) + CW_BST + 16 * blockIdx.x);

    if (IN(0)) { FRESH(); STAMP(0); REP(0) p0_prologue(F, INP(1), INP(3), INP(4), INP(5), INP(7), INP(8)); SEAM(0); }
    if (IN(1)) { FRESH(); STAMP(1); REP(1) t_norm0(F, INP(0), INP(2), INP(6)); SEAM(1); }
    layer_phases<0>(F, args, lo, hi, bar);
    layer_phases<1>(F, args, lo, hi, bar);
#if defined(PROBE_WAIT)
    if (multi) { STAMP(63);
        if (blockIdx.x == 0 && F.tid == 0) { volatile unsigned long long* tm_ = (volatile unsigned long long*)(F.ws + WS_CTL + 2048); const unsigned long long t0_ = __builtin_amdgcn_s_memrealtime(), w_ = tm_[1];
            while (__builtin_amdgcn_s_memrealtime() - t0_ < w_) __builtin_amdgcn_s_sleep(4); }
        xcd_barrier(bar); }
#endif
}

extern "C" void kernel_launch(void* const* d_in, const int* in_sizes, int n_in, void* d_out, int out_size, void* d_ws, size_t ws_size, hipStream_t stream) {
    static int grid = 0;
    if (grid == 0) {
        if (n_in != 20 || out_size != NBATCH * SEQ * DM || ws_size < WS_END) { fprintf(stderr, "kernel_launch: shape mismatch (n_in %d out %d ws %zu need %zu)\n", n_in, out_size, ws_size, (size_t)WS_END); grid = -1; return; }
        int dev = 0, cus = 0, per_cu = 0;
        if (hipGetDevice(&dev) != hipSuccess || hipDeviceGetAttribute(&cus, hipDeviceAttributeMultiprocessorCount, dev) != hipSuccess) { grid = -1; return; }
        if (hipFuncSetAttribute((const void*)fwd, hipFuncAttributeMaxDynamicSharedMemorySize, LDS_BYTES) != hipSuccess) { fprintf(stderr, "kernel_launch: hipFuncSetAttribute failed\n"); grid = -1; return; }
        if (hipOccupancyMaxActiveBlocksPerMultiprocessor(&per_cu, (const void*)fwd, NWAVES * 64, LDS_BYTES) != hipSuccess || per_cu < 1)
            fprintf(stderr, "kernel_launch: note: occupancy query reports %d workgroups per CU\n", per_cu);
        (void)hipGetLastError();
        grid = cus;
    }
    if (grid < 0) return;
    if (hipMemsetAsync((char*)d_ws + WS_CTL, 0, CTL_ZERO_BYTES, stream) != hipSuccess) return;
    Args a{};
    for (int i = 0; i < 20; ++i) a.in[i] = (const float*)d_in[i];
    a.out = (float*)d_out; a.ws = (unsigned char*)d_ws;
#if MK_ONE_LAUNCH
    a.ph_lo = 0; a.ph_hi = NPHASE;
    hipLaunchKernelGGL(fwd, dim3(grid), dim3(NWAVES * 64), LDS_BYTES, stream, a);
#if defined(PROBE_EXTRA)
    { const int extra[] = {PROBE_EXTRA}; for (int ph : extra) { a.ph_lo = ph; a.ph_hi = ph + 1; hipLaunchKernelGGL(fwd, dim3(grid), dim3(NWAVES * 64), LDS_BYTES, stream, a); } }
#endif
#else
    for (int ph = 0; ph < NPHASE; ++ph) {
        if (ph == 5) continue;
        a.ph_lo = ph; a.ph_hi = ph + 1;
        hipLaunchKernelGGL(fwd, dim3(grid), dim3(NWAVES * 64), LDS_BYTES, stream, a);
    }
#endif
    const hipError_t le = hipPeekAtLastError();
    if (le != hipSuccess) fprintf(stderr, "kernel_launch: launch failed: %s\n", hipGetErrorName(le));
}
```
